# Optimizing an MI355X kernel written in HIP

```python
import math
import jax, jax.numpy as jnp
from jax import lax
import numpy as np

D_MODEL = 1024
BATCH = 8
SEQ = 2048
DEPTH = 2
DEC_BATCH = 128
DEC_SEQ = 4
PAST_LEN = 16384
PAGE_SIZE = 128

N_MIXERS = 2
N_SSM_LAYERS = (DEPTH + 1) // 2
N_CONV_LAYERS = DEPTH // 2
SSM_GROUP = 16
SSM_GROUPS = D_MODEL // SSM_GROUP
SSM_STATE = 64
SSM_DT_MIN = 1e-3
SSM_DT_MAX = 1e-1
CONV_WIDTH = 3
MEM_TOKENS = 256
MEM_HEADS = 4
MEM_HEAD_DIM = D_MODEL // MEM_HEADS
PEER_HEADS = 8
PEER_KEYS = 128
PEER_EXPERTS = PEER_KEYS * PEER_KEYS
PEER_TOPK = 16
PEER_QUERY_DIM = 256
PEER_HALF = PEER_QUERY_DIM // 2
PEER_BLOCK = 256
RMS_EPS = 1e-6

kernel_name = 'hybrid_s5_shortconv_peer_memxattn_step'


def rmsnorm(x, g):
    xf = x.astype(jnp.float32)
    r = lax.rsqrt(jnp.mean(xf * xf, axis=-1, keepdims=True) + RMS_EPS)
    return (xf * r).astype(x.dtype) * g


def _cmul_combine(e1, e2):
    ar1, ai1, br1, bi1 = e1
    ar2, ai2, br2, bi2 = e2
    return (ar1 * ar2 - ai1 * ai2,
            ar1 * ai2 + ai1 * ar2,
            ar2 * br1 - ai2 * bi1 + br2,
            ar2 * bi1 + ai2 * br1 + bi2)


def s5_mixer(h, s0_re, s0_im, a_re, a_im, log_dt, b_re, b_im, c_re, c_im, d_skip, w_glu):
    f32 = jnp.float32
    bsz, s, _ = h.shape
    a_re = a_re.astype(f32)
    a_im = a_im.astype(f32)
    dt = jnp.exp(log_dt.astype(f32))[:, None]
    mag = jnp.exp(a_re * dt)
    ang = a_im * dt
    lb_re = mag * jnp.cos(ang)
    lb_im = mag * jnp.sin(ang)
    den = a_re * a_re + a_im * a_im
    f_re = ((lb_re - 1.0) * a_re + lb_im * a_im) / den
    f_im = (lb_im * a_re - (lb_re - 1.0) * a_im) / den
    b_re = b_re.astype(f32)
    b_im = b_im.astype(f32)
    bb_re = f_re[..., None] * b_re - f_im[..., None] * b_im
    bb_im = f_re[..., None] * b_im + f_im[..., None] * b_re
    u = h.astype(f32).reshape(bsz, s, SSM_GROUPS, SSM_GROUP)
    bu_re = jnp.einsum('bsgc,gpc->bsgp', u, bb_re)
    bu_im = jnp.einsum('bsgc,gpc->bsgp', u, bb_im)
    s0_re = s0_re.astype(f32)
    s0_im = s0_im.astype(f32)
    bu_re = bu_re.at[:, 0].add(lb_re * s0_re - lb_im * s0_im)
    bu_im = bu_im.at[:, 0].add(lb_re * s0_im + lb_im * s0_re)
    a_full_re = jnp.broadcast_to(lb_re, bu_re.shape)
    a_full_im = jnp.broadcast_to(lb_im, bu_im.shape)
    _, _, st_re, st_im = lax.associative_scan(
        _cmul_combine, (a_full_re, a_full_im, bu_re, bu_im), axis=1)
    c_re = c_re.astype(f32)
    c_im = c_im.astype(f32)
    y = (jnp.einsum('bsgp,gcp->bsgc', st_re, c_re)
         - jnp.einsum('bsgp,gcp->bsgc', st_im, c_im)).reshape(bsz, s, D_MODEL)
    y = y + d_skip.astype(f32) * h.astype(f32)
    z = jax.nn.gelu(y, approximate=False).astype(h.dtype)
    g_a, g_b = jnp.split(z @ w_glu, 2, axis=-1)
    return g_a * jax.nn.sigmoid(g_b), st_re[:, -1], st_im[:, -1]


def short_conv_mixer(h, buf, w_in, w_conv, w_out):
    s = h.shape[1]
    b_gate, c_gate, hv = jnp.split(h @ w_in, 3, axis=-1)
    v = c_gate * hv
    vp = jnp.concatenate([buf.astype(v.dtype), v], axis=1)
    conv = w_conv[0] * vp[:, 0:s]
    for k in range(1, CONV_WIDTH):
        conv = conv + w_conv[k] * vp[:, k:k + s]
    out = (b_gate * conv) @ w_out
    return out, vp[:, -(CONV_WIDTH - 1):]


def memory_kv(mem, w_k, w_v):
    bsz = mem.shape[0]
    k = jnp.einsum('bmd,ldf->lbmf', mem, w_k).reshape(DEPTH, bsz, MEM_TOKENS, MEM_HEADS, MEM_HEAD_DIM)
    v = jnp.einsum('bmd,ldf->lbmf', mem, w_v).reshape(DEPTH, bsz, MEM_TOKENS, MEM_HEADS, MEM_HEAD_DIM)
    return k, v


def memory_attention(h, mem_k, mem_v, w_q, w_o):
    bsz, s, _ = h.shape
    q = (h @ w_q).reshape(bsz, s, MEM_HEADS, MEM_HEAD_DIM)
    sc = jnp.einsum('bshd,bmhd->bhsm', q, mem_k).astype(jnp.float32) * (MEM_HEAD_DIM ** -0.5)
    p = jax.nn.softmax(sc, axis=-1).astype(h.dtype)
    o = jnp.einsum('bhsm,bmhd->bshd', p, mem_v).reshape(bsz, s, D_MODEL)
    return o @ w_o


def peer_ffn(h, w_query, key1, key2, u_tab, v_tab):
    bsz, s, d = h.shape
    t = bsz * s
    nb = -(-t // PEER_BLOCK)
    flat = jnp.pad(h.reshape(t, d), ((0, nb * PEER_BLOCK - t), (0, 0)))

    def block(hb):
        q = (hb @ w_query).reshape(PEER_BLOCK, PEER_HEADS, 2, PEER_HALF)
        s1 = jnp.einsum('thk,nk->thn', q[:, :, 0], key1)
        s2 = jnp.einsum('thk,nk->thn', q[:, :, 1], key2)
        v1, i1 = lax.top_k(s1, PEER_TOPK)
        v2, i2 = lax.top_k(s2, PEER_TOPK)
        cand = (v1[..., :, None] + v2[..., None, :]).reshape(PEER_BLOCK, PEER_HEADS, PEER_TOPK * PEER_TOPK)
        sc, ci = lax.top_k(cand, PEER_TOPK)
        e = (jnp.take_along_axis(i1, ci // PEER_TOPK, axis=-1) * PEER_KEYS
             + jnp.take_along_axis(i2, ci % PEER_TOPK, axis=-1))
        g = jax.nn.softmax(sc.astype(jnp.float32), axis=-1).astype(hb.dtype)
        act = jax.nn.gelu(jnp.einsum('thkd,td->thk', u_tab[e], hb), approximate=False)
        return jnp.einsum('thk,thkd->td', g * act, v_tab[e])

    out = lax.map(block, flat.reshape(nb, PEER_BLOCK, d))
    return out.reshape(nb * PEER_BLOCK, d)[:t].reshape(bsz, s, d)


def trunk(x, ssm_re0, ssm_im0, conv0, mem_k, mem_v, weights):
    (norm_mix, norm_mem, norm_ffn, norm_final,
     ssm_a_re, ssm_a_im, ssm_log_dt, ssm_b_re, ssm_b_im, ssm_c_re, ssm_c_im, ssm_d, ssm_w_glu,
     conv_w_in, conv_w, conv_w_out,
     mem_w_q, mem_w_o,
     peer_w_query, peer_key1, peer_key2, peer_u, peer_v) = weights
    ssm_re_out, ssm_im_out, conv_out = [], [], []
    for i in range(DEPTH):
        j = i // N_MIXERS
        h = rmsnorm(x, norm_mix[i])
        if i % N_MIXERS == 0:
            out, sr, si = s5_mixer(h, ssm_re0[j], ssm_im0[j], ssm_a_re[j], ssm_a_im[j], ssm_log_dt[j],
                                   ssm_b_re[j], ssm_b_im[j], ssm_c_re[j], ssm_c_im[j], ssm_d[j], ssm_w_glu[j])
            ssm_re_out.append(sr)
            ssm_im_out.append(si)
        else:
            out, cb = short_conv_mixer(h, conv0[j], conv_w_in[j], conv_w[j], conv_w_out[j])
            conv_out.append(cb)
        x = x + out
        x = x + memory_attention(rmsnorm(x, norm_mem[i]), mem_k[i], mem_v[i], mem_w_q[i], mem_w_o[i])
        x = x + peer_ffn(rmsnorm(x, norm_ffn[i]), peer_w_query[i], peer_key1[i], peer_key2[i],
                         peer_u[i], peer_v[i])
    y = rmsnorm(x, norm_final)
    return y, jnp.stack(ssm_re_out), jnp.stack(ssm_im_out), jnp.stack(conv_out)


def setup_inputs(seed: int = 0) -> dict:
    key = jax.random.key(seed)
    ks = jax.random.split(key, 40)
    f32 = jnp.float32
    nrm = lambda i, shape, scale: jax.random.normal(ks[i], shape, f32) * scale
    inp = {}
    inp['x_prompt'] = nrm(0, (BATCH, SEQ, D_MODEL), 1.0)
    inp['x_sample'] = nrm(1, (DEC_BATCH, DEC_SEQ, D_MODEL), 1.0)
    inp['mem_prompt'] = nrm(2, (BATCH, MEM_TOKENS, D_MODEL), 1.0)
    inp['state_ssm_re'] = nrm(3, (N_SSM_LAYERS, DEC_BATCH, SSM_GROUPS, SSM_STATE), 0.1)
    inp['state_ssm_im'] = nrm(4, (N_SSM_LAYERS, DEC_BATCH, SSM_GROUPS, SSM_STATE), 0.1)
    inp['state_conv'] = nrm(5, (N_CONV_LAYERS, DEC_BATCH, CONV_WIDTH - 1, D_MODEL), 1.0)
    inp['cache_mem_k'] = nrm(6, (DEPTH, DEC_BATCH, MEM_TOKENS, MEM_HEADS, MEM_HEAD_DIM), 1.0)
    inp['cache_mem_v'] = nrm(7, (DEPTH, DEC_BATCH, MEM_TOKENS, MEM_HEADS, MEM_HEAD_DIM), 1.0)
    inp['norm_mix'] = 1.0 + nrm(8, (DEPTH, D_MODEL), 0.01)
    inp['norm_mem'] = 1.0 + nrm(9, (DEPTH, D_MODEL), 0.01)
    inp['norm_ffn'] = 1.0 + nrm(10, (DEPTH, D_MODEL), 0.01)
    inp['norm_final'] = 1.0 + nrm(11, (D_MODEL,), 0.01)
    inp['ssm_a_re'] = -0.5 + nrm(12, (N_SSM_LAYERS, SSM_GROUPS, SSM_STATE), 0.01)
    inp['ssm_a_im'] = jnp.pi * jnp.arange(SSM_STATE, dtype=f32) + nrm(13, (N_SSM_LAYERS, SSM_GROUPS, SSM_STATE), 0.01)
    inp['ssm_log_dt'] = jax.random.uniform(ks[14], (N_SSM_LAYERS, SSM_GROUPS), f32,
                                           math.log(SSM_DT_MIN), math.log(SSM_DT_MAX))
    inp['ssm_b_re'] = nrm(15, (N_SSM_LAYERS, SSM_GROUPS, SSM_STATE, SSM_GROUP), (2 * SSM_GROUP) ** -0.5)
    inp['ssm_b_im'] = nrm(16, (N_SSM_LAYERS, SSM_GROUPS, SSM_STATE, SSM_GROUP), (2 * SSM_GROUP) ** -0.5)
    inp['ssm_c_re'] = nrm(17, (N_SSM_LAYERS, SSM_GROUPS, SSM_GROUP, SSM_STATE), SSM_STATE ** -0.5)
    inp['ssm_c_im'] = nrm(18, (N_SSM_LAYERS, SSM_GROUPS, SSM_GROUP, SSM_STATE), SSM_STATE ** -0.5)
    inp['ssm_d'] = nrm(19, (N_SSM_LAYERS, D_MODEL), 1.0)
    inp['ssm_w_glu'] = nrm(20, (N_SSM_LAYERS, D_MODEL, 2 * D_MODEL), D_MODEL ** -0.5)
    inp['conv_w_in'] = nrm(21, (N_CONV_LAYERS, D_MODEL, 3 * D_MODEL), D_MODEL ** -0.5)
    inp['conv_w'] = nrm(22, (N_CONV_LAYERS, CONV_WIDTH, D_MODEL), CONV_WIDTH ** -0.5)
    inp['conv_w_out'] = nrm(23, (N_CONV_LAYERS, D_MODEL, D_MODEL), D_MODEL ** -0.5)
    inp['mem_w_q'] = nrm(24, (DEPTH, D_MODEL, D_MODEL), D_MODEL ** -0.5)
    inp['mem_w_k'] = nrm(25, (DEPTH, D_MODEL, D_MODEL), D_MODEL ** -0.5)
    inp['mem_w_v'] = nrm(26, (DEPTH, D_MODEL, D_MODEL), D_MODEL ** -0.5)
    inp['mem_w_o'] = nrm(27, (DEPTH, D_MODEL, D_MODEL), D_MODEL ** -0.5)
    inp['peer_w_query'] = nrm(28, (DEPTH, D_MODEL, PEER_HEADS * PEER_QUERY_DIM), D_MODEL ** -0.5)
    inp['peer_key1'] = nrm(29, (DEPTH, PEER_KEYS, PEER_HALF), PEER_HALF ** -0.5)
    inp['peer_key2'] = nrm(30, (DEPTH, PEER_KEYS, PEER_HALF), PEER_HALF ** -0.5)
    inp['peer_u'] = nrm(31, (DEPTH, PEER_EXPERTS, D_MODEL), D_MODEL ** -0.5)
    inp['peer_v'] = nrm(32, (DEPTH, PEER_EXPERTS, D_MODEL), (PEER_HEADS * PEER_TOPK) ** -0.5)
    return inp


def reference(x_prompt, x_sample, mem_prompt, state_ssm_re, state_ssm_im, state_conv,
              cache_mem_k, cache_mem_v,
              norm_mix, norm_mem, norm_ffn, norm_final,
              ssm_a_re, ssm_a_im, ssm_log_dt, ssm_b_re, ssm_b_im, ssm_c_re, ssm_c_im, ssm_d, ssm_w_glu,
              conv_w_in, conv_w, conv_w_out,
              mem_w_q, mem_w_k, mem_w_v, mem_w_o,
              peer_w_query, peer_key1, peer_key2, peer_u, peer_v):
    weights = (norm_mix, norm_mem, norm_ffn, norm_final,
               ssm_a_re, ssm_a_im, ssm_log_dt, ssm_b_re, ssm_b_im, ssm_c_re, ssm_c_im, ssm_d, ssm_w_glu,
               conv_w_in, conv_w, conv_w_out,
               mem_w_q, mem_w_o,
               peer_w_query, peer_key1, peer_key2, peer_u, peer_v)
    bsz = x_prompt.shape[0]
    zero_re = jnp.zeros((N_SSM_LAYERS, bsz, SSM_GROUPS, SSM_STATE), jnp.float32)
    zero_im = jnp.zeros((N_SSM_LAYERS, bsz, SSM_GROUPS, SSM_STATE), jnp.float32)
    zero_conv = jnp.zeros((N_CONV_LAYERS, bsz, CONV_WIDTH - 1, D_MODEL), x_prompt.dtype)
    mem_k_prompt, mem_v_prompt = memory_kv(mem_prompt, mem_w_k, mem_w_v)
    y_prompt, ssm_re_prompt, ssm_im_prompt, conv_prompt = trunk(
        x_prompt, zero_re, zero_im, zero_conv, mem_k_prompt, mem_v_prompt, weights)
    y_sample, ssm_re_sample, ssm_im_sample, conv_sample = trunk(
        x_sample, state_ssm_re, state_ssm_im, state_conv, cache_mem_k, cache_mem_v, weights)
    return (y_prompt, y_sample, ssm_re_prompt, ssm_im_prompt, conv_prompt, mem_k_prompt, mem_v_prompt,
            ssm_re_sample, ssm_im_sample, conv_sample)
```

```cpp
#include <hip/hip_runtime.h>
#include <cstdio>
#include <cstdint>
namespace pg8 {
#define PG8_LAS __attribute__((address_space(3)))
typedef unsigned short bf16_t;
typedef short bf16x8 __attribute__((ext_vector_type(8)));
typedef float f32x4 __attribute__((ext_vector_type(4)));
typedef unsigned u32x4 __attribute__((ext_vector_type(4)));
constexpr int BM = 256, BK = 64, HALF = 128, HTB = HALF * BK * 2  , STAGE_BYTES = 8 * HTB, NXCD = 8, WGM = 8;

__host__ __device__ __forceinline__ int lds_byte(int r, int c) { const int st = (r >> 4) * 2 + (c >> 5), rr = r & 15, cc = c & 31, ob = rr * 64 + cc * 2; return st * 1024 + (ob ^ (((ob >> 9) & 1) << 5)); }
__host__ __device__ __forceinline__ void stage_rc(int b, int& R, int& C) { const int st = b / 1024, sb = b % 1024, swz = sb ^ (((sb >> 9) & 1) << 5); R = (st >> 1) * 16 + swz / 64; C = (st & 1) * 32 + (swz % 64) / 2; }
__host__ __device__ __forceinline__ int perm32(int rho) { const int n = rho >> 4, i = rho & 15; return 8 * (i >> 2) + 4 * n + (i & 3); }

__device__ __forceinline__ const char* pg8_uni(const char* p) { asm volatile("" : "+s"(p)); return p; }
__device__ __forceinline__ unsigned pg8_vo(unsigned v) { asm volatile("" : "+v"(v)); return v; }
struct Unit { int pm, pn; };
struct Gemm { const bf16_t* A; const bf16_t* Bt; int M, N, K; };

struct StaticOrder {
    int nM, nN, nwg, G, c;
    __host__ __device__ void init(int M, int N, int G_, int c_) { nM = M / BM; nN = N / BM; nwg = nM * nN; G = G_; c = c_; }
    __host__ __device__ bool next(int i, Unit& u) const {
        const long L = (long)i * G + c; if (L >= nwg) return false;
        int wgid = (int)L; { const int q = nwg / NXCD, r = nwg % NXCD, xcd = wgid % NXCD, off = wgid / NXCD; wgid = (xcd < r ? xcd * (q + 1) : r * (q + 1) + (xcd - r) * q) + off; }
        const int nig = WGM * nN, gid = wgid / nig, fm = gid * WGM, gsz = (nM - fm) < WGM ? (nM - fm) : WGM;
        u.pm = fm + ((wgid % nig) % gsz); u.pn = (wgid % nig) / gsz; return true;
    }
    __device__ __forceinline__ void a_ready(const Unit&) const {}
    __device__ __forceinline__ void done(const Unit&) const {}
};

__device__ __forceinline__ unsigned cvt_pk_bf16(float lo, float hi) { unsigned r; asm volatile("v_cvt_pk_bf16_f32 %0, %1, %2" : "=v"(r) : "v"(lo), "v"(hi)); return r; }
typedef float f32x2 __attribute__((ext_vector_type(2)));
__device__ __forceinline__ f32x2 gelu_pk(f32x2 v) {
    const f32x2 av = __builtin_elementwise_abs(v), d = av * 0.2316418882f + 1.0f;
    f32x2 t; t.x = __builtin_amdgcn_rcpf(d.x); t.y = __builtin_amdgcn_rcpf(d.y);
    f32x2 q = t * 0.5307027145f + (-0.7265760135f); q = q * t + 0.7107068705f; q = q * t + (-0.142248368f); q = q * t + 0.127414796f; q = q * t;
    const f32x2 s = (v * v) * (-0.72134752044f);
    f32x2 e; e.x = __builtin_amdgcn_exp2f(s.x); e.y = __builtin_amdgcn_exp2f(s.y);
    const f32x2 m = v * (q * e), r = v - m;
    f32x2 o; o.x = v.x < 0.f ? m.x : r.x; o.y = v.y < 0.f ? m.y : r.y; return o;
}
template <class Epi, class Sched, bool ALIGN_EPI = false, bool SP2 = false>
__device__ __forceinline__ void gemm_phase(PG8_LAS unsigned char* lds, const Gemm g, const Sched& S, const Epi& E) {
    const int tid = (int)pg8_vo(threadIdx.x), wid = __builtin_amdgcn_readfirstlane(tid >> 6), lane = tid & 63, wr = wid >> 2, wc = wid & 3, fr = lane & 15, fq = lane >> 4;
    const int K = g.K, nt = K / BK;
    unsigned voffA[2], voffB[2];
#pragma unroll
    for (int i = 0; i < 2; ++i) { int R, C; stage_rc(tid * 16 + i * 8192, R, C); const int Rb = Epi::PERM ? ((R & ~31) + perm32(R & 31)) : R;
        voffA[i] = (unsigned)(R * K + C) * 2u; voffB[i] = (unsigned)(Rb * K + C) * 2u; }
    const size_t kstep = (size_t)(BK * 2);
    const size_t hstep = (size_t)HALF * K * 2;
    const size_t tstep = 2 * hstep;
    const unsigned ldsw = (unsigned)wid * 1024u;
    const int aoff = lds_byte(wr * 64 + fr, fq * 8), boff = lds_byte(wc * 32 + fr, fq * 8);
#define PG8_SA(b, h) (((b) * 2 + (h)) * HTB)
#define PG8_SB(b, h) ((4 + (b) * 2 + (h)) * HTB)
#define PG8_STAGE(bufoff, gbase, voff) do { _Pragma("unroll") for (int _i = 0; _i < 2; ++_i) \
        __builtin_amdgcn_global_load_lds((const unsigned*)(pg8_uni((const char*)(gbase)) + pg8_vo((voff)[_i])), (PG8_LAS unsigned*)(lds + (bufoff) + ldsw + _i * 8192), 16, 0, 0); } while (0)
#define PG8_LDA(dst, b, h) do { _Pragma("unroll") for (int m = 0; m < 4; ++m) _Pragma("unroll") for (int k = 0; k < 2; ++k) dst[m][k] = *(const PG8_LAS bf16x8*)(lds + PG8_SA(b, h) + aoff + m * 2048 + k * 1024); } while (0)
#define PG8_LDB(dst, b, h) do { _Pragma("unroll") for (int n = 0; n < 2; ++n) _Pragma("unroll") for (int k = 0; k < 2; ++k) dst[n][k] = *(const PG8_LAS bf16x8*)(lds + PG8_SB(b, h) + boff + n * 2048 + k * 1024); } while (0)
#define PG8_MMA(ai, bj, At, Bt) do { __builtin_amdgcn_s_setprio(1); _Pragma("unroll") for (int m = 0; m < 4; ++m) _Pragma("unroll") for (int n = 0; n < 2; ++n) _Pragma("unroll") for (int k = 0; k < 2; ++k) \
        acc[ai][bj][m][n] = __builtin_amdgcn_mfma_f32_16x16x32_bf16(Bt[n][k], At[m][k], acc[ai][bj][m][n], 0, 0, 0); __builtin_amdgcn_s_setprio(0); } while (0)
#define PG8_WAIT_V(n) asm volatile("s_waitcnt vmcnt(" #n ")" ::: "memory")
#define PG8_WAIT_L(n) asm volatile("s_waitcnt lgkmcnt(" #n ")" ::: "memory")
#define PG8_BAR __builtin_amdgcn_s_barrier()
#define PG8_SCHED __builtin_amdgcn_sched_barrier(0)
    Unit cur, nxt; int ui = 0;
    if (!S.next(0, cur)) return;
    f32x4 acc[2][2][4][2];
#pragma unroll
    for (int a = 0; a < 2; ++a)
#pragma unroll
        for (int b = 0; b < 2; ++b)
#pragma unroll
            for (int m = 0; m < 4; ++m)
#pragma unroll
                for (int n = 0; n < 2; ++n) acc[a][b][m][n] = (f32x4){0.f, 0.f, 0.f, 0.f};
    bf16x8 At[4][2], B0[2][2], B1[2][2];
    const char* cA = (const char*)g.A + (size_t)cur.pm * tstep; const char* cB = (const char*)g.Bt + (size_t)cur.pn * tstep;
    S.a_ready(cur);
    if constexpr (SP2) {
        PG8_STAGE(PG8_SB(0, 0), cB, voffB); PG8_STAGE(PG8_SB(0, 1), cB + hstep, voffB); PG8_STAGE(PG8_SA(0, 0), cA, voffA); PG8_STAGE(PG8_SA(0, 1), cA + hstep, voffA);
        if (wr == 1) PG8_BAR;
        PG8_WAIT_V(2); PG8_BAR;
        PG8_STAGE(PG8_SB(1, 0), cB + kstep, voffB); PG8_STAGE(PG8_SA(1, 0), cA + kstep, voffA); PG8_STAGE(PG8_SB(1, 1), cB + hstep + kstep, voffB);
        PG8_WAIT_V(6); PG8_BAR;
    } else {
        PG8_STAGE(PG8_SB(0, 0), cB, voffB); PG8_STAGE(PG8_SA(0, 0), cA, voffA); PG8_STAGE(PG8_SB(0, 1), cB + hstep, voffB); PG8_STAGE(PG8_SA(0, 1), cA + hstep, voffA);
        if (wr == 1) PG8_BAR;
        PG8_WAIT_V(4); PG8_BAR;
        PG8_STAGE(PG8_SB(1, 0), cB + kstep, voffB); PG8_STAGE(PG8_SA(1, 0), cA + kstep, voffA); PG8_STAGE(PG8_SB(1, 1), cB + hstep + kstep, voffB);
        PG8_WAIT_V(6); PG8_BAR;
    }
    for (;;) {
        const bool has_next = S.next(ui + 1, nxt);
        const char* nA = has_next ? (const char*)g.A + (size_t)nxt.pm * tstep : cA; const char* nB = has_next ? (const char*)g.Bt + (size_t)nxt.pn * tstep : cB;
        for (int t = 0; t < nt; t += 2) {
            const bool last = (t == nt - 2);
            const char* a1 = cA + (size_t)(t + 1) * kstep;
            const char* a2 = last ? nA : cA + (size_t)(t + 2) * kstep; const char* b2 = last ? nB : cB + (size_t)(t + 2) * kstep;
            const char* a3 = a2 + kstep; const char* b3 = b2 + kstep;
            if (last && has_next) S.a_ready(nxt);
            if constexpr (SP2) {
            PG8_LDB(B0, 0, 0); PG8_LDB(B1, 0, 1); PG8_SCHED; PG8_LDA(At, 0, 0); PG8_STAGE(PG8_SA(1, 1), a1 + hstep, voffA);
            PG8_WAIT_V(8); PG8_WAIT_L(0); PG8_BAR; PG8_MMA(0, 0, At, B0); PG8_MMA(0, 1, At, B1); PG8_BAR; PG8_SCHED;
            PG8_LDA(At, 0, 1); PG8_STAGE(PG8_SB(0, 0), b2, voffB); PG8_STAGE(PG8_SB(0, 1), b2 + hstep, voffB); PG8_STAGE(PG8_SA(0, 0), a2, voffA);
            PG8_WAIT_V(8); PG8_WAIT_L(0); PG8_BAR; PG8_MMA(1, 0, At, B0); PG8_MMA(1, 1, At, B1); PG8_BAR; PG8_SCHED;
            PG8_LDB(B0, 1, 0); PG8_LDB(B1, 1, 1); PG8_SCHED; PG8_LDA(At, 1, 0); PG8_STAGE(PG8_SA(0, 1), a2 + hstep, voffA);
            PG8_WAIT_V(8); PG8_WAIT_L(0); PG8_BAR; PG8_MMA(0, 0, At, B0); PG8_MMA(0, 1, At, B1); PG8_BAR; PG8_SCHED;
            PG8_LDA(At, 1, 1); PG8_STAGE(PG8_SB(1, 0), b3, voffB); PG8_STAGE(PG8_SB(1, 1), b3 + hstep, voffB); PG8_STAGE(PG8_SA(1, 0), a3, voffA);
            PG8_WAIT_V(8); PG8_WAIT_L(0); PG8_BAR; PG8_MMA(1, 0, At, B0); PG8_MMA(1, 1, At, B1); PG8_BAR; PG8_SCHED;
            } else {
            PG8_LDB(B0, 0, 0); PG8_SCHED; PG8_LDA(At, 0, 0); PG8_STAGE(PG8_SA(1, 1), a1 + hstep, voffA);
            PG8_WAIT_L(8); PG8_BAR; PG8_WAIT_L(0); PG8_MMA(0, 0, At, B0); PG8_BAR; PG8_SCHED;
            PG8_LDB(B1, 0, 1); PG8_STAGE(PG8_SB(0, 0), b2, voffB);
            PG8_BAR; PG8_WAIT_L(0); PG8_MMA(0, 1, At, B1); PG8_BAR;
            PG8_LDA(At, 0, 1); PG8_STAGE(PG8_SA(0, 0), a2, voffA);
            PG8_BAR; PG8_WAIT_L(0); PG8_MMA(1, 0, At, B0); PG8_BAR; PG8_SCHED;
            PG8_STAGE(PG8_SB(0, 1), b2 + hstep, voffB);
            PG8_WAIT_V(6); PG8_BAR; PG8_MMA(1, 1, At, B1); PG8_BAR;
            PG8_LDB(B0, 1, 0); PG8_SCHED; PG8_LDA(At, 1, 0); PG8_STAGE(PG8_SA(0, 1), a2 + hstep, voffA);
            PG8_WAIT_L(8); PG8_BAR; PG8_WAIT_L(0); PG8_MMA(0, 0, At, B0); PG8_BAR; PG8_SCHED;
            PG8_LDB(B1, 1, 1); PG8_STAGE(PG8_SB(1, 0), b3, voffB);
            PG8_BAR; PG8_WAIT_L(0); PG8_MMA(0, 1, At, B1); PG8_BAR;
            PG8_LDA(At, 1, 1); PG8_STAGE(PG8_SA(1, 0), a3, voffA);
            PG8_BAR; PG8_WAIT_L(0); PG8_MMA(1, 0, At, B0); PG8_BAR; PG8_SCHED;
            PG8_STAGE(PG8_SB(1, 1), b3 + hstep, voffB);
            PG8_WAIT_V(6); PG8_BAR; PG8_MMA(1, 1, At, B1); PG8_BAR;
            }
        }
        if constexpr (ALIGN_EPI) { if (wr == 0) PG8_BAR; }
        if constexpr (!Epi::AFTER_DRAIN) { E(acc, cur, wr, wc, fr, fq); S.done(cur); }
        if (!has_next) break;
#pragma unroll
        for (int a = 0; a < 2; ++a)
#pragma unroll
            for (int b = 0; b < 2; ++b)
#pragma unroll
                for (int m = 0; m < 4; ++m)
#pragma unroll
                    for (int n = 0; n < 2; ++n) acc[a][b][m][n] = (f32x4){0.f, 0.f, 0.f, 0.f};
        cur = nxt; cA = nA; cB = nB; ++ui;
        if constexpr (ALIGN_EPI) { if (wr == 1) PG8_BAR; }
    }
    PG8_WAIT_V(0);
    if constexpr (!ALIGN_EPI) { if (wr == 0) PG8_BAR; }
    PG8_BAR;
    if constexpr (Epi::AFTER_DRAIN) { E.fused(acc, cur, wr, wc, fr, fq, lds, wid, lane); S.done(cur); }
#undef PG8_SA
#undef PG8_SB
#undef PG8_STAGE
#undef PG8_LDA
#undef PG8_LDB
#undef PG8_MMA
#undef PG8_WAIT_V
#undef PG8_WAIT_L
#undef PG8_BAR
#undef PG8_SCHED
}
}
#define GAS __attribute__((address_space(1)))
#define LAS __attribute__((address_space(3)))
typedef unsigned short bf16;
typedef unsigned v4u __attribute__((ext_vector_type(4)));
typedef unsigned v2u __attribute__((ext_vector_type(2)));
typedef int v4i __attribute__((ext_vector_type(4)));
typedef float f32x4 __attribute__((ext_vector_type(4)));
typedef float f32x2 __attribute__((ext_vector_type(2)));
typedef short bf16x8 __attribute__((ext_vector_type(8)));
typedef __bf16 bf16x2_t __attribute__((ext_vector_type(2)));
typedef GAS unsigned gu32;
#define RLX_AGENT __ATOMIC_RELAXED, __HIP_MEMORY_SCOPE_AGENT
#define LDS_WAIT() asm volatile("s_waitcnt lgkmcnt(0)" ::: "memory")
#define VM_WAIT() asm volatile("s_waitcnt vmcnt(0)" ::: "memory")
__device__ __forceinline__ unsigned f2bf(float f) { unsigned u = __builtin_bit_cast(unsigned, f); return (u + 0x7fffu + ((u >> 16) & 1u)) >> 16; }
__device__ __forceinline__ unsigned pk2(float lo, float hi) { return pg8::cvt_pk_bf16(lo, hi); }
__device__ __forceinline__ float bflo(unsigned w) { return __builtin_bit_cast(float, w << 16); }
__device__ __forceinline__ float bfhi(unsigned w) { return __builtin_bit_cast(float, w & 0xffff0000u); }
__device__ __forceinline__ float wave_sum(float v) {
#pragma unroll
    for (int o = 1; o < 64; o <<= 1) v += __shfl_xor(v, o);
    return v;
}
__device__ __forceinline__ float wave_max(float v) {
#pragma unroll
    for (int o = 1; o < 64; o <<= 1) v = fmaxf(v, __shfl_xor(v, o));
    return v;
}
__device__ __forceinline__ float gelu1(float v) { const f32x2 r = pg8::gelu_pk((f32x2){v, 0.f}); return r.x; }
#define XB_TMO      128
#define XB_XCNT(j)  (256  + 64 * (j))
#define XB_XSUB(j)  (1280 + 64 * (j))
#define XB_XGEN(j)  (2304 + 64 * (j))
#define XB_TOP      3328
#define XB_TOPGEN   3392
#define XCD_BAR_WORDS 3456
#define XB_SPIN_CAP (1u << 18)

__device__ __forceinline__ unsigned xb_ld(unsigned* p)              { return __hip_atomic_load(p, __ATOMIC_RELAXED, __HIP_MEMORY_SCOPE_AGENT); }
__device__ __forceinline__ unsigned xb_add(unsigned* p, unsigned v) { return __hip_atomic_fetch_add(p, v, __ATOMIC_RELAXED, __HIP_MEMORY_SCOPE_AGENT); }
__device__ __forceinline__ unsigned xb_xcc_id() { return (unsigned)__builtin_amdgcn_s_getreg((3 << 11) | 20) & 0xFu; }
#define XB_SPIN(cond, bar) do { unsigned _sp = 0; while (cond) { __builtin_amdgcn_s_sleep(1); \
    if ((++_sp & 255u) == 0u) { if (xb_ld(&(bar)[XB_TMO])) break; if (_sp > XB_SPIN_CAP) { atomicAdd(&(bar)[XB_TMO], 1u); break; } } } } while (0)

struct XcdBarrier {
    unsigned* bar; unsigned x;
    volatile LAS unsigned* st;
};

__device__ __forceinline__ XcdBarrier xcd_barrier_post(unsigned* bar, volatile LAS unsigned* st) {
    XcdBarrier b; b.bar = bar; b.x = xb_xcc_id(); b.st = st;
    if (threadIdx.x == 0) (void)xb_add(&bar[XB_XCNT(b.x)], 1u);
    return b;
}
__device__ __forceinline__ void xcd_barrier_complete(unsigned* bar, unsigned x, unsigned& nloc, unsigned& nx) {
    const unsigned G = gridDim.x * gridDim.y * gridDim.z;
    unsigned sum, cnt, mine, sp = 0u;
    for (;;) {
        sum = 0u; cnt = 0u; mine = 0u;
#pragma unroll
        for (unsigned j = 0; j < 16; ++j) { const unsigned c = xb_ld(&bar[XB_XCNT(j)]); sum += c; cnt += (c > 0u) ? 1u : 0u; mine = (j == x) ? c : mine; }
        if (sum == G) break;
        __builtin_amdgcn_s_sleep(1);
        if ((++sp & 255u) == 0u) { if (xb_ld(&bar[XB_TMO])) break; if (sp > XB_SPIN_CAP) { atomicAdd(&bar[XB_TMO], 1u); break; } }
    }
    nloc = mine > 0u ? mine : 1u; nx = cnt > 0u ? cnt : 1u;
}

__device__ __forceinline__ void xcd_barrier(const XcdBarrier& b) {
    asm volatile("s_waitcnt vmcnt(0)" ::: "memory");
    __syncthreads();
    if (threadIdx.x == 0) {
        unsigned* bar = b.bar;
        __builtin_amdgcn_s_waitcnt(0);
        unsigned nloc = b.st[0], nx = b.st[1];
        if (nloc == 0u) { xcd_barrier_complete(bar, b.x, nloc, nx); b.st[0] = nloc; b.st[1] = nx; }
        const unsigned old = xb_add(&bar[XB_XSUB(b.x)], 1u);
        const unsigned gen = old / nloc;
        if (old + 1u == (gen + 1u) * nloc) {
            __builtin_amdgcn_fence(__ATOMIC_RELEASE, "agent");
            asm volatile("s_waitcnt vmcnt(0)" ::: "memory");
            const unsigned og = xb_add(&bar[XB_TOP], 1u);
            const unsigned tg = og / nx;
            if (og + 1u == (tg + 1u) * nx) xb_add(&bar[XB_TOPGEN], 1u);
            else XB_SPIN(xb_ld(&bar[XB_TOPGEN]) == tg, bar);
            __builtin_amdgcn_fence(__ATOMIC_ACQUIRE, "agent");
            xb_add(&bar[XB_XGEN(b.x)], 1u);
            asm volatile("s_waitcnt vmcnt(0)" ::: "memory");
        } else {
            XB_SPIN(xb_ld(&bar[XB_XGEN(b.x)]) == gen, bar);
            __builtin_amdgcn_fence(__ATOMIC_ACQUIRE, "agent");
            asm volatile("s_waitcnt vmcnt(0)" ::: "memory");
        }
    }
    __syncthreads();
}
constexpr int NWAVES = 8;
constexpr int D = 1024, NB = 8, SEQ = 2048, TP = NB * SEQ, DB = 128, DSQ = 4, TS = DB * DSQ, T = TP + TS;
constexpr int MEMT = 256, NH = 4, HD = 256, MROWS = NB * MEMT;
constexpr int NEXP = 16384;
constexpr float RMS_EPS = 1e-6f;
constexpr size_t O_Y = 0, O_SRP = 17301504, O_SIP = 17334272, O_CP = 17367040, O_MK = 17383424, O_MV = 21577728, O_SRS = 25772032, O_SIS = 26296320, O_CS = 26820608, O_END = 27082752;
enum { I_XP = 0, I_XS, I_MEM, I_SRE, I_SIM, I_SCONV, I_CK, I_CV, I_NMIX, I_NMEM, I_NFFN, I_NFIN, I_ARE, I_AIM, I_LDT, I_BRE, I_BIM, I_CRE, I_CIM, I_SD, I_WGLU, I_WIN, I_CW, I_WOUT,
       I_WQ, I_WK, I_WV, I_WO, I_PWQ, I_K1, I_K2, I_PU, I_PV, N_IN };
constexpr int R_KV = 0, R_GLU = 4096, R_Q = 6144, R_O = 8192, R_PQ = 10240, R_WIN = 14336, R_WOUT = 17408, R_END = 18432;
constexpr size_t MiB = 1u << 20;
constexpr size_t WS_CTL = 0, CTL_ZERO_BYTES = 1 * MiB;
constexpr size_t WS_WALL = 2 * MiB;
constexpr size_t WS_KEYS = 38 * MiB;
constexpr size_t WS_BBW = 39 * MiB;
constexpr size_t WS_CCW = 39 * MiB + 512 * 1024;
constexpr size_t WS_LB = 40 * MiB;
constexpr size_t WS_MEMB = 41 * MiB;
constexpr size_t WS_KB = 45 * MiB;
constexpr size_t WS_VT = 53 * MiB;
constexpr size_t WS_EID = 61 * MiB;
constexpr size_t WS_EG = 70 * MiB;
constexpr size_t WS_HB = 80 * MiB;
constexpr size_t WS_ZB = 114 * MiB;
constexpr size_t WS_QB = 148 * MiB;
constexpr size_t WS_QP = 182 * MiB;
constexpr size_t WS_B1 = 249 * MiB;
constexpr size_t WS_V1 = 283 * MiB;
constexpr size_t WS_UV = 320 * MiB;
constexpr size_t WS_SSQ = 384 * MiB;
constexpr size_t WS_KT = 388 * MiB;
constexpr size_t WS_CP = 389 * MiB;
constexpr size_t WS_WE = 393 * MiB;
constexpr size_t WS_LB16 = 397 * MiB;
constexpr size_t WS_END = 398 * MiB;
constexpr int CW_BAR = 4096;
constexpr int RING_OFF = 0, RING_BYTES = 131072;
constexpr int LDSCTL_OFF = 146432, MISC_OFF = LDSCTL_OFF + 320;
constexpr int LDS_BYTES = 147456;
using pg8::Unit;
struct EpiKV {
    static constexpr bool PERM = false, AFTER_DRAIN = false;
    float* out; bf16* KB; bf16* VT;
    __device__ __forceinline__ void operator()(const f32x4 (&acc)[2][2][4][2], const Unit& u, int wr, int wc, int fr, int fq) const {
        fr = (int)pg8::pg8_vo((unsigned)fr); fq = (int)pg8::pg8_vo((unsigned)fq);
        const int b = u.pm, mat = u.pn >> 2, l = mat >> 1, isv = mat & 1, h = u.pn & 3;
        float* ob = out + (isv ? O_MV : O_MK) + (size_t)(l * NB + b) * MEMT * D + h * HD;
#pragma unroll
        for (int ai = 0; ai < 2; ++ai)
#pragma unroll
            for (int m = 0; m < 4; ++m) { const int mm = ai * 128 + wr * 64 + m * 16 + fr;
#pragma unroll
                for (int bj = 0; bj < 2; ++bj)
#pragma unroll
                    for (int n = 0; n < 2; ++n) { const int dl = bj * 128 + wc * 32 + n * 16 + 4 * fq; const f32x4 v = acc[ai][bj][m][n];
                        *(f32x4*)(ob + (size_t)mm * D + dl) = v;
                        if (!isv) { v2u w; w.x = pk2(v[0], v[1]); w.y = pk2(v[2], v[3]); *(v2u*)(KB + ((size_t)l * MROWS + b * MEMT + mm) * D + h * HD + dl) = w; }
                        else { bf16* vp = VT + ((((size_t)l * NB + b) * NH + h) * HD + dl) * MEMT + ((mm & ~31) | (((mm >> 2) & 3) << 3) | (((mm >> 4) & 1) << 2) | (mm & 3));
#pragma unroll
                            for (int j = 0; j < 4; ++j) vp[(size_t)j * MEMT] = (bf16)f2bf(v[j]); } } }
    }
};
struct EpiGLU {
    static constexpr bool PERM = false, AFTER_DRAIN = false;
    const float* xp; float* XR; bf16* HBo; float* SSQ; const float* gnext;
    __device__ __forceinline__ void operator()(const f32x4 (&acc)[2][2][4][2], const Unit& u, int wr, int wc, int fr, int fq) const {
        fr = (int)pg8::pg8_vo((unsigned)fr); fq = (int)pg8::pg8_vo((unsigned)fq);
        const int row0 = u.pm * 256 + wr * 64 + fr, col0 = u.pn * 128 + wc * 32 + 4 * fq;
        const f32x4 g0 = *(const f32x4*)(gnext + col0), g1 = *(const f32x4*)(gnext + col0 + 16);
#pragma unroll
        for (int ai = 0; ai < 2; ++ai)
#pragma unroll
            for (int mp = 0; mp < 2; ++mp) { f32x4 xv[2][2];
#pragma unroll
                for (int mm = 0; mm < 2; ++mm)
#pragma unroll
                    for (int n = 0; n < 2; ++n) xv[mm][n] = *(const f32x4*)(xp + (size_t)(row0 + ai * 128 + (2 * mp + mm) * 16) * D + col0 + n * 16);
#pragma unroll
                for (int mm = 0; mm < 2; ++mm) { const int m = 2 * mp + mm, row = row0 + ai * 128 + m * 16; const size_t ro = (size_t)row * D + col0; float ss = 0.f;
#pragma unroll
                    for (int n = 0; n < 2; ++n) { const f32x4 a = acc[ai][0][m][n], b = acc[ai][1][m][n]; f32x4 o;
#pragma unroll
                        for (int j = 0; j < 4; ++j) { o[j] = xv[mm][n][j] + a[j] / (1.0f + __expf(-b[j])); ss = fmaf(o[j], o[j], ss); }
                        *(f32x4*)(XR + ro + n * 16) = o; const f32x4 hg = o * (n ? g1 : g0); v2u w; w.x = pk2(hg[0], hg[1]); w.y = pk2(hg[2], hg[3]); *(v2u*)(HBo + ro + n * 16) = w; }
                    ss += __shfl_xor(ss, 16); ss += __shfl_xor(ss, 32);
                    if (fq == 0) SSQ[(size_t)row * 32 + u.pn * 4 + wc] = ss; }
                asm volatile("" ::: "memory"); }
    }
};
__device__ __forceinline__ float row_rinv(const float* SSQ, size_t row, int nslots) {
    const f32x4* p = (const f32x4*)(SSQ + row * 32); f32x4 s = p[0] + p[1] + p[2] + p[3];
    if (nslots > 16) s += p[4] + p[5] + p[6] + p[7];
    return 1.0f / sqrtf(((s[0] + s[1]) + (s[2] + s[3])) * (1.0f / D) + RMS_EPS);
}
struct EpiB16 {
    static constexpr bool PERM = true, AFTER_DRAIN = false;
    bf16* O; int ldc; const float* SSQ; int nslots;
    __device__ __forceinline__ void operator()(const f32x4 (&acc)[2][2][4][2], const Unit& u, int wr, int wc, int fr, int fq) const {
        fr = (int)pg8::pg8_vo((unsigned)fr); fq = (int)pg8::pg8_vo((unsigned)fq);
        const int rb = u.pm * 256 + wr * 64, row0 = rb + fr, col0 = u.pn * 256 + wc * 32 + 8 * fq, ln = fq * 16 + fr;
        const float r0 = row_rinv(SSQ, (size_t)(rb + ln), nslots), r1 = row_rinv(SSQ, (size_t)(rb + 128 + ln), nslots);
#pragma unroll
        for (int ai = 0; ai < 2; ++ai)
#pragma unroll
            for (int m = 0; m < 4; ++m) { const size_t row = (size_t)(row0 + ai * 128 + m * 16); bf16* rowp = O + row * ldc + col0; const float ri = __shfl(ai ? r1 : r0, m * 16 + fr);
#pragma unroll
                for (int bj = 0; bj < 2; ++bj) { const f32x4 v0 = acc[ai][bj][m][0] * ri, v1 = acc[ai][bj][m][1] * ri;
                    v4u w; w.x = pk2(v0[0], v0[1]); w.y = pk2(v0[2], v0[3]); w.z = pk2(v1[0], v1[1]); w.w = pk2(v1[2], v1[3]);
                    *(v4u*)(rowp + bj * 128) = w; } }
    }
};
struct EpiRes {
    static constexpr bool PERM = false, AFTER_DRAIN = false;
    float* XR; bf16* HBo; float* SSQ; const float* gnext;
    __device__ __forceinline__ void operator()(const f32x4 (&acc)[2][2][4][2], const Unit& u, int wr, int wc, int fr, int fq) const {
        fr = (int)pg8::pg8_vo((unsigned)fr); fq = (int)pg8::pg8_vo((unsigned)fq);
        const int row0 = u.pm * 256 + wr * 64 + fr, col0 = u.pn * 256 + wc * 32 + 4 * fq;
        f32x4 gv[2][2];
#pragma unroll
        for (int bj = 0; bj < 2; ++bj)
#pragma unroll
            for (int n = 0; n < 2; ++n) gv[bj][n] = *(const f32x4*)(gnext + col0 + bj * 128 + n * 16);
#pragma unroll
        for (int ai = 0; ai < 2; ++ai)
#pragma unroll
            for (int mp = 0; mp < 2; ++mp) { f32x4 xv[2][2][2];
#pragma unroll
                for (int mm = 0; mm < 2; ++mm)
#pragma unroll
                    for (int bj = 0; bj < 2; ++bj)
#pragma unroll
                        for (int n = 0; n < 2; ++n) xv[mm][bj][n] = *(const f32x4*)(XR + (size_t)(row0 + ai * 128 + (2 * mp + mm) * 16) * D + col0 + bj * 128 + n * 16);
#pragma unroll
                for (int mm = 0; mm < 2; ++mm) { const int m = 2 * mp + mm, row = row0 + ai * 128 + m * 16; const size_t ro = (size_t)row * D + col0; float ss = 0.f;
#pragma unroll
                    for (int bj = 0; bj < 2; ++bj)
#pragma unroll
                        for (int n = 0; n < 2; ++n) { const f32x4 o = xv[mm][bj][n] + acc[ai][bj][m][n]; *(f32x4*)(XR + ro + bj * 128 + n * 16) = o;
                            ss = fmaf(o[0], o[0], fmaf(o[1], o[1], fmaf(o[2], o[2], fmaf(o[3], o[3], ss))));
                            const f32x4 hg = o * gv[bj][n]; v2u w; w.x = pk2(hg[0], hg[1]); w.y = pk2(hg[2], hg[3]); *(v2u*)(HBo + ro + bj * 128 + n * 16) = w; }
                    ss += __shfl_xor(ss, 16); ss += __shfl_xor(ss, 32);
                    if (fq == 0) SSQ[(size_t)row * 32 + u.pn * 4 + wc] = ss; }
                asm volatile("" ::: "memory"); }
    }
};
struct EpiWin {
    static constexpr bool PERM = false, AFTER_DRAIN = false;
    bf16* B1; bf16* V1; float* out;
    __device__ __forceinline__ void operator()(const f32x4 (&acc)[2][2][4][2], const Unit& u, int wr, int wc, int fr, int fq) const {
        fr = (int)pg8::pg8_vo((unsigned)fr); fq = (int)pg8::pg8_vo((unsigned)fq);
        const int row0 = u.pm * 256 + wr * 64 + fr;
        if (u.pn < 8) {
#pragma unroll
            for (int ai = 0; ai < 2; ++ai)
#pragma unroll
                for (int m = 0; m < 4; ++m) { const int row = row0 + ai * 128 + m * 16; const int col0 = u.pn * 128 + wc * 32 + 4 * fq;
                    float* cs = nullptr;
                    { const int s = row & (SEQ - 1); if (s >= SEQ - 2) cs = out + O_CP + ((size_t)(row >> 11) * 2 + (s - (SEQ - 2))) * D; }
#pragma unroll
                    for (int n = 0; n < 2; ++n) { const f32x4 v = acc[ai][0][m][n] * acc[ai][1][m][n];
                        v2u w; w.x = pk2(v[0], v[1]); w.y = pk2(v[2], v[3]); *(v2u*)(V1 + (size_t)row * D + col0 + n * 16) = w;
                        if (cs) *(f32x4*)(cs + col0 + n * 16) = v; } }
        } else {
#pragma unroll
            for (int ai = 0; ai < 2; ++ai)
#pragma unroll
                for (int m = 0; m < 4; ++m) { bf16* rowp = B1 + (size_t)(row0 + ai * 128 + m * 16) * D + (u.pn - 8) * 256 + wc * 32 + 4 * fq;
#pragma unroll
                    for (int bj = 0; bj < 2; ++bj)
#pragma unroll
                        for (int n = 0; n < 2; ++n) { const f32x4 v = acc[ai][bj][m][n]; v2u w; w.x = pk2(v[0], v[1]); w.y = pk2(v[2], v[3]); *(v2u*)(rowp + bj * 128 + n * 16) = w; } }
        }
    }
};
__device__ __forceinline__ bf16x8 mk8(v4u w) { return __builtin_bit_cast(bf16x8, w); }
__device__ __forceinline__ f32x4 mfma16(bf16x8 a, bf16x8 b, f32x4 c) { return __builtin_amdgcn_mfma_f32_16x16x32_bf16(a, b, c, 0, 0, 0); }

__device__ __forceinline__ void p0_transpose_item(const float* W, int N, int src_n0, bf16* WTrows, int k0, LAS float* scr, int lane) {
#pragma unroll
    for (int i = 0; i < 8; ++i) { const int kk = 8 * i + (lane >> 3), n4 = (lane & 7) * 4; const f32x4 v = *(const f32x4*)(W + (size_t)(k0 + kk) * N + src_n0 + n4);
        scr[kk * 33 + n4] = v[0]; scr[kk * 33 + n4 + 1] = v[1]; scr[kk * 33 + n4 + 2] = v[2]; scr[kk * 33 + n4 + 3] = v[3]; }
    LDS_WAIT();
    const int c = lane & 7;
#pragma unroll
    for (int j = 0; j < 4; ++j) { const int n = (lane >> 3) + 8 * j; const LAS float* s = scr + (8 * c) * 33 + n;
        v4u o; o.x = pk2(s[0 * 33], s[1 * 33]); o.y = pk2(s[2 * 33], s[3 * 33]); o.z = pk2(s[4 * 33], s[5 * 33]); o.w = pk2(s[6 * 33], s[7 * 33]);
        *(v4u*)(WTrows + (size_t)n * D + k0 + 8 * c) = o; }
    LDS_WAIT();
}
__device__ __forceinline__ void rms_row_bf16(const float* xrow, const float* g, bf16* orow, int lane) {
    const f32x4* xr = (const f32x4*)xrow + lane; f32x4 v[4]; float s = 0.f;
#pragma unroll
    for (int j = 0; j < 4; ++j) { v[j] = xr[64 * j]; s += (v[j].x * v[j].x + v[j].y * v[j].y) + (v[j].z * v[j].z + v[j].w * v[j].w); }
    const float r = 1.0f / sqrtf(wave_sum(s) * (1.0f / D) + RMS_EPS);
#pragma unroll
    for (int j = 0; j < 4; ++j) { const f32x4 gv = ((const f32x4*)g)[lane + 64 * j]; v2u w; w.x = pk2(v[j].x * r * gv.x, v[j].y * r * gv.y); w.y = pk2(v[j].z * r * gv.z, v[j].w * r * gv.w);
        *(v2u*)(orow + 4 * lane + 256 * j) = w; }
}

#define LDS_ORDER() asm volatile("" ::: "memory")
template <bool SAMPLE, bool WITH_Y>
__device__ __forceinline__ void s5_run(const bf16* HB, bf16* ZB, const bf16* BBW, const bf16* CCW, const float* dsk, LAS float* ST, int lane,
                                       int g, int row0, int nchunks, int b0, const float* s0re, const float* s0im, float* ore, float* oim, float lbr, float lbi, float& sr, float& si) {
    const int tl = lane & 15, q4 = lane >> 4;
    const bf16x8 zero8 = {0, 0, 0, 0, 0, 0, 0, 0};
    bf16x8 Abb[8], Acc[4];
#pragma unroll
    for (int tt = 0; tt < 8; ++tt) Abb[tt] = (q4 < 2) ? *(const bf16x8*)(BBW + ((size_t)(g * 128 + 16 * tt + tl)) * 16 + 8 * q4) : zero8;
    if (WITH_Y) {
#pragma unroll
        for (int s = 0; s < 4; ++s) Acc[s] = *(const bf16x8*)(CCW + ((size_t)(g * 16 + tl)) * 128 + 32 * s + 8 * q4); }
    const f32x4 dv = WITH_Y ? *(const f32x4*)(dsk + 16 * g + 4 * q4) : (f32x4){0.f, 0.f, 0.f, 0.f};
    const bf16* hp = HB + (size_t)(row0 + tl) * D + 16 * g;
    bf16x8 Bn = (q4 < 2) ? *(const bf16x8*)(hp + 8 * q4) : zero8; v2u hn = WITH_Y ? *(const v2u*)(hp + 4 * q4) : (v2u){0u, 0u};
    for (int ch = 0; ch < nchunks; ++ch) {
        const int rowc = row0 + 16 * ch;
        const bf16x8 Bu = Bn; const v2u hw = hn;
        if (ch + 1 < nchunks) { const bf16* hq = hp + (size_t)(16 * (ch + 1)) * D; Bn = (q4 < 2) ? *(const bf16x8*)(hq + 8 * q4) : zero8; if (WITH_Y) hn = *(const v2u*)(hq + 4 * q4); }
#pragma unroll
        for (int tt = 0; tt < 8; ++tt) { const f32x4 a = mfma16(Abb[tt], Bu, (f32x4){0.f, 0.f, 0.f, 0.f}); *(LAS f32x4*)(ST + tl * 132 + 16 * tt + 4 * q4) = a; }
        LDS_ORDER();
        float br[16], bi[16];
#pragma unroll
        for (int t = 0; t < 16; ++t) { br[t] = ST[t * 132 + lane]; bi[t] = ST[t * 132 + 64 + lane]; }
#pragma unroll
        for (int t = 0; t < 16; ++t) {
            if (SAMPLE && (t & 3) == 0) { const size_t si0 = ((size_t)(b0 + (t >> 2)) * 64 + g) * 64 + lane; sr = s0re[si0]; si = s0im[si0]; }
            const float nr = fmaf(-lbi, si, fmaf(lbr, sr, br[t])), ni = fmaf(lbi, sr, fmaf(lbr, si, bi[t]));
            sr = nr; si = ni;
            if (WITH_Y) { ST[t * 132 + lane] = sr; ST[t * 132 + 64 + lane] = si; }
            if (SAMPLE && (t & 3) == 3) { const size_t so = ((size_t)(b0 + (t >> 2)) * 64 + g) * 64 + lane; ore[so] = sr; oim[so] = si; }
        }
        LDS_ORDER();
        if (WITH_Y) {
            f32x4 y = {0.f, 0.f, 0.f, 0.f};
#pragma unroll
            for (int s = 0; s < 4; ++s) { const f32x4 lo = *(const LAS f32x4*)(ST + tl * 132 + 32 * s + 8 * q4), hi = *(const LAS f32x4*)(ST + tl * 132 + 32 * s + 8 * q4 + 4);
                v4u w; w.x = pk2(lo[0], lo[1]); w.y = pk2(lo[2], lo[3]); w.z = pk2(hi[0], hi[1]); w.w = pk2(hi[2], hi[3]);
                y = mfma16(Acc[s], mk8(w), y); }
            LDS_ORDER();
            y[0] = fmaf(dv[0], bflo(hw.x), y[0]); y[1] = fmaf(dv[1], bfhi(hw.x), y[1]); y[2] = fmaf(dv[2], bflo(hw.y), y[2]); y[3] = fmaf(dv[3], bfhi(hw.y), y[3]);
            const f32x2 g0 = pg8::gelu_pk((f32x2){y[0], y[1]}), g1 = pg8::gelu_pk((f32x2){y[2], y[3]});
            v2u zo; zo.x = pk2(g0.x, g0.y); zo.y = pk2(g1.x, g1.y);
            *(v2u*)(ZB + (size_t)(rowc + tl) * D + 16 * g + 4 * q4) = zo;
        }
    }
}
constexpr int S5_ST_BYTES = 8448, S5_XE_OFF = 8 * S5_ST_BYTES;
constexpr int S5_MAT_OFF = S5_XE_OFF + 4096, S5_KT_OFF = S5_MAT_OFF + 65536, S5_LDS_END = S5_KT_OFF + 8704;
__device__ __forceinline__ void s5_prompt_seq(const bf16* HB, bf16* ZB, const bf16* KT, const bf16* CP, const bf16* WE, const float* LB16, const float* dsk, LAS unsigned char* lds, int tid, int b, int g, float* ore, float* oim) {
    const int lane = tid & 63, seg = tid >> 6, tl = lane & 15, q4 = lane >> 4;
    LAS float* ST = (LAS float*)(lds + seg * S5_ST_BYTES); LAS float* XE = (LAS float*)(lds + S5_XE_OFF);
    LAS unsigned char* MAT = lds + S5_MAT_OFF; LAS unsigned char* KTL = lds + S5_KT_OFF;
    const float l16r = LB16[(g * 64 + lane) * 2], l16i = LB16[(g * 64 + lane) * 2 + 1];
    const int row0 = b * SEQ + seg * 256;
    { const bf16* wsrc = WE + (size_t)g * 128 * 256;
#pragma unroll
      for (int i = 0; i < 8; ++i) { const int c = tid + 512 * i, row = c >> 5, ch = c & 31; *(LAS v4u*)(MAT + row * 512 + ((ch ^ (row & 15)) << 4)) = *(const v4u*)(wsrc + (size_t)row * 256 + ch * 8); }
      const bf16* ksrc = KT + (size_t)g * 17 * 256;
      for (int c = tid; c < 544; c += 512) *(LAS v4u*)(KTL + c * 16) = *(const v4u*)(ksrc + c * 8); }
    bf16x8 Uf[8];
    { const bf16* up = HB + (size_t)(row0 + 16 * tl + (q4 >> 1)) * D + 16 * g + 8 * (q4 & 1);
#pragma unroll
      for (int ks = 0; ks < 8; ++ks) Uf[ks] = *(const bf16x8*)(up + (size_t)(2 * ks) * D); }
    __syncthreads();
#pragma unroll 2
    for (int mt = 0; mt < 8; ++mt) { f32x4 a = {0.f, 0.f, 0.f, 0.f};
#pragma unroll
        for (int ks = 0; ks < 8; ++ks) a = mfma16(*(const LAS bf16x8*)(MAT + (16 * mt + tl) * 512 + (((4 * ks + q4) ^ tl) << 4)), Uf[ks], a);
        *(LAS f32x4*)(ST + tl * 132 + 16 * mt + 4 * q4) = a; }
    LDS_ORDER();
    float er[16], ei[16];
#pragma unroll
    for (int j = 0; j < 16; ++j) { er[j] = ST[j * 132 + lane]; ei[j] = ST[j * 132 + 64 + lane]; }
    float sr = 0.f, si = 0.f;
#pragma unroll
    for (int j = 0; j < 16; ++j) { const float nr = fmaf(-l16i, si, fmaf(l16r, sr, er[j])), ni = fmaf(l16i, sr, fmaf(l16r, si, ei[j])); sr = nr; si = ni; }
    XE[(seg * 64 + lane) * 2] = sr; XE[(seg * 64 + lane) * 2 + 1] = si;
    float pr = l16r, pi = l16i;
#pragma unroll
    for (int k = 0; k < 4; ++k) { const float nr = pr * pr - pi * pi, ni = 2.f * pr * pi; pr = nr; pi = ni; }
    __syncthreads();
    { const bf16* csrc = CP + (size_t)g * 256 * 128;
#pragma unroll
      for (int i = 0; i < 8; ++i) { const int c = tid + 512 * i, row = c >> 4, ch = c & 15; *(LAS v4u*)(MAT + row * 256 + ((ch ^ (row & 15)) << 4)) = *(const v4u*)(csrc + (size_t)row * 128 + ch * 8); } }
    float cr = 0.f, ci = 0.f;
    for (int sp = 0; sp < seg; ++sp) { const float xr_ = XE[(sp * 64 + lane) * 2], xi_ = XE[(sp * 64 + lane) * 2 + 1]; const float nr = pr * cr - pi * ci + xr_, ni = pr * ci + pi * cr + xi_; cr = nr; ci = ni; }
    sr = cr; si = ci;
#pragma unroll
    for (int j = 0; j < 16; ++j) { ST[j * 132 + lane] = sr; ST[j * 132 + 64 + lane] = si;
        const float nr = fmaf(-l16i, si, fmaf(l16r, sr, er[j])), ni = fmaf(l16i, sr, fmaf(l16r, si, ei[j])); sr = nr; si = ni; }
    if (seg == 7) { const size_t so = ((size_t)b * 64 + g) * 64 + lane; ore[so] = sr; oim[so] = si; }
    __syncthreads();
    bf16x8 Cf[4];
#pragma unroll
    for (int k4 = 0; k4 < 4; ++k4) { const f32x4 lo = *(const LAS f32x4*)(ST + tl * 132 + 32 * k4 + 8 * q4), hi = *(const LAS f32x4*)(ST + tl * 132 + 32 * k4 + 8 * q4 + 4);
        v4u w; w.x = pk2(lo[0], lo[1]); w.y = pk2(lo[2], lo[3]); w.z = pk2(hi[0], hi[1]); w.w = pk2(hi[2], hi[3]); Cf[k4] = mk8(w); }
    const f32x4 dv = *(const f32x4*)(dsk + 16 * g + 4 * q4);
    const LAS unsigned char* kp = KTL + tl * 32 + 16 * (q4 & 1);
    const bf16* hp = HB + (size_t)(row0 + 16 * tl) * D + 16 * g + 4 * q4; bf16* zp = ZB + (size_t)(row0 + 16 * tl) * D + 16 * g + 4 * q4;
    v2u hw[16];
#pragma unroll
    for (int t = 0; t < 16; ++t) hw[t] = *(const v2u*)(hp + (size_t)t * D);
#pragma unroll
    for (int t = 0; t < 16; ++t) { f32x4 y = {0.f, 0.f, 0.f, 0.f};
#pragma unroll
        for (int ks = 0; ks <= (t >> 1); ++ks) { const int tau = t - 2 * ks - (q4 >> 1); const int blk = tau >= 0 ? tau + 1 : 0; y = mfma16(*(const LAS bf16x8*)(kp + blk * 512), Uf[ks], y); }
#pragma unroll
        for (int k4 = 0; k4 < 4; ++k4) y = mfma16(*(const LAS bf16x8*)(MAT + (16 * t + tl) * 256 + (((4 * k4 + q4) ^ tl) << 4)), Cf[k4], y);
        y[0] = fmaf(dv[0], bflo(hw[t].x), y[0]); y[1] = fmaf(dv[1], bfhi(hw[t].x), y[1]); y[2] = fmaf(dv[2], bflo(hw[t].y), y[2]); y[3] = fmaf(dv[3], bfhi(hw[t].y), y[3]);
        const f32x2 g0 = pg8::gelu_pk((f32x2){y[0], y[1]}), g1 = pg8::gelu_pk((f32x2){y[2], y[3]});
        v2u zo; zo.x = pk2(g0.x, g0.y); zo.y = pk2(g1.x, g1.y);
        *(v2u*)(zp + (size_t)t * D) = zo; }
    __syncthreads();
}

__device__ __forceinline__ float xreduce16(const float (&p)[16], int lane) {
    float q[8], r[4], s[2];
    const bool b5 = (lane & 32) != 0, b4 = (lane & 16) != 0, b3 = (lane & 8) != 0, b2 = (lane & 4) != 0;
#pragma unroll
    for (int k = 0; k < 8; ++k) { const float send = b5 ? p[k] : p[k + 8], keep = b5 ? p[k + 8] : p[k]; q[k] = keep + __shfl_xor(send, 32); }
#pragma unroll
    for (int k = 0; k < 4; ++k) { const float send = b4 ? q[k] : q[k + 4], keep = b4 ? q[k + 4] : q[k]; r[k] = keep + __shfl_xor(send, 16); }
#pragma unroll
    for (int k = 0; k < 2; ++k) { const float send = b3 ? r[k] : r[k + 2], keep = b3 ? r[k + 2] : r[k]; s[k] = keep + __shfl_xor(send, 8); }
    const float send = b2 ? s[0] : s[1], keep = b2 ? s[1] : s[0]; float t = keep + __shfl_xor(send, 4);
    t += __shfl_xor(t, 2); t += __shfl_xor(t, 1);
    return t;
}

__host__ __device__ __forceinline__ int vt_pos(int m) { return (m & ~31) | (((m >> 2) & 3) << 3) | (((m >> 4) & 1) << 2) | (m & 3); }
__device__ __forceinline__ void stage_tile256(const bf16* src, int ldsrc, LAS unsigned char* tb, int tid) {
#pragma unroll 1
    for (int hp = 0; hp < 2; ++hp) { v4u r[8];
#pragma unroll
        for (int i = 0; i < 8; ++i) { const int c = tid + 512 * (8 * hp + i), row = c >> 5, ch = c & 31; r[i] = *(const v4u*)(src + (size_t)row * ldsrc + ch * 8); }
#pragma unroll
        for (int i = 0; i < 8; ++i) { const int c = tid + 512 * (8 * hp + i), row = c >> 5, ch = c & 31; *(LAS v4u*)(tb + row * 512 + ((ch ^ (row & 15)) << 4)) = r[i]; } }
}
__device__ __forceinline__ float attn_softmax(f32x4 (&S)[16], bf16x8 (&Pf)[8]) {
    float mx = -3.0e38f;
#pragma unroll
    for (int mt = 0; mt < 16; ++mt) mx = fmaxf(fmaxf(mx, fmaxf(S[mt][0], S[mt][1])), fmaxf(S[mt][2], S[mt][3]));
    mx = fmaxf(mx, __shfl_xor(mx, 16)); mx = fmaxf(mx, __shfl_xor(mx, 32));
    const float sc2 = 0.0625f * 1.4426950408889634f; float sum = 0.f;
#pragma unroll
    for (int mt = 0; mt < 16; ++mt)
#pragma unroll
        for (int i = 0; i < 4; ++i) { const float p = __builtin_amdgcn_exp2f((S[mt][i] - mx) * sc2); S[mt][i] = p; sum += p; }
    sum += __shfl_xor(sum, 16); sum += __shfl_xor(sum, 32);
#pragma unroll
    for (int ks = 0; ks < 8; ++ks) { v4u w; w.x = pk2(S[2 * ks][0], S[2 * ks][1]); w.y = pk2(S[2 * ks][2], S[2 * ks][3]); w.z = pk2(S[2 * ks + 1][0], S[2 * ks + 1][1]); w.w = pk2(S[2 * ks + 1][2], S[2 * ks + 1][3]); Pf[ks] = mk8(w); }
    return 1.0f / sum;
}
__device__ __forceinline__ void attn_prompt_wg(const bf16* QB, const bf16* KBl, const bf16* VTl, bf16* OB, int b, int h, int r0, LAS unsigned char* tb, int tid) {
    const int lane = tid & 63, w = tid >> 6, tl = lane & 15, q4 = lane >> 4;
    const size_t rowA = (size_t)b * SEQ + r0 + 16 * w + tl, rowB = rowA + 128;
    stage_tile256(KBl + (size_t)b * MEMT * D + h * HD, D, tb, tid);
    __syncthreads();
    f32x4 SA[16], SB[16];
#pragma unroll
    for (int mt = 0; mt < 16; ++mt) { SA[mt] = (f32x4){0.f, 0.f, 0.f, 0.f}; SB[mt] = (f32x4){0.f, 0.f, 0.f, 0.f}; }
    const bf16* qa = QB + rowA * D + h * HD + 8 * q4; const bf16* qb = QB + rowB * D + h * HD + 8 * q4;
    const LAS unsigned char* fb = tb + tl * 512;
#pragma unroll 2
    for (int ks = 0; ks < 8; ++ks) { const bf16x8 fa = *(const bf16x8*)(qa + 32 * ks), fbq = *(const bf16x8*)(qb + 32 * ks); const int co = ((4 * ks + q4) ^ tl) << 4;
#pragma unroll
        for (int mt = 0; mt < 16; ++mt) { const bf16x8 kf = *(const LAS bf16x8*)(fb + mt * 8192 + co); SA[mt] = mfma16(kf, fa, SA[mt]); SB[mt] = mfma16(kf, fbq, SB[mt]); } }
    bf16x8 PA[8], PB[8];
    const float invA = attn_softmax(SA, PA), invB = attn_softmax(SB, PB);
    __syncthreads();
    stage_tile256(VTl + ((size_t)b * NH + h) * HD * MEMT, MEMT, tb, tid);
    __syncthreads();
#pragma unroll 2
    for (int dt = 0; dt < 16; ++dt) { f32x4 oa = {0.f, 0.f, 0.f, 0.f}, ob = {0.f, 0.f, 0.f, 0.f};
#pragma unroll
        for (int ks = 0; ks < 8; ++ks) { const bf16x8 vf = *(const LAS bf16x8*)(fb + dt * 8192 + (((4 * ks + q4) ^ tl) << 4)); oa = mfma16(vf, PA[ks], oa); ob = mfma16(vf, PB[ks], ob); }
        v2u wa, wb; wa.x = pk2(oa[0] * invA, oa[1] * invA); wa.y = pk2(oa[2] * invA, oa[3] * invA); wb.x = pk2(ob[0] * invB, ob[1] * invB); wb.y = pk2(ob[2] * invB, ob[3] * invB);
        *(v2u*)(OB + rowA * D + h * HD + 16 * dt + 4 * q4) = wa; *(v2u*)(OB + rowB * D + h * HD + 16 * dt + 4 * q4) = wb; }
    __syncthreads();
}
__device__ __forceinline__ void attn_sample_task(const bf16* QB, const float* ck, const float* cv, bf16* OB, int l, int b, int h, LAS float* lds, int tid) {
    const int lane = tid & 63, w = tid >> 6;
    LAS float* sc = lds; LAS float* red = lds + 1024;
    const size_t cbase = ((((size_t)l * DB + b) * MEMT) * NH + h) * HD;
    const float* kp = ck + cbase + (size_t)(32 * w) * (NH * HD) + 4 * lane; const float* vp = cv + cbase + (size_t)(32 * w) * (NH * HD) + 4 * lane;
    f32x4 kr[32];
#pragma unroll
    for (int mi = 0; mi < 32; ++mi) kr[mi] = __builtin_nontemporal_load((const f32x4*)(kp + (size_t)mi * (NH * HD)));
    float qf[4][4];
#pragma unroll
    for (int s = 0; s < 4; ++s) { const v2u qw = *(const v2u*)(QB + (size_t)(TP + 4 * b + s) * D + h * HD + 4 * lane); qf[s][0] = bflo(qw.x); qf[s][1] = bfhi(qw.x); qf[s][2] = bflo(qw.y); qf[s][3] = bfhi(qw.y); }
#pragma unroll
    for (int gi = 0; gi < 8; ++gi) { float pd[16];
#pragma unroll
        for (int ri = 0; ri < 4; ++ri) { const f32x4 kv = kr[4 * gi + ri];
#pragma unroll
            for (int s = 0; s < 4; ++s) pd[4 * ri + s] = kv[0] * qf[s][0] + kv[1] * qf[s][1] + kv[2] * qf[s][2] + kv[3] * qf[s][3]; }
        const float tot = xreduce16(pd, lane); const int k = lane >> 2;
        if ((lane & 3) == 0) sc[(k & 3) * 256 + 32 * w + 4 * gi + (k >> 2)] = tot * 0.0625f; }
    f32x4 vr[32];
#pragma unroll
    for (int mi = 0; mi < 32; ++mi) vr[mi] = __builtin_nontemporal_load((const f32x4*)(vp + (size_t)mi * (NH * HD)));
    __syncthreads();
    if (w < 4) { float v[4]; float mx = -3.0e38f;
#pragma unroll
        for (int j = 0; j < 4; ++j) { v[j] = sc[w * 256 + lane + 64 * j]; mx = fmaxf(mx, v[j]); }
        mx = wave_max(mx); float sum = 0.f;
#pragma unroll
        for (int j = 0; j < 4; ++j) { v[j] = __expf(v[j] - mx); sum += v[j]; }
        sum = wave_sum(sum); const float inv = 1.0f / sum;
#pragma unroll
        for (int j = 0; j < 4; ++j) sc[w * 256 + lane + 64 * j] = v[j] * inv; }
    __syncthreads();
    f32x4 o[4];
#pragma unroll
    for (int s = 0; s < 4; ++s) o[s] = (f32x4){0.f, 0.f, 0.f, 0.f};
#pragma unroll
    for (int mi = 0; mi < 32; ++mi) {
#pragma unroll
        for (int s = 0; s < 4; ++s) { const float p = sc[s * 256 + 32 * w + mi]; o[s] += vr[mi] * p; } }
#pragma unroll
    for (int s = 0; s < 4; ++s) *(LAS f32x4*)(red + (w * 4 + s) * 256 + 4 * lane) = o[s];
    __syncthreads();
    { const int idx = tid * 2, s = idx >> 8, d = idx & 255; float a0 = 0.f, a1 = 0.f;
#pragma unroll
        for (int ww = 0; ww < 8; ++ww) { a0 += red[(ww * 4 + s) * 256 + d]; a1 += red[(ww * 4 + s) * 256 + d + 1]; }
        *(unsigned*)(OB + (size_t)(TP + 4 * b + s) * D + h * HD + d) = pk2(a0, a1); }
    __syncthreads();
}

__device__ __forceinline__ unsigned ord_of(float x) { const unsigned u = __builtin_bit_cast(unsigned, x); return u ^ ((u >> 31) ? 0xFFFFFFFFu : 0x80000000u); }
__device__ __forceinline__ float ord_inv(unsigned k) { const unsigned u = (k & 0x80000000u) ? (k ^ 0x80000000u) : ~k; return __builtin_bit_cast(float, u); }
__device__ __forceinline__ unsigned umax2(unsigned a, unsigned b) { return a > b ? a : b; }
__device__ __forceinline__ unsigned umax_x4(unsigned v) { v = umax2(v, (unsigned)__shfl_xor((int)v, 16)); return umax2(v, (unsigned)__shfl_xor((int)v, 32)); }
constexpr int PSEL_KEYS = 65536, PSEL_TI = 2048;
__device__ __forceinline__ void peer_stage_keys(const bf16* KEYl, LAS unsigned char* kl, int tid) {
#pragma unroll
    for (int i = 0; i < 8; ++i) { const int c = tid + 512 * i, hr = c >> 4, ch = c & 15; *(LAS v4u*)(kl + hr * 256 + ((ch ^ (hr & 15)) << 4)) = *(const v4u*)(KEYl + (size_t)hr * 128 + ch * 8); }
}
__device__ __forceinline__ unsigned umin2(unsigned a, unsigned b) { return a < b ? a : b; }
__device__ __forceinline__ void ce_desc(unsigned& a, unsigned& b) { const unsigned hi = umax2(a, b), lo = umin2(a, b); a = hi; b = lo; }
template <int N> __device__ __forceinline__ void bitonic_sort_desc(unsigned (&a)[N]) {
#pragma unroll
    for (int k = 2; k <= N; k <<= 1)
#pragma unroll
        for (int j = k >> 1; j > 0; j >>= 1)
#pragma unroll
            for (int i = 0; i < N; ++i) { const int l = i ^ j; if (l > i) { if ((i & k) == 0) ce_desc(a[i], a[l]); else ce_desc(a[l], a[i]); } }
}
__device__ __forceinline__ void merge_top16(unsigned (&a)[16], int mask) {
    unsigned c[16];
#pragma unroll
    for (int i = 0; i < 16; ++i) c[i] = umax2(a[i], (unsigned)__shfl_xor((int)a[15 - i], mask));
#pragma unroll
    for (int j = 8; j > 0; j >>= 1)
#pragma unroll
        for (int i = 0; i < 16; ++i) { const int l = i ^ j; if (l > i) ce_desc(c[i], c[l]); }
#pragma unroll
    for (int i = 0; i < 16; ++i) a[i] = c[i];
}
__device__ __forceinline__ void peer_select_task(const bf16* QP, const LAS unsigned char* kl, int* EID, float* EG, int row0, int hh, LAS int* TI, int lane) {
    const int tl = lane & 15, q4 = lane >> 4;
    unsigned bk[2][16];
#pragma unroll
    for (int half = 0; half < 2; ++half) {
        f32x4 acc[8];
#pragma unroll
        for (int nt = 0; nt < 8; ++nt) acc[nt] = (f32x4){0.f, 0.f, 0.f, 0.f};
        const bf16* qb = QP + (size_t)(row0 + tl) * 2048 + hh * 256 + half * 128 + 8 * q4;
        const LAS unsigned char* kb = kl + (half * 128 + tl) * 256;
#pragma unroll
        for (int ks = 0; ks < 4; ++ks) { const bf16x8 qf = *(const bf16x8*)(qb + 32 * ks); const int co = ((4 * ks + q4) ^ tl) << 4;
#pragma unroll
            for (int nt = 0; nt < 8; ++nt) { const bf16x8 kf = *(const LAS bf16x8*)(kb + nt * 4096 + co); acc[nt] = mfma16(kf, qf, acc[nt]); } }
        unsigned kx[32];
#pragma unroll
        for (int nt = 0; nt < 8; ++nt)
#pragma unroll
            for (int i = 0; i < 4; ++i) kx[4 * nt + i] = (ord_of(acc[nt][i]) & 0xFFFFFF80u) | (unsigned)(16 * nt + 4 * q4 + i);
        bitonic_sort_desc<32>(kx);
        unsigned top[16];
#pragma unroll
        for (int r = 0; r < 16; ++r) top[r] = kx[r];
        merge_top16(top, 16); merge_top16(top, 32);
#pragma unroll
        for (int r = 0; r < 16; ++r) bk[half][r] = top[r];
    }
    if (q4 == 0) {
#pragma unroll
        for (int r = 0; r < 16; r += 4) { *(LAS v4i*)(TI + tl * 32 + r) = (v4i){(int)(bk[0][r] & 127u), (int)(bk[0][r + 1] & 127u), (int)(bk[0][r + 2] & 127u), (int)(bk[0][r + 3] & 127u)};
            *(LAS v4i*)(TI + tl * 32 + 16 + r) = (v4i){(int)(bk[1][r] & 127u), (int)(bk[1][r + 1] & 127u), (int)(bk[1][r + 2] & 127u), (int)(bk[1][r + 3] & 127u)}; } }
    float v2[16];
#pragma unroll
    for (int j = 0; j < 16; ++j) v2[j] = ord_inv(bk[1][j] & 0xFFFFFF80u);
    unsigned cx[32];
    { int sl = 0;
#pragma unroll
      for (int a = 0; a < 4; ++a) { const unsigned b0 = bk[0][4 * a], b1 = bk[0][4 * a + 1], b2 = bk[0][4 * a + 2], b3 = bk[0][4 * a + 3];
          const float v1s = ord_inv((q4 == 0 ? b0 : q4 == 1 ? b1 : q4 == 2 ? b2 : b3) & 0xFFFFFF80u); const int i = 4 * a + q4;
#pragma unroll
          for (int j = 0; j < 16 / (4 * a + 1); ++j) { const bool ok = (i + 1) * (j + 1) <= 16; cx[sl] = ok ? ((ord_of(v1s + v2[j]) & 0xFFFFFF00u) | (unsigned)(i * 16 + j)) : 0u; ++sl; } }
#pragma unroll
      for (int c = 21; c < 32; ++c) cx[c] = 0u; }
    bitonic_sort_desc<32>(cx);
    unsigned ct[16];
#pragma unroll
    for (int r = 0; r < 16; ++r) ct[r] = cx[r];
    merge_top16(ct, 16); merge_top16(ct, 32);
    LDS_WAIT();
    float sv[16]; float sum = 0.f; const float smax = ord_inv(ct[0] & 0xFFFFFF00u);
#pragma unroll
    for (int r = 0; r < 16; ++r) { sv[r] = __expf(ord_inv(ct[r] & 0xFFFFFF00u) - smax); sum += sv[r]; }
    const float inv = 1.0f / sum;
    unsigned c0, c1, c2, c3; f32x4 go;
    if (q4 == 0) { c0 = ct[0]; c1 = ct[1]; c2 = ct[2]; c3 = ct[3]; go = (f32x4){sv[0], sv[1], sv[2], sv[3]}; }
    else if (q4 == 1) { c0 = ct[4]; c1 = ct[5]; c2 = ct[6]; c3 = ct[7]; go = (f32x4){sv[4], sv[5], sv[6], sv[7]}; }
    else if (q4 == 2) { c0 = ct[8]; c1 = ct[9]; c2 = ct[10]; c3 = ct[11]; go = (f32x4){sv[8], sv[9], sv[10], sv[11]}; }
    else { c0 = ct[12]; c1 = ct[13]; c2 = ct[14]; c3 = ct[15]; go = (f32x4){sv[12], sv[13], sv[14], sv[15]}; }
    const LAS int* ti = TI + tl * 32;
    v4i eo;
    eo[0] = ti[(c0 >> 4) & 15] * 128 + ti[16 + (c0 & 15)]; eo[1] = ti[(c1 >> 4) & 15] * 128 + ti[16 + (c1 & 15)];
    eo[2] = ti[(c2 >> 4) & 15] * 128 + ti[16 + (c2 & 15)]; eo[3] = ti[(c3 >> 4) & 15] * 128 + ti[16 + (c3 & 15)];
    *(v4i*)(EID + (size_t)(row0 + tl) * 128 + hh * 16 + 4 * q4) = eo; *(f32x4*)(EG + (size_t)(row0 + tl) * 128 + hh * 16 + 4 * q4) = go * inv;
    LDS_WAIT();
}

constexpr float U_SCALE = 32.f, V_SCALE = 8.f;
__device__ __forceinline__ void cvt16(const v4u w, float (&f)[16]) {
#pragma unroll
    for (int q = 0; q < 4; ++q) { const f32x2 a = __builtin_amdgcn_cvt_pk_f32_fp8((int)w[q], false), b = __builtin_amdgcn_cvt_pk_f32_fp8((int)w[q], true); f[4 * q] = a.x; f[4 * q + 1] = a.y; f[4 * q + 2] = b.x; f[4 * q + 3] = b.y; }
}
__device__ __forceinline__ float xreduce8(const float (&p)[8], int lane) {
    float q[4], r[2];
    const bool b5 = (lane & 32) != 0, b4 = (lane & 16) != 0, b3 = (lane & 8) != 0;
#pragma unroll
    for (int k = 0; k < 4; ++k) { const float send = b5 ? p[k] : p[k + 4], keep = b5 ? p[k + 4] : p[k]; q[k] = keep + __shfl_xor(send, 32); }
#pragma unroll
    for (int k = 0; k < 2; ++k) { const float send = b4 ? q[k] : q[k + 2], keep = b4 ? q[k + 2] : q[k]; r[k] = keep + __shfl_xor(send, 16); }
    const float send = b3 ? r[0] : r[1], keep = b3 ? r[1] : r[0]; float t = keep + __shfl_xor(send, 8);
    t += __shfl_xor(t, 4); t += __shfl_xor(t, 2); t += __shfl_xor(t, 1);
    return t;
}
template <bool FINAL, int EMASK = 0x3FFF>
__device__ __forceinline__ void peer_gather_wave(int m0, int step, int lane, bf16* HB, const int* EID, const float* EG, const unsigned char* UV, float* XR, const float* gnext, const float* SSQ) {
    int t = m0; if (t >= T) return;
    const unsigned char* uvl = UV + 16 * lane;
    int eid = EID[(size_t)t * 128 + (lane >> 3)]; float gt = EG[(size_t)t * 128 + (lane >> 3)];
    v4u ub[8];
#pragma unroll
    for (int k = 0; k < 8; ++k) { const int e = __builtin_amdgcn_readlane(eid, 8 * k) & EMASK; ub[k] = *(const v4u*)(uvl + (size_t)e * 2048); }
    for (;;) {
        const int tn = t + step; const bool more = tn < T;
        const float rin = row_rinv(SSQ, (size_t)t, 16) * (1.0f / U_SCALE);
        float hf[16], acc[16];
        { const v4u hr0 = *(const v4u*)(HB + (size_t)t * D + 16 * lane), hr1 = *(const v4u*)(HB + (size_t)t * D + 16 * lane + 8);
          hf[0] = bflo(hr0.x); hf[1] = bfhi(hr0.x); hf[2] = bflo(hr0.y); hf[3] = bfhi(hr0.y); hf[4] = bflo(hr0.z); hf[5] = bfhi(hr0.z); hf[6] = bflo(hr0.w); hf[7] = bfhi(hr0.w);
          hf[8] = bflo(hr1.x); hf[9] = bfhi(hr1.x); hf[10] = bflo(hr1.y); hf[11] = bfhi(hr1.y); hf[12] = bflo(hr1.z); hf[13] = bfhi(hr1.z); hf[14] = bflo(hr1.w); hf[15] = bfhi(hr1.w); }
#pragma unroll
        for (int i = 0; i < 16; ++i) acc[i] = 0.f;
#pragma unroll 1
        for (int st = 0; st < 16; ++st) {
            v4u vb[8];
#pragma unroll
            for (int k = 0; k < 8; ++k) { const int e = __builtin_amdgcn_readlane(eid, 8 * k) & EMASK; vb[k] = *(const v4u*)(uvl + (size_t)e * 2048 + 1024); }
            const bool nx = (st < 15) || more; const size_t ni = (st < 15) ? ((size_t)t * 128 + (st + 1) * 8) : ((size_t)tn * 128);
            int eid_n = 0; float gt_n = 0.f;
            if (nx) { eid_n = EID[ni + (lane >> 3)]; gt_n = EG[ni + (lane >> 3)]; }
            float pd[8];
#pragma unroll
            for (int k = 0; k < 8; ++k) { float f[16]; cvt16(ub[k], f); float d = f[0] * hf[0];
#pragma unroll
                for (int i = 1; i < 16; ++i) d = fmaf(f[i], hf[i], d);
                pd[k] = d; }
            const float tot = xreduce8(pd, lane);
            const float wv = gt * gelu1(tot * rin) * (1.0f / V_SCALE);
            if (nx) {
#pragma unroll
                for (int k = 0; k < 8; ++k) { const int e = __builtin_amdgcn_readlane(eid_n, 8 * k) & EMASK; ub[k] = *(const v4u*)(uvl + (size_t)e * 2048); } }
#pragma unroll
            for (int k = 0; k < 8; ++k) { const float wk = __builtin_bit_cast(float, __builtin_amdgcn_readlane(__builtin_bit_cast(int, wv), 8 * k)); float f[16]; cvt16(vb[k], f);
#pragma unroll
                for (int i = 0; i < 16; ++i) acc[i] = fmaf(wk, f[i], acc[i]); }
            eid = eid_n; gt = gt_n;
        }
        float* xr = XR + (size_t)t * D + 16 * lane;
        f32x4 x[4];
#pragma unroll
        for (int j = 0; j < 4; ++j) x[j] = *(const f32x4*)(xr + 4 * j);
        float ss = 0.f;
#pragma unroll
        for (int j = 0; j < 4; ++j)
#pragma unroll
            for (int i = 0; i < 4; ++i) { x[j][i] += acc[4 * j + i]; ss = fmaf(x[j][i], x[j][i], ss); }
        const float r = 1.0f / sqrtf(wave_sum(ss) * (1.0f / D) + RMS_EPS);
        f32x4 gv[4];
#pragma unroll
        for (int j = 0; j < 4; ++j) gv[j] = *(const f32x4*)(gnext + 16 * lane + 4 * j);
        if (FINAL) {
#pragma unroll
            for (int j = 0; j < 4; ++j) *(f32x4*)(xr + 4 * j) = x[j] * r * gv[j];
        } else {
#pragma unroll
            for (int j = 0; j < 4; ++j) *(f32x4*)(xr + 4 * j) = x[j];
            const f32x4 a = x[0] * r * gv[0], bq = x[1] * r * gv[1], c = x[2] * r * gv[2], dq = x[3] * r * gv[3];
            v4u w0, w1;
            w0.x = pk2(a[0], a[1]); w0.y = pk2(a[2], a[3]); w0.z = pk2(bq[0], bq[1]); w0.w = pk2(bq[2], bq[3]);
            w1.x = pk2(c[0], c[1]); w1.y = pk2(c[2], c[3]); w1.z = pk2(dq[0], dq[1]); w1.w = pk2(dq[2], dq[3]);
            *(v4u*)(HB + (size_t)t * D + 16 * lane) = w0; *(v4u*)(HB + (size_t)t * D + 16 * lane + 8) = w1;
        }
        if (!more) break;
        t = tn;
    }
}

constexpr float U6_SCALE = 64.f, V6_SCALE = 16.f;
typedef float v32f __attribute__((ext_vector_type(32)));
typedef float v16f __attribute__((ext_vector_type(16)));
typedef unsigned v6u __attribute__((ext_vector_type(6)));
typedef unsigned v3u __attribute__((ext_vector_type(3)));
__device__ __forceinline__ v6u load6(const unsigned char* p) { const v3u a = *(const v3u*)p, b = *(const v3u*)(p + 12); v6u r; r[0] = a[0]; r[1] = a[1]; r[2] = a[2]; r[3] = b[0]; r[4] = b[1]; r[5] = b[2]; return r; }
__device__ __forceinline__ int mbcnt64(unsigned long long m) { return (int)__builtin_amdgcn_mbcnt_hi((unsigned)(m >> 32), __builtin_amdgcn_mbcnt_lo((unsigned)m, 0u)); }
template <bool FINAL>
__device__ __forceinline__ void peer_gather_wave6(int m0, int step, int lane, bf16* HB, const int* EID, const float* EG, const unsigned char* UV, float* XR, const float* gnext, const float* SSQ, LAS unsigned char* lw) {
    int t = m0; if (t >= T) return;
    int buf = 0;
#define PG6_SORT(TOK, BUF, FLIP) do { const size_t tb_ = (size_t)(TOK) * 128; const int e0_ = EID[tb_ + lane], e1_ = EID[tb_ + 64 + lane]; const float g0_ = EG[tb_ + lane], g1_ = EG[tb_ + 64 + lane]; \
        const int b0_ = (e0_ >> 10) ^ (FLIP), b1_ = (e1_ >> 10) ^ (FLIP); int off_ = 0, p0_ = 0, p1_ = 0; \
        _Pragma("unroll") for (int k_ = 0; k_ < 16; ++k_) { const unsigned long long m0_ = __ballot(b0_ == k_), m1_ = __ballot(b1_ == k_); const int c0_ = __popcll(m0_), c1_ = __popcll(m1_); \
            p0_ = (b0_ == k_) ? off_ + mbcnt64(m0_) : p0_; p1_ = (b1_ == k_) ? off_ + c0_ + mbcnt64(m1_) : p1_; off_ += c0_ + c1_; } \
        LAS int* se_ = (LAS int*)(lw + (BUF) * 1024); LAS float* sg_ = (LAS float*)(lw + (BUF) * 1024 + 512); se_[p0_] = e0_; sg_[p0_] = g0_; se_[p1_] = e1_; sg_[p1_] = g1_; } while (0)
#define PG6_IDS(BUF, ST, E_, G_) do { E_ = ((const LAS int*)(lw + (BUF) * 1024))[(ST) * 8 + xl]; G_ = ((const LAS float*)(lw + (BUF) * 1024 + 512))[(ST) * 8 + xl]; } while (0)
    const int hw = lane >> 5, li = lane & 31; const bool b4 = (lane & 16) != 0, b3 = (lane & 8) != 0;
    const int xl = 4 * ((lane >> 4) & 1) + 2 * ((lane >> 3) & 1) + hw;
    const unsigned char* uvl = UV + 24 * li;
    int flip = 0;
    PG6_SORT(t, 0, 0); LDS_WAIT();
    int eid; float gt; PG6_IDS(0, 0, eid, gt);
    v6u ub[4];
#pragma unroll
    for (int k = 0; k < 4; ++k) { const int ea = __builtin_amdgcn_readlane(eid, 8 * k), eb = __builtin_amdgcn_readlane(eid, 32 + 8 * k); ub[k] = load6(uvl + (size_t)(hw ? eb : ea) * 1536); }
    for (;;) {
        const int tn = t + step; const bool more = tn < T;
        const float rin = row_rinv(SSQ, (size_t)t, 16) * (1.0f / U6_SCALE);
        float hf[32], acc[32];
        { const v4u* hp = (const v4u*)(HB + (size_t)t * D + 32 * li);
#pragma unroll
          for (int q = 0; q < 4; ++q) { const v4u h = hp[q]; hf[8 * q] = bflo(h.x); hf[8 * q + 1] = bfhi(h.x); hf[8 * q + 2] = bflo(h.y); hf[8 * q + 3] = bfhi(h.y); hf[8 * q + 4] = bflo(h.z); hf[8 * q + 5] = bfhi(h.z); hf[8 * q + 6] = bflo(h.w); hf[8 * q + 7] = bfhi(h.w); } }
#pragma unroll
        for (int i = 0; i < 32; ++i) acc[i] = 0.f;
#pragma unroll 1
        for (int st = 0; st < 16; ++st) {
            v6u vb[4];
#pragma unroll
            for (int k = 0; k < 4; ++k) { const int ea = __builtin_amdgcn_readlane(eid, 8 * k), eb = __builtin_amdgcn_readlane(eid, 32 + 8 * k); vb[k] = load6(uvl + (size_t)(hw ? eb : ea) * 1536 + 768); }
            const bool nx = (st < 15) || more;
            if (st == 10 && more) PG6_SORT(tn, buf ^ 1, flip ^ 15);
            int eid_n = 0; float gt_n = 0.f;
            if (st < 15) PG6_IDS(buf, st + 1, eid_n, gt_n); else if (more) PG6_IDS(buf ^ 1, 0, eid_n, gt_n);
            float pd[4];
#pragma unroll
            for (int k = 0; k < 4; ++k) { const v32f f = __builtin_amdgcn_cvt_scalef32_pk32_f32_fp6(ub[k], 1.0f); float d = f[0] * hf[0];
#pragma unroll
                for (int i = 1; i < 32; ++i) d = fmaf(f[i], hf[i], d);
                pd[k] = d; }
            float q0, q1;
            { const float s0 = b4 ? pd[0] : pd[2], k0 = b4 ? pd[2] : pd[0]; q0 = k0 + __shfl_xor(s0, 16); const float s1 = b4 ? pd[1] : pd[3], k1 = b4 ? pd[3] : pd[1]; q1 = k1 + __shfl_xor(s1, 16); }
            float tot; { const float sd = b3 ? q0 : q1, kp = b3 ? q1 : q0; tot = kp + __shfl_xor(sd, 8); }
            tot += __shfl_xor(tot, 4); tot += __shfl_xor(tot, 2); tot += __shfl_xor(tot, 1);
            const float wv = gt * gelu1(tot * rin) * (1.0f / V6_SCALE);
            if (nx) {
#pragma unroll
                for (int k = 0; k < 4; ++k) { const int ea = __builtin_amdgcn_readlane(eid_n, 8 * k), eb = __builtin_amdgcn_readlane(eid_n, 32 + 8 * k); ub[k] = load6(uvl + (size_t)(hw ? eb : ea) * 1536); } }
#pragma unroll
            for (int k = 0; k < 4; ++k) { const float wa = __builtin_bit_cast(float, __builtin_amdgcn_readlane(__builtin_bit_cast(int, wv), 8 * k)), wb = __builtin_bit_cast(float, __builtin_amdgcn_readlane(__builtin_bit_cast(int, wv), 32 + 8 * k));
                const float wk = hw ? wb : wa; const v32f f = __builtin_amdgcn_cvt_scalef32_pk32_f32_fp6(vb[k], 1.0f);
#pragma unroll
                for (int i = 0; i < 32; ++i) acc[i] = fmaf(wk, f[i], acc[i]); }
            eid = eid_n; gt = gt_n;
        }
        float av[16];
#pragma unroll
        for (int i = 0; i < 16; ++i) { const float lo = acc[i] + __shfl_xor(acc[i], 32), hi = acc[16 + i] + __shfl_xor(acc[16 + i], 32); av[i] = hw ? hi : lo; }
        float* xr = XR + (size_t)t * D + 32 * li + 16 * hw;
        f32x4 x[4];
#pragma unroll
        for (int j = 0; j < 4; ++j) x[j] = *(const f32x4*)(xr + 4 * j);
        float ss = 0.f;
#pragma unroll
        for (int j = 0; j < 4; ++j)
#pragma unroll
            for (int i = 0; i < 4; ++i) { x[j][i] += av[4 * j + i]; ss = fmaf(x[j][i], x[j][i], ss); }
        const float r = 1.0f / sqrtf(wave_sum(ss) * (1.0f / D) + RMS_EPS);
        f32x4 gv[4];
#pragma unroll
        for (int j = 0; j < 4; ++j) gv[j] = *(const f32x4*)(gnext + 32 * li + 16 * hw + 4 * j);
        if (FINAL) {
#pragma unroll
            for (int j = 0; j < 4; ++j) *(f32x4*)(xr + 4 * j) = x[j] * r * gv[j];
        } else {
#pragma unroll
            for (int j = 0; j < 4; ++j) *(f32x4*)(xr + 4 * j) = x[j];
            const f32x4 a = x[0] * r * gv[0], bq = x[1] * r * gv[1], c = x[2] * r * gv[2], dq = x[3] * r * gv[3];
            v4u w0, w1;
            w0.x = pk2(a[0], a[1]); w0.y = pk2(a[2], a[3]); w0.z = pk2(bq[0], bq[1]); w0.w = pk2(bq[2], bq[3]);
            w1.x = pk2(c[0], c[1]); w1.y = pk2(c[2], c[3]); w1.z = pk2(dq[0], dq[1]); w1.w = pk2(dq[2], dq[3]);
            *(v4u*)(HB + (size_t)t * D + 32 * li + 16 * hw) = w0; *(v4u*)(HB + (size_t)t * D + 32 * li + 16 * hw + 8) = w1;
        }
        if (!more) break;
        t = tn; buf ^= 1; flip ^= 15;
    }
#undef PG6_SORT
#undef PG6_IDS
}

enum { SK_GLU = 0, SK_RES = 1, SK_B16 = 2, SK_WINV = 3, SK_WINB = 4 };
struct SkArgs { const bf16* A; const bf16* W; float* xr; bf16* hbo; float* ssq; const float* gnext; const float* xs; bf16* O; int ldc; int nslots; bf16* v1; bf16* b1; float* out; };
constexpr int SK_LDS_FLOATS = 8 * 32 * 68;
template <int MODE>
__device__ __forceinline__ void skinny_tile(const SkArgs& a, int rb, int cb, LAS float* P, int tid) {
    constexpr bool PAIRED = (MODE == SK_GLU || MODE == SK_WINV);
    const int lane = tid & 63, w = tid >> 6, tl = lane & 15, q4 = lane >> 4;
    const int g0 = PAIRED ? ((cb >> 2) * 256 + (cb & 3) * 32) : 64 * cb;
    f32x4 acc[2][4];
#pragma unroll
    for (int mt = 0; mt < 2; ++mt)
#pragma unroll
        for (int nt = 0; nt < 4; ++nt) acc[mt][nt] = (f32x4){0.f, 0.f, 0.f, 0.f};
    const bf16* ap = a.A + (size_t)(TP + 32 * rb + tl) * D + 128 * w + 8 * q4;
    const bf16* wp = a.W + (size_t)(g0 + tl) * D + 128 * w + 8 * q4;
    bf16x8 af[4][2], bfr[4][4];
#pragma unroll
    for (int ks = 0; ks < 4; ++ks) {
#pragma unroll
        for (int mt = 0; mt < 2; ++mt) af[ks][mt] = *(const bf16x8*)(ap + (size_t)(16 * mt) * D + 32 * ks);
#pragma unroll
        for (int nt = 0; nt < 4; ++nt) { const int wro = PAIRED ? ((nt >> 1) * 128 + (nt & 1) * 16) : 16 * nt; bfr[ks][nt] = *(const bf16x8*)(wp + (size_t)wro * D + 32 * ks); } }
    const int row = tid >> 4, c4 = (tid & 15) * 4; const size_t grow = (size_t)TP + 32 * rb + row;
    const int pcol = (cb >> 2) * 128 + (cb & 3) * 32 + (c4 & 31), col = 64 * cb + c4;
    f32x4 e0 = {0.f, 0.f, 0.f, 0.f}, e1 = {0.f, 0.f, 0.f, 0.f}; float ri = 0.f;
    if (MODE == SK_GLU) { e0 = *(const f32x4*)(a.xs + (size_t)(32 * rb + row) * D + pcol); e1 = *(const f32x4*)(a.gnext + pcol); }
    if (MODE == SK_RES) { e0 = *(const f32x4*)(a.xr + grow * D + col); e1 = *(const f32x4*)(a.gnext + col); }
    if (MODE == SK_B16) ri = row_rinv(a.ssq, grow, a.nslots);
#pragma unroll
    for (int ks = 0; ks < 4; ++ks)
#pragma unroll
        for (int nt = 0; nt < 4; ++nt)
#pragma unroll
            for (int mt = 0; mt < 2; ++mt) acc[mt][nt] = mfma16(bfr[ks][nt], af[ks][mt], acc[mt][nt]);
#pragma unroll
    for (int mt = 0; mt < 2; ++mt)
#pragma unroll
        for (int nt = 0; nt < 4; ++nt) *(LAS f32x4*)(P + (w * 32 + 16 * mt + tl) * 68 + 16 * nt + 4 * q4) = acc[mt][nt];
    __syncthreads();
    f32x4 v = {0.f, 0.f, 0.f, 0.f}, vb = {0.f, 0.f, 0.f, 0.f};
#pragma unroll
    for (int ww = 0; ww < 8; ++ww) v += *(const LAS f32x4*)(P + (ww * 32 + row) * 68 + c4);
    if (PAIRED && c4 < 32) {
#pragma unroll
        for (int ww = 0; ww < 8; ++ww) vb += *(const LAS f32x4*)(P + (ww * 32 + row) * 68 + c4 + 32); }
    if (MODE == SK_GLU) {
        float ss = 0.f;
        if (c4 < 32) { f32x4 o;
#pragma unroll
            for (int j = 0; j < 4; ++j) { o[j] = e0[j] + v[j] / (1.0f + __expf(-vb[j])); ss = fmaf(o[j], o[j], ss); }
            *(f32x4*)(a.xr + grow * D + pcol) = o; const f32x4 hg = o * e1; v2u wv; wv.x = pk2(hg[0], hg[1]); wv.y = pk2(hg[2], hg[3]); *(v2u*)(a.hbo + grow * D + pcol) = wv; }
        ss += __shfl_xor(ss, 1); ss += __shfl_xor(ss, 2); ss += __shfl_xor(ss, 4);
        if ((tid & 15) == 0) a.ssq[grow * 32 + cb] = ss;
    } else if (MODE == SK_RES) {
        const f32x4 o = e0 + v; *(f32x4*)(a.xr + grow * D + col) = o;
        float ss = o[0] * o[0] + o[1] * o[1] + o[2] * o[2] + o[3] * o[3];
        const f32x4 hg = o * e1; v2u wv; wv.x = pk2(hg[0], hg[1]); wv.y = pk2(hg[2], hg[3]); *(v2u*)(a.hbo + grow * D + col) = wv;
        ss += __shfl_xor(ss, 1); ss += __shfl_xor(ss, 2); ss += __shfl_xor(ss, 4); ss += __shfl_xor(ss, 8);
        if ((tid & 15) == 0) a.ssq[grow * 32 + cb] = ss;
    } else if (MODE == SK_B16) {
        const f32x4 o = v * ri; v2u wv; wv.x = pk2(o[0], o[1]); wv.y = pk2(o[2], o[3]);
        *(v2u*)(a.O + grow * a.ldc + col) = wv;
    } else if (MODE == SK_WINV) {
        if (c4 < 32) { const f32x4 vv = v * vb; v2u wv; wv.x = pk2(vv[0], vv[1]); wv.y = pk2(vv[2], vv[3]); *(v2u*)(a.v1 + grow * D + pcol) = wv;
            const int rs = 32 * rb + row, s = rs & 3; if (s >= 2) *(f32x4*)(a.out + O_CS + ((size_t)(rs >> 2) * 2 + (s - 2)) * D + pcol) = vv; }
    } else {
        v2u wv; wv.x = pk2(v[0], v[1]); wv.y = pk2(v[2], v[3]); *(v2u*)(a.b1 + grow * D + col) = wv;
    }
    __syncthreads();
}
#ifndef REP_P0
#define REP_P0 1
#endif
#ifndef REP_P1
#define REP_P1 1
#endif
#ifndef REP_GEMM
#define REP_GEMM 1
#endif
#ifndef REP_ATTN
#define REP_ATTN 1
#endif
#ifndef REP_PSEL
#define REP_PSEL 1
#endif
#ifndef REP_THIN
#define REP_THIN 1
#endif
#ifndef REP_SK
#define REP_SK 1
#endif
#ifndef REP_TAB
#define REP_TAB 1
#endif
#ifndef REP_KV
#define REP_KV 1
#endif
#ifndef REP_S5P
#define REP_S5P 1
#endif
#ifndef REP_S5S
#define REP_S5S 1
#endif
struct Args { const float* in[N_IN]; float* out; unsigned char* ws; int ph_lo, ph_hi; };
__device__ __forceinline__ int opaque_idx(int k) { int r; asm volatile("s_mov_b32 %0, %1" : "=s"(r) : "s"(k)); return r; }
#define INP(k) ((const float*)(const GAS float*)(args.in[opaque_idx(k)]))
__device__ __forceinline__ unsigned char* opq_p(unsigned char* p) { GAS unsigned char* g = (GAS unsigned char*)p; asm volatile("" : "+s"(g)); return (unsigned char*)g; }
__device__ __forceinline__ float* opq_f(float* p) { GAS float* g = (GAS float*)p; asm volatile("" : "+s"(g)); return (float*)g; }
__device__ __forceinline__ int opq_i(int v) { asm volatile("" : "+s"(v)); return v; }
__device__ __forceinline__ int opq_v(int v) { asm volatile("" : "+v"(v)); return v; }
#define PH_LOCALS unsigned char* ws = opq_p(args.ws); float* out = opq_f(args.out); (void)ws; (void)out; \
    const int tid = opq_v(tid0), lane = tid & 63, wave = __builtin_amdgcn_readfirstlane(tid >> 6), G = opq_i((int)gridDim.x), bx = opq_i((int)blockIdx.x), gw = bx * NWAVES + wave, NGW = G * NWAVES; (void)lane; (void)gw; (void)NGW;
#define WALL ((bf16*)(ws + WS_WALL))
#define KEYS ((bf16*)(ws + WS_KEYS))
#define BBW ((bf16*)(ws + WS_BBW))
#define CCW ((bf16*)(ws + WS_CCW))
#define LBc ((float*)(ws + WS_LB))
#define MEMB ((bf16*)(ws + WS_MEMB))
#define KB ((bf16*)(ws + WS_KB))
#define VT ((bf16*)(ws + WS_VT))
#define EID ((int*)(ws + WS_EID))
#define EG ((float*)(ws + WS_EG))
#define HB ((bf16*)(ws + WS_HB))
#define ZB ((bf16*)(ws + WS_ZB))
#define QB ((bf16*)(ws + WS_QB))
#define QP ((bf16*)(ws + WS_QP))
#define B1 ((bf16*)(ws + WS_B1))
#define V1 ((bf16*)(ws + WS_V1))
#define UVT ((unsigned char*)(ws + WS_UV))
#define XR (out + O_Y)
#define SSQB ((float*)(ws + WS_SSQ))
#define KTB ((bf16*)(ws + WS_KT))
#define CPB ((bf16*)(ws + WS_CP))
#define WEB ((bf16*)(ws + WS_WE))
#define LB16B ((float*)(ws + WS_LB16))

constexpr int N_PHASES = 18;

#define TABLE_CONVERT(LAYER, W0, NW) do { const float* sU = INP(I_PU) + (size_t)(LAYER) * NEXP * D; const float* sV = INP(I_PV) + (size_t)(LAYER) * NEXP * D; unsigned char* dst = UVT + (size_t)(LAYER) * NEXP * 1536; \
            const size_t ng = (size_t)NEXP * 32; \
            for (size_t i = (size_t)(W0) * 64 + lane; i < 2 * ng; i += (size_t)(NW) * 64) { const bool isv = i >= ng; const size_t j = isv ? i - ng : i; const size_t row = j >> 5; const int c = (int)(j & 31); \
                const f32x4* s = (const f32x4*)((isv ? sV : sU) + row * D + 32 * c); const float sc = isv ? V6_SCALE : U6_SCALE; v16f a, b; \
                _Pragma("unroll") for (int q = 0; q < 8; ++q) { const f32x4 x0 = s[q] * sc; a[2 * q] = x0[0]; b[2 * q] = x0[1]; a[2 * q + 1] = x0[2]; b[2 * q + 1] = x0[3]; } \
                const v6u w = __builtin_amdgcn_cvt_scalef32_2xpk16_fp6_f32(a, b, 1.0f); \
                unsigned char* dp = dst + (row * 2 + (isv ? 1 : 0)) * 768 + 24 * c; \
                *(v2u*)dp = (v2u){w[0], w[1]}; *(v2u*)(dp + 8) = (v2u){w[2], w[3]}; *(v2u*)(dp + 16) = (v2u){w[4], w[5]}; } } while (0)
__global__ void __launch_bounds__(NWAVES * 64, 2) mk_fwd(Args args) {
    extern __shared__ __attribute__((aligned(16))) unsigned char lds[];
    LAS unsigned char* L = (LAS unsigned char*)lds;
    volatile LAS unsigned* MISC = (volatile LAS unsigned*)(L + MISC_OFF);
    const int tid0 = threadIdx.x;
    gu32* ctl = (gu32*)(args.ws + WS_CTL);

    for (int u = tid0; u < (LDS_BYTES - LDSCTL_OFF) / 4; u += NWAVES * 64) ((LAS unsigned*)(L + LDSCTL_OFF))[u] = 0u;
    __syncthreads();
    XcdBarrier bar = xcd_barrier_post((unsigned*)(ctl + CW_BAR), MISC + 8);
    const int lo = args.ph_lo, hi = args.ph_hi;
#define IN(k) (opq_i(lo) <= (k) && (k) < opq_i(hi))
#define SEAM(k) do { if (IN(k) && IN((k) + 1)) xcd_barrier(bar); } while (0)
#define GEMM_PHASE(EpiT, Aptr, Brow, Mrows, Ncols, Eobj) do { pg8::Gemm g_{(const pg8::bf16_t*)(Aptr), (const pg8::bf16_t*)(WALL + (size_t)(Brow) * D), (Mrows), (Ncols), D}; \
        pg8::StaticOrder S_; S_.init((Mrows), (Ncols), G, bx); pg8::gemm_phase<EpiT, pg8::StaticOrder, true, true>(L + RING_OFF, g_, S_, Eobj); } while (0)

    if (IN(0)) { PH_LOCALS
      for (int rep_ = 0; rep_ < REP_P0; ++rep_) {
        LAS float* scr = (LAS float*)(L + RING_OFF + wave * 16384);
        for (int it = gw; it < (R_END / 32) * 16; it += NGW) {
            const int nb = it >> 4, kb = it & 15; int r = nb * 32; const float* src; int N, sn0;
            if (r < R_GLU) { const int mat = r >> 10, l = mat >> 1; src = ((mat & 1) ? INP(I_WV) : INP(I_WK)) + (size_t)l * D * D; N = D; sn0 = r & 1023; }
            else if (r < R_Q) { r -= R_GLU; src = INP(I_WGLU); N = 2 * D; sn0 = ((r >> 7) & 1) * 1024 + (r >> 8) * 128 + (r & 127); }
            else if (r < R_O) { r -= R_Q; src = INP(I_WQ) + (size_t)(r >> 10) * D * D; N = D; sn0 = r & 1023; }
            else if (r < R_PQ) { r -= R_O; src = INP(I_WO) + (size_t)(r >> 10) * D * D; N = D; sn0 = r & 1023; }
            else if (r < R_WIN) { r -= R_PQ; src = INP(I_PWQ) + (size_t)(r >> 11) * D * 2048; N = 2048; sn0 = r & 2047; }
            else if (r < R_WOUT) { r -= R_WIN; src = INP(I_WIN); N = 3 * D; sn0 = (r < 2048) ? (1024 + ((r >> 7) & 1) * 1024 + (r >> 8) * 128 + (r & 127)) : (r - 2048); }
            else { r -= R_WOUT; src = INP(I_WOUT); N = D; sn0 = r; }
            p0_transpose_item(src, N, sn0, WALL + (size_t)(nb * 32) * D, kb * 64, scr, lane);
        }
        TABLE_CONVERT(0, gw, NGW);
        {
            const int gt = bx * 512 + tid, NT = G * 512;
            for (int i = gt; i < 2 * 2 * 128 * 128; i += NT) { const int l = i >> 15, hf = (i >> 14) & 1, r = i & 16383; const float* k1 = INP(I_K1); const float* k2 = INP(I_K2); KEYS[i] = (bf16)f2bf((hf ? k2 : k1)[(size_t)l * 16384 + r]); }
            for (int i = gt; i < MROWS * D / 4; i += NT) { const f32x4 a = ((const f32x4*)INP(I_MEM))[i]; v2u w; w.x = pk2(a[0], a[1]); w.y = pk2(a[2], a[3]); ((v2u*)MEMB)[i] = w; }
            for (int i = gt; i < 64 * 64; i += NT) { const int g = i >> 6, p = i & 63;
                const double are = INP(I_ARE)[i], aim = INP(I_AIM)[i], dt = exp((double)INP(I_LDT)[g]);
                const double mag = exp(are * dt), ang = aim * dt, lbr = mag * cos(ang), lbi = mag * sin(ang), den = are * are + aim * aim;
                const double fr = ((lbr - 1.0) * are + lbi * aim) / den, fi = (lbi * are - (lbr - 1.0) * aim) / den;
                LBc[2 * i] = (float)lbr; LBc[2 * i + 1] = (float)lbi;
                for (int c = 0; c < 16; ++c) { const double br = INP(I_BRE)[(size_t)i * 16 + c], bi = INP(I_BIM)[(size_t)i * 16 + c];
                    BBW[((size_t)g * 128 + p) * 16 + c] = (bf16)f2bf((float)(fr * br - fi * bi)); BBW[((size_t)g * 128 + 64 + p) * 16 + c] = (bf16)f2bf((float)(fr * bi + fi * br));
                    CCW[((size_t)g * 16 + c) * 128 + p] = (bf16)f2bf(INP(I_CRE)[((size_t)g * 16 + c) * 64 + p]); CCW[((size_t)g * 16 + c) * 128 + 64 + p] = (bf16)f2bf(-INP(I_CIM)[((size_t)g * 16 + c) * 64 + p]); } }
        }
        {
            const int gt = bx * 512 + tid, NT = G * 512;
            const float* pare = INP(I_ARE); const float* paim = INP(I_AIM); const float* pldt = INP(I_LDT); const float* pbre = INP(I_BRE); const float* pbim = INP(I_BIM); const float* pcre = INP(I_CRE); const float* pcim = INP(I_CIM);
            for (int i = gt; i < 64 * 64; i += NT) { const int g = i >> 6; const double are = pare[i], aim = paim[i], dt = exp((double)pldt[g]); const double m16 = exp(16.0 * are * dt);
                LB16B[2 * i] = (float)(m16 * cos(16.0 * aim * dt)); LB16B[2 * i + 1] = (float)(m16 * sin(16.0 * aim * dt)); }
            for (int i = gt; i < 64 * 64 * 16; i += NT) { const int gp = i >> 4, n = i & 15, g = gp >> 6, p = gp & 63;
                const float are = pare[gp], aim = paim[gp], dt = expf(pldt[g]);
                const float m1 = expf(are * dt); float s1, c1; sincosf(aim * dt, &s1, &c1); const float lbr = m1 * c1, lbi = m1 * s1, den = are * are + aim * aim;
                const float fr = ((lbr - 1.0f) * are + lbi * aim) / den, fi = (lbi * are - (lbr - 1.0f) * aim) / den;
                const float mn = expf((float)n * are * dt); float sn, cn; sincosf((float)n * aim * dt, &sn, &cn); const float pnr = mn * cn, pni = mn * sn;
                const float qr = pnr * lbr - pni * lbi, qi = pnr * lbi + pni * lbr;
                const int sidx = 15 - n;
                for (int c = 0; c < 16; ++c) { const float br = pbre[(size_t)gp * 16 + c], bi = pbim[(size_t)gp * 16 + c]; const float bbr = fr * br - fi * bi, bbi = fr * bi + fi * br;
                    WEB[((size_t)g * 128 + p) * 256 + sidx * 16 + c] = (bf16)f2bf(pnr * bbr - pni * bbi); WEB[((size_t)g * 128 + 64 + p) * 256 + sidx * 16 + c] = (bf16)f2bf(pnr * bbi + pni * bbr);
                    const float cr = pcre[((size_t)g * 16 + c) * 64 + p], ci = pcim[((size_t)g * 16 + c) * 64 + p];
                    CPB[(((size_t)g * 16 + n) * 16 + c) * 128 + p] = (bf16)f2bf(cr * qr - ci * qi); CPB[(((size_t)g * 16 + n) * 16 + c) * 128 + 64 + p] = (bf16)f2bf(-(cr * qi + ci * qr)); } }
            for (int i = gt; i < 64 * 16 * 16; i += NT) { const int g = i >> 8, c = (i >> 4) & 15, cc = i & 15; const float dt = expf(pldt[g]);
                float acc[16];
#pragma unroll
                for (int tau = 0; tau < 16; ++tau) acc[tau] = 0.f;
                for (int p = 0; p < 64; ++p) { const int gp = g * 64 + p; const float are = pare[gp], aim = paim[gp];
                    const float m1 = expf(are * dt); float sn, cs; sincosf(aim * dt, &sn, &cs); const float lbr = m1 * cs, lbi = m1 * sn, den = are * are + aim * aim;
                    const float fr = ((lbr - 1.0f) * are + lbi * aim) / den, fi = (lbi * are - (lbr - 1.0f) * aim) / den;
                    const float br = pbre[(size_t)gp * 16 + cc], bi = pbim[(size_t)gp * 16 + cc]; const float bbr = fr * br - fi * bi, bbi = fr * bi + fi * br;
                    const float cr = pcre[((size_t)g * 16 + c) * 64 + p], ci = pcim[((size_t)g * 16 + c) * 64 + p];
                    float zr = cr * bbr - ci * bbi, zi = cr * bbi + ci * bbr;
#pragma unroll
                    for (int tau = 0; tau < 16; ++tau) { acc[tau] += zr; const float nr = zr * lbr - zi * lbi, ni = zr * lbi + zi * lbr; zr = nr; zi = ni; } }
#pragma unroll
                for (int tau = 0; tau < 16; ++tau) KTB[(((size_t)g * 17 + 1 + tau) * 16 + c) * 16 + cc] = (bf16)f2bf(acc[tau]);
                KTB[(((size_t)g * 17) * 16 + c) * 16 + cc] = (bf16)0; }
        }
        for (int m = gw; m < T; m += NGW) { const float* xp_ = INP(I_XP); const float* xs_ = INP(I_XS); rms_row_bf16(m < TP ? xp_ + (size_t)m * D : xs_ + (size_t)(m - TP) * D, INP(I_NMIX), HB + (size_t)m * D, lane); }
      }
    }
    SEAM(0);
    if (IN(1)) { PH_LOCALS
      for (int rep_ = 0; rep_ < REP_P1; ++rep_) {
        { EpiKV E{out, KB, VT}; for (int r2_ = 0; r2_ < REP_KV; ++r2_) GEMM_PHASE(EpiKV, MEMB, R_KV, MROWS, 4096, E); }
        {
            const int half = G / 2, per = (NB * 64 + G - 1) / G;
            const int s_lo = bx * per, s_hi = min(NB * 64, s_lo + per);
            for (int r2_ = 0; r2_ < REP_S5P; ++r2_)
#pragma unroll 1
            for (int sq = s_lo; sq < s_hi; ++sq) s5_prompt_seq(HB, ZB, KTB, CPB, WEB, LB16B, INP(I_SD), L + RING_OFF, tid, sq >> 6, sq & 63, out + O_SRP, out + O_SIP);
            for (int r3_ = 0; r3_ < REP_TAB; ++r3_) if (bx >= half) TABLE_CONVERT(1, (bx - half) * NWAVES + wave, (G - half) * NWAVES);
            const int tid2 = opq_v(tid0), lane = tid2 & 63, wave = __builtin_amdgcn_readfirstlane(tid2 >> 6), gw = bx * NWAVES + wave;
            LAS float* ST = (LAS float*)(L + RING_OFF + wave * S5_ST_BYTES);
            for (int r2_ = 0; r2_ < REP_S5S; ++r2_)
#pragma unroll 1
            for (int tk = gw; tk < (DB / 4) * 64; tk += NGW) { const int b0 = (tk >> 6) * 4, g = tk & 63; float sr = 0.f, si = 0.f;
                const float lbr = LBc[(g * 64 + lane) * 2], lbi = LBc[(g * 64 + lane) * 2 + 1];
                s5_run<true, true>(HB, ZB, BBW, CCW, INP(I_SD), ST, lane, g, TP + 4 * b0, 1, b0, INP(I_SRE), INP(I_SIM), out + O_SRS, out + O_SIS, lbr, lbi, sr, si); }
        }
        if (REP_P1 > 1) __syncthreads();
      }
    }
    SEAM(1);
    if (IN(2)) { PH_LOCALS
        { EpiGLU E{INP(I_XP), XR, HB, SSQB, INP(I_NMEM)}; for (int rep_ = 0; rep_ < REP_GEMM; ++rep_) GEMM_PHASE(EpiGLU, ZB, R_GLU, TP, 2048, E); }
        { SkArgs sa{}; sa.A = ZB; sa.W = WALL + (size_t)R_GLU * D; sa.xr = XR; sa.hbo = HB; sa.ssq = SSQB; sa.gnext = INP(I_NMEM); sa.xs = INP(I_XS);
for (int rep_ = 0; rep_ < REP_SK; ++rep_)
#pragma unroll 1
          for (int tk = bx; tk < 16 * 32; tk += G) skinny_tile<SK_GLU>(sa, tk & 15, tk >> 4, (LAS float*)(L + RING_OFF), tid); }
    }
    SEAM(2);
#pragma unroll 1
    for (int layer = 0; layer < 2; ++layer) {
        const int pb = layer == 0 ? 3 : 12;
        if (layer == 1) {
            if (IN(9)) { PH_LOCALS
                { EpiWin E{B1, V1, out}; for (int rep_ = 0; rep_ < REP_GEMM; ++rep_) GEMM_PHASE(EpiWin, HB, R_WIN, TP, 3072, E); }
                { SkArgs sa{}; sa.A = HB; sa.W = WALL + (size_t)R_WIN * D; sa.v1 = V1; sa.out = out;
for (int rep_ = 0; rep_ < REP_SK; ++rep_)
#pragma unroll 1
                  for (int tk = bx; tk < 16 * 32; tk += G) skinny_tile<SK_WINV>(sa, tk & 15, tk >> 4, (LAS float*)(L + RING_OFF), tid);
                  sa.W = WALL + (size_t)(R_WIN + 2048) * D; sa.b1 = B1;
for (int rep_ = 0; rep_ < REP_SK; ++rep_)
#pragma unroll 1
                  for (int tk = bx; tk < 16 * 16; tk += G) skinny_tile<SK_WINB>(sa, tk & 15, tk >> 4, (LAS float*)(L + RING_OFF), tid); }
            }
            SEAM(9);
            if (IN(10)) { PH_LOCALS
                const float* cw = INP(I_CW);
                for (int m = gw; m < T; m += NGW) {
                    const bool smp = m >= TP; const int s = smp ? ((m - TP) & 3) : (m & (SEQ - 1));
#pragma unroll
                    for (int hh = 0; hh < 2; ++hh) { const int c0 = hh * 512 + 8 * lane;
                        const v4u bw = *(const v4u*)(B1 + (size_t)m * D + c0), v0 = *(const v4u*)(V1 + (size_t)m * D + c0);
                        float vm1[8], vm2[8];
                        if (s >= 1) { const v4u t1 = *(const v4u*)(V1 + (size_t)(m - 1) * D + c0); vm1[0] = bflo(t1.x); vm1[1] = bfhi(t1.x); vm1[2] = bflo(t1.y); vm1[3] = bfhi(t1.y); vm1[4] = bflo(t1.z); vm1[5] = bfhi(t1.z); vm1[6] = bflo(t1.w); vm1[7] = bfhi(t1.w); }
                        else if (smp) { const float* sp = INP(I_SCONV) + ((size_t)((m - TP) >> 2) * 2 + 1) * D + c0; const f32x4 a = *(const f32x4*)sp, b = *(const f32x4*)(sp + 4); vm1[0] = a[0]; vm1[1] = a[1]; vm1[2] = a[2]; vm1[3] = a[3]; vm1[4] = b[0]; vm1[5] = b[1]; vm1[6] = b[2]; vm1[7] = b[3]; }
                        else {
#pragma unroll
                            for (int i = 0; i < 8; ++i) vm1[i] = 0.f; }
                        if (s >= 2) { const v4u t2 = *(const v4u*)(V1 + (size_t)(m - 2) * D + c0); vm2[0] = bflo(t2.x); vm2[1] = bfhi(t2.x); vm2[2] = bflo(t2.y); vm2[3] = bfhi(t2.y); vm2[4] = bflo(t2.z); vm2[5] = bfhi(t2.z); vm2[6] = bflo(t2.w); vm2[7] = bfhi(t2.w); }
                        else if (smp) { const float* sp = INP(I_SCONV) + ((size_t)((m - TP) >> 2) * 2 + s) * D + c0; const f32x4 a = *(const f32x4*)sp, b = *(const f32x4*)(sp + 4); vm2[0] = a[0]; vm2[1] = a[1]; vm2[2] = a[2]; vm2[3] = a[3]; vm2[4] = b[0]; vm2[5] = b[1]; vm2[6] = b[2]; vm2[7] = b[3]; }
                        else {
#pragma unroll
                            for (int i = 0; i < 8; ++i) vm2[i] = 0.f; }
                        float vc[8], bg[8], w0[8], w1[8], w2[8];
                        vc[0] = bflo(v0.x); vc[1] = bfhi(v0.x); vc[2] = bflo(v0.y); vc[3] = bfhi(v0.y); vc[4] = bflo(v0.z); vc[5] = bfhi(v0.z); vc[6] = bflo(v0.w); vc[7] = bfhi(v0.w);
                        bg[0] = bflo(bw.x); bg[1] = bfhi(bw.x); bg[2] = bflo(bw.y); bg[3] = bfhi(bw.y); bg[4] = bflo(bw.z); bg[5] = bfhi(bw.z); bg[6] = bflo(bw.w); bg[7] = bfhi(bw.w);
                        { const f32x4 a = *(const f32x4*)(cw + c0), b = *(const f32x4*)(cw + c0 + 4); w0[0] = a[0]; w0[1] = a[1]; w0[2] = a[2]; w0[3] = a[3]; w0[4] = b[0]; w0[5] = b[1]; w0[6] = b[2]; w0[7] = b[3]; }
                        { const f32x4 a = *(const f32x4*)(cw + D + c0), b = *(const f32x4*)(cw + D + c0 + 4); w1[0] = a[0]; w1[1] = a[1]; w1[2] = a[2]; w1[3] = a[3]; w1[4] = b[0]; w1[5] = b[1]; w1[6] = b[2]; w1[7] = b[3]; }
                        { const f32x4 a = *(const f32x4*)(cw + 2 * D + c0), b = *(const f32x4*)(cw + 2 * D + c0 + 4); w2[0] = a[0]; w2[1] = a[1]; w2[2] = a[2]; w2[3] = a[3]; w2[4] = b[0]; w2[5] = b[1]; w2[6] = b[2]; w2[7] = b[3]; }
                        float r[8];
#pragma unroll
                        for (int i = 0; i < 8; ++i) r[i] = bg[i] * (w0[i] * vm2[i] + w1[i] * vm1[i] + w2[i] * vc[i]);
                        v4u ow; ow.x = pk2(r[0], r[1]); ow.y = pk2(r[2], r[3]); ow.z = pk2(r[4], r[5]); ow.w = pk2(r[6], r[7]);
                        *(v4u*)(ZB + (size_t)m * D + c0) = ow; }
                }
            }
            SEAM(10);
            if (IN(11)) { PH_LOCALS
                { EpiRes E{XR, HB, SSQB, INP(I_NMEM) + D}; GEMM_PHASE(EpiRes, ZB, R_WOUT, TP, 1024, E); }
                { SkArgs sa{}; sa.A = ZB; sa.W = WALL + (size_t)R_WOUT * D; sa.xr = XR; sa.hbo = HB; sa.ssq = SSQB; sa.gnext = INP(I_NMEM) + D;
#pragma unroll 1
                  for (int tk = bx; tk < 16 * 16; tk += G) skinny_tile<SK_RES>(sa, tk & 15, tk >> 4, (LAS float*)(L + RING_OFF), tid); }
            }
            SEAM(11);
        }
        const int ns_q = layer == 0 ? 32 : 16;
        if (IN(pb + 0)) { PH_LOCALS
            { EpiB16 E{QB, D, SSQB, ns_q}; for (int rep_ = 0; rep_ < REP_GEMM; ++rep_) GEMM_PHASE(EpiB16, HB, R_Q + layer * 1024, TP, 1024, E); }
            { SkArgs sa{}; sa.A = HB; sa.W = WALL + (size_t)(R_Q + layer * 1024) * D; sa.ssq = SSQB; sa.nslots = ns_q; sa.O = QB; sa.ldc = D;
for (int rep_ = 0; rep_ < REP_SK; ++rep_)
#pragma unroll 1
              for (int tk = bx; tk < 16 * 16; tk += G) skinny_tile<SK_B16>(sa, tk & 15, tk >> 4, (LAS float*)(L + RING_OFF), tid); }
        }
        SEAM(pb + 0);
        if (IN(pb + 1)) { PH_LOCALS
          for (int rep_ = 0; rep_ < REP_ATTN; ++rep_) {
            const bf16* KBl = KB + (size_t)layer * MROWS * D; const bf16* VTl = VT + (size_t)layer * NB * NH * HD * MEMT;
#pragma unroll 1
            for (int pass = 0; pass < 2; ++pass) {
              if ((pass ^ (bx & 1)) == 0) {
#pragma unroll 1
                for (int tk = bx; tk < NB * NH * (SEQ / 256); tk += G) { const int rb = tk & 7, bh = tk >> 3; attn_prompt_wg(QB, KBl, VTl, ZB, bh >> 2, bh & 3, rb * 256, L + RING_OFF, tid); }
              } else {
#pragma unroll 1
                for (int tk = bx; tk < DB * NH; tk += G) attn_sample_task(QB, INP(I_CK), INP(I_CV), ZB, layer, tk >> 2, tk & 3, (LAS float*)(L + RING_OFF), tid);
              }
            }
          }
        }
        SEAM(pb + 1);
        if (IN(pb + 2)) { PH_LOCALS
            { EpiRes E{XR, HB, SSQB, INP(I_NFFN) + layer * D}; GEMM_PHASE(EpiRes, ZB, R_O + layer * 1024, TP, 1024, E); }
            { SkArgs sa{}; sa.A = ZB; sa.W = WALL + (size_t)(R_O + layer * 1024) * D; sa.xr = XR; sa.hbo = HB; sa.ssq = SSQB; sa.gnext = INP(I_NFFN) + layer * D;
#pragma unroll 1
              for (int tk = bx; tk < 16 * 16; tk += G) skinny_tile<SK_RES>(sa, tk & 15, tk >> 4, (LAS float*)(L + RING_OFF), tid); }
        }
        SEAM(pb + 2);
        if (IN(pb + 3)) { PH_LOCALS
            { EpiB16 E{QP, 2048, SSQB, 16}; for (int rep_ = 0; rep_ < REP_GEMM; ++rep_) GEMM_PHASE(EpiB16, HB, R_PQ + layer * 2048, TP, 2048, E); }
            { SkArgs sa{}; sa.A = HB; sa.W = WALL + (size_t)(R_PQ + layer * 2048) * D; sa.ssq = SSQB; sa.nslots = 16; sa.O = QP; sa.ldc = 2048;
for (int rep_ = 0; rep_ < REP_SK; ++rep_)
#pragma unroll 1
              for (int tk = bx; tk < 16 * 32; tk += G) skinny_tile<SK_B16>(sa, tk & 15, tk >> 4, (LAS float*)(L + RING_OFF), tid); }
        }
        SEAM(pb + 3);
        if (IN(pb + 4)) { PH_LOCALS
          peer_stage_keys(KEYS + (size_t)layer * 2 * 128 * 128, L + RING_OFF, tid);
          __syncthreads();
          LAS int* ti = (LAS int*)(L + RING_OFF + PSEL_KEYS + wave * PSEL_TI);
          for (int rep_ = 0; rep_ < REP_PSEL; ++rep_)
#pragma unroll 1
            for (int tk = gw; tk < (T / 16) * 8; tk += NGW) peer_select_task(QP, L + RING_OFF, EID, EG, (tk >> 3) * 16, tk & 7, ti, lane);
        }
        SEAM(pb + 4);
        if (IN(pb + 5)) { PH_LOCALS
            const unsigned char* UVl = UVT + (size_t)layer * NEXP * 1536;
            if (layer == 0) peer_gather_wave6<false>(gw, NGW, lane, HB, EID, EG, UVl, XR, INP(I_NMIX) + D, SSQB, L + RING_OFF + wave * 2048);
            else peer_gather_wave6<true>(gw, NGW, lane, HB, EID, EG, UVl, XR, INP(I_NFIN), SSQB, L + RING_OFF + wave * 2048);
        }
        if (layer == 0) SEAM(pb + 5);
    }
#undef IN
#undef SEAM
#undef GEMM_PHASE
}

#ifndef MK_PER_PHASE
#define MK_PER_PHASE 0
#endif
extern "C" void kernel_launch(void* const* d_in, const int* in_sizes, int n_in, void* d_out, int out_size, void* d_ws, size_t ws_size, hipStream_t stream) {
    static int grid = 0;
    if (grid == 0) {
        if (n_in != N_IN || out_size != (int)O_END || ws_size < WS_END) { fprintf(stderr, "kernel_launch: unexpected shapes: n_in %d out %d ws %zu; nothing launched\n", n_in, out_size, ws_size); grid = -1; return; }
        int dev = 0, cus = 0, per_cu = 0;
        if (hipGetDevice(&dev) != hipSuccess || hipDeviceGetAttribute(&cus, hipDeviceAttributeMultiprocessorCount, dev) != hipSuccess) { fprintf(stderr, "kernel_launch: device query failed\n"); grid = -1; return; }
        if (hipFuncSetAttribute((const void*)mk_fwd, hipFuncAttributeMaxDynamicSharedMemorySize, LDS_BYTES) != hipSuccess) { fprintf(stderr, "kernel_launch: hipFuncSetAttribute failed\n"); grid = -1; return; }
        if (hipOccupancyMaxActiveBlocksPerMultiprocessor(&per_cu, (const void*)mk_fwd, NWAVES * 64, LDS_BYTES) != hipSuccess || per_cu < 1) { fprintf(stderr, "kernel_launch: occupancy query says %d blocks per CU\n", per_cu); per_cu = 1; }
        (void)hipGetLastError();
        grid = cus;
        if (grid > 256) grid = 256;
    }
    if (grid < 0) return;
    if (hipMemsetAsync((char*)d_ws + WS_CTL, 0, CTL_ZERO_BYTES, stream) != hipSuccess) { fprintf(stderr, "kernel_launch: memset failed\n"); return; }
    Args a{};
    for (int i = 0; i < N_IN; ++i) a.in[i] = (const float*)d_in[i];
    a.out = (float*)d_out; a.ws = (unsigned char*)d_ws;
#if MK_PER_PHASE
    for (int p = 0; p < N_PHASES; ++p) { a.ph_lo = p; a.ph_hi = p + 1; hipLaunchKernelGGL(mk_fwd, dim3(grid), dim3(NWAVES * 64), LDS_BYTES, stream, a); }
#else
    a.ph_lo = 0; a.ph_hi = N_PHASES;
    hipLaunchKernelGGL(mk_fwd, dim3(grid), dim3(NWAVES * 64), LDS_BYTES, stream, a);
#endif
    const hipError_t le = hipPeekAtLastError();
    if (le != hipSuccess) fprintf(stderr, "kernel_launch: launch failed: %s\n", hipGetErrorName(le));
}
```

```cpp
#include <hip/hip_runtime.h>
#include <cstdio>
#include <cstdint>
namespace pg8 {
#define PG8_LAS __attribute__((address_space(3)))
typedef unsigned short bf16_t;
typedef short bf16x8 __attribute__((ext_vector_type(8)));
typedef float f32x4 __attribute__((ext_vector_type(4)));
typedef unsigned u32x4 __attribute__((ext_vector_type(4)));
constexpr int BM = 256, BK = 64, HALF = 128, HTB = HALF * BK * 2  , STAGE_BYTES = 8 * HTB, NXCD = 8, WGM = 8;

__host__ __device__ __forceinline__ int lds_byte(int r, int c) { const int st = (r >> 4) * 2 + (c >> 5), rr = r & 15, cc = c & 31, ob = rr * 64 + cc * 2; return st * 1024 + (ob ^ (((ob >> 9) & 1) << 5)); }
__host__ __device__ __forceinline__ void stage_rc(int b, int& R, int& C) { const int st = b / 1024, sb = b % 1024, swz = sb ^ (((sb >> 9) & 1) << 5); R = (st >> 1) * 16 + swz / 64; C = (st & 1) * 32 + (swz % 64) / 2; }
__host__ __device__ __forceinline__ int perm32(int rho) { const int n = rho >> 4, i = rho & 15; return 8 * (i >> 2) + 4 * n + (i & 3); }

__device__ __forceinline__ const char* pg8_uni(const char* p) { asm volatile("" : "+s"(p)); return p; }
__device__ __forceinline__ unsigned pg8_vo(unsigned v) { asm volatile("" : "+v"(v)); return v; }
struct Unit { int pm, pn; };
struct Gemm { const bf16_t* A; const bf16_t* Bt; int M, N, K; };

struct StaticOrder {
    int nM, nN, nwg, G, c;
    __host__ __device__ void init(int M, int N, int G_, int c_) { nM = M / BM; nN = N / BM; nwg = nM * nN; G = G_; c = c_; }
    __host__ __device__ bool next(int i, Unit& u) const {
        const long L = (long)i * G + c; if (L >= nwg) return false;
        int wgid = (int)L; { const int q = nwg / NXCD, r = nwg % NXCD, xcd = wgid % NXCD, off = wgid / NXCD; wgid = (xcd < r ? xcd * (q + 1) : r * (q + 1) + (xcd - r) * q) + off; }
        const int nig = WGM * nN, gid = wgid / nig, fm = gid * WGM, gsz = (nM - fm) < WGM ? (nM - fm) : WGM;
        u.pm = fm + ((wgid % nig) % gsz); u.pn = (wgid % nig) / gsz; return true;
    }
    __device__ __forceinline__ void a_ready(const Unit&) const {}
    __device__ __forceinline__ void done(const Unit&) const {}
};

__device__ __forceinline__ unsigned cvt_pk_bf16(float lo, float hi) { unsigned r; asm volatile("v_cvt_pk_bf16_f32 %0, %1, %2" : "=v"(r) : "v"(lo), "v"(hi)); return r; }
typedef float f32x2 __attribute__((ext_vector_type(2)));
__device__ __forceinline__ f32x2 gelu_pk(f32x2 v) {
    const f32x2 av = __builtin_elementwise_abs(v), d = av * 0.2316418882f + 1.0f;
    f32x2 t; t.x = __builtin_amdgcn_rcpf(d.x); t.y = __builtin_amdgcn_rcpf(d.y);
    f32x2 q = t * 0.5307027145f + (-0.7265760135f); q = q * t + 0.7107068705f; q = q * t + (-0.142248368f); q = q * t + 0.127414796f; q = q * t;
    const f32x2 s = (v * v) * (-0.72134752044f);
    f32x2 e; e.x = __builtin_amdgcn_exp2f(s.x); e.y = __builtin_amdgcn_exp2f(s.y);
    const f32x2 m = v * (q * e), r = v - m;
    f32x2 o; o.x = v.x < 0.f ? m.x : r.x; o.y = v.y < 0.f ? m.y : r.y; return o;
}
template <class Epi, class Sched, bool ALIGN_EPI = false, bool SP2 = false>
__device__ __forceinline__ void gemm_phase(PG8_LAS unsigned char* lds, const Gemm g, const Sched& S, const Epi& E) {
    const int tid = (int)pg8_vo(threadIdx.x), wid = __builtin_amdgcn_readfirstlane(tid >> 6), lane = tid & 63, wr = wid >> 2, wc = wid & 3, fr = lane & 15, fq = lane >> 4;
    const int K = g.K, nt = K / BK;
    unsigned voffA[2], voffB[2];
#pragma unroll
    for (int i = 0; i < 2; ++i) { int R, C; stage_rc(tid * 16 + i * 8192, R, C); const int Rb = Epi::PERM ? ((R & ~31) + perm32(R & 31)) : R;
        voffA[i] = (unsigned)(R * K + C) * 2u; voffB[i] = (unsigned)(Rb * K + C) * 2u; }
    const size_t kstep = (size_t)(BK * 2);
    const size_t hstep = (size_t)HALF * K * 2;
    const size_t tstep = 2 * hstep;
    const unsigned ldsw = (unsigned)wid * 1024u;
    const int aoff = lds_byte(wr * 64 + fr, fq * 8), boff = lds_byte(wc * 32 + fr, fq * 8);
#define PG8_SA(b, h) (((b) * 2 + (h)) * HTB)
#define PG8_SB(b, h) ((4 + (b) * 2 + (h)) * HTB)
#define PG8_STAGE(bufoff, gbase, voff) do { _Pragma("unroll") for (int _i = 0; _i < 2; ++_i) \
        __builtin_amdgcn_global_load_lds((const unsigned*)(pg8_uni((const char*)(gbase)) + pg8_vo((voff)[_i])), (PG8_LAS unsigned*)(lds + (bufoff) + ldsw + _i * 8192), 16, 0, 0); } while (0)
#define PG8_LDA(dst, b, h) do { _Pragma("unroll") for (int m = 0; m < 4; ++m) _Pragma("unroll") for (int k = 0; k < 2; ++k) dst[m][k] = *(const PG8_LAS bf16x8*)(lds + PG8_SA(b, h) + aoff + m * 2048 + k * 1024); } while (0)
#define PG8_LDB(dst, b, h) do { _Pragma("unroll") for (int n = 0; n < 2; ++n) _Pragma("unroll") for (int k = 0; k < 2; ++k) dst[n][k] = *(const PG8_LAS bf16x8*)(lds + PG8_SB(b, h) + boff + n * 2048 + k * 1024); } while (0)
#define PG8_MMA(ai, bj, At, Bt) do { __builtin_amdgcn_s_setprio(1); _Pragma("unroll") for (int m = 0; m < 4; ++m) _Pragma("unroll") for (int n = 0; n < 2; ++n) _Pragma("unroll") for (int k = 0; k < 2; ++k) \
        acc[ai][bj][m][n] = __builtin_amdgcn_mfma_f32_16x16x32_bf16(Bt[n][k], At[m][k], acc[ai][bj][m][n], 0, 0, 0); __builtin_amdgcn_s_setprio(0); } while (0)
#define PG8_WAIT_V(n) asm volatile("s_waitcnt vmcnt(" #n ")" ::: "memory")
#define PG8_WAIT_L(n) asm volatile("s_waitcnt lgkmcnt(" #n ")" ::: "memory")
#define PG8_BAR __builtin_amdgcn_s_barrier()
#define PG8_SCHED __builtin_amdgcn_sched_barrier(0)
    Unit cur, nxt; int ui = 0;
    if (!S.next(0, cur)) return;
    f32x4 acc[2][2][4][2];
#pragma unroll
    for (int a = 0; a < 2; ++a)
#pragma unroll
        for (int b = 0; b < 2; ++b)
#pragma unroll
            for (int m = 0; m < 4; ++m)
#pragma unroll
                for (int n = 0; n < 2; ++n) acc[a][b][m][n] = (f32x4){0.f, 0.f, 0.f, 0.f};
    bf16x8 At[4][2], B0[2][2], B1[2][2];
    const char* cA = (const char*)g.A + (size_t)cur.pm * tstep; const char* cB = (const char*)g.Bt + (size_t)cur.pn * tstep;
    S.a_ready(cur);
    if constexpr (SP2) {
        PG8_STAGE(PG8_SB(0, 0), cB, voffB); PG8_STAGE(PG8_SB(0, 1), cB + hstep, voffB); PG8_STAGE(PG8_SA(0, 0), cA, voffA); PG8_STAGE(PG8_SA(0, 1), cA + hstep, voffA);
        if (wr == 1) PG8_BAR;
        PG8_WAIT_V(2); PG8_BAR;
        PG8_STAGE(PG8_SB(1, 0), cB + kstep, voffB); PG8_STAGE(PG8_SA(1, 0), cA + kstep, voffA); PG8_STAGE(PG8_SB(1, 1), cB + hstep + kstep, voffB);
        PG8_WAIT_V(6); PG8_BAR;
    } else {
        PG8_STAGE(PG8_SB(0, 0), cB, voffB); PG8_STAGE(PG8_SA(0, 0), cA, voffA); PG8_STAGE(PG8_SB(0, 1), cB + hstep, voffB); PG8_STAGE(PG8_SA(0, 1), cA + hstep, voffA);
        if (wr == 1) PG8_BAR;
        PG8_WAIT_V(4); PG8_BAR;
        PG8_STAGE(PG8_SB(1, 0), cB + kstep, voffB); PG8_STAGE(PG8_SA(1, 0), cA + kstep, voffA); PG8_STAGE(PG8_SB(1, 1), cB + hstep + kstep, voffB);
        PG8_WAIT_V(6); PG8_BAR;
    }
    for (;;) {
        const bool has_next = S.next(ui + 1, nxt);
        const char* nA = has_next ? (const char*)g.A + (size_t)nxt.pm * tstep : cA; const char* nB = has_next ? (const char*)g.Bt + (size_t)nxt.pn * tstep : cB;
        for (int t = 0; t < nt; t += 2) {
            const bool last = (t == nt - 2);
            const char* a1 = cA + (size_t)(t + 1) * kstep;
            const char* a2 = last ? nA : cA + (size_t)(t + 2) * kstep; const char* b2 = last ? nB : cB + (size_t)(t + 2) * kstep;
            const char* a3 = a2 + kstep; const char* b3 = b2 + kstep;
            if (last && has_next) S.a_ready(nxt);
            if constexpr (SP2) {
            PG8_LDB(B0, 0, 0); PG8_LDB(B1, 0, 1); PG8_SCHED; PG8_LDA(At, 0, 0); PG8_STAGE(PG8_SA(1, 1), a1 + hstep, voffA);
            PG8_WAIT_V(8); PG8_WAIT_L(0); PG8_BAR; PG8_MMA(0, 0, At, B0); PG8_MMA(0, 1, At, B1); PG8_BAR; PG8_SCHED;
            PG8_LDA(At, 0, 1); PG8_STAGE(PG8_SB(0, 0), b2, voffB); PG8_STAGE(PG8_SB(0, 1), b2 + hstep, voffB); PG8_STAGE(PG8_SA(0, 0), a2, voffA);
            PG8_WAIT_V(8); PG8_WAIT_L(0); PG8_BAR; PG8_MMA(1, 0, At, B0); PG8_MMA(1, 1, At, B1); PG8_BAR; PG8_SCHED;
            PG8_LDB(B0, 1, 0); PG8_LDB(B1, 1, 1); PG8_SCHED; PG8_LDA(At, 1, 0); PG8_STAGE(PG8_SA(0, 1), a2 + hstep, voffA);
            PG8_WAIT_V(8); PG8_WAIT_L(0); PG8_BAR; PG8_MMA(0, 0, At, B0); PG8_MMA(0, 1, At, B1); PG8_BAR; PG8_SCHED;
            PG8_LDA(At, 1, 1); PG8_STAGE(PG8_SB(1, 0), b3, voffB); PG8_STAGE(PG8_SB(1, 1), b3 + hstep, voffB); PG8_STAGE(PG8_SA(1, 0), a3, voffA);
            PG8_WAIT_V(8); PG8_WAIT_L(0); PG8_BAR; PG8_MMA(1, 0, At, B0); PG8_MMA(1, 1, At, B1); PG8_BAR; PG8_SCHED;
            } else {
            PG8_LDB(B0, 0, 0); PG8_SCHED; PG8_LDA(At, 0, 0); PG8_STAGE(PG8_SA(1, 1), a1 + hstep, voffA);
            PG8_WAIT_L(8); PG8_BAR; PG8_WAIT_L(0); PG8_MMA(0, 0, At, B0); PG8_BAR; PG8_SCHED;
            PG8_LDB(B1, 0, 1); PG8_STAGE(PG8_SB(0, 0), b2, voffB);
            PG8_BAR; PG8_WAIT_L(0); PG8_MMA(0, 1, At, B1); PG8_BAR;
            PG8_LDA(At, 0, 1); PG8_STAGE(PG8_SA(0, 0), a2, voffA);
            PG8_BAR; PG8_WAIT_L(0); PG8_MMA(1, 0, At, B0); PG8_BAR; PG8_SCHED;
            PG8_STAGE(PG8_SB(0, 1), b2 + hstep, voffB);
            PG8_WAIT_V(6); PG8_BAR; PG8_MMA(1, 1, At, B1); PG8_BAR;
            PG8_LDB(B0, 1, 0); PG8_SCHED; PG8_LDA(At, 1, 0); PG8_STAGE(PG8_SA(0, 1), a2 + hstep, voffA);
            PG8_WAIT_L(8); PG8_BAR; PG8_WAIT_L(0); PG8_MMA(0, 0, At, B0); PG8_BAR; PG8_SCHED;
            PG8_LDB(B1, 1, 1); PG8_STAGE(PG8_SB(1, 0), b3, voffB);
            PG8_BAR; PG8_WAIT_L(0); PG8_MMA(0, 1, At, B1); PG8_BAR;
            PG8_LDA(At, 1, 1); PG8_STAGE(PG8_SA(1, 0), a3, voffA);
            PG8_BAR; PG8_WAIT_L(0); PG8_MMA(1, 0, At, B0); PG8_BAR; PG8_SCHED;
            PG8_STAGE(PG8_SB(1, 1), b3 + hstep, voffB);
            PG8_WAIT_V(6); PG8_BAR; PG8_MMA(1, 1, At, B1); PG8_BAR;
            }
        }
        if constexpr (ALIGN_EPI) { if (wr == 0) PG8_BAR; }
        if constexpr (!Epi::AFTER_DRAIN) { E(acc, cur, wr, wc, fr, fq); S.done(cur); }
        if (!has_next) break;
#pragma unroll
        for (int a = 0; a < 2; ++a)
#pragma unroll
            for (int b = 0; b < 2; ++b)
#pragma unroll
                for (int m = 0; m < 4; ++m)
#pragma unroll
                    for (int n = 0; n < 2; ++n) acc[a][b][m][n] = (f32x4){0.f, 0.f, 0.f, 0.f};
        cur = nxt; cA = nA; cB = nB; ++ui;
        if constexpr (ALIGN_EPI) { if (wr == 1) PG8_BAR; }
    }
    PG8_WAIT_V(0);
    if constexpr (!ALIGN_EPI) { if (wr == 0) PG8_BAR; }
    PG8_BAR;
    if constexpr (Epi::AFTER_DRAIN) { E.fused(acc, cur, wr, wc, fr, fq, lds, wid, lane); S.done(cur); }
#undef PG8_SA
#undef PG8_SB
#undef PG8_STAGE
#undef PG8_LDA
#undef PG8_LDB
#undef PG8_MMA
#undef PG8_WAIT_V
#undef PG8_WAIT_L
#undef PG8_BAR
#undef PG8_SCHED
}
}
#define GAS __attribute__((address_space(1)))
#define LAS __attribute__((address_space(3)))
typedef unsigned short bf16;
typedef unsigned v4u __attribute__((ext_vector_type(4)));
typedef unsigned v2u __attribute__((ext_vector_type(2)));
typedef int v4i __attribute__((ext_vector_type(4)));
typedef float f32x4 __attribute__((ext_vector_type(4)));
typedef float f32x2 __attribute__((ext_vector_type(2)));
typedef short bf16x8 __attribute__((ext_vector_type(8)));
typedef __bf16 bf16x2_t __attribute__((ext_vector_type(2)));
typedef GAS unsigned gu32;
#define RLX_AGENT __ATOMIC_RELAXED, __HIP_MEMORY_SCOPE_AGENT
#define LDS_WAIT() asm volatile("s_waitcnt lgkmcnt(0)" ::: "memory")
#define VM_WAIT() asm volatile("s_waitcnt vmcnt(0)" ::: "memory")
__device__ __forceinline__ unsigned f2bf(float f) { unsigned u = __builtin_bit_cast(unsigned, f); return (u + 0x7fffu + ((u >> 16) & 1u)) >> 16; }
__device__ __forceinline__ unsigned pk2(float lo, float hi) { return pg8::cvt_pk_bf16(lo, hi); }
__device__ __forceinline__ float bflo(unsigned w) { return __builtin_bit_cast(float, w << 16); }
__device__ __forceinline__ float bfhi(unsigned w) { return __builtin_bit_cast(float, w & 0xffff0000u); }
__device__ __forceinline__ float wave_sum(float v) {
#pragma unroll
    for (int o = 1; o < 64; o <<= 1) v += __shfl_xor(v, o);
    return v;
}
__device__ __forceinline__ float wave_max(float v) {
#pragma unroll
    for (int o = 1; o < 64; o <<= 1) v = fmaxf(v, __shfl_xor(v, o));
    return v;
}
__device__ __forceinline__ float gelu1(float v) { const f32x2 r = pg8::gelu_pk((f32x2){v, 0.f}); return r.x; }
#define XB_TMO      128
#define XB_XCNT(j)  (256  + 64 * (j))
#define XB_XSUB(j)  (1280 + 64 * (j))
#define XB_XGEN(j)  (2304 + 64 * (j))
#define XB_TOP      3328
#define XB_TOPGEN   3392
#define XCD_BAR_WORDS 3456
#define XB_SPIN_CAP (1u << 18)

__device__ __forceinline__ unsigned xb_ld(unsigned* p)              { return __hip_atomic_load(p, __ATOMIC_RELAXED, __HIP_MEMORY_SCOPE_AGENT); }
__device__ __forceinline__ unsigned xb_add(unsigned* p, unsigned v) { return __hip_atomic_fetch_add(p, v, __ATOMIC_RELAXED, __HIP_MEMORY_SCOPE_AGENT); }
__device__ __forceinline__ unsigned xb_xcc_id() { return (unsigned)__builtin_amdgcn_s_getreg((3 << 11) | 20) & 0xFu; }
#define XB_SPIN(cond, bar) do { unsigned _sp = 0; while (cond) { __builtin_amdgcn_s_sleep(1); \
    if ((++_sp & 255u) == 0u) { if (xb_ld(&(bar)[XB_TMO])) break; if (_sp > XB_SPIN_CAP) { atomicAdd(&(bar)[XB_TMO], 1u); break; } } } } while (0)

struct XcdBarrier {
    unsigned* bar; unsigned x;
    volatile LAS unsigned* st;
};

__device__ __forceinline__ XcdBarrier xcd_barrier_post(unsigned* bar, volatile LAS unsigned* st) {
    XcdBarrier b; b.bar = bar; b.x = xb_xcc_id(); b.st = st;
    if (threadIdx.x == 0) (void)xb_add(&bar[XB_XCNT(b.x)], 1u);
    return b;
}
__device__ __forceinline__ void xcd_barrier_complete(unsigned* bar, unsigned x, unsigned& nloc, unsigned& nx) {
    const unsigned G = gridDim.x * gridDim.y * gridDim.z;
    unsigned sum, cnt, mine, sp = 0u;
    for (;;) {
        sum = 0u; cnt = 0u; mine = 0u;
#pragma unroll
        for (unsigned j = 0; j < 16; ++j) { const unsigned c = xb_ld(&bar[XB_XCNT(j)]); sum += c; cnt += (c > 0u) ? 1u : 0u; mine = (j == x) ? c : mine; }
        if (sum == G) break;
        __builtin_amdgcn_s_sleep(1);
        if ((++sp & 255u) == 0u) { if (xb_ld(&bar[XB_TMO])) break; if (sp > XB_SPIN_CAP) { atomicAdd(&bar[XB_TMO], 1u); break; } }
    }
    nloc = mine > 0u ? mine : 1u; nx = cnt > 0u ? cnt : 1u;
}

__device__ __forceinline__ void xcd_barrier(const XcdBarrier& b) {
    asm volatile("s_waitcnt vmcnt(0)" ::: "memory");
    __syncthreads();
    if (threadIdx.x == 0) {
        unsigned* bar = b.bar;
        __builtin_amdgcn_s_waitcnt(0);
        unsigned nloc = b.st[0], nx = b.st[1];
        if (nloc == 0u) { xcd_barrier_complete(bar, b.x, nloc, nx); b.st[0] = nloc; b.st[1] = nx; }
        const unsigned old = xb_add(&bar[XB_XSUB(b.x)], 1u);
        const unsigned gen = old / nloc;
        if (old + 1u == (gen + 1u) * nloc) {
            __builtin_amdgcn_fence(__ATOMIC_RELEASE, "agent");
            asm volatile("s_waitcnt vmcnt(0)" ::: "memory");
            const unsigned og = xb_add(&bar[XB_TOP], 1u);
            const unsigned tg = og / nx;
            if (og + 1u == (tg + 1u) * nx) xb_add(&bar[XB_TOPGEN], 1u);
            else XB_SPIN(xb_ld(&bar[XB_TOPGEN]) == tg, bar);
            __builtin_amdgcn_fence(__ATOMIC_ACQUIRE, "agent");
            xb_add(&bar[XB_XGEN(b.x)], 1u);
            asm volatile("s_waitcnt vmcnt(0)" ::: "memory");
        } else {
            XB_SPIN(xb_ld(&bar[XB_XGEN(b.x)]) == gen, bar);
            __builtin_amdgcn_fence(__ATOMIC_ACQUIRE, "agent");
            asm volatile("s_waitcnt vmcnt(0)" ::: "memory");
        }
    }
    __syncthreads();
}
constexpr int NWAVES = 8;
constexpr int D = 1024, NB = 8, SEQ = 2048, TP = NB * SEQ, DB = 128, DSQ = 4, TS = DB * DSQ, T = TP + TS;
constexpr int MEMT = 256, NH = 4, HD = 256, MROWS = NB * MEMT;
constexpr int NEXP = 16384;
constexpr float RMS_EPS = 1e-6f;
constexpr size_t O_Y = 0, O_SRP = 17301504, O_SIP = 17334272, O_CP = 17367040, O_MK = 17383424, O_MV = 21577728, O_SRS = 25772032, O_SIS = 26296320, O_CS = 26820608, O_END = 27082752;
enum { I_XP = 0, I_XS, I_MEM, I_SRE, I_SIM, I_SCONV, I_CK, I_CV, I_NMIX, I_NMEM, I_NFFN, I_NFIN, I_ARE, I_AIM, I_LDT, I_BRE, I_BIM, I_CRE, I_CIM, I_SD, I_WGLU, I_WIN, I_CW, I_WOUT,
       I_WQ, I_WK, I_WV, I_WO, I_PWQ, I_K1, I_K2, I_PU, I_PV, N_IN };
constexpr int R_KV = 0, R_GLU = 4096, R_Q = 6144, R_O = 8192, R_PQ = 10240, R_WIN = 14336, R_WOUT = 17408, R_END = 18432;
constexpr size_t MiB = 1u << 20;
constexpr size_t WS_CTL = 0, CTL_ZERO_BYTES = 1 * MiB;
constexpr size_t WS_WALL = 2 * MiB;
constexpr size_t WS_KEYS = 38 * MiB;
constexpr size_t WS_BBW = 39 * MiB;
constexpr size_t WS_CCW = 39 * MiB + 512 * 1024;
constexpr size_t WS_LB = 40 * MiB;
constexpr size_t WS_MEMB = 41 * MiB;
constexpr size_t WS_KB = 45 * MiB;
constexpr size_t WS_VT = 53 * MiB;
constexpr size_t WS_EID = 61 * MiB;
constexpr size_t WS_EG = 70 * MiB;
constexpr size_t WS_HB = 80 * MiB;
constexpr size_t WS_ZB = 114 * MiB;
constexpr size_t WS_QB = 148 * MiB;
constexpr size_t WS_QP = 182 * MiB;
constexpr size_t WS_B1 = 249 * MiB;
constexpr size_t WS_V1 = 283 * MiB;
constexpr size_t WS_UV = 320 * MiB;
constexpr size_t WS_SSQ = 384 * MiB;
constexpr size_t WS_KT = 388 * MiB;
constexpr size_t WS_CP = 389 * MiB;
constexpr size_t WS_WE = 393 * MiB;
constexpr size_t WS_LB16 = 397 * MiB;
constexpr size_t WS_END = 398 * MiB;
constexpr int CW_BAR = 4096;
constexpr int RING_OFF = 0, RING_BYTES = 131072;
constexpr int LDSCTL_OFF = 146432, MISC_OFF = LDSCTL_OFF + 320;
constexpr int LDS_BYTES = 147456;
using pg8::Unit;
struct EpiKV {
    static constexpr bool PERM = false, AFTER_DRAIN = false;
    float* out; bf16* KB; bf16* VT;
    __device__ __forceinline__ void operator()(const f32x4 (&acc)[2][2][4][2], const Unit& u, int wr, int wc, int fr, int fq) const {
        fr = (int)pg8::pg8_vo((unsigned)fr); fq = (int)pg8::pg8_vo((unsigned)fq);
        const int b = u.pm, mat = u.pn >> 2, l = mat >> 1, isv = mat & 1, h = u.pn & 3;
        float* ob = out + (isv ? O_MV : O_MK) + (size_t)(l * NB + b) * MEMT * D + h * HD;
#pragma unroll
        for (int ai = 0; ai < 2; ++ai)
#pragma unroll
            for (int m = 0; m < 4; ++m) { const int mm = ai * 128 + wr * 64 + m * 16 + fr;
#pragma unroll
                for (int bj = 0; bj < 2; ++bj)
#pragma unroll
                    for (int n = 0; n < 2; ++n) { const int dl = bj * 128 + wc * 32 + n * 16 + 4 * fq; const f32x4 v = acc[ai][bj][m][n];
                        *(f32x4*)(ob + (size_t)mm * D + dl) = v;
                        if (!isv) { v2u w; w.x = pk2(v[0], v[1]); w.y = pk2(v[2], v[3]); *(v2u*)(KB + ((size_t)l * MROWS + b * MEMT + mm) * D + h * HD + dl) = w; }
                        else { bf16* vp = VT + ((((size_t)l * NB + b) * NH + h) * HD + dl) * MEMT + ((mm & ~31) | (((mm >> 2) & 3) << 3) | (((mm >> 4) & 1) << 2) | (mm & 3));
#pragma unroll
                            for (int j = 0; j < 4; ++j) vp[(size_t)j * MEMT] = (bf16)f2bf(v[j]); } } }
    }
};
struct EpiGLU {
    static constexpr bool PERM = false, AFTER_DRAIN = false;
    const float* xp; float* XR; bf16* HBo; float* SSQ; const float* gnext;
    __device__ __forceinline__ void operator()(const f32x4 (&acc)[2][2][4][2], const Unit& u, int wr, int wc, int fr, int fq) const {
        fr = (int)pg8::pg8_vo((unsigned)fr); fq = (int)pg8::pg8_vo((unsigned)fq);
        const int row0 = u.pm * 256 + wr * 64 + fr, col0 = u.pn * 128 + wc * 32 + 4 * fq;
        const f32x4 g0 = *(const f32x4*)(gnext + col0), g1 = *(const f32x4*)(gnext + col0 + 16);
#pragma unroll
        for (int ai = 0; ai < 2; ++ai)
#pragma unroll
            for (int mp = 0; mp < 2; ++mp) { f32x4 xv[2][2];
#pragma unroll
                for (int mm = 0; mm < 2; ++mm)
#pragma unroll
                    for (int n = 0; n < 2; ++n) xv[mm][n] = *(const f32x4*)(xp + (size_t)(row0 + ai * 128 + (2 * mp + mm) * 16) * D + col0 + n * 16);
#pragma unroll
                for (int mm = 0; mm < 2; ++mm) { const int m = 2 * mp + mm, row = row0 + ai * 128 + m * 16; const size_t ro = (size_t)row * D + col0; float ss = 0.f;
#pragma unroll
                    for (int n = 0; n < 2; ++n) { const f32x4 a = acc[ai][0][m][n], b = acc[ai][1][m][n]; f32x4 o;
#pragma unroll
                        for (int j = 0; j < 4; ++j) { o[j] = xv[mm][n][j] + a[j] / (1.0f + __expf(-b[j])); ss = fmaf(o[j], o[j], ss); }
                        *(f32x4*)(XR + ro + n * 16) = o; const f32x4 hg = o * (n ? g1 : g0); v2u w; w.x = pk2(hg[0], hg[1]); w.y = pk2(hg[2], hg[3]); *(v2u*)(HBo + ro + n * 16) = w; }
                    ss += __shfl_xor(ss, 16); ss += __shfl_xor(ss, 32);
                    if (fq == 0) SSQ[(size_t)row * 32 + u.pn * 4 + wc] = ss; }
                asm volatile("" ::: "memory"); }
    }
};
__device__ __forceinline__ float row_rinv(const float* SSQ, size_t row, int nslots) {
    const f32x4* p = (const f32x4*)(SSQ + row * 32); f32x4 s = p[0] + p[1] + p[2] + p[3];
    if (nslots > 16) s += p[4] + p[5] + p[6] + p[7];
    return 1.0f / sqrtf(((s[0] + s[1]) + (s[2] + s[3])) * (1.0f / D) + RMS_EPS);
}
struct EpiB16 {
    static constexpr bool PERM = true, AFTER_DRAIN = false;
    bf16* O; int ldc; const float* SSQ; int nslots;
    __device__ __forceinline__ void operator()(const f32x4 (&acc)[2][2][4][2], const Unit& u, int wr, int wc, int fr, int fq) const {
        fr = (int)pg8::pg8_vo((unsigned)fr); fq = (int)pg8::pg8_vo((unsigned)fq);
        const int rb = u.pm * 256 + wr * 64, row0 = rb + fr, col0 = u.pn * 256 + wc * 32 + 8 * fq, ln = fq * 16 + fr;
        const float r0 = row_rinv(SSQ, (size_t)(rb + ln), nslots), r1 = row_rinv(SSQ, (size_t)(rb + 128 + ln), nslots);
#pragma unroll
        for (int ai = 0; ai < 2; ++ai)
#pragma unroll
            for (int m = 0; m < 4; ++m) { const size_t row = (size_t)(row0 + ai * 128 + m * 16); bf16* rowp = O + row * ldc + col0; const float ri = __shfl(ai ? r1 : r0, m * 16 + fr);
#pragma unroll
                for (int bj = 0; bj < 2; ++bj) { const f32x4 v0 = acc[ai][bj][m][0] * ri, v1 = acc[ai][bj][m][1] * ri;
                    v4u w; w.x = pk2(v0[0], v0[1]); w.y = pk2(v0[2], v0[3]); w.z = pk2(v1[0], v1[1]); w.w = pk2(v1[2], v1[3]);
                    *(v4u*)(rowp + bj * 128) = w; } }
    }
};
struct EpiRes {
    static constexpr bool PERM = false, AFTER_DRAIN = false;
    float* XR; bf16* HBo; float* SSQ; const float* gnext;
    __device__ __forceinline__ void operator()(const f32x4 (&acc)[2][2][4][2], const Unit& u, int wr, int wc, int fr, int fq) const {
        fr = (int)pg8::pg8_vo((unsigned)fr); fq = (int)pg8::pg8_vo((unsigned)fq);
        const int row0 = u.pm * 256 + wr * 64 + fr, col0 = u.pn * 256 + wc * 32 + 4 * fq;
        f32x4 gv[2][2];
#pragma unroll
        for (int bj = 0; bj < 2; ++bj)
#pragma unroll
            for (int n = 0; n < 2; ++n) gv[bj][n] = *(const f32x4*)(gnext + col0 + bj * 128 + n * 16);
#pragma unroll
        for (int ai = 0; ai < 2; ++ai)
#pragma unroll
            for (int mp = 0; mp < 2; ++mp) { f32x4 xv[2][2][2];
#pragma unroll
                for (int mm = 0; mm < 2; ++mm)
#pragma unroll
                    for (int bj = 0; bj < 2; ++bj)
#pragma unroll
                        for (int n = 0; n < 2; ++n) xv[mm][bj][n] = *(const f32x4*)(XR + (size_t)(row0 + ai * 128 + (2 * mp + mm) * 16) * D + col0 + bj * 128 + n * 16);
#pragma unroll
                for (int mm = 0; mm < 2; ++mm) { const int m = 2 * mp + mm, row = row0 + ai * 128 + m * 16; const size_t ro = (size_t)row * D + col0; float ss = 0.f;
#pragma unroll
                    for (int bj = 0; bj < 2; ++bj)
#pragma unroll
                        for (int n = 0; n < 2; ++n) { const f32x4 o = xv[mm][bj][n] + acc[ai][bj][m][n]; *(f32x4*)(XR + ro + bj * 128 + n * 16) = o;
                            ss = fmaf(o[0], o[0], fmaf(o[1], o[1], fmaf(o[2], o[2], fmaf(o[3], o[3], ss))));
                            const f32x4 hg = o * gv[bj][n]; v2u w; w.x = pk2(hg[0], hg[1]); w.y = pk2(hg[2], hg[3]); *(v2u*)(HBo + ro + bj * 128 + n * 16) = w; }
                    ss += __shfl_xor(ss, 16); ss += __shfl_xor(ss, 32);
                    if (fq == 0) SSQ[(size_t)row * 32 + u.pn * 4 + wc] = ss; }
                asm volatile("" ::: "memory"); }
    }
};
struct EpiWin {
    static constexpr bool PERM = false, AFTER_DRAIN = false;
    bf16* B1; bf16* V1; float* out;
    __device__ __forceinline__ void operator()(const f32x4 (&acc)[2][2][4][2], const Unit& u, int wr, int wc, int fr, int fq) const {
        fr = (int)pg8::pg8_vo((unsigned)fr); fq = (int)pg8::pg8_vo((unsigned)fq);
        const int row0 = u.pm * 256 + wr * 64 + fr;
        if (u.pn < 8) {
#pragma unroll
            for (int ai = 0; ai < 2; ++ai)
#pragma unroll
                for (int m = 0; m < 4; ++m) { const int row = row0 + ai * 128 + m * 16; const int col0 = u.pn * 128 + wc * 32 + 4 * fq;
                    float* cs = nullptr;
                    { const int s = row & (SEQ - 1); if (s >= SEQ - 2) cs = out + O_CP + ((size_t)(row >> 11) * 2 + (s - (SEQ - 2))) * D; }
#pragma unroll
                    for (int n = 0; n < 2; ++n) { const f32x4 v = acc[ai][0][m][n] * acc[ai][1][m][n];
                        v2u w; w.x = pk2(v[0], v[1]); w.y = pk2(v[2], v[3]); *(v2u*)(V1 + (size_t)row * D + col0 + n * 16) = w;
                        if (cs) *(f32x4*)(cs + col0 + n * 16) = v; } }
        } else {
#pragma unroll
            for (int ai = 0; ai < 2; ++ai)
#pragma unroll
                for (int m = 0; m < 4; ++m) { bf16* rowp = B1 + (size_t)(row0 + ai * 128 + m * 16) * D + (u.pn - 8) * 256 + wc * 32 + 4 * fq;
#pragma unroll
                    for (int bj = 0; bj < 2; ++bj)
#pragma unroll
                        for (int n = 0; n < 2; ++n) { const f32x4 v = acc[ai][bj][m][n]; v2u w; w.x = pk2(v[0], v[1]); w.y = pk2(v[2], v[3]); *(v2u*)(rowp + bj * 128 + n * 16) = w; } }
        }
    }
};
__device__ __forceinline__ bf16x8 mk8(v4u w) { return __builtin_bit_cast(bf16x8, w); }
__device__ __forceinline__ f32x4 mfma16(bf16x8 a, bf16x8 b, f32x4 c) { return __builtin_amdgcn_mfma_f32_16x16x32_bf16(a, b, c, 0, 0, 0); }

__device__ __forceinline__ void p0_transpose_item(const float* W, int N, int src_n0, bf16* WTrows, int k0, LAS float* scr, int lane) {
#pragma unroll
    for (int i = 0; i < 8; ++i) { const int kk = 8 * i + (lane >> 3), n4 = (lane & 7) * 4; const f32x4 v = *(const f32x4*)(W + (size_t)(k0 + kk) * N + src_n0 + n4);
        scr[kk * 33 + n4] = v[0]; scr[kk * 33 + n4 + 1] = v[1]; scr[kk * 33 + n4 + 2] = v[2]; scr[kk * 33 + n4 + 3] = v[3]; }
    LDS_WAIT();
    const int c = lane & 7;
#pragma unroll
    for (int j = 0; j < 4; ++j) { const int n = (lane >> 3) + 8 * j; const LAS float* s = scr + (8 * c) * 33 + n;
        v4u o; o.x = pk2(s[0 * 33], s[1 * 33]); o.y = pk2(s[2 * 33], s[3 * 33]); o.z = pk2(s[4 * 33], s[5 * 33]); o.w = pk2(s[6 * 33], s[7 * 33]);
        *(v4u*)(WTrows + (size_t)n * D + k0 + 8 * c) = o; }
    LDS_WAIT();
}
__device__ __forceinline__ void rms_row_bf16(const float* xrow, const float* g, bf16* orow, int lane) {
    const f32x4* xr = (const f32x4*)xrow + lane; f32x4 v[4]; float s = 0.f;
#pragma unroll
    for (int j = 0; j < 4; ++j) { v[j] = xr[64 * j]; s += (v[j].x * v[j].x + v[j].y * v[j].y) + (v[j].z * v[j].z + v[j].w * v[j].w); }
    const float r = 1.0f / sqrtf(wave_sum(s) * (1.0f / D) + RMS_EPS);
#pragma unroll
    for (int j = 0; j < 4; ++j) { const f32x4 gv = ((const f32x4*)g)[lane + 64 * j]; v2u w; w.x = pk2(v[j].x * r * gv.x, v[j].y * r * gv.y); w.y = pk2(v[j].z * r * gv.z, v[j].w * r * gv.w);
        *(v2u*)(orow + 4 * lane + 256 * j) = w; }
}

#define LDS_ORDER() asm volatile("" ::: "memory")
template <bool SAMPLE, bool WITH_Y>
__device__ __forceinline__ void s5_run(const bf16* HB, bf16* ZB, const bf16* BBW, const bf16* CCW, const float* dsk, LAS float* ST, int lane,
                                       int g, int row0, int nchunks, int b0, const float* s0re, const float* s0im, float* ore, float* oim, float lbr, float lbi, float& sr, float& si) {
    const int tl = lane & 15, q4 = lane >> 4;
    const bf16x8 zero8 = {0, 0, 0, 0, 0, 0, 0, 0};
    bf16x8 Abb[8], Acc[4];
#pragma unroll
    for (int tt = 0; tt < 8; ++tt) Abb[tt] = (q4 < 2) ? *(const bf16x8*)(BBW + ((size_t)(g * 128 + 16 * tt + tl)) * 16 + 8 * q4) : zero8;
    if (WITH_Y) {
#pragma unroll
        for (int s = 0; s < 4; ++s) Acc[s] = *(const bf16x8*)(CCW + ((size_t)(g * 16 + tl)) * 128 + 32 * s + 8 * q4); }
    const f32x4 dv = WITH_Y ? *(const f32x4*)(dsk + 16 * g + 4 * q4) : (f32x4){0.f, 0.f, 0.f, 0.f};
    const bf16* hp = HB + (size_t)(row0 + tl) * D + 16 * g;
    bf16x8 Bn = (q4 < 2) ? *(const bf16x8*)(hp + 8 * q4) : zero8; v2u hn = WITH_Y ? *(const v2u*)(hp + 4 * q4) : (v2u){0u, 0u};
    for (int ch = 0; ch < nchunks; ++ch) {
        const int rowc = row0 + 16 * ch;
        const bf16x8 Bu = Bn; const v2u hw = hn;
        if (ch + 1 < nchunks) { const bf16* hq = hp + (size_t)(16 * (ch + 1)) * D; Bn = (q4 < 2) ? *(const bf16x8*)(hq + 8 * q4) : zero8; if (WITH_Y) hn = *(const v2u*)(hq + 4 * q4); }
#pragma unroll
        for (int tt = 0; tt < 8; ++tt) { const f32x4 a = mfma16(Abb[tt], Bu, (f32x4){0.f, 0.f, 0.f, 0.f}); *(LAS f32x4*)(ST + tl * 132 + 16 * tt + 4 * q4) = a; }
        LDS_ORDER();
        float br[16], bi[16];
#pragma unroll
        for (int t = 0; t < 16; ++t) { br[t] = ST[t * 132 + lane]; bi[t] = ST[t * 132 + 64 + lane]; }
#pragma unroll
        for (int t = 0; t < 16; ++t) {
            if (SAMPLE && (t & 3) == 0) { const size_t si0 = ((size_t)(b0 + (t >> 2)) * 64 + g) * 64 + lane; sr = s0re[si0]; si = s0im[si0]; }
            const float nr = fmaf(-lbi, si, fmaf(lbr, sr, br[t])), ni = fmaf(lbi, sr, fmaf(lbr, si, bi[t]));
            sr = nr; si = ni;
            if (WITH_Y) { ST[t * 132 + lane] = sr; ST[t * 132 + 64 + lane] = si; }
            if (SAMPLE && (t & 3) == 3) { const size_t so = ((size_t)(b0 + (t >> 2)) * 64 + g) * 64 + lane; ore[so] = sr; oim[so] = si; }
        }
        LDS_ORDER();
        if (WITH_Y) {
            f32x4 y = {0.f, 0.f, 0.f, 0.f};
#pragma unroll
            for (int s = 0; s < 4; ++s) { const f32x4 lo = *(const LAS f32x4*)(ST + tl * 132 + 32 * s + 8 * q4), hi = *(const LAS f32x4*)(ST + tl * 132 + 32 * s + 8 * q4 + 4);
                v4u w; w.x = pk2(lo[0], lo[1]); w.y = pk2(lo[2], lo[3]); w.z = pk2(hi[0], hi[1]); w.w = pk2(hi[2], hi[3]);
                y = mfma16(Acc[s], mk8(w), y); }
            LDS_ORDER();
            y[0] = fmaf(dv[0], bflo(hw.x), y[0]); y[1] = fmaf(dv[1], bfhi(hw.x), y[1]); y[2] = fmaf(dv[2], bflo(hw.y), y[2]); y[3] = fmaf(dv[3], bfhi(hw.y), y[3]);
            const f32x2 g0 = pg8::gelu_pk((f32x2){y[0], y[1]}), g1 = pg8::gelu_pk((f32x2){y[2], y[3]});
            v2u zo; zo.x = pk2(g0.x, g0.y); zo.y = pk2(g1.x, g1.y);
            *(v2u*)(ZB + (size_t)(rowc + tl) * D + 16 * g + 4 * q4) = zo;
        }
    }
}
constexpr int S5_ST_BYTES = 8448, S5_XE_OFF = 8 * S5_ST_BYTES;
constexpr int S5_MAT_OFF = S5_XE_OFF + 4096, S5_KT_OFF = S5_MAT_OFF + 65536, S5_LDS_END = S5_KT_OFF + 8704;
__device__ __forceinline__ void s5_prompt_seq(const bf16* HB, bf16* ZB, const bf16* KT, const bf16* CP, const bf16* WE, const float* LB16, const float* dsk, LAS unsigned char* lds, int tid, int b, int g, float* ore, float* oim) {
    const int lane = tid & 63, seg = tid >> 6, tl = lane & 15, q4 = lane >> 4;
    LAS float* ST = (LAS float*)(lds + seg * S5_ST_BYTES); LAS float* XE = (LAS float*)(lds + S5_XE_OFF);
    LAS unsigned char* MAT = lds + S5_MAT_OFF; LAS unsigned char* KTL = lds + S5_KT_OFF;
    const float l16r = LB16[(g * 64 + lane) * 2], l16i = LB16[(g * 64 + lane) * 2 + 1];
    const int row0 = b * SEQ + seg * 256;
    { const bf16* wsrc = WE + (size_t)g * 128 * 256;
#pragma unroll
      for (int i = 0; i < 8; ++i) { const int c = tid + 512 * i, row = c >> 5, ch = c & 31; *(LAS v4u*)(MAT + row * 512 + ((ch ^ (row & 15)) << 4)) = *(const v4u*)(wsrc + (size_t)row * 256 + ch * 8); }
      const bf16* ksrc = KT + (size_t)g * 17 * 256;
      for (int c = tid; c < 544; c += 512) *(LAS v4u*)(KTL + c * 16) = *(const v4u*)(ksrc + c * 8); }
    bf16x8 Uf[8];
    { const bf16* up = HB + (size_t)(row0 + 16 * tl + (q4 >> 1)) * D + 16 * g + 8 * (q4 & 1);
#pragma unroll
      for (int ks = 0; ks < 8; ++ks) Uf[ks] = *(const bf16x8*)(up + (size_t)(2 * ks) * D); }
    __syncthreads();
#pragma unroll 2
    for (int mt = 0; mt < 8; ++mt) { f32x4 a = {0.f, 0.f, 0.f, 0.f};
#pragma unroll
        for (int ks = 0; ks < 8; ++ks) a = mfma16(*(const LAS bf16x8*)(MAT + (16 * mt + tl) * 512 + (((4 * ks + q4) ^ tl) << 4)), Uf[ks], a);
        *(LAS f32x4*)(ST + tl * 132 + 16 * mt + 4 * q4) = a; }
    LDS_ORDER();
    float er[16], ei[16];
#pragma unroll
    for (int j = 0; j < 16; ++j) { er[j] = ST[j * 132 + lane]; ei[j] = ST[j * 132 + 64 + lane]; }
    float sr = 0.f, si = 0.f;
#pragma unroll
    for (int j = 0; j < 16; ++j) { const float nr = fmaf(-l16i, si, fmaf(l16r, sr, er[j])), ni = fmaf(l16i, sr, fmaf(l16r, si, ei[j])); sr = nr; si = ni; }
    XE[(seg * 64 + lane) * 2] = sr; XE[(seg * 64 + lane) * 2 + 1] = si;
    float pr = l16r, pi = l16i;
#pragma unroll
    for (int k = 0; k < 4; ++k) { const float nr = pr * pr - pi * pi, ni = 2.f * pr * pi; pr = nr; pi = ni; }
    __syncthreads();
    { const bf16* csrc = CP + (size_t)g * 256 * 128;
#pragma unroll
      for (int i = 0; i < 8; ++i) { const int c = tid + 512 * i, row = c >> 4, ch = c & 15; *(LAS v4u*)(MAT + row * 256 + ((ch ^ (row & 15)) << 4)) = *(const v4u*)(csrc + (size_t)row * 128 + ch * 8); } }
    float cr = 0.f, ci = 0.f;
    for (int sp = 0; sp < seg; ++sp) { const float xr_ = XE[(sp * 64 + lane) * 2], xi_ = XE[(sp * 64 + lane) * 2 + 1]; const float nr = pr * cr - pi * ci + xr_, ni = pr * ci + pi * cr + xi_; cr = nr; ci = ni; }
    sr = cr; si = ci;
#pragma unroll
    for (int j = 0; j < 16; ++j) { ST[j * 132 + lane] = sr; ST[j * 132 + 64 + lane] = si;
        const float nr = fmaf(-l16i, si, fmaf(l16r, sr, er[j])), ni = fmaf(l16i, sr, fmaf(l16r, si, ei[j])); sr = nr; si = ni; }
    if (seg == 7) { const size_t so = ((size_t)b * 64 + g) * 64 + lane; ore[so] = sr; oim[so] = si; }
    __syncthreads();
    bf16x8 Cf[4];
#pragma unroll
    for (int k4 = 0; k4 < 4; ++k4) { const f32x4 lo = *(const LAS f32x4*)(ST + tl * 132 + 32 * k4 + 8 * q4), hi = *(const LAS f32x4*)(ST + tl * 132 + 32 * k4 + 8 * q4 + 4);
        v4u w; w.x = pk2(lo[0], lo[1]); w.y = pk2(lo[2], lo[3]); w.z = pk2(hi[0], hi[1]); w.w = pk2(hi[2], hi[3]); Cf[k4] = mk8(w); }
    const f32x4 dv = *(const f32x4*)(dsk + 16 * g + 4 * q4);
    const LAS unsigned char* kp = KTL + tl * 32 + 16 * (q4 & 1);
    const bf16* hp = HB + (size_t)(row0 + 16 * tl) * D + 16 * g + 4 * q4; bf16* zp = ZB + (size_t)(row0 + 16 * tl) * D + 16 * g + 4 * q4;
    v2u hw[16];
#pragma unroll
    for (int t = 0; t < 16; ++t) hw[t] = *(const v2u*)(hp + (size_t)t * D);
#pragma unroll
    for (int t = 0; t < 16; ++t) { f32x4 y = {0.f, 0.f, 0.f, 0.f};
#pragma unroll
        for (int ks = 0; ks <= (t >> 1); ++ks) { const int tau = t - 2 * ks - (q4 >> 1); const int blk = tau >= 0 ? tau + 1 : 0; y = mfma16(*(const LAS bf16x8*)(kp + blk * 512), Uf[ks], y); }
#pragma unroll
        for (int k4 = 0; k4 < 4; ++k4) y = mfma16(*(const LAS bf16x8*)(MAT + (16 * t + tl) * 256 + (((4 * k4 + q4) ^ tl) << 4)), Cf[k4], y);
        y[0] = fmaf(dv[0], bflo(hw[t].x), y[0]); y[1] = fmaf(dv[1], bfhi(hw[t].x), y[1]); y[2] = fmaf(dv[2], bflo(hw[t].y), y[2]); y[3] = fmaf(dv[3], bfhi(hw[t].y), y[3]);
        const f32x2 g0 = pg8::gelu_pk((f32x2){y[0], y[1]}), g1 = pg8::gelu_pk((f32x2){y[2], y[3]});
        v2u zo; zo.x = pk2(g0.x, g0.y); zo.y = pk2(g1.x, g1.y);
        *(v2u*)(zp + (size_t)t * D) = zo; }
    __syncthreads();
}

__device__ __forceinline__ float xreduce16(const float (&p)[16], int lane) {
    float q[8], r[4], s[2];
    const bool b5 = (lane & 32) != 0, b4 = (lane & 16) != 0, b3 = (lane & 8) != 0, b2 = (lane & 4) != 0;
#pragma unroll
    for (int k = 0; k < 8; ++k) { const float send = b5 ? p[k] : p[k + 8], keep = b5 ? p[k + 8] : p[k]; q[k] = keep + __shfl_xor(send, 32); }
#pragma unroll
    for (int k = 0; k < 4; ++k) { const float send = b4 ? q[k] : q[k + 4], keep = b4 ? q[k + 4] : q[k]; r[k] = keep + __shfl_xor(send, 16); }
#pragma unroll
    for (int k = 0; k < 2; ++k) { const float send = b3 ? r[k] : r[k + 2], keep = b3 ? r[k + 2] : r[k]; s[k] = keep + __shfl_xor(send, 8); }
    const float send = b2 ? s[0] : s[1], keep = b2 ? s[1] : s[0]; float t = keep + __shfl_xor(send, 4);
    t += __shfl_xor(t, 2); t += __shfl_xor(t, 1);
    return t;
}

__host__ __device__ __forceinline__ int vt_pos(int m) { return (m & ~31) | (((m >> 2) & 3) << 3) | (((m >> 4) & 1) << 2) | (m & 3); }
__device__ __forceinline__ void stage_tile256(const bf16* src, int ldsrc, LAS unsigned char* tb, int tid) {
#pragma unroll 1
    for (int hp = 0; hp < 2; ++hp) { v4u r[8];
#pragma unroll
        for (int i = 0; i < 8; ++i) { const int c = tid + 512 * (8 * hp + i), row = c >> 5, ch = c & 31; r[i] = *(const v4u*)(src + (size_t)row * ldsrc + ch * 8); }
#pragma unroll
        for (int i = 0; i < 8; ++i) { const int c = tid + 512 * (8 * hp + i), row = c >> 5, ch = c & 31; *(LAS v4u*)(tb + row * 512 + ((ch ^ (row & 15)) << 4)) = r[i]; } }
}
__device__ __forceinline__ float attn_softmax(f32x4 (&S)[16], bf16x8 (&Pf)[8]) {
    float mx = -3.0e38f;
#pragma unroll
    for (int mt = 0; mt < 16; ++mt) mx = fmaxf(fmaxf(mx, fmaxf(S[mt][0], S[mt][1])), fmaxf(S[mt][2], S[mt][3]));
    mx = fmaxf(mx, __shfl_xor(mx, 16)); mx = fmaxf(mx, __shfl_xor(mx, 32));
    const float sc2 = 0.0625f * 1.4426950408889634f; float sum = 0.f;
#pragma unroll
    for (int mt = 0; mt < 16; ++mt)
#pragma unroll
        for (int i = 0; i < 4; ++i) { const float p = __builtin_amdgcn_exp2f((S[mt][i] - mx) * sc2); S[mt][i] = p; sum += p; }
    sum += __shfl_xor(sum, 16); sum += __shfl_xor(sum, 32);
#pragma unroll
    for (int ks = 0; ks < 8; ++ks) { v4u w; w.x = pk2(S[2 * ks][0], S[2 * ks][1]); w.y = pk2(S[2 * ks][2], S[2 * ks][3]); w.z = pk2(S[2 * ks + 1][0], S[2 * ks + 1][1]); w.w = pk2(S[2 * ks + 1][2], S[2 * ks + 1][3]); Pf[ks] = mk8(w); }
    return 1.0f / sum;
}
__device__ __forceinline__ void attn_prompt_wg(const bf16* QB, const bf16* KBl, const bf16* VTl, bf16* OB, int b, int h, int r0, LAS unsigned char* tb, int tid) {
    const int lane = tid & 63, w = tid >> 6, tl = lane & 15, q4 = lane >> 4;
    const size_t rowA = (size_t)b * SEQ + r0 + 16 * w + tl, rowB = rowA + 128;
    stage_tile256(KBl + (size_t)b * MEMT * D + h * HD, D, tb, tid);
    __syncthreads();
    f32x4 SA[16], SB[16];
#pragma unroll
    for (int mt = 0; mt < 16; ++mt) { SA[mt] = (f32x4){0.f, 0.f, 0.f, 0.f}; SB[mt] = (f32x4){0.f, 0.f, 0.f, 0.f}; }
    const bf16* qa = QB + rowA * D + h * HD + 8 * q4; const bf16* qb = QB + rowB * D + h * HD + 8 * q4;
    const LAS unsigned char* fb = tb + tl * 512;
#pragma unroll 2
    for (int ks = 0; ks < 8; ++ks) { const bf16x8 fa = *(const bf16x8*)(qa + 32 * ks), fbq = *(const bf16x8*)(qb + 32 * ks); const int co = ((4 * ks + q4) ^ tl) << 4;
#pragma unroll
        for (int mt = 0; mt < 16; ++mt) { const bf16x8 kf = *(const LAS bf16x8*)(fb + mt * 8192 + co); SA[mt] = mfma16(kf, fa, SA[mt]); SB[mt] = mfma16(kf, fbq, SB[mt]); } }
    bf16x8 PA[8], PB[8];
    const float invA = attn_softmax(SA, PA), invB = attn_softmax(SB, PB);
    __syncthreads();
    stage_tile256(VTl + ((size_t)b * NH + h) * HD * MEMT, MEMT, tb, tid);
    __syncthreads();
#pragma unroll 2
    for (int dt = 0; dt < 16; ++dt) { f32x4 oa = {0.f, 0.f, 0.f, 0.f}, ob = {0.f, 0.f, 0.f, 0.f};
#pragma unroll
        for (int ks = 0; ks < 8; ++ks) { const bf16x8 vf = *(const LAS bf16x8*)(fb + dt * 8192 + (((4 * ks + q4) ^ tl) << 4)); oa = mfma16(vf, PA[ks], oa); ob = mfma16(vf, PB[ks], ob); }
        v2u wa, wb; wa.x = pk2(oa[0] * invA, oa[1] * invA); wa.y = pk2(oa[2] * invA, oa[3] * invA); wb.x = pk2(ob[0] * invB, ob[1] * invB); wb.y = pk2(ob[2] * invB, ob[3] * invB);
        *(v2u*)(OB + rowA * D + h * HD + 16 * dt + 4 * q4) = wa; *(v2u*)(OB + rowB * D + h * HD + 16 * dt + 4 * q4) = wb; }
    __syncthreads();
}
__device__ __forceinline__ void attn_sample_task(const bf16* QB, const float* ck, const float* cv, bf16* OB, int l, int b, int h, LAS float* lds, int tid) {
    const int lane = tid & 63, w = tid >> 6;
    LAS float* sc = lds; LAS float* red = lds + 1024;
    const size_t cbase = ((((size_t)l * DB + b) * MEMT) * NH + h) * HD;
    const float* kp = ck + cbase + (size_t)(32 * w) * (NH * HD) + 4 * lane; const float* vp = cv + cbase + (size_t)(32 * w) * (NH * HD) + 4 * lane;
    f32x4 kr[32];
#pragma unroll
    for (int mi = 0; mi < 32; ++mi) kr[mi] = __builtin_nontemporal_load((const f32x4*)(kp + (size_t)mi * (NH * HD)));
    float qf[4][4];
#pragma unroll
    for (int s = 0; s < 4; ++s) { const v2u qw = *(const v2u*)(QB + (size_t)(TP + 4 * b + s) * D + h * HD + 4 * lane); qf[s][0] = bflo(qw.x); qf[s][1] = bfhi(qw.x); qf[s][2] = bflo(qw.y); qf[s][3] = bfhi(qw.y); }
#pragma unroll
    for (int gi = 0; gi < 8; ++gi) { float pd[16];
#pragma unroll
        for (int ri = 0; ri < 4; ++ri) { const f32x4 kv = kr[4 * gi + ri];
#pragma unroll
            for (int s = 0; s < 4; ++s) pd[4 * ri + s] = kv[0] * qf[s][0] + kv[1] * qf[s][1] + kv[2] * qf[s][2] + kv[3] * qf[s][3]; }
        const float tot = xreduce16(pd, lane); const int k = lane >> 2;
        if ((lane & 3) == 0) sc[(k & 3) * 256 + 32 * w + 4 * gi + (k >> 2)] = tot * 0.0625f; }
    f32x4 vr[32];
#pragma unroll
    for (int mi = 0; mi < 32; ++mi) vr[mi] = __builtin_nontemporal_load((const f32x4*)(vp + (size_t)mi * (NH * HD)));
    __syncthreads();
    if (w < 4) { float v[4]; float mx = -3.0e38f;
#pragma unroll
        for (int j = 0; j < 4; ++j) { v[j] = sc[w * 256 + lane + 64 * j]; mx = fmaxf(mx, v[j]); }
        mx = wave_max(mx); float sum = 0.f;
#pragma unroll
        for (int j = 0; j < 4; ++j) { v[j] = __expf(v[j] - mx); sum += v[j]; }
        sum = wave_sum(sum); const float inv = 1.0f / sum;
#pragma unroll
        for (int j = 0; j < 4; ++j) sc[w * 256 + lane + 64 * j] = v[j] * inv; }
    __syncthreads();
    f32x4 o[4];
#pragma unroll
    for (int s = 0; s < 4; ++s) o[s] = (f32x4){0.f, 0.f, 0.f, 0.f};
#pragma unroll
    for (int mi = 0; mi < 32; ++mi) {
#pragma unroll
        for (int s = 0; s < 4; ++s) { const float p = sc[s * 256 + 32 * w + mi]; o[s] += vr[mi] * p; } }
#pragma unroll
    for (int s = 0; s < 4; ++s) *(LAS f32x4*)(red + (w * 4 + s) * 256 + 4 * lane) = o[s];
    __syncthreads();
    { const int idx = tid * 2, s = idx >> 8, d = idx & 255; float a0 = 0.f, a1 = 0.f;
#pragma unroll
        for (int ww = 0; ww < 8; ++ww) { a0 += red[(ww * 4 + s) * 256 + d]; a1 += red[(ww * 4 + s) * 256 + d + 1]; }
        *(unsigned*)(OB + (size_t)(TP + 4 * b + s) * D + h * HD + d) = pk2(a0, a1); }
    __syncthreads();
}

__device__ __forceinline__ unsigned ord_of(float x) { const unsigned u = __builtin_bit_cast(unsigned, x); return u ^ ((u >> 31) ? 0xFFFFFFFFu : 0x80000000u); }
__device__ __forceinline__ float ord_inv(unsigned k) { const unsigned u = (k & 0x80000000u) ? (k ^ 0x80000000u) : ~k; return __builtin_bit_cast(float, u); }
__device__ __forceinline__ unsigned umax2(unsigned a, unsigned b) { return a > b ? a : b; }
__device__ __forceinline__ unsigned umax_x4(unsigned v) { v = umax2(v, (unsigned)__shfl_xor((int)v, 16)); return umax2(v, (unsigned)__shfl_xor((int)v, 32)); }
constexpr int PSEL_KEYS = 65536, PSEL_TI = 2048;
__device__ __forceinline__ void peer_stage_keys(const bf16* KEYl, LAS unsigned char* kl, int tid) {
#pragma unroll
    for (int i = 0; i < 8; ++i) { const int c = tid + 512 * i, hr = c >> 4, ch = c & 15; *(LAS v4u*)(kl + hr * 256 + ((ch ^ (hr & 15)) << 4)) = *(const v4u*)(KEYl + (size_t)hr * 128 + ch * 8); }
}
__device__ __forceinline__ unsigned umin2(unsigned a, unsigned b) { return a < b ? a : b; }
__device__ __forceinline__ void ce_desc(unsigned& a, unsigned& b) { const unsigned hi = umax2(a, b), lo = umin2(a, b); a = hi; b = lo; }
template <int N> __device__ __forceinline__ void bitonic_sort_desc(unsigned (&a)[N]) {
#pragma unroll
    for (int k = 2; k <= N; k <<= 1)
#pragma unroll
        for (int j = k >> 1; j > 0; j >>= 1)
#pragma unroll
            for (int i = 0; i < N; ++i) { const int l = i ^ j; if (l > i) { if ((i & k) == 0) ce_desc(a[i], a[l]); else ce_desc(a[l], a[i]); } }
}
__device__ __forceinline__ void merge_top16(unsigned (&a)[16], int mask) {
    unsigned c[16];
#pragma unroll
    for (int i = 0; i < 16; ++i) c[i] = umax2(a[i], (unsigned)__shfl_xor((int)a[15 - i], mask));
#pragma unroll
    for (int j = 8; j > 0; j >>= 1)
#pragma unroll
        for (int i = 0; i < 16; ++i) { const int l = i ^ j; if (l > i) ce_desc(c[i], c[l]); }
#pragma unroll
    for (int i = 0; i < 16; ++i) a[i] = c[i];
}
__device__ __forceinline__ void peer_select_task(const bf16* QP, const LAS unsigned char* kl, int* EID, float* EG, int row0, int hh, LAS int* TI, int lane) {
    const int tl = lane & 15, q4 = lane >> 4;
    unsigned bk[2][16];
#pragma unroll
    for (int half = 0; half < 2; ++half) {
        f32x4 acc[8];
#pragma unroll
        for (int nt = 0; nt < 8; ++nt) acc[nt] = (f32x4){0.f, 0.f, 0.f, 0.f};
        const bf16* qb = QP + (size_t)(row0 + tl) * 2048 + hh * 256 + half * 128 + 8 * q4;
        const LAS unsigned char* kb = kl + (half * 128 + tl) * 256;
#pragma unroll
        for (int ks = 0; ks < 4; ++ks) { const bf16x8 qf = *(const bf16x8*)(qb + 32 * ks); const int co = ((4 * ks + q4) ^ tl) << 4;
#pragma unroll
            for (int nt = 0; nt < 8; ++nt) { const bf16x8 kf = *(const LAS bf16x8*)(kb + nt * 4096 + co); acc[nt] = mfma16(kf, qf, acc[nt]); } }
        unsigned kx[32];
#pragma unroll
        for (int nt = 0; nt < 8; ++nt)
#pragma unroll
            for (int i = 0; i < 4; ++i) kx[4 * nt + i] = (ord_of(acc[nt][i]) & 0xFFFFFF80u) | (unsigned)(16 * nt + 4 * q4 + i);
        bitonic_sort_desc<32>(kx);
        unsigned top[16];
#pragma unroll
        for (int r = 0; r < 16; ++r) top[r] = kx[r];
        merge_top16(top, 16); merge_top16(top, 32);
#pragma unroll
        for (int r = 0; r < 16; ++r) bk[half][r] = top[r];
    }
    if (q4 == 0) {
#pragma unroll
        for (int r = 0; r < 16; r += 4) { *(LAS v4i*)(TI + tl * 32 + r) = (v4i){(int)(bk[0][r] & 127u), (int)(bk[0][r + 1] & 127u), (int)(bk[0][r + 2] & 127u), (int)(bk[0][r + 3] & 127u)};
            *(LAS v4i*)(TI + tl * 32 + 16 + r) = (v4i){(int)(bk[1][r] & 127u), (int)(bk[1][r + 1] & 127u), (int)(bk[1][r + 2] & 127u), (int)(bk[1][r + 3] & 127u)}; } }
    float v2[16];
#pragma unroll
    for (int j = 0; j < 16; ++j) v2[j] = ord_inv(bk[1][j] & 0xFFFFFF80u);
    unsigned cx[32];
    { int sl = 0;
#pragma unroll
      for (int a = 0; a < 4; ++a) { const unsigned b0 = bk[0][4 * a], b1 = bk[0][4 * a + 1], b2 = bk[0][4 * a + 2], b3 = bk[0][4 * a + 3];
          const float v1s = ord_inv((q4 == 0 ? b0 : q4 == 1 ? b1 : q4 == 2 ? b2 : b3) & 0xFFFFFF80u); const int i = 4 * a + q4;
#pragma unroll
          for (int j = 0; j < 16 / (4 * a + 1); ++j) { const bool ok = (i + 1) * (j + 1) <= 16; cx[sl] = ok ? ((ord_of(v1s + v2[j]) & 0xFFFFFF00u) | (unsigned)(i * 16 + j)) : 0u; ++sl; } }
#pragma unroll
      for (int c = 21; c < 32; ++c) cx[c] = 0u; }
    bitonic_sort_desc<32>(cx);
    unsigned ct[16];
#pragma unroll
    for (int r = 0; r < 16; ++r) ct[r] = cx[r];
    merge_top16(ct, 16); merge_top16(ct, 32);
    LDS_WAIT();
    float sv[16]; float sum = 0.f; const float smax = ord_inv(ct[0] & 0xFFFFFF00u);
#pragma unroll
    for (int r = 0; r < 16; ++r) { sv[r] = __expf(ord_inv(ct[r] & 0xFFFFFF00u) - smax); sum += sv[r]; }
    const float inv = 1.0f / sum;
    unsigned c0, c1, c2, c3; f32x4 go;
    if (q4 == 0) { c0 = ct[0]; c1 = ct[1]; c2 = ct[2]; c3 = ct[3]; go = (f32x4){sv[0], sv[1], sv[2], sv[3]}; }
    else if (q4 == 1) { c0 = ct[4]; c1 = ct[5]; c2 = ct[6]; c3 = ct[7]; go = (f32x4){sv[4], sv[5], sv[6], sv[7]}; }
    else if (q4 == 2) { c0 = ct[8]; c1 = ct[9]; c2 = ct[10]; c3 = ct[11]; go = (f32x4){sv[8], sv[9], sv[10], sv[11]}; }
    else { c0 = ct[12]; c1 = ct[13]; c2 = ct[14]; c3 = ct[15]; go = (f32x4){sv[12], sv[13], sv[14], sv[15]}; }
    const LAS int* ti = TI + tl * 32;
    v4i eo;
    eo[0] = ti[(c0 >> 4) & 15] * 128 + ti[16 + (c0 & 15)]; eo[1] = ti[(c1 >> 4) & 15] * 128 + ti[16 + (c1 & 15)];
    eo[2] = ti[(c2 >> 4) & 15] * 128 + ti[16 + (c2 & 15)]; eo[3] = ti[(c3 >> 4) & 15] * 128 + ti[16 + (c3 & 15)];
    *(v4i*)(EID + (size_t)(row0 + tl) * 128 + hh * 16 + 4 * q4) = eo; *(f32x4*)(EG + (size_t)(row0 + tl) * 128 + hh * 16 + 4 * q4) = go * inv;
    LDS_WAIT();
}

constexpr float U_SCALE = 32.f, V_SCALE = 8.f;
__device__ __forceinline__ void cvt16(const v4u w, float (&f)[16]) {
#pragma unroll
    for (int q = 0; q < 4; ++q) { const f32x2 a = __builtin_amdgcn_cvt_pk_f32_fp8((int)w[q], false), b = __builtin_amdgcn_cvt_pk_f32_fp8((int)w[q], true); f[4 * q] = a.x; f[4 * q + 1] = a.y; f[4 * q + 2] = b.x; f[4 * q + 3] = b.y; }
}
__device__ __forceinline__ float xreduce8(const float (&p)[8], int lane) {
    float q[4], r[2];
    const bool b5 = (lane & 32) != 0, b4 = (lane & 16) != 0, b3 = (lane & 8) != 0;
#pragma unroll
    for (int k = 0; k < 4; ++k) { const float send = b5 ? p[k] : p[k + 4], keep = b5 ? p[k + 4] : p[k]; q[k] = keep + __shfl_xor(send, 32); }
#pragma unroll
    for (int k = 0; k < 2; ++k) { const float send = b4 ? q[k] : q[k + 2], keep = b4 ? q[k + 2] : q[k]; r[k] = keep + __shfl_xor(send, 16); }
    const float send = b3 ? r[0] : r[1], keep = b3 ? r[1] : r[0]; float t = keep + __shfl_xor(send, 8);
    t += __shfl_xor(t, 4); t += __shfl_xor(t, 2); t += __shfl_xor(t, 1);
    return t;
}
template <bool FINAL, int EMASK = 0x3FFF>
__device__ __forceinline__ void peer_gather_wave(int m0, int step, int lane, bf16* HB, const int* EID, const float* EG, const unsigned char* UV, float* XR, const float* gnext, const float* SSQ) {
    int t = m0; if (t >= T) return;
    const unsigned char* uvl = UV + 16 * lane;
    int eid = EID[(size_t)t * 128 + (lane >> 3)]; float gt = EG[(size_t)t * 128 + (lane >> 3)];
    v4u ub[8];
#pragma unroll
    for (int k = 0; k < 8; ++k) { const int e = __builtin_amdgcn_readlane(eid, 8 * k) & EMASK; ub[k] = *(const v4u*)(uvl + (size_t)e * 2048); }
    for (;;) {
        const int tn = t + step; const bool more = tn < T;
        const float rin = row_rinv(SSQ, (size_t)t, 16) * (1.0f / U_SCALE);
        float hf[16], acc[16];
        { const v4u hr0 = *(const v4u*)(HB + (size_t)t * D + 16 * lane), hr1 = *(const v4u*)(HB + (size_t)t * D + 16 * lane + 8);
          hf[0] = bflo(hr0.x); hf[1] = bfhi(hr0.x); hf[2] = bflo(hr0.y); hf[3] = bfhi(hr0.y); hf[4] = bflo(hr0.z); hf[5] = bfhi(hr0.z); hf[6] = bflo(hr0.w); hf[7] = bfhi(hr0.w);
          hf[8] = bflo(hr1.x); hf[9] = bfhi(hr1.x); hf[10] = bflo(hr1.y); hf[11] = bfhi(hr1.y); hf[12] = bflo(hr1.z); hf[13] = bfhi(hr1.z); hf[14] = bflo(hr1.w); hf[15] = bfhi(hr1.w); }
#pragma unroll
        for (int i = 0; i < 16; ++i) acc[i] = 0.f;
#pragma unroll 1
        for (int st = 0; st < 16; ++st) {
            v4u vb[8];
#pragma unroll
            for (int k = 0; k < 8; ++k) { const int e = __builtin_amdgcn_readlane(eid, 8 * k) & EMASK; vb[k] = *(const v4u*)(uvl + (size_t)e * 2048 + 1024); }
            const bool nx = (st < 15) || more; const size_t ni = (st < 15) ? ((size_t)t * 128 + (st + 1) * 8) : ((size_t)tn * 128);
            int eid_n = 0; float gt_n = 0.f;
            if (nx) { eid_n = EID[ni + (lane >> 3)]; gt_n = EG[ni + (lane >> 3)]; }
            float pd[8];
#pragma unroll
            for (int k = 0; k < 8; ++k) { float f[16]; cvt16(ub[k], f); float d = f[0] * hf[0];
#pragma unroll
                for (int i = 1; i < 16; ++i) d = fmaf(f[i], hf[i], d);
                pd[k] = d; }
            const float tot = xreduce8(pd, lane);
            const float wv = gt * gelu1(tot * rin) * (1.0f / V_SCALE);
            if (nx) {
#pragma unroll
                for (int k = 0; k < 8; ++k) { const int e = __builtin_amdgcn_readlane(eid_n, 8 * k) & EMASK; ub[k] = *(const v4u*)(uvl + (size_t)e * 2048); } }
#pragma unroll
            for (int k = 0; k < 8; ++k) { const float wk = __builtin_bit_cast(float, __builtin_amdgcn_readlane(__builtin_bit_cast(int, wv), 8 * k)); float f[16]; cvt16(vb[k], f);
#pragma unroll
                for (int i = 0; i < 16; ++i) acc[i] = fmaf(wk, f[i], acc[i]); }
            eid = eid_n; gt = gt_n;
        }
        float* xr = XR + (size_t)t * D + 16 * lane;
        f32x4 x[4];
#pragma unroll
        for (int j = 0; j < 4; ++j) x[j] = *(const f32x4*)(xr + 4 * j);
        float ss = 0.f;
#pragma unroll
        for (int j = 0; j < 4; ++j)
#pragma unroll
            for (int i = 0; i < 4; ++i) { x[j][i] += acc[4 * j + i]; ss = fmaf(x[j][i], x[j][i], ss); }
        const float r = 1.0f / sqrtf(wave_sum(ss) * (1.0f / D) + RMS_EPS);
        f32x4 gv[4];
#pragma unroll
        for (int j = 0; j < 4; ++j) gv[j] = *(const f32x4*)(gnext + 16 * lane + 4 * j);
        if (FINAL) {
#pragma unroll
            for (int j = 0; j < 4; ++j) *(f32x4*)(xr + 4 * j) = x[j] * r * gv[j];
        } else {
#pragma unroll
            for (int j = 0; j < 4; ++j) *(f32x4*)(xr + 4 * j) = x[j];
            const f32x4 a = x[0] * r * gv[0], bq = x[1] * r * gv[1], c = x[2] * r * gv[2], dq = x[3] * r * gv[3];
            v4u w0, w1;
            w0.x = pk2(a[0], a[1]); w0.y = pk2(a[2], a[3]); w0.z = pk2(bq[0], bq[1]); w0.w = pk2(bq[2], bq[3]);
            w1.x = pk2(c[0], c[1]); w1.y = pk2(c[2], c[3]); w1.z = pk2(dq[0], dq[1]); w1.w = pk2(dq[2], dq[3]);
            *(v4u*)(HB + (size_t)t * D + 16 * lane) = w0; *(v4u*)(HB + (size_t)t * D + 16 * lane + 8) = w1;
        }
        if (!more) break;
        t = tn;
    }
}

constexpr float U6_SCALE = 64.f, V6_SCALE = 16.f;
typedef float v32f __attribute__((ext_vector_type(32)));
typedef float v16f __attribute__((ext_vector_type(16)));
typedef unsigned v6u __attribute__((ext_vector_type(6)));
typedef unsigned v3u __attribute__((ext_vector_type(3)));
__device__ __forceinline__ v6u load6(const unsigned char* p) { const v3u a = *(const v3u*)p, b = *(const v3u*)(p + 12); v6u r; r[0] = a[0]; r[1] = a[1]; r[2] = a[2]; r[3] = b[0]; r[4] = b[1]; r[5] = b[2]; return r; }
__device__ __forceinline__ int mbcnt64(unsigned long long m) { return (int)__builtin_amdgcn_mbcnt_hi((unsigned)(m >> 32), __builtin_amdgcn_mbcnt_lo((unsigned)m, 0u)); }
template <bool FINAL>
__device__ __forceinline__ void peer_gather_wave6(int m0, int step, int lane, bf16* HB, const int* EID, const float* EG, const unsigned char* UV, float* XR, const float* gnext, const float* SSQ, LAS unsigned char* lw) {
    int t = m0; if (t >= T) return;
    int buf = 0;
#define PG6_SORT(TOK, BUF, FLIP) do { const size_t tb_ = (size_t)(TOK) * 128; const int e0_ = EID[tb_ + lane], e1_ = EID[tb_ + 64 + lane]; const float g0_ = EG[tb_ + lane], g1_ = EG[tb_ + 64 + lane]; \
        const int b0_ = (e0_ >> 10) ^ (FLIP), b1_ = (e1_ >> 10) ^ (FLIP); int off_ = 0, p0_ = 0, p1_ = 0; \
        _Pragma("unroll") for (int k_ = 0; k_ < 16; ++k_) { const unsigned long long m0_ = __ballot(b0_ == k_), m1_ = __ballot(b1_ == k_); const int c0_ = __popcll(m0_), c1_ = __popcll(m1_); \
            p0_ = (b0_ == k_) ? off_ + mbcnt64(m0_) : p0_; p1_ = (b1_ == k_) ? off_ + c0_ + mbcnt64(m1_) : p1_; off_ += c0_ + c1_; } \
        LAS int* se_ = (LAS int*)(lw + (BUF) * 1024); LAS float* sg_ = (LAS float*)(lw + (BUF) * 1024 + 512); se_[p0_] = e0_; sg_[p0_] = g0_; se_[p1_] = e1_; sg_[p1_] = g1_; } while (0)
#define PG6_IDS(BUF, ST, E_, G_) do { E_ = ((const LAS int*)(lw + (BUF) * 1024))[(ST) * 8 + xl]; G_ = ((const LAS float*)(lw + (BUF) * 1024 + 512))[(ST) * 8 + xl]; } while (0)
    const int hw = lane >> 5, li = lane & 31; const bool b4 = (lane & 16) != 0, b3 = (lane & 8) != 0;
    const int xl = 4 * ((lane >> 4) & 1) + 2 * ((lane >> 3) & 1) + hw;
    const unsigned char* uvl = UV + 24 * li;
    int flip = 0;
    PG6_SORT(t, 0, 0); LDS_WAIT();
    int eid; float gt; PG6_IDS(0, 0, eid, gt);
    v6u ub[4];
#pragma unroll
    for (int k = 0; k < 4; ++k) { const int ea = __builtin_amdgcn_readlane(eid, 8 * k), eb = __builtin_amdgcn_readlane(eid, 32 + 8 * k); ub[k] = load6(uvl + (size_t)(hw ? eb : ea) * 1536); }
    for (;;) {
        const int tn = t + step; const bool more = tn < T;
        const float rin = row_rinv(SSQ, (size_t)t, 16) * (1.0f / U6_SCALE);
        float hf[32], acc[32];
        { const v4u* hp = (const v4u*)(HB + (size_t)t * D + 32 * li);
#pragma unroll
          for (int q = 0; q < 4; ++q) { const v4u h = hp[q]; hf[8 * q] = bflo(h.x); hf[8 * q + 1] = bfhi(h.x); hf[8 * q + 2] = bflo(h.y); hf[8 * q + 3] = bfhi(h.y); hf[8 * q + 4] = bflo(h.z); hf[8 * q + 5] = bfhi(h.z); hf[8 * q + 6] = bflo(h.w); hf[8 * q + 7] = bfhi(h.w); } }
#pragma unroll
        for (int i = 0; i < 32; ++i) acc[i] = 0.f;
#pragma unroll 1
        for (int st = 0; st < 16; ++st) {
            v6u vb[4];
#pragma unroll
            for (int k = 0; k < 4; ++k) { const int ea = __builtin_amdgcn_readlane(eid, 8 * k), eb = __builtin_amdgcn_readlane(eid, 32 + 8 * k); vb[k] = load6(uvl + (size_t)(hw ? eb : ea) * 1536 + 768); }
            const bool nx = (st < 15) || more;
            if (st == 10 && more) PG6_SORT(tn, buf ^ 1, flip ^ 15);
            int eid_n = 0; float gt_n = 0.f;
            if (st < 15) PG6_IDS(buf, st + 1, eid_n, gt_n); else if (more) PG6_IDS(buf ^ 1, 0, eid_n, gt_n);
            float pd[4];
#pragma unroll
            for (int k = 0; k < 4; ++k) { const v32f f = __builtin_amdgcn_cvt_scalef32_pk32_f32_fp6(ub[k], 1.0f); float d = f[0] * hf[0];
#pragma unroll
                for (int i = 1; i < 32; ++i) d = fmaf(f[i], hf[i], d);
                pd[k] = d; }
            float q0, q1;
            { const float s0 = b4 ? pd[0] : pd[2], k0 = b4 ? pd[2] : pd[0]; q0 = k0 + __shfl_xor(s0, 16); const float s1 = b4 ? pd[1] : pd[3], k1 = b4 ? pd[3] : pd[1]; q1 = k1 + __shfl_xor(s1, 16); }
            float tot; { const float sd = b3 ? q0 : q1, kp = b3 ? q1 : q0; tot = kp + __shfl_xor(sd, 8); }
            tot += __shfl_xor(tot, 4); tot += __shfl_xor(tot, 2); tot += __shfl_xor(tot, 1);
            const float wv = gt * gelu1(tot * rin) * (1.0f / V6_SCALE);
            if (nx) {
#pragma unroll
                for (int k = 0; k < 4; ++k) { const int ea = __builtin_amdgcn_readlane(eid_n, 8 * k), eb = __builtin_amdgcn_readlane(eid_n, 32 + 8 * k); ub[k] = load6(uvl + (size_t)(hw ? eb : ea) * 1536); } }
#pragma unroll
            for (int k = 0; k < 4; ++k) { const float wa = __builtin_bit_cast(float, __builtin_amdgcn_readlane(__builtin_bit_cast(int, wv), 8 * k)), wb = __builtin_bit_cast(float, __builtin_amdgcn_readlane(__builtin_bit_cast(int, wv), 32 + 8 * k));
                const float wk = hw ? wb : wa; const v32f f = __builtin_amdgcn_cvt_scalef32_pk32_f32_fp6(vb[k], 1.0f);
#pragma unroll
                for (int i = 0; i < 32; ++i) acc[i] = fmaf(wk, f[i], acc[i]); }
            eid = eid_n; gt = gt_n;
        }
        float av[16];
#pragma unroll
        for (int i = 0; i < 16; ++i) { const float lo = acc[i] + __shfl_xor(acc[i], 32), hi = acc[16 + i] + __shfl_xor(acc[16 + i], 32); av[i] = hw ? hi : lo; }
        float* xr = XR + (size_t)t * D + 32 * li + 16 * hw;
        f32x4 x[4];
#pragma unroll
        for (int j = 0; j < 4; ++j) x[j] = *(const f32x4*)(xr + 4 * j);
        float ss = 0.f;
#pragma unroll
        for (int j = 0; j < 4; ++j)
#pragma unroll
            for (int i = 0; i < 4; ++i) { x[j][i] += av[4 * j + i]; ss = fmaf(x[j][i], x[j][i], ss); }
        const float r = 1.0f / sqrtf(wave_sum(ss) * (1.0f / D) + RMS_EPS);
        f32x4 gv[4];
#pragma unroll
        for (int j = 0; j < 4; ++j) gv[j] = *(const f32x4*)(gnext + 32 * li + 16 * hw + 4 * j);
        if (FINAL) {
#pragma unroll
            for (int j = 0; j < 4; ++j) *(f32x4*)(xr + 4 * j) = x[j] * r * gv[j];
        } else {
#pragma unroll
            for (int j = 0; j < 4; ++j) *(f32x4*)(xr + 4 * j) = x[j];
            const f32x4 a = x[0] * r * gv[0], bq = x[1] * r * gv[1], c = x[2] * r * gv[2], dq = x[3] * r * gv[3];
            v4u w0, w1;
            w0.x = pk2(a[0], a[1]); w0.y = pk2(a[2], a[3]); w0.z = pk2(bq[0], bq[1]); w0.w = pk2(bq[2], bq[3]);
            w1.x = pk2(c[0], c[1]); w1.y = pk2(c[2], c[3]); w1.z = pk2(dq[0], dq[1]); w1.w = pk2(dq[2], dq[3]);
            *(v4u*)(HB + (size_t)t * D + 32 * li + 16 * hw) = w0; *(v4u*)(HB + (size_t)t * D + 32 * li + 16 * hw + 8) = w1;
        }
        if (!more) break;
        t = tn; buf ^= 1; flip ^= 15;
    }
#undef PG6_SORT
#undef PG6_IDS
}

enum { SK_GLU = 0, SK_RES = 1, SK_B16 = 2, SK_WINV = 3, SK_WINB = 4 };
struct SkArgs { const bf16* A; const bf16* W; float* xr; bf16* hbo; float* ssq; const float* gnext; const float* xs; bf16* O; int ldc; int nslots; bf16* v1; bf16* b1; float* out; };
constexpr int SK_LDS_FLOATS = 8 * 32 * 68;
template <int MODE>
__device__ __forceinline__ void skinny_tile(const SkArgs& a, int rb, int cb, LAS float* P, int tid) {
    constexpr bool PAIRED = (MODE == SK_GLU || MODE == SK_WINV);
    const int lane = tid & 63, w = tid >> 6, tl = lane & 15, q4 = lane >> 4;
    const int g0 = PAIRED ? ((cb >> 2) * 256 + (cb & 3) * 32) : 64 * cb;
    f32x4 acc[2][4];
#pragma unroll
    for (int mt = 0; mt < 2; ++mt)
#pragma unroll
        for (int nt = 0; nt < 4; ++nt) acc[mt][nt] = (f32x4){0.f, 0.f, 0.f, 0.f};
    const bf16* ap = a.A + (size_t)(TP + 32 * rb + tl) * D + 128 * w + 8 * q4;
    const bf16* wp = a.W + (size_t)(g0 + tl) * D + 128 * w + 8 * q4;
    bf16x8 af[4][2], bfr[4][4];
#pragma unroll
    for (int ks = 0; ks < 4; ++ks) {
#pragma unroll
        for (int mt = 0; mt < 2; ++mt) af[ks][mt] = *(const bf16x8*)(ap + (size_t)(16 * mt) * D + 32 * ks);
#pragma unroll
        for (int nt = 0; nt < 4; ++nt) { const int wro = PAIRED ? ((nt >> 1) * 128 + (nt & 1) * 16) : 16 * nt; bfr[ks][nt] = *(const bf16x8*)(wp + (size_t)wro * D + 32 * ks); } }
    const int row = tid >> 4, c4 = (tid & 15) * 4; const size_t grow = (size_t)TP + 32 * rb + row;
    const int pcol = (cb >> 2) * 128 + (cb & 3) * 32 + (c4 & 31), col = 64 * cb + c4;
    f32x4 e0 = {0.f, 0.f, 0.f, 0.f}, e1 = {0.f, 0.f, 0.f, 0.f}; float ri = 0.f;
    if (MODE == SK_GLU) { e0 = *(const f32x4*)(a.xs + (size_t)(32 * rb + row) * D + pcol); e1 = *(const f32x4*)(a.gnext + pcol); }
    if (MODE == SK_RES) { e0 = *(const f32x4*)(a.xr + grow * D + col); e1 = *(const f32x4*)(a.gnext + col); }
    if (MODE == SK_B16) ri = row_rinv(a.ssq, grow, a.nslots);
#pragma unroll
    for (int ks = 0; ks < 4; ++ks)
#pragma unroll
        for (int nt = 0; nt < 4; ++nt)
#pragma unroll
            for (int mt = 0; mt < 2; ++mt) acc[mt][nt] = mfma16(bfr[ks][nt], af[ks][mt], acc[mt][nt]);
#pragma unroll
    for (int mt = 0; mt < 2; ++mt)
#pragma unroll
        for (int nt = 0; nt < 4; ++nt) *(LAS f32x4*)(P + (w * 32 + 16 * mt + tl) * 68 + 16 * nt + 4 * q4) = acc[mt][nt];
    __syncthreads();
    f32x4 v = {0.f, 0.f, 0.f, 0.f}, vb = {0.f, 0.f, 0.f, 0.f};
#pragma unroll
    for (int ww = 0; ww < 8; ++ww) v += *(const LAS f32x4*)(P + (ww * 32 + row) * 68 + c4);
    if (PAIRED && c4 < 32) {
#pragma unroll
        for (int ww = 0; ww < 8; ++ww) vb += *(const LAS f32x4*)(P + (ww * 32 + row) * 68 + c4 + 32); }
    if (MODE == SK_GLU) {
        float ss = 0.f;
        if (c4 < 32) { f32x4 o;
#pragma unroll
            for (int j = 0; j < 4; ++j) { o[j] = e0[j] + v[j] / (1.0f + __expf(-vb[j])); ss = fmaf(o[j], o[j], ss); }
            *(f32x4*)(a.xr + grow * D + pcol) = o; const f32x4 hg = o * e1; v2u wv; wv.x = pk2(hg[0], hg[1]); wv.y = pk2(hg[2], hg[3]); *(v2u*)(a.hbo + grow * D + pcol) = wv; }
        ss += __shfl_xor(ss, 1); ss += __shfl_xor(ss, 2); ss += __shfl_xor(ss, 4);
        if ((tid & 15) == 0) a.ssq[grow * 32 + cb] = ss;
    } else if (MODE == SK_RES) {
        const f32x4 o = e0 + v; *(f32x4*)(a.xr + grow * D + col) = o;
        float ss = o[0] * o[0] + o[1] * o[1] + o[2] * o[2] + o[3] * o[3];
        const f32x4 hg = o * e1; v2u wv; wv.x = pk2(hg[0], hg[1]); wv.y = pk2(hg[2], hg[3]); *(v2u*)(a.hbo + grow * D + col) = wv;
        ss += __shfl_xor(ss, 1); ss += __shfl_xor(ss, 2); ss += __shfl_xor(ss, 4); ss += __shfl_xor(ss, 8);
        if ((tid & 15) == 0) a.ssq[grow * 32 + cb] = ss;
    } else if (MODE == SK_B16) {
        const f32x4 o = v * ri; v2u wv; wv.x = pk2(o[0], o[1]); wv.y = pk2(o[2], o[3]);
        *(v2u*)(a.O + grow * a.ldc + col) = wv;
    } else if (MODE == SK_WINV) {
        if (c4 < 32) { const f32x4 vv = v * vb; v2u wv; wv.x = pk2(vv[0], vv[1]); wv.y = pk2(vv[2], vv[3]); *(v2u*)(a.v1 + grow * D + pcol) = wv;
            const int rs = 32 * rb + row, s = rs & 3; if (s >= 2) *(f32x4*)(a.out + O_CS + ((size_t)(rs >> 2) * 2 + (s - 2)) * D + pcol) = vv; }
    } else {
        v2u wv; wv.x = pk2(v[0], v[1]); wv.y = pk2(v[2], v[3]); *(v2u*)(a.b1 + grow * D + col) = wv;
    }
    __syncthreads();
}
#ifndef REP_P0
#define REP_P0 1
#endif
#ifndef REP_P1
#define REP_P1 1
#endif
#ifndef REP_GEMM
#define REP_GEMM 1
#endif
#ifndef REP_ATTN
#define REP_ATTN 1
#endif
#ifndef REP_PSEL
#define REP_PSEL 1
#endif
#ifndef REP_THIN
#define REP_THIN 1
#endif
#ifndef REP_SK
#define REP_SK 1
#endif
#ifndef REP_TAB
#define REP_TAB 1
#endif
#ifndef REP_KV
#define REP_KV 1
#endif
#ifndef REP_S5P
#define REP_S5P 1
#endif
#ifndef REP_S5S
#define REP_S5S 1
#endif
struct Args { const float* in[N_IN]; float* out; unsigned char* ws; int ph_lo, ph_hi; };
__device__ __forceinline__ int opaque_idx(int k) { int r; asm volatile("s_mov_b32 %0, %1" : "=s"(r) : "s"(k)); return r; }
#define INP(k) ((const float*)(const GAS float*)(args.in[opaque_idx(k)]))
__device__ __forceinline__ unsigned char* opq_p(unsigned char* p) { GAS unsigned char* g = (GAS unsigned char*)p; asm volatile("" : "+s"(g)); return (unsigned char*)g; }
__device__ __forceinline__ float* opq_f(float* p) { GAS float* g = (GAS float*)p; asm volatile("" : "+s"(g)); return (float*)g; }
__device__ __forceinline__ int opq_i(int v) { asm volatile("" : "+s"(v)); return v; }
__device__ __forceinline__ int opq_v(int v) { asm volatile("" : "+v"(v)); return v; }
#define PH_LOCALS unsigned char* ws = opq_p(args.ws); float* out = opq_f(args.out); (void)ws; (void)out; \
    const int tid = opq_v(tid0), lane = tid & 63, wave = __builtin_amdgcn_readfirstlane(tid >> 6), G = opq_i((int)gridDim.x), bx = opq_i((int)blockIdx.x), gw = bx * NWAVES + wave, NGW = G * NWAVES; (void)lane; (void)gw; (void)NGW;
#define WALL ((bf16*)(ws + WS_WALL))
#define KEYS ((bf16*)(ws + WS_KEYS))
#define BBW ((bf16*)(ws + WS_BBW))
#define CCW ((bf16*)(ws + WS_CCW))
#define LBc ((float*)(ws + WS_LB))
#define MEMB ((bf16*)(ws + WS_MEMB))
#define KB ((bf16*)(ws + WS_KB))
#define VT ((bf16*)(ws + WS_VT))
#define EID ((int*)(ws + WS_EID))
#define EG ((float*)(ws + WS_EG))
#define HB ((bf16*)(ws + WS_HB))
#define ZB ((bf16*)(ws + WS_ZB))
#define QB ((bf16*)(ws + WS_QB))
#define QP ((bf16*)(ws + WS_QP))
#define B1 ((bf16*)(ws + WS_B1))
#define V1 ((bf16*)(ws + WS_V1))
#define UVT ((unsigned char*)(ws + WS_UV))
#define XR (out + O_Y)
#define SSQB ((float*)(ws + WS_SSQ))
#define KTB ((bf16*)(ws + WS_KT))
#define CPB ((bf16*)(ws + WS_CP))
#define WEB ((bf16*)(ws + WS_WE))
#define LB16B ((float*)(ws + WS_LB16))

constexpr int N_PHASES = 18;

#define TABLE_CONVERT(LAYER, W0, NW) do { const float* sU = INP(I_PU) + (size_t)(LAYER) * NEXP * D; const float* sV = INP(I_PV) + (size_t)(LAYER) * NEXP * D; unsigned char* dst = UVT + (size_t)(LAYER) * NEXP * 1536; \
            const size_t ng = (size_t)NEXP * 32; \
            for (size_t i = (size_t)(W0) * 64 + lane; i < 2 * ng; i += (size_t)(NW) * 64) { const bool isv = i >= ng; const size_t j = isv ? i - ng : i; const size_t row = j >> 5; const int c = (int)(j & 31); \
                const f32x4* s = (const f32x4*)((isv ? sV : sU) + row * D + 32 * c); const float sc = isv ? V6_SCALE : U6_SCALE; v16f a, b; \
                _Pragma("unroll") for (int q = 0; q < 8; ++q) { const f32x4 x0 = s[q] * sc; a[2 * q] = x0[0]; b[2 * q] = x0[1]; a[2 * q + 1] = x0[2]; b[2 * q + 1] = x0[3]; } \
                const v6u w = __builtin_amdgcn_cvt_scalef32_2xpk16_fp6_f32(a, b, 1.0f); \
                unsigned char* dp = dst + (row * 2 + (isv ? 1 : 0)) * 768 + 24 * c; \
                *(v2u*)dp = (v2u){w[0], w[1]}; *(v2u*)(dp + 8) = (v2u){w[2], w[3]}; *(v2u*)(dp + 16) = (v2u){w[4], w[5]}; } } while (0)
__global__ void __launch_bounds__(NWAVES * 64, 2) mk_fwd(Args args) {
    extern __shared__ __attribute__((aligned(16))) unsigned char lds[];
    LAS unsigned char* L = (LAS unsigned char*)lds;
    volatile LAS unsigned* MISC = (volatile LAS unsigned*)(L + MISC_OFF);
    const int tid0 = threadIdx.x;
    gu32* ctl = (gu32*)(args.ws + WS_CTL);

    for (int u = tid0; u < (LDS_BYTES - LDSCTL_OFF) / 4; u += NWAVES * 64) ((LAS unsigned*)(L + LDSCTL_OFF))[u] = 0u;
    __syncthreads();
    XcdBarrier bar = xcd_barrier_post((unsigned*)(ctl + CW_BAR), MISC + 8);
    const int lo = args.ph_lo, hi = args.ph_hi;
#define IN(k) (opq_i(lo) <= (k) && (k) < opq_i(hi))
#define SEAM(k) do { if (IN(k) && IN((k) + 1)) xcd_barrier(bar); } while (0)
#define GEMM_PHASE(EpiT, Aptr, Brow, Mrows, Ncols, Eobj) do { pg8::Gemm g_{(const pg8::bf16_t*)(Aptr), (const pg8::bf16_t*)(WALL + (size_t)(Brow) * D), (Mrows), (Ncols), D}; \
        pg8::StaticOrder S_; S_.init((Mrows), (Ncols), G, bx); pg8::gemm_phase<EpiT, pg8::StaticOrder, true, true>(L + RING_OFF, g_, S_, Eobj); } while (0)

    if (IN(0)) { PH_LOCALS
      for (int rep_ = 0; rep_ < REP_P0; ++rep_) {
        LAS float* scr = (LAS float*)(L + RING_OFF + wave * 16384);
        for (int it = gw; it < (R_END / 32) * 16; it += NGW) {
            const int nb = it >> 4, kb = it & 15; int r = nb * 32; const float* src; int N, sn0;
            if (r < R_GLU) { const int mat = r >> 10, l = mat >> 1; src = ((mat & 1) ? INP(I_WV) : INP(I_WK)) + (size_t)l * D * D; N = D; sn0 = r & 1023; }
            else if (r < R_Q) { r -= R_GLU; src = INP(I_WGLU); N = 2 * D; sn0 = ((r >> 7) & 1) * 1024 + (r >> 8) * 128 + (r & 127); }
            else if (r < R_O) { r -= R_Q; src = INP(I_WQ) + (size_t)(r >> 10) * D * D; N = D; sn0 = r & 1023; }
            else if (r < R_PQ) { r -= R_O; src = INP(I_WO) + (size_t)(r >> 10) * D * D; N = D; sn0 = r & 1023; }
            else if (r < R_WIN) { r -= R_PQ; src = INP(I_PWQ) + (size_t)(r >> 11) * D * 2048; N = 2048; sn0 = r & 2047; }
            else if (r < R_WOUT) { r -= R_WIN; src = INP(I_WIN); N = 3 * D; sn0 = (r < 2048) ? (1024 + ((r >> 7) & 1) * 1024 + (r >> 8) * 128 + (r & 127)) : (r - 2048); }
            else { r -= R_WOUT; src = INP(I_WOUT); N = D; sn0 = r; }
            p0_transpose_item(src, N, sn0, WALL + (size_t)(nb * 32) * D, kb * 64, scr, lane);
        }
        TABLE_CONVERT(0, gw, NGW);
        {
            const int gt = bx * 512 + tid, NT = G * 512;
            for (int i = gt; i < 2 * 2 * 128 * 128; i += NT) { const int l = i >> 15, hf = (i >> 14) & 1, r = i & 16383; const float* k1 = INP(I_K1); const float* k2 = INP(I_K2); KEYS[i] = (bf16)f2bf((hf ? k2 : k1)[(size_t)l * 16384 + r]); }
            for (int i = gt; i < MROWS * D / 4; i += NT) { const f32x4 a = ((const f32x4*)INP(I_MEM))[i]; v2u w; w.x = pk2(a[0], a[1]); w.y = pk2(a[2], a[3]); ((v2u*)MEMB)[i] = w; }
            for (int i = gt; i < 64 * 64; i += NT) { const int g = i >> 6, p = i & 63;
                const double are = INP(I_ARE)[i], aim = INP(I_AIM)[i], dt = exp((double)INP(I_LDT)[g]);
                const double mag = exp(are * dt), ang = aim * dt, lbr = mag * cos(ang), lbi = mag * sin(ang), den = are * are + aim * aim;
                const double fr = ((lbr - 1.0) * are + lbi * aim) / den, fi = (lbi * are - (lbr - 1.0) * aim) / den;
                LBc[2 * i] = (float)lbr; LBc[2 * i + 1] = (float)lbi;
                for (int c = 0; c < 16; ++c) { const double br = INP(I_BRE)[(size_t)i * 16 + c], bi = INP(I_BIM)[(size_t)i * 16 + c];
                    BBW[((size_t)g * 128 + p) * 16 + c] = (bf16)f2bf((float)(fr * br - fi * bi)); BBW[((size_t)g * 128 + 64 + p) * 16 + c] = (bf16)f2bf((float)(fr * bi + fi * br));
                    CCW[((size_t)g * 16 + c) * 128 + p] = (bf16)f2bf(INP(I_CRE)[((size_t)g * 16 + c) * 64 + p]); CCW[((size_t)g * 16 + c) * 128 + 64 + p] = (bf16)f2bf(-INP(I_CIM)[((size_t)g * 16 + c) * 64 + p]); } }
        }
        {
            const int gt = bx * 512 + tid, NT = G * 512;
            const float* pare = INP(I_ARE); const float* paim = INP(I_AIM); const float* pldt = INP(I_LDT); const float* pbre = INP(I_BRE); const float* pbim = INP(I_BIM); const float* pcre = INP(I_CRE); const float* pcim = INP(I_CIM);
            for (int i = gt; i < 64 * 64; i += NT) { const int g = i >> 6; const double are = pare[i], aim = paim[i], dt = exp((double)pldt[g]); const double m16 = exp(16.0 * are * dt);
                LB16B[2 * i] = (float)(m16 * cos(16.0 * aim * dt)); LB16B[2 * i + 1] = (float)(m16 * sin(16.0 * aim * dt)); }
            for (int i = gt; i < 64 * 64 * 16; i += NT) { const int g = i >> 10, n = (i >> 6) & 15, p = i & 63, gp = g * 64 + p;
                const float are = pare[gp], aim = paim[gp], dt = expf(pldt[g]);
                const float m1 = expf(are * dt); float s1, c1; sincosf(aim * dt, &s1, &c1); const float lbr = m1 * c1, lbi = m1 * s1, den = are * are + aim * aim;
                const float fr = ((lbr - 1.0f) * are + lbi * aim) / den, fi = (lbi * are - (lbr - 1.0f) * aim) / den;
                const float mn = expf((float)n * are * dt); float sn, cn; sincosf((float)n * aim * dt, &sn, &cn); const float pnr = mn * cn, pni = mn * sn;
                const float qr = pnr * lbr - pni * lbi, qi = pnr * lbi + pni * lbr;
                const int sidx = 15 - n; float wre[16], wim[16];
                const f32x4* b4r = (const f32x4*)(pbre + (size_t)gp * 16); const f32x4* b4i = (const f32x4*)(pbim + (size_t)gp * 16);
#pragma unroll
                for (int c4 = 0; c4 < 4; ++c4) { const f32x4 brv = b4r[c4], biv = b4i[c4];
#pragma unroll
                    for (int j = 0; j < 4; ++j) { const float bbr = fr * brv[j] - fi * biv[j], bbi = fr * biv[j] + fi * brv[j]; wre[4 * c4 + j] = pnr * bbr - pni * bbi; wim[4 * c4 + j] = pnr * bbi + pni * bbr; } }
                v4u o0, o1;
                o0.x = pk2(wre[0], wre[1]); o0.y = pk2(wre[2], wre[3]); o0.z = pk2(wre[4], wre[5]); o0.w = pk2(wre[6], wre[7]); o1.x = pk2(wre[8], wre[9]); o1.y = pk2(wre[10], wre[11]); o1.z = pk2(wre[12], wre[13]); o1.w = pk2(wre[14], wre[15]);
                *(v4u*)(WEB + ((size_t)g * 128 + p) * 256 + sidx * 16) = o0; *(v4u*)(WEB + ((size_t)g * 128 + p) * 256 + sidx * 16 + 8) = o1;
                o0.x = pk2(wim[0], wim[1]); o0.y = pk2(wim[2], wim[3]); o0.z = pk2(wim[4], wim[5]); o0.w = pk2(wim[6], wim[7]); o1.x = pk2(wim[8], wim[9]); o1.y = pk2(wim[10], wim[11]); o1.z = pk2(wim[12], wim[13]); o1.w = pk2(wim[14], wim[15]);
                *(v4u*)(WEB + ((size_t)g * 128 + 64 + p) * 256 + sidx * 16) = o0; *(v4u*)(WEB + ((size_t)g * 128 + 64 + p) * 256 + sidx * 16 + 8) = o1;
                for (int c = 0; c < 16; ++c) { const float cr = pcre[((size_t)g * 16 + c) * 64 + p], ci = pcim[((size_t)g * 16 + c) * 64 + p];
                    CPB[(((size_t)g * 16 + n) * 16 + c) * 128 + p] = (bf16)f2bf(cr * qr - ci * qi); CPB[(((size_t)g * 16 + n) * 16 + c) * 128 + 64 + p] = (bf16)f2bf(-(cr * qi + ci * qr)); } }
            for (int i = gt; i < 64 * 16 * 16; i += NT) { const int g = i >> 8, c = (i >> 4) & 15, cc = i & 15; const float dt = expf(pldt[g]);
                float acc[16];
#pragma unroll
                for (int tau = 0; tau < 16; ++tau) acc[tau] = 0.f;
                for (int p = 0; p < 64; ++p) { const int gp = g * 64 + p; const float are = pare[gp], aim = paim[gp];
                    const float m1 = expf(are * dt); float sn, cs; sincosf(aim * dt, &sn, &cs); const float lbr = m1 * cs, lbi = m1 * sn, den = are * are + aim * aim;
                    const float fr = ((lbr - 1.0f) * are + lbi * aim) / den, fi = (lbi * are - (lbr - 1.0f) * aim) / den;
                    const float br = pbre[(size_t)gp * 16 + cc], bi = pbim[(size_t)gp * 16 + cc]; const float bbr = fr * br - fi * bi, bbi = fr * bi + fi * br;
                    const float cr = pcre[((size_t)g * 16 + c) * 64 + p], ci = pcim[((size_t)g * 16 + c) * 64 + p];
                    float zr = cr * bbr - ci * bbi, zi = cr * bbi + ci * bbr;
#pragma unroll
                    for (int tau = 0; tau < 16; ++tau) { acc[tau] += zr; const float nr = zr * lbr - zi * lbi, ni = zr * lbi + zi * lbr; zr = nr; zi = ni; } }
#pragma unroll
                for (int tau = 0; tau < 16; ++tau) KTB[(((size_t)g * 17 + 1 + tau) * 16 + c) * 16 + cc] = (bf16)f2bf(acc[tau]);
                KTB[(((size_t)g * 17) * 16 + c) * 16 + cc] = (bf16)0; }
        }
        for (int m = gw; m < T; m += NGW) { const float* xp_ = INP(I_XP); const float* xs_ = INP(I_XS); rms_row_bf16(m < TP ? xp_ + (size_t)m * D : xs_ + (size_t)(m - TP) * D, INP(I_NMIX), HB + (size_t)m * D, lane); }
      }
    }
    SEAM(0);
    if (IN(1)) { PH_LOCALS
      for (int rep_ = 0; rep_ < REP_P1; ++rep_) {
        { EpiKV E{out, KB, VT}; for (int r2_ = 0; r2_ < REP_KV; ++r2_) GEMM_PHASE(EpiKV, MEMB, R_KV, MROWS, 4096, E); }
        {
            const int half = G / 2, per = (NB * 64 + G - 1) / G;
            const int s_lo = bx * per, s_hi = min(NB * 64, s_lo + per);
            for (int r2_ = 0; r2_ < REP_S5P; ++r2_)
#pragma unroll 1
            for (int sq = s_lo; sq < s_hi; ++sq) s5_prompt_seq(HB, ZB, KTB, CPB, WEB, LB16B, INP(I_SD), L + RING_OFF, tid, sq >> 6, sq & 63, out + O_SRP, out + O_SIP);
            for (int r3_ = 0; r3_ < REP_TAB; ++r3_) if (bx >= half) TABLE_CONVERT(1, (bx - half) * NWAVES + wave, (G - half) * NWAVES);
            const int tid2 = opq_v(tid0), lane = tid2 & 63, wave = __builtin_amdgcn_readfirstlane(tid2 >> 6), gw = bx * NWAVES + wave;
            LAS float* ST = (LAS float*)(L + RING_OFF + wave * S5_ST_BYTES);
            for (int r2_ = 0; r2_ < REP_S5S; ++r2_)
#pragma unroll 1
            for (int tk = gw; tk < (DB / 4) * 64; tk += NGW) { const int b0 = (tk >> 6) * 4, g = tk & 63; float sr = 0.f, si = 0.f;
                const float lbr = LBc[(g * 64 + lane) * 2], lbi = LBc[(g * 64 + lane) * 2 + 1];
                s5_run<true, true>(HB, ZB, BBW, CCW, INP(I_SD), ST, lane, g, TP + 4 * b0, 1, b0, INP(I_SRE), INP(I_SIM), out + O_SRS, out + O_SIS, lbr, lbi, sr, si); }
        }
        if (REP_P1 > 1) __syncthreads();
      }
    }
    SEAM(1);
    if (IN(2)) { PH_LOCALS
        { EpiGLU E{INP(I_XP), XR, HB, SSQB, INP(I_NMEM)}; for (int rep_ = 0; rep_ < REP_GEMM; ++rep_) GEMM_PHASE(EpiGLU, ZB, R_GLU, TP, 2048, E); }
        { SkArgs sa{}; sa.A = ZB; sa.W = WALL + (size_t)R_GLU * D; sa.xr = XR; sa.hbo = HB; sa.ssq = SSQB; sa.gnext = INP(I_NMEM); sa.xs = INP(I_XS);
for (int rep_ = 0; rep_ < REP_SK; ++rep_)
#pragma unroll 1
          for (int tk = bx; tk < 16 * 32; tk += G) skinny_tile<SK_GLU>(sa, tk & 15, tk >> 4, (LAS float*)(L + RING_OFF), tid); }
    }
    SEAM(2);
#pragma unroll 1
    for (int layer = 0; layer < 2; ++layer) {
        const int pb = layer == 0 ? 3 : 12;
        if (layer == 1) {
            if (IN(9)) { PH_LOCALS
                { EpiWin E{B1, V1, out}; for (int rep_ = 0; rep_ < REP_GEMM; ++rep_) GEMM_PHASE(EpiWin, HB, R_WIN, TP, 3072, E); }
                { SkArgs sa{}; sa.A = HB; sa.W = WALL + (size_t)R_WIN * D; sa.v1 = V1; sa.out = out;
for (int rep_ = 0; rep_ < REP_SK; ++rep_)
#pragma unroll 1
                  for (int tk = bx; tk < 16 * 32; tk += G) skinny_tile<SK_WINV>(sa, tk & 15, tk >> 4, (LAS float*)(L + RING_OFF), tid);
                  sa.W = WALL + (size_t)(R_WIN + 2048) * D; sa.b1 = B1;
for (int rep_ = 0; rep_ < REP_SK; ++rep_)
#pragma unroll 1
                  for (int tk = bx; tk < 16 * 16; tk += G) skinny_tile<SK_WINB>(sa, tk & 15, tk >> 4, (LAS float*)(L + RING_OFF), tid); }
            }
            SEAM(9);
            if (IN(10)) { PH_LOCALS
                const float* cw = INP(I_CW);
                for (int m = gw; m < T; m += NGW) {
                    const bool smp = m >= TP; const int s = smp ? ((m - TP) & 3) : (m & (SEQ - 1));
#pragma unroll
                    for (int hh = 0; hh < 2; ++hh) { const int c0 = hh * 512 + 8 * lane;
                        const v4u bw = *(const v4u*)(B1 + (size_t)m * D + c0), v0 = *(const v4u*)(V1 + (size_t)m * D + c0);
                        float vm1[8], vm2[8];
                        if (s >= 1) { const v4u t1 = *(const v4u*)(V1 + (size_t)(m - 1) * D + c0); vm1[0] = bflo(t1.x); vm1[1] = bfhi(t1.x); vm1[2] = bflo(t1.y); vm1[3] = bfhi(t1.y); vm1[4] = bflo(t1.z); vm1[5] = bfhi(t1.z); vm1[6] = bflo(t1.w); vm1[7] = bfhi(t1.w); }
                        else if (smp) { const float* sp = INP(I_SCONV) + ((size_t)((m - TP) >> 2) * 2 + 1) * D + c0; const f32x4 a = *(const f32x4*)sp, b = *(const f32x4*)(sp + 4); vm1[0] = a[0]; vm1[1] = a[1]; vm1[2] = a[2]; vm1[3] = a[3]; vm1[4] = b[0]; vm1[5] = b[1]; vm1[6] = b[2]; vm1[7] = b[3]; }
                        else {
#pragma unroll
                            for (int i = 0; i < 8; ++i) vm1[i] = 0.f; }
                        if (s >= 2) { const v4u t2 = *(const v4u*)(V1 + (size_t)(m - 2) * D + c0); vm2[0] = bflo(t2.x); vm2[1] = bfhi(t2.x); vm2[2] = bflo(t2.y); vm2[3] = bfhi(t2.y); vm2[4] = bflo(t2.z); vm2[5] = bfhi(t2.z); vm2[6] = bflo(t2.w); vm2[7] = bfhi(t2.w); }
                        else if (smp) { const float* sp = INP(I_SCONV) + ((size_t)((m - TP) >> 2) * 2 + s) * D + c0; const f32x4 a = *(const f32x4*)sp, b = *(const f32x4*)(sp + 4); vm2[0] = a[0]; vm2[1] = a[1]; vm2[2] = a[2]; vm2[3] = a[3]; vm2[4] = b[0]; vm2[5] = b[1]; vm2[6] = b[2]; vm2[7] = b[3]; }
                        else {
#pragma unroll
                            for (int i = 0; i < 8; ++i) vm2[i] = 0.f; }
                        float vc[8], bg[8], w0[8], w1[8], w2[8];
                        vc[0] = bflo(v0.x); vc[1] = bfhi(v0.x); vc[2] = bflo(v0.y); vc[3] = bfhi(v0.y); vc[4] = bflo(v0.z); vc[5] = bfhi(v0.z); vc[6] = bflo(v0.w); vc[7] = bfhi(v0.w);
                        bg[0] = bflo(bw.x); bg[1] = bfhi(bw.x); bg[2] = bflo(bw.y); bg[3] = bfhi(bw.y); bg[4] = bflo(bw.z); bg[5] = bfhi(bw.z); bg[6] = bflo(bw.w); bg[7] = bfhi(bw.w);
                        { const f32x4 a = *(const f32x4*)(cw + c0), b = *(const f32x4*)(cw + c0 + 4); w0[0] = a[0]; w0[1] = a[1]; w0[2] = a[2]; w0[3] = a[3]; w0[4] = b[0]; w0[5] = b[1]; w0[6] = b[2]; w0[7] = b[3]; }
                        { const f32x4 a = *(const f32x4*)(cw + D + c0), b = *(const f32x4*)(cw + D + c0 + 4); w1[0] = a[0]; w1[1] = a[1]; w1[2] = a[2]; w1[3] = a[3]; w1[4] = b[0]; w1[5] = b[1]; w1[6] = b[2]; w1[7] = b[3]; }
                        { const f32x4 a = *(const f32x4*)(cw + 2 * D + c0), b = *(const f32x4*)(cw + 2 * D + c0 + 4); w2[0] = a[0]; w2[1] = a[1]; w2[2] = a[2]; w2[3] = a[3]; w2[4] = b[0]; w2[5] = b[1]; w2[6] = b[2]; w2[7] = b[3]; }
                        float r[8];
#pragma unroll
                        for (int i = 0; i < 8; ++i) r[i] = bg[i] * (w0[i] * vm2[i] + w1[i] * vm1[i] + w2[i] * vc[i]);
                        v4u ow; ow.x = pk2(r[0], r[1]); ow.y = pk2(r[2], r[3]); ow.z = pk2(r[4], r[5]); ow.w = pk2(r[6], r[7]);
                        *(v4u*)(ZB + (size_t)m * D + c0) = ow; }
                }
            }
            SEAM(10);
            if (IN(11)) { PH_LOCALS
                { EpiRes E{XR, HB, SSQB, INP(I_NMEM) + D}; GEMM_PHASE(EpiRes, ZB, R_WOUT, TP, 1024, E); }
                { SkArgs sa{}; sa.A = ZB; sa.W = WALL + (size_t)R_WOUT * D; sa.xr = XR; sa.hbo = HB; sa.ssq = SSQB; sa.gnext = INP(I_NMEM) + D;
#pragma unroll 1
                  for (int tk = bx; tk < 16 * 16; tk += G) skinny_tile<SK_RES>(sa, tk & 15, tk >> 4, (LAS float*)(L + RING_OFF), tid); }
            }
            SEAM(11);
        }
        const int ns_q = layer == 0 ? 32 : 16;
        if (IN(pb + 0)) { PH_LOCALS
            { EpiB16 E{QB, D, SSQB, ns_q}; for (int rep_ = 0; rep_ < REP_GEMM; ++rep_) GEMM_PHASE(EpiB16, HB, R_Q + layer * 1024, TP, 1024, E); }
            { SkArgs sa{}; sa.A = HB; sa.W = WALL + (size_t)(R_Q + layer * 1024) * D; sa.ssq = SSQB; sa.nslots = ns_q; sa.O = QB; sa.ldc = D;
for (int rep_ = 0; rep_ < REP_SK; ++rep_)
#pragma unroll 1
              for (int tk = bx; tk < 16 * 16; tk += G) skinny_tile<SK_B16>(sa, tk & 15, tk >> 4, (LAS float*)(L + RING_OFF), tid); }
        }
        SEAM(pb + 0);
        if (IN(pb + 1)) { PH_LOCALS
          for (int rep_ = 0; rep_ < REP_ATTN; ++rep_) {
            const bf16* KBl = KB + (size_t)layer * MROWS * D; const bf16* VTl = VT + (size_t)layer * NB * NH * HD * MEMT;
#pragma unroll 1
            for (int pass = 0; pass < 2; ++pass) {
              if ((pass ^ (bx & 1)) == 0) {
#pragma unroll 1
                for (int tk = bx; tk < NB * NH * (SEQ / 256); tk += G) { const int rb = tk & 7, bh = tk >> 3; attn_prompt_wg(QB, KBl, VTl, ZB, bh >> 2, bh & 3, rb * 256, L + RING_OFF, tid); }
              } else {
#pragma unroll 1
                for (int tk = bx; tk < DB * NH; tk += G) attn_sample_task(QB, INP(I_CK), INP(I_CV), ZB, layer, tk >> 2, tk & 3, (LAS float*)(L + RING_OFF), tid);
              }
            }
          }
        }
        SEAM(pb + 1);
        if (IN(pb + 2)) { PH_LOCALS
            { EpiRes E{XR, HB, SSQB, INP(I_NFFN) + layer * D}; GEMM_PHASE(EpiRes, ZB, R_O + layer * 1024, TP, 1024, E); }
            { SkArgs sa{}; sa.A = ZB; sa.W = WALL + (size_t)(R_O + layer * 1024) * D; sa.xr = XR; sa.hbo = HB; sa.ssq = SSQB; sa.gnext = INP(I_NFFN) + layer * D;
#pragma unroll 1
              for (int tk = bx; tk < 16 * 16; tk += G) skinny_tile<SK_RES>(sa, tk & 15, tk >> 4, (LAS float*)(L + RING_OFF), tid); }
        }
        SEAM(pb + 2);
        if (IN(pb + 3)) { PH_LOCALS
            { EpiB16 E{QP, 2048, SSQB, 16}; for (int rep_ = 0; rep_ < REP_GEMM; ++rep_) GEMM_PHASE(EpiB16, HB, R_PQ + layer * 2048, TP, 2048, E); }
            { SkArgs sa{}; sa.A = HB; sa.W = WALL + (size_t)(R_PQ + layer * 2048) * D; sa.ssq = SSQB; sa.nslots = 16; sa.O = QP; sa.ldc = 2048;
for (int rep_ = 0; rep_ < REP_SK; ++rep_)
#pragma unroll 1
              for (int tk = bx; tk < 16 * 32; tk += G) skinny_tile<SK_B16>(sa, tk & 15, tk >> 4, (LAS float*)(L + RING_OFF), tid); }
        }
        SEAM(pb + 3);
        if (IN(pb + 4)) { PH_LOCALS
          peer_stage_keys(KEYS + (size_t)layer * 2 * 128 * 128, L + RING_OFF, tid);
          __syncthreads();
          LAS int* ti = (LAS int*)(L + RING_OFF + PSEL_KEYS + wave * PSEL_TI);
          for (int rep_ = 0; rep_ < REP_PSEL; ++rep_)
#pragma unroll 1
            for (int tk = gw; tk < (T / 16) * 8; tk += NGW) peer_select_task(QP, L + RING_OFF, EID, EG, (tk >> 3) * 16, tk & 7, ti, lane);
        }
        SEAM(pb + 4);
        if (IN(pb + 5)) { PH_LOCALS
            const unsigned char* UVl = UVT + (size_t)layer * NEXP * 1536;
            if (layer == 0) peer_gather_wave6<false>(gw, NGW, lane, HB, EID, EG, UVl, XR, INP(I_NMIX) + D, SSQB, L + RING_OFF + wave * 2048);
            else peer_gather_wave6<true>(gw, NGW, lane, HB, EID, EG, UVl, XR, INP(I_NFIN), SSQB, L + RING_OFF + wave * 2048);
        }
        if (layer == 0) SEAM(pb + 5);
    }
#undef IN
#undef SEAM
#undef GEMM_PHASE
}

#ifndef MK_PER_PHASE
#define MK_PER_PHASE 0
#endif
extern "C" void kernel_launch(void* const* d_in, const int* in_sizes, int n_in, void* d_out, int out_size, void* d_ws, size_t ws_size, hipStream_t stream) {
    static int grid = 0;
    if (grid == 0) {
        if (n_in != N_IN || out_size != (int)O_END || ws_size < WS_END) { fprintf(stderr, "kernel_launch: unexpected shapes: n_in %d out %d ws %zu; nothing launched\n", n_in, out_size, ws_size); grid = -1; return; }
        int dev = 0, cus = 0, per_cu = 0;
        if (hipGetDevice(&dev) != hipSuccess || hipDeviceGetAttribute(&cus, hipDeviceAttributeMultiprocessorCount, dev) != hipSuccess) { fprintf(stderr, "kernel_launch: device query failed\n"); grid = -1; return; }
        if (hipFuncSetAttribute((const void*)mk_fwd, hipFuncAttributeMaxDynamicSharedMemorySize, LDS_BYTES) != hipSuccess) { fprintf(stderr, "kernel_launch: hipFuncSetAttribute failed\n"); grid = -1; return; }
        if (hipOccupancyMaxActiveBlocksPerMultiprocessor(&per_cu, (const void*)mk_fwd, NWAVES * 64, LDS_BYTES) != hipSuccess || per_cu < 1) { fprintf(stderr, "kernel_launch: occupancy query says %d blocks per CU\n", per_cu); per_cu = 1; }
        (void)hipGetLastError();
        grid = cus;
        if (grid > 256) grid = 256;
    }
    if (grid < 0) return;
    if (hipMemsetAsync((char*)d_ws + WS_CTL, 0, CTL_ZERO_BYTES, stream) != hipSuccess) { fprintf(stderr, "kernel_launch: memset failed\n"); return; }
    Args a{};
    for (int i = 0; i < N_IN; ++i) a.in[i] = (const float*)d_in[i];
    a.out = (float*)d_out; a.ws = (unsigned char*)d_ws;
#if MK_PER_PHASE
    for (int p = 0; p < N_PHASES; ++p) { a.ph_lo = p; a.ph_hi = p + 1; hipLaunchKernelGGL(mk_fwd, dim3(grid), dim3(NWAVES * 64), LDS_BYTES, stream, a); }
#else
    a.ph_lo = 0; a.ph_hi = N_PHASES;
    hipLaunchKernelGGL(mk_fwd, dim3(grid), dim3(NWAVES * 64), LDS_BYTES, stream, a);
#endif
    const hipError_t le = hipPeekAtLastError();
    if (le != hipSuccess) fprintf(stderr, "kernel_launch: launch failed: %s\n", hipGetErrorName(le));
}
```

```cpp
#include <hip/hip_runtime.h>
#include <cstdio>
#include <cstdint>
namespace pg8 {
#define PG8_LAS __attribute__((address_space(3)))
typedef unsigned short bf16_t;
typedef short bf16x8 __attribute__((ext_vector_type(8)));
typedef float f32x4 __attribute__((ext_vector_type(4)));
typedef unsigned u32x4 __attribute__((ext_vector_type(4)));
constexpr int BM = 256, BK = 64, HALF = 128, HTB = HALF * BK * 2  , STAGE_BYTES = 8 * HTB, NXCD = 8, WGM = 8;

__host__ __device__ __forceinline__ int lds_byte(int r, int c) { const int st = (r >> 4) * 2 + (c >> 5), rr = r & 15, cc = c & 31, ob = rr * 64 + cc * 2; return st * 1024 + (ob ^ (((ob >> 9) & 1) << 5)); }
__host__ __device__ __forceinline__ void stage_rc(int b, int& R, int& C) { const int st = b / 1024, sb = b % 1024, swz = sb ^ (((sb >> 9) & 1) << 5); R = (st >> 1) * 16 + swz / 64; C = (st & 1) * 32 + (swz % 64) / 2; }
__host__ __device__ __forceinline__ int perm32(int rho) { const int n = rho >> 4, i = rho & 15; return 8 * (i >> 2) + 4 * n + (i & 3); }

__device__ __forceinline__ const char* pg8_uni(const char* p) { asm volatile("" : "+s"(p)); return p; }
__device__ __forceinline__ unsigned pg8_vo(unsigned v) { asm volatile("" : "+v"(v)); return v; }
struct Unit { int pm, pn; };
struct Gemm { const bf16_t* A; const bf16_t* Bt; int M, N, K; };

struct StaticOrder {
    int nM, nN, nwg, G, c;
    __host__ __device__ void init(int M, int N, int G_, int c_) { nM = M / BM; nN = N / BM; nwg = nM * nN; G = G_; c = c_; }
    __host__ __device__ bool next(int i, Unit& u) const {
        const long L = (long)i * G + c; if (L >= nwg) return false;
        int wgid = (int)L; { const int q = nwg / NXCD, r = nwg % NXCD, xcd = wgid % NXCD, off = wgid / NXCD; wgid = (xcd < r ? xcd * (q + 1) : r * (q + 1) + (xcd - r) * q) + off; }
        const int nig = WGM * nN, gid = wgid / nig, fm = gid * WGM, gsz = (nM - fm) < WGM ? (nM - fm) : WGM;
        u.pm = fm + ((wgid % nig) % gsz); u.pn = (wgid % nig) / gsz; return true;
    }
    __device__ __forceinline__ void a_ready(const Unit&) const {}
    __device__ __forceinline__ void done(const Unit&) const {}
};

__device__ __forceinline__ unsigned cvt_pk_bf16(float lo, float hi) { unsigned r; asm volatile("v_cvt_pk_bf16_f32 %0, %1, %2" : "=v"(r) : "v"(lo), "v"(hi)); return r; }
typedef float f32x2 __attribute__((ext_vector_type(2)));
__device__ __forceinline__ f32x2 gelu_pk(f32x2 v) {
    const f32x2 av = __builtin_elementwise_abs(v), d = av * 0.2316418882f + 1.0f;
    f32x2 t; t.x = __builtin_amdgcn_rcpf(d.x); t.y = __builtin_amdgcn_rcpf(d.y);
    f32x2 q = t * 0.5307027145f + (-0.7265760135f); q = q * t + 0.7107068705f; q = q * t + (-0.142248368f); q = q * t + 0.127414796f; q = q * t;
    const f32x2 s = (v * v) * (-0.72134752044f);
    f32x2 e; e.x = __builtin_amdgcn_exp2f(s.x); e.y = __builtin_amdgcn_exp2f(s.y);
    const f32x2 m = v * (q * e), r = v - m;
    f32x2 o; o.x = v.x < 0.f ? m.x : r.x; o.y = v.y < 0.f ? m.y : r.y; return o;
}
template <class Epi, class Sched, bool ALIGN_EPI = false, bool SP2 = false>
__device__ __forceinline__ void gemm_phase(PG8_LAS unsigned char* lds, const Gemm g, const Sched& S, const Epi& E) {
    const int tid = (int)pg8_vo(threadIdx.x), wid = __builtin_amdgcn_readfirstlane(tid >> 6), lane = tid & 63, wr = wid >> 2, wc = wid & 3, fr = lane & 15, fq = lane >> 4;
    const int K = g.K, nt = K / BK;
    unsigned voffA[2], voffB[2];
#pragma unroll
    for (int i = 0; i < 2; ++i) { int R, C; stage_rc(tid * 16 + i * 8192, R, C); const int Rb = Epi::PERM ? ((R & ~31) + perm32(R & 31)) : R;
        voffA[i] = (unsigned)(R * K + C) * 2u; voffB[i] = (unsigned)(Rb * K + C) * 2u; }
    const size_t kstep = (size_t)(BK * 2);
    const size_t hstep = (size_t)HALF * K * 2;
    const size_t tstep = 2 * hstep;
    const unsigned ldsw = (unsigned)wid * 1024u;
    const int aoff = lds_byte(wr * 64 + fr, fq * 8), boff = lds_byte(wc * 32 + fr, fq * 8);
#define PG8_SA(b, h) (((b) * 2 + (h)) * HTB)
#define PG8_SB(b, h) ((4 + (b) * 2 + (h)) * HTB)
#define PG8_STAGE(bufoff, gbase, voff) do { _Pragma("unroll") for (int _i = 0; _i < 2; ++_i) \
        __builtin_amdgcn_global_load_lds((const unsigned*)(pg8_uni((const char*)(gbase)) + pg8_vo((voff)[_i])), (PG8_LAS unsigned*)(lds + (bufoff) + ldsw + _i * 8192), 16, 0, 0); } while (0)
#define PG8_LDA(dst, b, h) do { _Pragma("unroll") for (int m = 0; m < 4; ++m) _Pragma("unroll") for (int k = 0; k < 2; ++k) dst[m][k] = *(const PG8_LAS bf16x8*)(lds + PG8_SA(b, h) + aoff + m * 2048 + k * 1024); } while (0)
#define PG8_LDB(dst, b, h) do { _Pragma("unroll") for (int n = 0; n < 2; ++n) _Pragma("unroll") for (int k = 0; k < 2; ++k) dst[n][k] = *(const PG8_LAS bf16x8*)(lds + PG8_SB(b, h) + boff + n * 2048 + k * 1024); } while (0)
#define PG8_MMA(ai, bj, At, Bt) do { __builtin_amdgcn_s_setprio(1); _Pragma("unroll") for (int m = 0; m < 4; ++m) _Pragma("unroll") for (int n = 0; n < 2; ++n) _Pragma("unroll") for (int k = 0; k < 2; ++k) \
        acc[ai][bj][m][n] = __builtin_amdgcn_mfma_f32_16x16x32_bf16(Bt[n][k], At[m][k], acc[ai][bj][m][n], 0, 0, 0); __builtin_amdgcn_s_setprio(0); } while (0)
#define PG8_WAIT_V(n) asm volatile("s_waitcnt vmcnt(" #n ")" ::: "memory")
#define PG8_WAIT_L(n) asm volatile("s_waitcnt lgkmcnt(" #n ")" ::: "memory")
#define PG8_BAR __builtin_amdgcn_s_barrier()
#define PG8_SCHED __builtin_amdgcn_sched_barrier(0)
    Unit cur, nxt; int ui = 0;
    if (!S.next(0, cur)) return;
    f32x4 acc[2][2][4][2];
#pragma unroll
    for (int a = 0; a < 2; ++a)
#pragma unroll
        for (int b = 0; b < 2; ++b)
#pragma unroll
            for (int m = 0; m < 4; ++m)
#pragma unroll
                for (int n = 0; n < 2; ++n) acc[a][b][m][n] = (f32x4){0.f, 0.f, 0.f, 0.f};
    bf16x8 At[4][2], B0[2][2], B1[2][2];
    const char* cA = (const char*)g.A + (size_t)cur.pm * tstep; const char* cB = (const char*)g.Bt + (size_t)cur.pn * tstep;
    S.a_ready(cur);
    if constexpr (SP2) {
        PG8_STAGE(PG8_SB(0, 0), cB, voffB); PG8_STAGE(PG8_SB(0, 1), cB + hstep, voffB); PG8_STAGE(PG8_SA(0, 0), cA, voffA); PG8_STAGE(PG8_SA(0, 1), cA + hstep, voffA);
        if (wr == 1) PG8_BAR;
        PG8_WAIT_V(2); PG8_BAR;
        PG8_STAGE(PG8_SB(1, 0), cB + kstep, voffB); PG8_STAGE(PG8_SA(1, 0), cA + kstep, voffA); PG8_STAGE(PG8_SB(1, 1), cB + hstep + kstep, voffB);
        PG8_WAIT_V(6); PG8_BAR;
    } else {
        PG8_STAGE(PG8_SB(0, 0), cB, voffB); PG8_STAGE(PG8_SA(0, 0), cA, voffA); PG8_STAGE(PG8_SB(0, 1), cB + hstep, voffB); PG8_STAGE(PG8_SA(0, 1), cA + hstep, voffA);
        if (wr == 1) PG8_BAR;
        PG8_WAIT_V(4); PG8_BAR;
        PG8_STAGE(PG8_SB(1, 0), cB + kstep, voffB); PG8_STAGE(PG8_SA(1, 0), cA + kstep, voffA); PG8_STAGE(PG8_SB(1, 1), cB + hstep + kstep, voffB);
        PG8_WAIT_V(6); PG8_BAR;
    }
    for (;;) {
        const bool has_next = S.next(ui + 1, nxt);
        const char* nA = has_next ? (const char*)g.A + (size_t)nxt.pm * tstep : cA; const char* nB = has_next ? (const char*)g.Bt + (size_t)nxt.pn * tstep : cB;
        for (int t = 0; t < nt; t += 2) {
            const bool last = (t == nt - 2);
            const char* a1 = cA + (size_t)(t + 1) * kstep;
            const char* a2 = last ? nA : cA + (size_t)(t + 2) * kstep; const char* b2 = last ? nB : cB + (size_t)(t + 2) * kstep;
            const char* a3 = a2 + kstep; const char* b3 = b2 + kstep;
            if (last && has_next) S.a_ready(nxt);
            if constexpr (SP2) {
            PG8_LDB(B0, 0, 0); PG8_LDB(B1, 0, 1); PG8_SCHED; PG8_LDA(At, 0, 0); PG8_STAGE(PG8_SA(1, 1), a1 + hstep, voffA);
            PG8_WAIT_V(8); PG8_WAIT_L(0); PG8_BAR; PG8_MMA(0, 0, At, B0); PG8_MMA(0, 1, At, B1); PG8_BAR; PG8_SCHED;
            PG8_LDA(At, 0, 1); PG8_STAGE(PG8_SB(0, 0), b2, voffB); PG8_STAGE(PG8_SB(0, 1), b2 + hstep, voffB); PG8_STAGE(PG8_SA(0, 0), a2, voffA);
            PG8_WAIT_V(8); PG8_WAIT_L(0); PG8_BAR; PG8_MMA(1, 0, At, B0); PG8_MMA(1, 1, At, B1); PG8_BAR; PG8_SCHED;
            PG8_LDB(B0, 1, 0); PG8_LDB(B1, 1, 1); PG8_SCHED; PG8_LDA(At, 1, 0); PG8_STAGE(PG8_SA(0, 1), a2 + hstep, voffA);
            PG8_WAIT_V(8); PG8_WAIT_L(0); PG8_BAR; PG8_MMA(0, 0, At, B0); PG8_MMA(0, 1, At, B1); PG8_BAR; PG8_SCHED;
            PG8_LDA(At, 1, 1); PG8_STAGE(PG8_SB(1, 0), b3, voffB); PG8_STAGE(PG8_SB(1, 1), b3 + hstep, voffB); PG8_STAGE(PG8_SA(1, 0), a3, voffA);
            PG8_WAIT_V(8); PG8_WAIT_L(0); PG8_BAR; PG8_MMA(1, 0, At, B0); PG8_MMA(1, 1, At, B1); PG8_BAR; PG8_SCHED;
            } else {
            PG8_LDB(B0, 0, 0); PG8_SCHED; PG8_LDA(At, 0, 0); PG8_STAGE(PG8_SA(1, 1), a1 + hstep, voffA);
            PG8_WAIT_L(8); PG8_BAR; PG8_WAIT_L(0); PG8_MMA(0, 0, At, B0); PG8_BAR; PG8_SCHED;
            PG8_LDB(B1, 0, 1); PG8_STAGE(PG8_SB(0, 0), b2, voffB);
            PG8_BAR; PG8_WAIT_L(0); PG8_MMA(0, 1, At, B1); PG8_BAR;
            PG8_LDA(At, 0, 1); PG8_STAGE(PG8_SA(0, 0), a2, voffA);
            PG8_BAR; PG8_WAIT_L(0); PG8_MMA(1, 0, At, B0); PG8_BAR; PG8_SCHED;
            PG8_STAGE(PG8_SB(0, 1), b2 + hstep, voffB);
            PG8_WAIT_V(6); PG8_BAR; PG8_MMA(1, 1, At, B1); PG8_BAR;
            PG8_LDB(B0, 1, 0); PG8_SCHED; PG8_LDA(At, 1, 0); PG8_STAGE(PG8_SA(0, 1), a2 + hstep, voffA);
            PG8_WAIT_L(8); PG8_BAR; PG8_WAIT_L(0); PG8_MMA(0, 0, At, B0); PG8_BAR; PG8_SCHED;
            PG8_LDB(B1, 1, 1); PG8_STAGE(PG8_SB(1, 0), b3, voffB);
            PG8_BAR; PG8_WAIT_L(0); PG8_MMA(0, 1, At, B1); PG8_BAR;
            PG8_LDA(At, 1, 1); PG8_STAGE(PG8_SA(1, 0), a3, voffA);
            PG8_BAR; PG8_WAIT_L(0); PG8_MMA(1, 0, At, B0); PG8_BAR; PG8_SCHED;
            PG8_STAGE(PG8_SB(1, 1), b3 + hstep, voffB);
            PG8_WAIT_V(6); PG8_BAR; PG8_MMA(1, 1, At, B1); PG8_BAR;
            }
        }
        if constexpr (ALIGN_EPI) { if (wr == 0) PG8_BAR; }
        if constexpr (!Epi::AFTER_DRAIN) { E(acc, cur, wr, wc, fr, fq); S.done(cur); }
        if (!has_next) break;
#pragma unroll
        for (int a = 0; a < 2; ++a)
#pragma unroll
            for (int b = 0; b < 2; ++b)
#pragma unroll
                for (int m = 0; m < 4; ++m)
#pragma unroll
                    for (int n = 0; n < 2; ++n) acc[a][b][m][n] = (f32x4){0.f, 0.f, 0.f, 0.f};
        cur = nxt; cA = nA; cB = nB; ++ui;
        if constexpr (ALIGN_EPI) { if (wr == 1) PG8_BAR; }
    }
    PG8_WAIT_V(0);
    if constexpr (!ALIGN_EPI) { if (wr == 0) PG8_BAR; }
    PG8_BAR;
    if constexpr (Epi::AFTER_DRAIN) { E.fused(acc, cur, wr, wc, fr, fq, lds, wid, lane); S.done(cur); }
#undef PG8_SA
#undef PG8_SB
#undef PG8_STAGE
#undef PG8_LDA
#undef PG8_LDB
#undef PG8_MMA
#undef PG8_WAIT_V
#undef PG8_WAIT_L
#undef PG8_BAR
#undef PG8_SCHED
}
}
#define GAS __attribute__((address_space(1)))
#define LAS __attribute__((address_space(3)))
typedef unsigned short bf16;
typedef unsigned v4u __attribute__((ext_vector_type(4)));
typedef unsigned v2u __attribute__((ext_vector_type(2)));
typedef int v4i __attribute__((ext_vector_type(4)));
typedef float f32x4 __attribute__((ext_vector_type(4)));
typedef float f32x2 __attribute__((ext_vector_type(2)));
typedef short bf16x8 __attribute__((ext_vector_type(8)));
typedef __bf16 bf16x2_t __attribute__((ext_vector_type(2)));
typedef GAS unsigned gu32;
#define RLX_AGENT __ATOMIC_RELAXED, __HIP_MEMORY_SCOPE_AGENT
#define LDS_WAIT() asm volatile("s_waitcnt lgkmcnt(0)" ::: "memory")
#define VM_WAIT() asm volatile("s_waitcnt vmcnt(0)" ::: "memory")
__device__ __forceinline__ unsigned f2bf(float f) { unsigned u = __builtin_bit_cast(unsigned, f); return (u + 0x7fffu + ((u >> 16) & 1u)) >> 16; }
__device__ __forceinline__ unsigned pk2(float lo, float hi) { return pg8::cvt_pk_bf16(lo, hi); }
__device__ __forceinline__ float bflo(unsigned w) { return __builtin_bit_cast(float, w << 16); }
__device__ __forceinline__ float bfhi(unsigned w) { return __builtin_bit_cast(float, w & 0xffff0000u); }
__device__ __forceinline__ float wave_sum(float v) {
#pragma unroll
    for (int o = 1; o < 64; o <<= 1) v += __shfl_xor(v, o);
    return v;
}
__device__ __forceinline__ float wave_max(float v) {
#pragma unroll
    for (int o = 1; o < 64; o <<= 1) v = fmaxf(v, __shfl_xor(v, o));
    return v;
}
__device__ __forceinline__ float gelu1(float v) { const f32x2 r = pg8::gelu_pk((f32x2){v, 0.f}); return r.x; }
#define XB_TMO      128
#define XB_XCNT(j)  (256  + 64 * (j))
#define XB_XSUB(j)  (1280 + 64 * (j))
#define XB_XGEN(j)  (2304 + 64 * (j))
#define XB_TOP      3328
#define XB_TOPGEN   3392
#define XCD_BAR_WORDS 3456
#define XB_SPIN_CAP (1u << 18)

__device__ __forceinline__ unsigned xb_ld(unsigned* p)              { return __hip_atomic_load(p, __ATOMIC_RELAXED, __HIP_MEMORY_SCOPE_AGENT); }
__device__ __forceinline__ unsigned xb_add(unsigned* p, unsigned v) { return __hip_atomic_fetch_add(p, v, __ATOMIC_RELAXED, __HIP_MEMORY_SCOPE_AGENT); }
__device__ __forceinline__ unsigned xb_xcc_id() { return (unsigned)__builtin_amdgcn_s_getreg((3 << 11) | 20) & 0xFu; }
#define XB_SPIN(cond, bar) do { unsigned _sp = 0; while (cond) { __builtin_amdgcn_s_sleep(1); \
    if ((++_sp & 255u) == 0u) { if (xb_ld(&(bar)[XB_TMO])) break; if (_sp > XB_SPIN_CAP) { atomicAdd(&(bar)[XB_TMO], 1u); break; } } } } while (0)

struct XcdBarrier {
    unsigned* bar; unsigned x;
    volatile LAS unsigned* st;
};

__device__ __forceinline__ XcdBarrier xcd_barrier_post(unsigned* bar, volatile LAS unsigned* st) {
    XcdBarrier b; b.bar = bar; b.x = xb_xcc_id(); b.st = st;
    if (threadIdx.x == 0) (void)xb_add(&bar[XB_XCNT(b.x)], 1u);
    return b;
}
__device__ __forceinline__ void xcd_barrier_complete(unsigned* bar, unsigned x, unsigned& nloc, unsigned& nx) {
    const unsigned G = gridDim.x * gridDim.y * gridDim.z;
    unsigned sum, cnt, mine, sp = 0u;
    for (;;) {
        sum = 0u; cnt = 0u; mine = 0u;
#pragma unroll
        for (unsigned j = 0; j < 16; ++j) { const unsigned c = xb_ld(&bar[XB_XCNT(j)]); sum += c; cnt += (c > 0u) ? 1u : 0u; mine = (j == x) ? c : mine; }
        if (sum == G) break;
        __builtin_amdgcn_s_sleep(1);
        if ((++sp & 255u) == 0u) { if (xb_ld(&bar[XB_TMO])) break; if (sp > XB_SPIN_CAP) { atomicAdd(&bar[XB_TMO], 1u); break; } }
    }
    nloc = mine > 0u ? mine : 1u; nx = cnt > 0u ? cnt : 1u;
}

__device__ __forceinline__ void xcd_barrier(const XcdBarrier& b) {
    asm volatile("s_waitcnt vmcnt(0)" ::: "memory");
    __syncthreads();
    if (threadIdx.x == 0) {
        unsigned* bar = b.bar;
        __builtin_amdgcn_s_waitcnt(0);
        unsigned nloc = b.st[0], nx = b.st[1];
        if (nloc == 0u) { xcd_barrier_complete(bar, b.x, nloc, nx); b.st[0] = nloc; b.st[1] = nx; }
        const unsigned old = xb_add(&bar[XB_XSUB(b.x)], 1u);
        const unsigned gen = old / nloc;
        if (old + 1u == (gen + 1u) * nloc) {
            __builtin_amdgcn_fence(__ATOMIC_RELEASE, "agent");
            asm volatile("s_waitcnt vmcnt(0)" ::: "memory");
            const unsigned og = xb_add(&bar[XB_TOP], 1u);
            const unsigned tg = og / nx;
            if (og + 1u == (tg + 1u) * nx) xb_add(&bar[XB_TOPGEN], 1u);
            else XB_SPIN(xb_ld(&bar[XB_TOPGEN]) == tg, bar);
            __builtin_amdgcn_fence(__ATOMIC_ACQUIRE, "agent");
            xb_add(&bar[XB_XGEN(b.x)], 1u);
            asm volatile("s_waitcnt vmcnt(0)" ::: "memory");
        } else {
            XB_SPIN(xb_ld(&bar[XB_XGEN(b.x)]) == gen, bar);
            __builtin_amdgcn_fence(__ATOMIC_ACQUIRE, "agent");
            asm volatile("s_waitcnt vmcnt(0)" ::: "memory");
        }
    }
    __syncthreads();
}
constexpr int NWAVES = 8;
constexpr int D = 1024, NB = 8, SEQ = 2048, TP = NB * SEQ, DB = 128, DSQ = 4, TS = DB * DSQ, T = TP + TS;
constexpr int MEMT = 256, NH = 4, HD = 256, MROWS = NB * MEMT;
constexpr int NEXP = 16384;
constexpr float RMS_EPS = 1e-6f;
constexpr size_t O_Y = 0, O_SRP = 17301504, O_SIP = 17334272, O_CP = 17367040, O_MK = 17383424, O_MV = 21577728, O_SRS = 25772032, O_SIS = 26296320, O_CS = 26820608, O_END = 27082752;
enum { I_XP = 0, I_XS, I_MEM, I_SRE, I_SIM, I_SCONV, I_CK, I_CV, I_NMIX, I_NMEM, I_NFFN, I_NFIN, I_ARE, I_AIM, I_LDT, I_BRE, I_BIM, I_CRE, I_CIM, I_SD, I_WGLU, I_WIN, I_CW, I_WOUT,
       I_WQ, I_WK, I_WV, I_WO, I_PWQ, I_K1, I_K2, I_PU, I_PV, N_IN };
constexpr int R_KV = 0, R_GLU = 4096, R_Q = 6144, R_O = 8192, R_PQ = 10240, R_WIN = 14336, R_WOUT = 17408, R_END = 18432;
constexpr size_t MiB = 1u << 20;
constexpr size_t WS_CTL = 0, CTL_ZERO_BYTES = 1 * MiB;
constexpr size_t WS_WALL = 2 * MiB;
constexpr size_t WS_KEYS = 38 * MiB;
constexpr size_t WS_BBW = 39 * MiB;
constexpr size_t WS_CCW = 39 * MiB + 512 * 1024;
constexpr size_t WS_LB = 40 * MiB;
constexpr size_t WS_MEMB = 41 * MiB;
constexpr size_t WS_KB = 45 * MiB;
constexpr size_t WS_VT = 53 * MiB;
constexpr size_t WS_EID = 61 * MiB;
constexpr size_t WS_EG = 70 * MiB;
constexpr size_t WS_HB = 80 * MiB;
constexpr size_t WS_ZB = 114 * MiB;
constexpr size_t WS_QB = 148 * MiB;
constexpr size_t WS_QP = 182 * MiB;
constexpr size_t WS_B1 = 249 * MiB;
constexpr size_t WS_V1 = 283 * MiB;
constexpr size_t WS_UV = 320 * MiB;
constexpr size_t WS_SSQ = 384 * MiB;
constexpr size_t WS_END = 388 * MiB;
constexpr int CW_BAR = 4096;
constexpr int RING_OFF = 0, RING_BYTES = 131072;
constexpr int LDSCTL_OFF = RING_BYTES, MISC_OFF = LDSCTL_OFF + 320;
constexpr int LDS_BYTES = 147456;
using pg8::Unit;
struct EpiKV {
    static constexpr bool PERM = false, AFTER_DRAIN = false;
    float* out; bf16* KB; bf16* VT;
    __device__ __forceinline__ void operator()(const f32x4 (&acc)[2][2][4][2], const Unit& u, int wr, int wc, int fr, int fq) const {
        fr = (int)pg8::pg8_vo((unsigned)fr); fq = (int)pg8::pg8_vo((unsigned)fq);
        const int b = u.pm, mat = u.pn >> 2, l = mat >> 1, isv = mat & 1, h = u.pn & 3;
        float* ob = out + (isv ? O_MV : O_MK) + (size_t)(l * NB + b) * MEMT * D + h * HD;
#pragma unroll
        for (int ai = 0; ai < 2; ++ai)
#pragma unroll
            for (int m = 0; m < 4; ++m) { const int mm = ai * 128 + wr * 64 + m * 16 + fr;
#pragma unroll
                for (int bj = 0; bj < 2; ++bj)
#pragma unroll
                    for (int n = 0; n < 2; ++n) { const int dl = bj * 128 + wc * 32 + n * 16 + 4 * fq; const f32x4 v = acc[ai][bj][m][n];
                        *(f32x4*)(ob + (size_t)mm * D + dl) = v;
                        if (!isv) { v2u w; w.x = pk2(v[0], v[1]); w.y = pk2(v[2], v[3]); *(v2u*)(KB + ((size_t)l * MROWS + b * MEMT + mm) * D + h * HD + dl) = w; }
                        else { bf16* vp = VT + ((((size_t)l * NB + b) * NH + h) * HD + dl) * MEMT + ((mm & ~31) | (((mm >> 2) & 3) << 3) | (((mm >> 4) & 1) << 2) | (mm & 3));
#pragma unroll
                            for (int j = 0; j < 4; ++j) vp[(size_t)j * MEMT] = (bf16)f2bf(v[j]); } } }
    }
};
struct EpiGLU {
    static constexpr bool PERM = false, AFTER_DRAIN = false;
    const float* xp; float* XR; bf16* HBo; float* SSQ; const float* gnext;
    __device__ __forceinline__ void operator()(const f32x4 (&acc)[2][2][4][2], const Unit& u, int wr, int wc, int fr, int fq) const {
        fr = (int)pg8::pg8_vo((unsigned)fr); fq = (int)pg8::pg8_vo((unsigned)fq);
        const int row0 = u.pm * 256 + wr * 64 + fr, col0 = u.pn * 128 + wc * 32 + 4 * fq;
        const f32x4 g0 = *(const f32x4*)(gnext + col0), g1 = *(const f32x4*)(gnext + col0 + 16);
#pragma unroll
        for (int ai = 0; ai < 2; ++ai)
#pragma unroll
            for (int mp = 0; mp < 2; ++mp) { f32x4 xv[2][2];
#pragma unroll
                for (int mm = 0; mm < 2; ++mm)
#pragma unroll
                    for (int n = 0; n < 2; ++n) xv[mm][n] = *(const f32x4*)(xp + (size_t)(row0 + ai * 128 + (2 * mp + mm) * 16) * D + col0 + n * 16);
#pragma unroll
                for (int mm = 0; mm < 2; ++mm) { const int m = 2 * mp + mm, row = row0 + ai * 128 + m * 16; const size_t ro = (size_t)row * D + col0; float ss = 0.f;
#pragma unroll
                    for (int n = 0; n < 2; ++n) { const f32x4 a = acc[ai][0][m][n], b = acc[ai][1][m][n]; f32x4 o;
#pragma unroll
                        for (int j = 0; j < 4; ++j) { o[j] = xv[mm][n][j] + a[j] / (1.0f + __expf(-b[j])); ss = fmaf(o[j], o[j], ss); }
                        *(f32x4*)(XR + ro + n * 16) = o; const f32x4 hg = o * (n ? g1 : g0); v2u w; w.x = pk2(hg[0], hg[1]); w.y = pk2(hg[2], hg[3]); *(v2u*)(HBo + ro + n * 16) = w; }
                    ss += __shfl_xor(ss, 16); ss += __shfl_xor(ss, 32);
                    if (fq == 0) SSQ[(size_t)row * 32 + u.pn * 4 + wc] = ss; }
                asm volatile("" ::: "memory"); }
    }
};
__device__ __forceinline__ float row_rinv(const float* SSQ, size_t row, int nslots) {
    const f32x4* p = (const f32x4*)(SSQ + row * 32); f32x4 s = p[0] + p[1] + p[2] + p[3];
    if (nslots > 16) s += p[4] + p[5] + p[6] + p[7];
    return 1.0f / sqrtf(((s[0] + s[1]) + (s[2] + s[3])) * (1.0f / D) + RMS_EPS);
}
struct EpiB16 {
    static constexpr bool PERM = true, AFTER_DRAIN = false;
    bf16* O; int ldc; const float* SSQ; int nslots;
    __device__ __forceinline__ void operator()(const f32x4 (&acc)[2][2][4][2], const Unit& u, int wr, int wc, int fr, int fq) const {
        fr = (int)pg8::pg8_vo((unsigned)fr); fq = (int)pg8::pg8_vo((unsigned)fq);
        const int rb = u.pm * 256 + wr * 64, row0 = rb + fr, col0 = u.pn * 256 + wc * 32 + 8 * fq, ln = fq * 16 + fr;
        const float r0 = row_rinv(SSQ, (size_t)(rb + ln), nslots), r1 = row_rinv(SSQ, (size_t)(rb + 128 + ln), nslots);
#pragma unroll
        for (int ai = 0; ai < 2; ++ai)
#pragma unroll
            for (int m = 0; m < 4; ++m) { const size_t row = (size_t)(row0 + ai * 128 + m * 16); bf16* rowp = O + row * ldc + col0; const float ri = __shfl(ai ? r1 : r0, m * 16 + fr);
#pragma unroll
                for (int bj = 0; bj < 2; ++bj) { const f32x4 v0 = acc[ai][bj][m][0] * ri, v1 = acc[ai][bj][m][1] * ri;
                    v4u w; w.x = pk2(v0[0], v0[1]); w.y = pk2(v0[2], v0[3]); w.z = pk2(v1[0], v1[1]); w.w = pk2(v1[2], v1[3]);
                    *(v4u*)(rowp + bj * 128) = w; } }
    }
};
struct EpiRes {
    static constexpr bool PERM = false, AFTER_DRAIN = false;
    float* XR; bf16* HBo; float* SSQ; const float* gnext;
    __device__ __forceinline__ void operator()(const f32x4 (&acc)[2][2][4][2], const Unit& u, int wr, int wc, int fr, int fq) const {
        fr = (int)pg8::pg8_vo((unsigned)fr); fq = (int)pg8::pg8_vo((unsigned)fq);
        const int row0 = u.pm * 256 + wr * 64 + fr, col0 = u.pn * 256 + wc * 32 + 4 * fq;
        f32x4 gv[2][2];
#pragma unroll
        for (int bj = 0; bj < 2; ++bj)
#pragma unroll
            for (int n = 0; n < 2; ++n) gv[bj][n] = *(const f32x4*)(gnext + col0 + bj * 128 + n * 16);
#pragma unroll
        for (int ai = 0; ai < 2; ++ai)
#pragma unroll
            for (int mp = 0; mp < 2; ++mp) { f32x4 xv[2][2][2];
#pragma unroll
                for (int mm = 0; mm < 2; ++mm)
#pragma unroll
                    for (int bj = 0; bj < 2; ++bj)
#pragma unroll
                        for (int n = 0; n < 2; ++n) xv[mm][bj][n] = *(const f32x4*)(XR + (size_t)(row0 + ai * 128 + (2 * mp + mm) * 16) * D + col0 + bj * 128 + n * 16);
#pragma unroll
                for (int mm = 0; mm < 2; ++mm) { const int m = 2 * mp + mm, row = row0 + ai * 128 + m * 16; const size_t ro = (size_t)row * D + col0; float ss = 0.f;
#pragma unroll
                    for (int bj = 0; bj < 2; ++bj)
#pragma unroll
                        for (int n = 0; n < 2; ++n) { const f32x4 o = xv[mm][bj][n] + acc[ai][bj][m][n]; *(f32x4*)(XR + ro + bj * 128 + n * 16) = o;
                            ss = fmaf(o[0], o[0], fmaf(o[1], o[1], fmaf(o[2], o[2], fmaf(o[3], o[3], ss))));
                            const f32x4 hg = o * gv[bj][n]; v2u w; w.x = pk2(hg[0], hg[1]); w.y = pk2(hg[2], hg[3]); *(v2u*)(HBo + ro + bj * 128 + n * 16) = w; }
                    ss += __shfl_xor(ss, 16); ss += __shfl_xor(ss, 32);
                    if (fq == 0) SSQ[(size_t)row * 32 + u.pn * 4 + wc] = ss; }
                asm volatile("" ::: "memory"); }
    }
};
struct EpiWin {
    static constexpr bool PERM = false, AFTER_DRAIN = false;
    bf16* B1; bf16* V1; float* out;
    __device__ __forceinline__ void operator()(const f32x4 (&acc)[2][2][4][2], const Unit& u, int wr, int wc, int fr, int fq) const {
        fr = (int)pg8::pg8_vo((unsigned)fr); fq = (int)pg8::pg8_vo((unsigned)fq);
        const int row0 = u.pm * 256 + wr * 64 + fr;
        if (u.pn < 8) {
#pragma unroll
            for (int ai = 0; ai < 2; ++ai)
#pragma unroll
                for (int m = 0; m < 4; ++m) { const int row = row0 + ai * 128 + m * 16; const int col0 = u.pn * 128 + wc * 32 + 4 * fq;
                    float* cs = nullptr;
                    { const int s = row & (SEQ - 1); if (s >= SEQ - 2) cs = out + O_CP + ((size_t)(row >> 11) * 2 + (s - (SEQ - 2))) * D; }
#pragma unroll
                    for (int n = 0; n < 2; ++n) { const f32x4 v = acc[ai][0][m][n] * acc[ai][1][m][n];
                        v2u w; w.x = pk2(v[0], v[1]); w.y = pk2(v[2], v[3]); *(v2u*)(V1 + (size_t)row * D + col0 + n * 16) = w;
                        if (cs) *(f32x4*)(cs + col0 + n * 16) = v; } }
        } else {
#pragma unroll
            for (int ai = 0; ai < 2; ++ai)
#pragma unroll
                for (int m = 0; m < 4; ++m) { bf16* rowp = B1 + (size_t)(row0 + ai * 128 + m * 16) * D + (u.pn - 8) * 256 + wc * 32 + 4 * fq;
#pragma unroll
                    for (int bj = 0; bj < 2; ++bj)
#pragma unroll
                        for (int n = 0; n < 2; ++n) { const f32x4 v = acc[ai][bj][m][n]; v2u w; w.x = pk2(v[0], v[1]); w.y = pk2(v[2], v[3]); *(v2u*)(rowp + bj * 128 + n * 16) = w; } }
        }
    }
};
__device__ __forceinline__ bf16x8 mk8(v4u w) { return __builtin_bit_cast(bf16x8, w); }
__device__ __forceinline__ f32x4 mfma16(bf16x8 a, bf16x8 b, f32x4 c) { return __builtin_amdgcn_mfma_f32_16x16x32_bf16(a, b, c, 0, 0, 0); }

__device__ __forceinline__ void p0_transpose_item(const float* W, int N, int src_n0, bf16* WTrows, int k0, LAS float* scr, int lane) {
#pragma unroll
    for (int i = 0; i < 8; ++i) { const int kk = 8 * i + (lane >> 3), n4 = (lane & 7) * 4; const f32x4 v = *(const f32x4*)(W + (size_t)(k0 + kk) * N + src_n0 + n4);
        scr[kk * 33 + n4] = v[0]; scr[kk * 33 + n4 + 1] = v[1]; scr[kk * 33 + n4 + 2] = v[2]; scr[kk * 33 + n4 + 3] = v[3]; }
    LDS_WAIT();
    const int c = lane & 7;
#pragma unroll
    for (int j = 0; j < 4; ++j) { const int n = (lane >> 3) + 8 * j; const LAS float* s = scr + (8 * c) * 33 + n;
        v4u o; o.x = pk2(s[0 * 33], s[1 * 33]); o.y = pk2(s[2 * 33], s[3 * 33]); o.z = pk2(s[4 * 33], s[5 * 33]); o.w = pk2(s[6 * 33], s[7 * 33]);
        *(v4u*)(WTrows + (size_t)n * D + k0 + 8 * c) = o; }
    LDS_WAIT();
}
__device__ __forceinline__ void rms_row_bf16(const float* xrow, const float* g, bf16* orow, int lane) {
    const f32x4* xr = (const f32x4*)xrow + lane; f32x4 v[4]; float s = 0.f;
#pragma unroll
    for (int j = 0; j < 4; ++j) { v[j] = xr[64 * j]; s += (v[j].x * v[j].x + v[j].y * v[j].y) + (v[j].z * v[j].z + v[j].w * v[j].w); }
    const float r = 1.0f / sqrtf(wave_sum(s) * (1.0f / D) + RMS_EPS);
#pragma unroll
    for (int j = 0; j < 4; ++j) { const f32x4 gv = ((const f32x4*)g)[lane + 64 * j]; v2u w; w.x = pk2(v[j].x * r * gv.x, v[j].y * r * gv.y); w.y = pk2(v[j].z * r * gv.z, v[j].w * r * gv.w);
        *(v2u*)(orow + 4 * lane + 256 * j) = w; }
}

template <bool SAMPLE, bool WITH_Y>
__device__ __forceinline__ void s5_run(const bf16* HB, bf16* ZB, const bf16* BBW, const bf16* CCW, const float* dsk, LAS float* ST, int lane,
                                       int g, int row0, int nchunks, int b0, const float* s0re, const float* s0im, float* ore, float* oim, float lbr, float lbi, float& sr, float& si) {
    const int tl = lane & 15, q4 = lane >> 4;
    const bf16x8 zero8 = {0, 0, 0, 0, 0, 0, 0, 0};
    bf16x8 Abb[8], Acc[4];
#pragma unroll
    for (int tt = 0; tt < 8; ++tt) Abb[tt] = (q4 < 2) ? *(const bf16x8*)(BBW + ((size_t)(g * 128 + 16 * tt + tl)) * 16 + 8 * q4) : zero8;
    if (WITH_Y) {
#pragma unroll
        for (int s = 0; s < 4; ++s) Acc[s] = *(const bf16x8*)(CCW + ((size_t)(g * 16 + tl)) * 128 + 32 * s + 8 * q4); }
    const f32x4 dv = WITH_Y ? *(const f32x4*)(dsk + 16 * g + 4 * q4) : (f32x4){0.f, 0.f, 0.f, 0.f};
    const bf16* hp = HB + (size_t)(row0 + tl) * D + 16 * g;
    bf16x8 Bn = (q4 < 2) ? *(const bf16x8*)(hp + 8 * q4) : zero8; v2u hn = WITH_Y ? *(const v2u*)(hp + 4 * q4) : (v2u){0u, 0u};
    for (int ch = 0; ch < nchunks; ++ch) {
        const int rowc = row0 + 16 * ch;
        const bf16x8 Bu = Bn; const v2u hw = hn;
        if (ch + 1 < nchunks) { const bf16* hq = hp + (size_t)(16 * (ch + 1)) * D; Bn = (q4 < 2) ? *(const bf16x8*)(hq + 8 * q4) : zero8; if (WITH_Y) hn = *(const v2u*)(hq + 4 * q4); }
#pragma unroll
        for (int tt = 0; tt < 8; ++tt) { const f32x4 a = mfma16(Abb[tt], Bu, (f32x4){0.f, 0.f, 0.f, 0.f}); *(LAS f32x4*)(ST + tl * 132 + 16 * tt + 4 * q4) = a; }
        LDS_WAIT();
        float br[16], bi[16];
#pragma unroll
        for (int t = 0; t < 16; ++t) { br[t] = ST[t * 132 + lane]; bi[t] = ST[t * 132 + 64 + lane]; }
#pragma unroll
        for (int t = 0; t < 16; ++t) {
            if (SAMPLE && (t & 3) == 0) { const size_t si0 = ((size_t)(b0 + (t >> 2)) * 64 + g) * 64 + lane; sr = s0re[si0]; si = s0im[si0]; }
            const float nr = fmaf(-lbi, si, fmaf(lbr, sr, br[t])), ni = fmaf(lbi, sr, fmaf(lbr, si, bi[t]));
            sr = nr; si = ni;
            if (WITH_Y) { ST[t * 132 + lane] = sr; ST[t * 132 + 64 + lane] = si; }
            if (SAMPLE && (t & 3) == 3) { const size_t so = ((size_t)(b0 + (t >> 2)) * 64 + g) * 64 + lane; ore[so] = sr; oim[so] = si; }
        }
        LDS_WAIT();
        if (WITH_Y) {
            f32x4 y = {0.f, 0.f, 0.f, 0.f};
#pragma unroll
            for (int s = 0; s < 4; ++s) { const f32x4 lo = *(const LAS f32x4*)(ST + tl * 132 + 32 * s + 8 * q4), hi = *(const LAS f32x4*)(ST + tl * 132 + 32 * s + 8 * q4 + 4);
                v4u w; w.x = pk2(lo[0], lo[1]); w.y = pk2(lo[2], lo[3]); w.z = pk2(hi[0], hi[1]); w.w = pk2(hi[2], hi[3]);
                y = mfma16(Acc[s], mk8(w), y); }
            LDS_WAIT();
            y[0] = fmaf(dv[0], bflo(hw.x), y[0]); y[1] = fmaf(dv[1], bfhi(hw.x), y[1]); y[2] = fmaf(dv[2], bflo(hw.y), y[2]); y[3] = fmaf(dv[3], bfhi(hw.y), y[3]);
            const f32x2 g0 = pg8::gelu_pk((f32x2){y[0], y[1]}), g1 = pg8::gelu_pk((f32x2){y[2], y[3]});
            v2u zo; zo.x = pk2(g0.x, g0.y); zo.y = pk2(g1.x, g1.y);
            *(v2u*)(ZB + (size_t)(rowc + tl) * D + 16 * g + 4 * q4) = zo;
        }
    }
}
constexpr int S5_ST_BYTES = 8448, S5_XE_OFF = 8 * S5_ST_BYTES;
__device__ __forceinline__ void s5_prompt_seq(const bf16* HB, bf16* ZB, const bf16* BBW, const bf16* CCW, const float* LB, const float* dsk, LAS unsigned char* lds, int tid, int b, int g, float* ore, float* oim) {
    const int lane = tid & 63, seg = tid >> 6;
    LAS float* ST = (LAS float*)(lds + seg * S5_ST_BYTES); LAS float* XE = (LAS float*)(lds + S5_XE_OFF);
    const float lbr = LB[(g * 64 + lane) * 2], lbi = LB[(g * 64 + lane) * 2 + 1];
    const int row0 = b * SEQ + seg * 256;
    float sr = 0.f, si = 0.f;
    s5_run<false, false>(HB, ZB, BBW, CCW, dsk, ST, lane, g, row0, 16, b, nullptr, nullptr, nullptr, nullptr, lbr, lbi, sr, si);
    XE[(seg * 64 + lane) * 2] = sr; XE[(seg * 64 + lane) * 2 + 1] = si;
    float pr = lbr, pi = lbi;
#pragma unroll
    for (int k = 0; k < 8; ++k) { const float nr = pr * pr - pi * pi, ni = 2.f * pr * pi; pr = nr; pi = ni; }
    __syncthreads();
    float cr = 0.f, ci = 0.f;
    for (int sp = 0; sp < seg; ++sp) { const float er = XE[(sp * 64 + lane) * 2], ei = XE[(sp * 64 + lane) * 2 + 1]; const float nr = pr * cr - pi * ci + er, ni = pr * ci + pi * cr + ei; cr = nr; ci = ni; }
    __syncthreads();
    sr = cr; si = ci;
    s5_run<false, true>(HB, ZB, BBW, CCW, dsk, ST, lane, g, row0, 16, b, nullptr, nullptr, nullptr, nullptr, lbr, lbi, sr, si);
    if (seg == 7) { const size_t so = ((size_t)b * 64 + g) * 64 + lane; ore[so] = sr; oim[so] = si; }
}

__device__ __forceinline__ float xreduce16(const float (&p)[16], int lane) {
    float q[8], r[4], s[2];
    const bool b5 = (lane & 32) != 0, b4 = (lane & 16) != 0, b3 = (lane & 8) != 0, b2 = (lane & 4) != 0;
#pragma unroll
    for (int k = 0; k < 8; ++k) { const float send = b5 ? p[k] : p[k + 8], keep = b5 ? p[k + 8] : p[k]; q[k] = keep + __shfl_xor(send, 32); }
#pragma unroll
    for (int k = 0; k < 4; ++k) { const float send = b4 ? q[k] : q[k + 4], keep = b4 ? q[k + 4] : q[k]; r[k] = keep + __shfl_xor(send, 16); }
#pragma unroll
    for (int k = 0; k < 2; ++k) { const float send = b3 ? r[k] : r[k + 2], keep = b3 ? r[k + 2] : r[k]; s[k] = keep + __shfl_xor(send, 8); }
    const float send = b2 ? s[0] : s[1], keep = b2 ? s[1] : s[0]; float t = keep + __shfl_xor(send, 4);
    t += __shfl_xor(t, 2); t += __shfl_xor(t, 1);
    return t;
}

__host__ __device__ __forceinline__ int vt_pos(int m) { return (m & ~31) | (((m >> 2) & 3) << 3) | (((m >> 4) & 1) << 2) | (m & 3); }
__device__ __forceinline__ void stage_tile256(const bf16* src, int ldsrc, LAS unsigned char* tb, int tid) {
#pragma unroll 1
    for (int hp = 0; hp < 2; ++hp) { v4u r[8];
#pragma unroll
        for (int i = 0; i < 8; ++i) { const int c = tid + 512 * (8 * hp + i), row = c >> 5, ch = c & 31; r[i] = *(const v4u*)(src + (size_t)row * ldsrc + ch * 8); }
#pragma unroll
        for (int i = 0; i < 8; ++i) { const int c = tid + 512 * (8 * hp + i), row = c >> 5, ch = c & 31; *(LAS v4u*)(tb + row * 512 + ((ch ^ (row & 15)) << 4)) = r[i]; } }
}
__device__ __forceinline__ float attn_softmax(f32x4 (&S)[16], bf16x8 (&Pf)[8]) {
    float mx = -3.0e38f;
#pragma unroll
    for (int mt = 0; mt < 16; ++mt) mx = fmaxf(fmaxf(mx, fmaxf(S[mt][0], S[mt][1])), fmaxf(S[mt][2], S[mt][3]));
    mx = fmaxf(mx, __shfl_xor(mx, 16)); mx = fmaxf(mx, __shfl_xor(mx, 32));
    const float sc2 = 0.0625f * 1.4426950408889634f; float sum = 0.f;
#pragma unroll
    for (int mt = 0; mt < 16; ++mt)
#pragma unroll
        for (int i = 0; i < 4; ++i) { const float p = __builtin_amdgcn_exp2f((S[mt][i] - mx) * sc2); S[mt][i] = p; sum += p; }
    sum += __shfl_xor(sum, 16); sum += __shfl_xor(sum, 32);
#pragma unroll
    for (int ks = 0; ks < 8; ++ks) { v4u w; w.x = pk2(S[2 * ks][0], S[2 * ks][1]); w.y = pk2(S[2 * ks][2], S[2 * ks][3]); w.z = pk2(S[2 * ks + 1][0], S[2 * ks + 1][1]); w.w = pk2(S[2 * ks + 1][2], S[2 * ks + 1][3]); Pf[ks] = mk8(w); }
    return 1.0f / sum;
}
__device__ __forceinline__ void attn_prompt_wg(const bf16* QB, const bf16* KBl, const bf16* VTl, bf16* OB, int b, int h, int r0, LAS unsigned char* tb, int tid) {
    const int lane = tid & 63, w = tid >> 6, tl = lane & 15, q4 = lane >> 4;
    const size_t rowA = (size_t)b * SEQ + r0 + 16 * w + tl, rowB = rowA + 128;
    stage_tile256(KBl + (size_t)b * MEMT * D + h * HD, D, tb, tid);
    __syncthreads();
    f32x4 SA[16], SB[16];
#pragma unroll
    for (int mt = 0; mt < 16; ++mt) { SA[mt] = (f32x4){0.f, 0.f, 0.f, 0.f}; SB[mt] = (f32x4){0.f, 0.f, 0.f, 0.f}; }
    const bf16* qa = QB + rowA * D + h * HD + 8 * q4; const bf16* qb = QB + rowB * D + h * HD + 8 * q4;
    const LAS unsigned char* fb = tb + tl * 512;
#pragma unroll 2
    for (int ks = 0; ks < 8; ++ks) { const bf16x8 fa = *(const bf16x8*)(qa + 32 * ks), fbq = *(const bf16x8*)(qb + 32 * ks); const int co = ((4 * ks + q4) ^ tl) << 4;
#pragma unroll
        for (int mt = 0; mt < 16; ++mt) { const bf16x8 kf = *(const LAS bf16x8*)(fb + mt * 8192 + co); SA[mt] = mfma16(kf, fa, SA[mt]); SB[mt] = mfma16(kf, fbq, SB[mt]); } }
    bf16x8 PA[8], PB[8];
    const float invA = attn_softmax(SA, PA), invB = attn_softmax(SB, PB);
    __syncthreads();
    stage_tile256(VTl + ((size_t)b * NH + h) * HD * MEMT, MEMT, tb, tid);
    __syncthreads();
#pragma unroll 2
    for (int dt = 0; dt < 16; ++dt) { f32x4 oa = {0.f, 0.f, 0.f, 0.f}, ob = {0.f, 0.f, 0.f, 0.f};
#pragma unroll
        for (int ks = 0; ks < 8; ++ks) { const bf16x8 vf = *(const LAS bf16x8*)(fb + dt * 8192 + (((4 * ks + q4) ^ tl) << 4)); oa = mfma16(vf, PA[ks], oa); ob = mfma16(vf, PB[ks], ob); }
        v2u wa, wb; wa.x = pk2(oa[0] * invA, oa[1] * invA); wa.y = pk2(oa[2] * invA, oa[3] * invA); wb.x = pk2(ob[0] * invB, ob[1] * invB); wb.y = pk2(ob[2] * invB, ob[3] * invB);
        *(v2u*)(OB + rowA * D + h * HD + 16 * dt + 4 * q4) = wa; *(v2u*)(OB + rowB * D + h * HD + 16 * dt + 4 * q4) = wb; }
    __syncthreads();
}
__device__ __forceinline__ void attn_sample_task(const bf16* QB, const float* ck, const float* cv, bf16* OB, int l, int b, int h, LAS float* lds, int tid) {
    const int lane = tid & 63, w = tid >> 6;
    LAS float* sc = lds; LAS float* red = lds + 1024;
    const size_t cbase = ((((size_t)l * DB + b) * MEMT) * NH + h) * HD;
    const float* kp = ck + cbase + (size_t)(32 * w) * (NH * HD) + 4 * lane; const float* vp = cv + cbase + (size_t)(32 * w) * (NH * HD) + 4 * lane;
    f32x4 kr[32];
#pragma unroll
    for (int mi = 0; mi < 32; ++mi) kr[mi] = __builtin_nontemporal_load((const f32x4*)(kp + (size_t)mi * (NH * HD)));
    float qf[4][4];
#pragma unroll
    for (int s = 0; s < 4; ++s) { const v2u qw = *(const v2u*)(QB + (size_t)(TP + 4 * b + s) * D + h * HD + 4 * lane); qf[s][0] = bflo(qw.x); qf[s][1] = bfhi(qw.x); qf[s][2] = bflo(qw.y); qf[s][3] = bfhi(qw.y); }
#pragma unroll
    for (int gi = 0; gi < 8; ++gi) { float pd[16];
#pragma unroll
        for (int ri = 0; ri < 4; ++ri) { const f32x4 kv = kr[4 * gi + ri];
#pragma unroll
            for (int s = 0; s < 4; ++s) pd[4 * ri + s] = kv[0] * qf[s][0] + kv[1] * qf[s][1] + kv[2] * qf[s][2] + kv[3] * qf[s][3]; }
        const float tot = xreduce16(pd, lane); const int k = lane >> 2;
        if ((lane & 3) == 0) sc[(k & 3) * 256 + 32 * w + 4 * gi + (k >> 2)] = tot * 0.0625f; }
    f32x4 vr[32];
#pragma unroll
    for (int mi = 0; mi < 32; ++mi) vr[mi] = __builtin_nontemporal_load((const f32x4*)(vp + (size_t)mi * (NH * HD)));
    __syncthreads();
    if (w < 4) { float v[4]; float mx = -3.0e38f;
#pragma unroll
        for (int j = 0; j < 4; ++j) { v[j] = sc[w * 256 + lane + 64 * j]; mx = fmaxf(mx, v[j]); }
        mx = wave_max(mx); float sum = 0.f;
#pragma unroll
        for (int j = 0; j < 4; ++j) { v[j] = __expf(v[j] - mx); sum += v[j]; }
        sum = wave_sum(sum); const float inv = 1.0f / sum;
#pragma unroll
        for (int j = 0; j < 4; ++j) sc[w * 256 + lane + 64 * j] = v[j] * inv; }
    __syncthreads();
    f32x4 o[4];
#pragma unroll
    for (int s = 0; s < 4; ++s) o[s] = (f32x4){0.f, 0.f, 0.f, 0.f};
#pragma unroll
    for (int mi = 0; mi < 32; ++mi) {
#pragma unroll
        for (int s = 0; s < 4; ++s) { const float p = sc[s * 256 + 32 * w + mi]; o[s] += vr[mi] * p; } }
#pragma unroll
    for (int s = 0; s < 4; ++s) *(LAS f32x4*)(red + (w * 4 + s) * 256 + 4 * lane) = o[s];
    __syncthreads();
    { const int idx = tid * 2, s = idx >> 8, d = idx & 255; float a0 = 0.f, a1 = 0.f;
#pragma unroll
        for (int ww = 0; ww < 8; ++ww) { a0 += red[(ww * 4 + s) * 256 + d]; a1 += red[(ww * 4 + s) * 256 + d + 1]; }
        *(unsigned*)(OB + (size_t)(TP + 4 * b + s) * D + h * HD + d) = pk2(a0, a1); }
    __syncthreads();
}

__device__ __forceinline__ unsigned ord_of(float x) { const unsigned u = __builtin_bit_cast(unsigned, x); return u ^ ((u >> 31) ? 0xFFFFFFFFu : 0x80000000u); }
__device__ __forceinline__ float ord_inv(unsigned k) { const unsigned u = (k & 0x80000000u) ? (k ^ 0x80000000u) : ~k; return __builtin_bit_cast(float, u); }
__device__ __forceinline__ unsigned umax2(unsigned a, unsigned b) { return a > b ? a : b; }
__device__ __forceinline__ unsigned umax_x4(unsigned v) { v = umax2(v, (unsigned)__shfl_xor((int)v, 16)); return umax2(v, (unsigned)__shfl_xor((int)v, 32)); }
constexpr int PSEL_KEYS = 65536, PSEL_TI = 2048;
__device__ __forceinline__ void peer_stage_keys(const bf16* KEYl, LAS unsigned char* kl, int tid) {
#pragma unroll
    for (int i = 0; i < 8; ++i) { const int c = tid + 512 * i, hr = c >> 4, ch = c & 15; *(LAS v4u*)(kl + hr * 256 + ((ch ^ (hr & 15)) << 4)) = *(const v4u*)(KEYl + (size_t)hr * 128 + ch * 8); }
}
__device__ __forceinline__ unsigned umin2(unsigned a, unsigned b) { return a < b ? a : b; }
__device__ __forceinline__ void ce_desc(unsigned& a, unsigned& b) { const unsigned hi = umax2(a, b), lo = umin2(a, b); a = hi; b = lo; }
template <int N> __device__ __forceinline__ void bitonic_sort_desc(unsigned (&a)[N]) {
#pragma unroll
    for (int k = 2; k <= N; k <<= 1)
#pragma unroll
        for (int j = k >> 1; j > 0; j >>= 1)
#pragma unroll
            for (int i = 0; i < N; ++i) { const int l = i ^ j; if (l > i) { if ((i & k) == 0) ce_desc(a[i], a[l]); else ce_desc(a[l], a[i]); } }
}
__device__ __forceinline__ void merge_top16(unsigned (&a)[16], int mask) {
    unsigned c[16];
#pragma unroll
    for (int i = 0; i < 16; ++i) c[i] = umax2(a[i], (unsigned)__shfl_xor((int)a[15 - i], mask));
#pragma unroll
    for (int j = 8; j > 0; j >>= 1)
#pragma unroll
        for (int i = 0; i < 16; ++i) { const int l = i ^ j; if (l > i) ce_desc(c[i], c[l]); }
#pragma unroll
    for (int i = 0; i < 16; ++i) a[i] = c[i];
}
__device__ __forceinline__ void peer_select_task(const bf16* QP, const LAS unsigned char* kl, int* EID, float* EG, int row0, int hh, LAS int* TI, int lane) {
    const int tl = lane & 15, q4 = lane >> 4;
    unsigned bk[2][16];
#pragma unroll
    for (int half = 0; half < 2; ++half) {
        f32x4 acc[8];
#pragma unroll
        for (int nt = 0; nt < 8; ++nt) acc[nt] = (f32x4){0.f, 0.f, 0.f, 0.f};
        const bf16* qb = QP + (size_t)(row0 + tl) * 2048 + hh * 256 + half * 128 + 8 * q4;
        const LAS unsigned char* kb = kl + (half * 128 + tl) * 256;
#pragma unroll
        for (int ks = 0; ks < 4; ++ks) { const bf16x8 qf = *(const bf16x8*)(qb + 32 * ks); const int co = ((4 * ks + q4) ^ tl) << 4;
#pragma unroll
            for (int nt = 0; nt < 8; ++nt) { const bf16x8 kf = *(const LAS bf16x8*)(kb + nt * 4096 + co); acc[nt] = mfma16(kf, qf, acc[nt]); } }
        unsigned kx[32];
#pragma unroll
        for (int nt = 0; nt < 8; ++nt)
#pragma unroll
            for (int i = 0; i < 4; ++i) kx[4 * nt + i] = (ord_of(acc[nt][i]) & 0xFFFFFF80u) | (unsigned)(16 * nt + 4 * q4 + i);
        bitonic_sort_desc<32>(kx);
        unsigned top[16];
#pragma unroll
        for (int r = 0; r < 16; ++r) top[r] = kx[r];
        merge_top16(top, 16); merge_top16(top, 32);
#pragma unroll
        for (int r = 0; r < 16; ++r) bk[half][r] = top[r];
    }
    if (q4 == 0) {
#pragma unroll
        for (int r = 0; r < 16; r += 4) { *(LAS v4i*)(TI + tl * 32 + r) = (v4i){(int)(bk[0][r] & 127u), (int)(bk[0][r + 1] & 127u), (int)(bk[0][r + 2] & 127u), (int)(bk[0][r + 3] & 127u)};
            *(LAS v4i*)(TI + tl * 32 + 16 + r) = (v4i){(int)(bk[1][r] & 127u), (int)(bk[1][r + 1] & 127u), (int)(bk[1][r + 2] & 127u), (int)(bk[1][r + 3] & 127u)}; } }
    float v2[16];
#pragma unroll
    for (int j = 0; j < 16; ++j) v2[j] = ord_inv(bk[1][j] & 0xFFFFFF80u);
    unsigned cx[32];
    { int sl = 0;
#pragma unroll
      for (int a = 0; a < 4; ++a) { const unsigned b0 = bk[0][4 * a], b1 = bk[0][4 * a + 1], b2 = bk[0][4 * a + 2], b3 = bk[0][4 * a + 3];
          const float v1s = ord_inv((q4 == 0 ? b0 : q4 == 1 ? b1 : q4 == 2 ? b2 : b3) & 0xFFFFFF80u); const int i = 4 * a + q4;
#pragma unroll
          for (int j = 0; j < 16 / (4 * a + 1); ++j) { const bool ok = (i + 1) * (j + 1) <= 16; cx[sl] = ok ? ((ord_of(v1s + v2[j]) & 0xFFFFFF00u) | (unsigned)(i * 16 + j)) : 0u; ++sl; } }
#pragma unroll
      for (int c = 21; c < 32; ++c) cx[c] = 0u; }
    bitonic_sort_desc<32>(cx);
    unsigned ct[16];
#pragma unroll
    for (int r = 0; r < 16; ++r) ct[r] = cx[r];
    merge_top16(ct, 16); merge_top16(ct, 32);
    LDS_WAIT();
    float sv[16]; float sum = 0.f; const float smax = ord_inv(ct[0] & 0xFFFFFF00u);
#pragma unroll
    for (int r = 0; r < 16; ++r) { sv[r] = __expf(ord_inv(ct[r] & 0xFFFFFF00u) - smax); sum += sv[r]; }
    const float inv = 1.0f / sum;
    unsigned c0, c1, c2, c3; f32x4 go;
    if (q4 == 0) { c0 = ct[0]; c1 = ct[1]; c2 = ct[2]; c3 = ct[3]; go = (f32x4){sv[0], sv[1], sv[2], sv[3]}; }
    else if (q4 == 1) { c0 = ct[4]; c1 = ct[5]; c2 = ct[6]; c3 = ct[7]; go = (f32x4){sv[4], sv[5], sv[6], sv[7]}; }
    else if (q4 == 2) { c0 = ct[8]; c1 = ct[9]; c2 = ct[10]; c3 = ct[11]; go = (f32x4){sv[8], sv[9], sv[10], sv[11]}; }
    else { c0 = ct[12]; c1 = ct[13]; c2 = ct[14]; c3 = ct[15]; go = (f32x4){sv[12], sv[13], sv[14], sv[15]}; }
    const LAS int* ti = TI + tl * 32;
    v4i eo;
    eo[0] = ti[(c0 >> 4) & 15] * 128 + ti[16 + (c0 & 15)]; eo[1] = ti[(c1 >> 4) & 15] * 128 + ti[16 + (c1 & 15)];
    eo[2] = ti[(c2 >> 4) & 15] * 128 + ti[16 + (c2 & 15)]; eo[3] = ti[(c3 >> 4) & 15] * 128 + ti[16 + (c3 & 15)];
    *(v4i*)(EID + (size_t)(row0 + tl) * 128 + hh * 16 + 4 * q4) = eo; *(f32x4*)(EG + (size_t)(row0 + tl) * 128 + hh * 16 + 4 * q4) = go * inv;
    LDS_WAIT();
}

constexpr float U_SCALE = 32.f, V_SCALE = 8.f;
__device__ __forceinline__ void cvt16(const v4u w, float (&f)[16]) {
#pragma unroll
    for (int q = 0; q < 4; ++q) { const f32x2 a = __builtin_amdgcn_cvt_pk_f32_fp8((int)w[q], false), b = __builtin_amdgcn_cvt_pk_f32_fp8((int)w[q], true); f[4 * q] = a.x; f[4 * q + 1] = a.y; f[4 * q + 2] = b.x; f[4 * q + 3] = b.y; }
}
__device__ __forceinline__ float xreduce8(const float (&p)[8], int lane) {
    float q[4], r[2];
    const bool b5 = (lane & 32) != 0, b4 = (lane & 16) != 0, b3 = (lane & 8) != 0;
#pragma unroll
    for (int k = 0; k < 4; ++k) { const float send = b5 ? p[k] : p[k + 4], keep = b5 ? p[k + 4] : p[k]; q[k] = keep + __shfl_xor(send, 32); }
#pragma unroll
    for (int k = 0; k < 2; ++k) { const float send = b4 ? q[k] : q[k + 2], keep = b4 ? q[k + 2] : q[k]; r[k] = keep + __shfl_xor(send, 16); }
    const float send = b3 ? r[0] : r[1], keep = b3 ? r[1] : r[0]; float t = keep + __shfl_xor(send, 8);
    t += __shfl_xor(t, 4); t += __shfl_xor(t, 2); t += __shfl_xor(t, 1);
    return t;
}
template <bool FINAL, int EMASK = 0x3FFF>
__device__ __forceinline__ void peer_gather_wave(int m0, int step, int lane, bf16* HB, const int* EID, const float* EG, const unsigned char* UV, float* XR, const float* gnext, const float* SSQ) {
    int t = m0; if (t >= T) return;
    const unsigned char* uvl = UV + 16 * lane;
    int eid = EID[(size_t)t * 128 + (lane >> 3)]; float gt = EG[(size_t)t * 128 + (lane >> 3)];
    v4u ub[8];
#pragma unroll
    for (int k = 0; k < 8; ++k) { const int e = __builtin_amdgcn_readlane(eid, 8 * k) & EMASK; ub[k] = *(const v4u*)(uvl + (size_t)e * 2048); }
    for (;;) {
        const int tn = t + step; const bool more = tn < T;
        const float rin = row_rinv(SSQ, (size_t)t, 16) * (1.0f / U_SCALE);
        float hf[16], acc[16];
        { const v4u hr0 = *(const v4u*)(HB + (size_t)t * D + 16 * lane), hr1 = *(const v4u*)(HB + (size_t)t * D + 16 * lane + 8);
          hf[0] = bflo(hr0.x); hf[1] = bfhi(hr0.x); hf[2] = bflo(hr0.y); hf[3] = bfhi(hr0.y); hf[4] = bflo(hr0.z); hf[5] = bfhi(hr0.z); hf[6] = bflo(hr0.w); hf[7] = bfhi(hr0.w);
          hf[8] = bflo(hr1.x); hf[9] = bfhi(hr1.x); hf[10] = bflo(hr1.y); hf[11] = bfhi(hr1.y); hf[12] = bflo(hr1.z); hf[13] = bfhi(hr1.z); hf[14] = bflo(hr1.w); hf[15] = bfhi(hr1.w); }
#pragma unroll
        for (int i = 0; i < 16; ++i) acc[i] = 0.f;
#pragma unroll 1
        for (int st = 0; st < 16; ++st) {
            v4u vb[8];
#pragma unroll
            for (int k = 0; k < 8; ++k) { const int e = __builtin_amdgcn_readlane(eid, 8 * k) & EMASK; vb[k] = *(const v4u*)(uvl + (size_t)e * 2048 + 1024); }
            const bool nx = (st < 15) || more; const size_t ni = (st < 15) ? ((size_t)t * 128 + (st + 1) * 8) : ((size_t)tn * 128);
            int eid_n = 0; float gt_n = 0.f;
            if (nx) { eid_n = EID[ni + (lane >> 3)]; gt_n = EG[ni + (lane >> 3)]; }
            float pd[8];
#pragma unroll
            for (int k = 0; k < 8; ++k) { float f[16]; cvt16(ub[k], f); float d = f[0] * hf[0];
#pragma unroll
                for (int i = 1; i < 16; ++i) d = fmaf(f[i], hf[i], d);
                pd[k] = d; }
            const float tot = xreduce8(pd, lane);
            const float wv = gt * gelu1(tot * rin) * (1.0f / V_SCALE);
            if (nx) {
#pragma unroll
                for (int k = 0; k < 8; ++k) { const int e = __builtin_amdgcn_readlane(eid_n, 8 * k) & EMASK; ub[k] = *(const v4u*)(uvl + (size_t)e * 2048); } }
#pragma unroll
            for (int k = 0; k < 8; ++k) { const float wk = __builtin_bit_cast(float, __builtin_amdgcn_readlane(__builtin_bit_cast(int, wv), 8 * k)); float f[16]; cvt16(vb[k], f);
#pragma unroll
                for (int i = 0; i < 16; ++i) acc[i] = fmaf(wk, f[i], acc[i]); }
            eid = eid_n; gt = gt_n;
        }
        float* xr = XR + (size_t)t * D + 16 * lane;
        f32x4 x[4];
#pragma unroll
        for (int j = 0; j < 4; ++j) x[j] = *(const f32x4*)(xr + 4 * j);
        float ss = 0.f;
#pragma unroll
        for (int j = 0; j < 4; ++j)
#pragma unroll
            for (int i = 0; i < 4; ++i) { x[j][i] += acc[4 * j + i]; ss = fmaf(x[j][i], x[j][i], ss); }
        const float r = 1.0f / sqrtf(wave_sum(ss) * (1.0f / D) + RMS_EPS);
        f32x4 gv[4];
#pragma unroll
        for (int j = 0; j < 4; ++j) gv[j] = *(const f32x4*)(gnext + 16 * lane + 4 * j);
        if (FINAL) {
#pragma unroll
            for (int j = 0; j < 4; ++j) *(f32x4*)(xr + 4 * j) = x[j] * r * gv[j];
        } else {
#pragma unroll
            for (int j = 0; j < 4; ++j) *(f32x4*)(xr + 4 * j) = x[j];
            const f32x4 a = x[0] * r * gv[0], bq = x[1] * r * gv[1], c = x[2] * r * gv[2], dq = x[3] * r * gv[3];
            v4u w0, w1;
            w0.x = pk2(a[0], a[1]); w0.y = pk2(a[2], a[3]); w0.z = pk2(bq[0], bq[1]); w0.w = pk2(bq[2], bq[3]);
            w1.x = pk2(c[0], c[1]); w1.y = pk2(c[2], c[3]); w1.z = pk2(dq[0], dq[1]); w1.w = pk2(dq[2], dq[3]);
            *(v4u*)(HB + (size_t)t * D + 16 * lane) = w0; *(v4u*)(HB + (size_t)t * D + 16 * lane + 8) = w1;
        }
        if (!more) break;
        t = tn;
    }
}

constexpr float U6_SCALE = 64.f, V6_SCALE = 16.f;
typedef float v32f __attribute__((ext_vector_type(32)));
typedef float v16f __attribute__((ext_vector_type(16)));
typedef unsigned v6u __attribute__((ext_vector_type(6)));
typedef unsigned v3u __attribute__((ext_vector_type(3)));
__device__ __forceinline__ v6u load6(const unsigned char* p) { const v3u a = *(const v3u*)p, b = *(const v3u*)(p + 12); v6u r; r[0] = a[0]; r[1] = a[1]; r[2] = a[2]; r[3] = b[0]; r[4] = b[1]; r[5] = b[2]; return r; }
__device__ __forceinline__ int mbcnt64(unsigned long long m) { return (int)__builtin_amdgcn_mbcnt_hi((unsigned)(m >> 32), __builtin_amdgcn_mbcnt_lo((unsigned)m, 0u)); }
template <bool FINAL>
__device__ __forceinline__ void peer_gather_wave6(int m0, int step, int tlim, int lane, bf16* HB, const int* EID, const float* EG, const unsigned char* UV, float* XR, const float* gnext, const float* SSQ, LAS unsigned char* lw) {
    int t = m0; if (t >= tlim) return;
    int buf = 0;
#define PG6_SORT(TOK, BUF, FLIP) do { const size_t tb_ = (size_t)(TOK) * 128; const int e0_ = EID[tb_ + lane], e1_ = EID[tb_ + 64 + lane]; const float g0_ = EG[tb_ + lane], g1_ = EG[tb_ + 64 + lane]; \
        const int b0_ = (e0_ >> 10) ^ (FLIP), b1_ = (e1_ >> 10) ^ (FLIP); int off_ = 0, p0_ = 0, p1_ = 0; \
        _Pragma("unroll") for (int k_ = 0; k_ < 16; ++k_) { const unsigned long long m0_ = __ballot(b0_ == k_), m1_ = __ballot(b1_ == k_); const int c0_ = __popcll(m0_), c1_ = __popcll(m1_); \
            p0_ = (b0_ == k_) ? off_ + mbcnt64(m0_) : p0_; p1_ = (b1_ == k_) ? off_ + c0_ + mbcnt64(m1_) : p1_; off_ += c0_ + c1_; } \
        LAS int* se_ = (LAS int*)(lw + (BUF) * 1024); LAS float* sg_ = (LAS float*)(lw + (BUF) * 1024 + 512); se_[p0_] = e0_; sg_[p0_] = g0_; se_[p1_] = e1_; sg_[p1_] = g1_; } while (0)
#define PG6_IDS(BUF, ST, E_, G_) do { E_ = ((const LAS int*)(lw + (BUF) * 1024))[(ST) * 8 + xl]; G_ = ((const LAS float*)(lw + (BUF) * 1024 + 512))[(ST) * 8 + xl]; } while (0)
    const int hw = lane >> 5, li = lane & 31; const bool b4 = (lane & 16) != 0, b3 = (lane & 8) != 0;
    const int xl = 4 * ((lane >> 4) & 1) + 2 * ((lane >> 3) & 1) + hw;
    const unsigned char* uvl = UV + 24 * li;
    int flip = 0;
    PG6_SORT(t, 0, 0); LDS_WAIT();
    int eid; float gt; PG6_IDS(0, 0, eid, gt);
    v6u ub[4];
#pragma unroll
    for (int k = 0; k < 4; ++k) { const int ea = __builtin_amdgcn_readlane(eid, 8 * k), eb = __builtin_amdgcn_readlane(eid, 32 + 8 * k); ub[k] = load6(uvl + (size_t)(hw ? eb : ea) * 1536); }
    for (;;) {
        const int tn = t + step; const bool more = tn < tlim;
        const float rin = row_rinv(SSQ, (size_t)t, 16) * (1.0f / U6_SCALE);
        float hf[32], acc[32];
        { const v4u* hp = (const v4u*)(HB + (size_t)t * D + 32 * li);
#pragma unroll
          for (int q = 0; q < 4; ++q) { const v4u h = hp[q]; hf[8 * q] = bflo(h.x); hf[8 * q + 1] = bfhi(h.x); hf[8 * q + 2] = bflo(h.y); hf[8 * q + 3] = bfhi(h.y); hf[8 * q + 4] = bflo(h.z); hf[8 * q + 5] = bfhi(h.z); hf[8 * q + 6] = bflo(h.w); hf[8 * q + 7] = bfhi(h.w); } }
#pragma unroll
        for (int i = 0; i < 32; ++i) acc[i] = 0.f;
#pragma unroll 1
        for (int st = 0; st < 16; ++st) {
            v6u vb[4];
#pragma unroll
            for (int k = 0; k < 4; ++k) { const int ea = __builtin_amdgcn_readlane(eid, 8 * k), eb = __builtin_amdgcn_readlane(eid, 32 + 8 * k); vb[k] = load6(uvl + (size_t)(hw ? eb : ea) * 1536 + 768); }
            const bool nx = (st < 15) || more;
            if (st == 10 && more) PG6_SORT(tn, buf ^ 1, flip ^ 15);
            int eid_n = 0; float gt_n = 0.f;
            if (st < 15) PG6_IDS(buf, st + 1, eid_n, gt_n); else if (more) PG6_IDS(buf ^ 1, 0, eid_n, gt_n);
            float pd[4];
#pragma unroll
            for (int k = 0; k < 4; ++k) { const v32f f = __builtin_amdgcn_cvt_scalef32_pk32_f32_fp6(ub[k], 1.0f); float d = f[0] * hf[0];
#pragma unroll
                for (int i = 1; i < 32; ++i) d = fmaf(f[i], hf[i], d);
                pd[k] = d; }
            float q0, q1;
            { const float s0 = b4 ? pd[0] : pd[2], k0 = b4 ? pd[2] : pd[0]; q0 = k0 + __shfl_xor(s0, 16); const float s1 = b4 ? pd[1] : pd[3], k1 = b4 ? pd[3] : pd[1]; q1 = k1 + __shfl_xor(s1, 16); }
            float tot; { const float sd = b3 ? q0 : q1, kp = b3 ? q1 : q0; tot = kp + __shfl_xor(sd, 8); }
            tot += __shfl_xor(tot, 4); tot += __shfl_xor(tot, 2); tot += __shfl_xor(tot, 1);
            const float wv = gt * gelu1(tot * rin) * (1.0f / V6_SCALE);
            if (nx) {
#pragma unroll
                for (int k = 0; k < 4; ++k) { const int ea = __builtin_amdgcn_readlane(eid_n, 8 * k), eb = __builtin_amdgcn_readlane(eid_n, 32 + 8 * k); ub[k] = load6(uvl + (size_t)(hw ? eb : ea) * 1536); } }
#pragma unroll
            for (int k = 0; k < 4; ++k) { const float wa = __builtin_bit_cast(float, __builtin_amdgcn_readlane(__builtin_bit_cast(int, wv), 8 * k)), wb = __builtin_bit_cast(float, __builtin_amdgcn_readlane(__builtin_bit_cast(int, wv), 32 + 8 * k));
                const float wk = hw ? wb : wa; const v32f f = __builtin_amdgcn_cvt_scalef32_pk32_f32_fp6(vb[k], 1.0f);
#pragma unroll
                for (int i = 0; i < 32; ++i) acc[i] = fmaf(wk, f[i], acc[i]); }
            eid = eid_n; gt = gt_n;
        }
        float av[16];
#pragma unroll
        for (int i = 0; i < 16; ++i) { const float lo = acc[i] + __shfl_xor(acc[i], 32), hi = acc[16 + i] + __shfl_xor(acc[16 + i], 32); av[i] = hw ? hi : lo; }
        float* xr = XR + (size_t)t * D + 32 * li + 16 * hw;
        f32x4 x[4];
#pragma unroll
        for (int j = 0; j < 4; ++j) x[j] = *(const f32x4*)(xr + 4 * j);
        float ss = 0.f;
#pragma unroll
        for (int j = 0; j < 4; ++j)
#pragma unroll
            for (int i = 0; i < 4; ++i) { x[j][i] += av[4 * j + i]; ss = fmaf(x[j][i], x[j][i], ss); }
        const float r = 1.0f / sqrtf(wave_sum(ss) * (1.0f / D) + RMS_EPS);
        f32x4 gv[4];
#pragma unroll
        for (int j = 0; j < 4; ++j) gv[j] = *(const f32x4*)(gnext + 32 * li + 16 * hw + 4 * j);
        if (FINAL) {
#pragma unroll
            for (int j = 0; j < 4; ++j) *(f32x4*)(xr + 4 * j) = x[j] * r * gv[j];
        } else {
#pragma unroll
            for (int j = 0; j < 4; ++j) *(f32x4*)(xr + 4 * j) = x[j];
            const f32x4 a = x[0] * r * gv[0], bq = x[1] * r * gv[1], c = x[2] * r * gv[2], dq = x[3] * r * gv[3];
            v4u w0, w1;
            w0.x = pk2(a[0], a[1]); w0.y = pk2(a[2], a[3]); w0.z = pk2(bq[0], bq[1]); w0.w = pk2(bq[2], bq[3]);
            w1.x = pk2(c[0], c[1]); w1.y = pk2(c[2], c[3]); w1.z = pk2(dq[0], dq[1]); w1.w = pk2(dq[2], dq[3]);
            *(v4u*)(HB + (size_t)t * D + 32 * li + 16 * hw) = w0; *(v4u*)(HB + (size_t)t * D + 32 * li + 16 * hw + 8) = w1;
        }
        if (!more) break;
        t = tn; buf ^= 1; flip ^= 15;
    }
#undef PG6_SORT
#undef PG6_IDS
}

template <bool FINAL>
__device__ __forceinline__ void peer_gather_wg2(int t0, int tid, bf16* HB, const int* EID, const float* EG, const unsigned char* UV, float* XR, const float* gnext, const float* SSQ, LAS float* PL) {
    const int lane = tid & 63, w = tid >> 6;
    const int hw = lane >> 5, li = lane & 31; const bool b4 = (lane & 16) != 0, b3 = (lane & 8) != 0;
    const int xl = 4 * ((lane >> 4) & 1) + 2 * ((lane >> 3) & 1) + hw;
    const unsigned char* uvl = UV + 24 * li;
#pragma unroll 1
    for (int k = 0; k < 2; ++k) { const int t = t0 + k;
        const float rin = row_rinv(SSQ, (size_t)t, 16) * (1.0f / U6_SCALE);
        float hf[32], acc[32];
        { const v4u* hp = (const v4u*)(HB + (size_t)t * D + 32 * li);
#pragma unroll
          for (int q = 0; q < 4; ++q) { const v4u h = hp[q]; hf[8 * q] = bflo(h.x); hf[8 * q + 1] = bfhi(h.x); hf[8 * q + 2] = bflo(h.y); hf[8 * q + 3] = bfhi(h.y); hf[8 * q + 4] = bflo(h.z); hf[8 * q + 5] = bfhi(h.z); hf[8 * q + 6] = bflo(h.w); hf[8 * q + 7] = bfhi(h.w); } }
#pragma unroll
        for (int i = 0; i < 32; ++i) acc[i] = 0.f;
#pragma unroll 1
        for (int st = 0; st < 2; ++st) {
            const size_t ib = (size_t)t * 128 + w * 16 + st * 8;
            const int eid = EID[ib + xl]; const float gt = EG[ib + xl];
            v6u ub[4], vb[4];
#pragma unroll
            for (int kk = 0; kk < 4; ++kk) { const int ea = __builtin_amdgcn_readlane(eid, 8 * kk), eb = __builtin_amdgcn_readlane(eid, 32 + 8 * kk); const unsigned char* p = uvl + (size_t)(hw ? eb : ea) * 1536; ub[kk] = load6(p); vb[kk] = load6(p + 768); }
            float pd[4];
#pragma unroll
            for (int kk = 0; kk < 4; ++kk) { const v32f f = __builtin_amdgcn_cvt_scalef32_pk32_f32_fp6(ub[kk], 1.0f); float d = f[0] * hf[0];
#pragma unroll
                for (int i = 1; i < 32; ++i) d = fmaf(f[i], hf[i], d);
                pd[kk] = d; }
            float q0, q1;
            { const float s0 = b4 ? pd[0] : pd[2], k0 = b4 ? pd[2] : pd[0]; q0 = k0 + __shfl_xor(s0, 16); const float s1 = b4 ? pd[1] : pd[3], k1 = b4 ? pd[3] : pd[1]; q1 = k1 + __shfl_xor(s1, 16); }
            float tot; { const float sd = b3 ? q0 : q1, kp = b3 ? q1 : q0; tot = kp + __shfl_xor(sd, 8); }
            tot += __shfl_xor(tot, 4); tot += __shfl_xor(tot, 2); tot += __shfl_xor(tot, 1);
            const float wv = gt * gelu1(tot * rin) * (1.0f / V6_SCALE);
#pragma unroll
            for (int kk = 0; kk < 4; ++kk) { const float wa = __builtin_bit_cast(float, __builtin_amdgcn_readlane(__builtin_bit_cast(int, wv), 8 * kk)), wb = __builtin_bit_cast(float, __builtin_amdgcn_readlane(__builtin_bit_cast(int, wv), 32 + 8 * kk));
                const float wk = hw ? wb : wa; const v32f f = __builtin_amdgcn_cvt_scalef32_pk32_f32_fp6(vb[kk], 1.0f);
#pragma unroll
                for (int i = 0; i < 32; ++i) acc[i] = fmaf(wk, f[i], acc[i]); }
        }
        LAS float* pl = PL + ((k * 8 + w) * D + 32 * li + 16 * hw);
#pragma unroll
        for (int j = 0; j < 4; ++j) { f32x4 o;
#pragma unroll
            for (int i = 0; i < 4; ++i) { const int c = 4 * j + i; const float lo = acc[c] + __shfl_xor(acc[c], 32), hi = acc[16 + c] + __shfl_xor(acc[16 + c], 32); o[i] = hw ? hi : lo; }
            *(LAS f32x4*)(pl + 4 * j) = o; }
    }
    __syncthreads();
    LAS float* ssw = PL + 2 * 8 * D;
    float xs[2][2];
#pragma unroll
    for (int k = 0; k < 2; ++k) { const int c0 = 128 * w + 2 * lane; const f32x2 xv = *(const f32x2*)(XR + (size_t)(t0 + k) * D + c0); float a0 = xv.x, a1 = xv.y;
#pragma unroll
        for (int ww = 0; ww < 8; ++ww) { const f32x2 pv = *(const LAS f32x2*)(PL + (k * 8 + ww) * D + c0); a0 += pv.x; a1 += pv.y; }
        xs[k][0] = a0; xs[k][1] = a1; const float ss = wave_sum(a0 * a0 + a1 * a1); if (lane == 0) ssw[k * 8 + w] = ss; }
    __syncthreads();
#pragma unroll
    for (int k = 0; k < 2; ++k) { const int c0 = 128 * w + 2 * lane; float tot = 0.f;
#pragma unroll
        for (int ww = 0; ww < 8; ++ww) tot += ssw[k * 8 + ww];
        const float r = 1.0f / sqrtf(tot * (1.0f / D) + RMS_EPS); const f32x2 gv = *(const f32x2*)(gnext + c0);
        float* xr = XR + (size_t)(t0 + k) * D + c0;
        if (FINAL) { *(f32x2*)xr = (f32x2){xs[k][0] * r * gv.x, xs[k][1] * r * gv.y}; }
        else { *(f32x2*)xr = (f32x2){xs[k][0], xs[k][1]}; *(unsigned*)(HB + (size_t)(t0 + k) * D + c0) = pk2(xs[k][0] * r * gv.x, xs[k][1] * r * gv.y); } }
    __syncthreads();
}

enum { SK_GLU = 0, SK_RES = 1, SK_B16 = 2, SK_WINV = 3, SK_WINB = 4 };
struct SkArgs { const bf16* A; const bf16* W; float* xr; bf16* hbo; float* ssq; const float* gnext; const float* xs; bf16* O; int ldc; int nslots; bf16* v1; bf16* b1; float* out; };
constexpr int SK_LDS_FLOATS = 8 * 32 * 68;
template <int MODE>
__device__ __forceinline__ void skinny_tile(const SkArgs& a, int rb, int cb, LAS float* P, int tid) {
    constexpr bool PAIRED = (MODE == SK_GLU || MODE == SK_WINV);
    const int lane = tid & 63, w = tid >> 6, tl = lane & 15, q4 = lane >> 4;
    const int g0 = PAIRED ? ((cb >> 2) * 256 + (cb & 3) * 32) : 64 * cb;
    f32x4 acc[2][4];
#pragma unroll
    for (int mt = 0; mt < 2; ++mt)
#pragma unroll
        for (int nt = 0; nt < 4; ++nt) acc[mt][nt] = (f32x4){0.f, 0.f, 0.f, 0.f};
    const bf16* ap = a.A + (size_t)(TP + 32 * rb + tl) * D + 128 * w + 8 * q4;
    const bf16* wp = a.W + (size_t)(g0 + tl) * D + 128 * w + 8 * q4;
    bf16x8 af[4][2], bfr[4][4];
#pragma unroll
    for (int ks = 0; ks < 4; ++ks) {
#pragma unroll
        for (int mt = 0; mt < 2; ++mt) af[ks][mt] = *(const bf16x8*)(ap + (size_t)(16 * mt) * D + 32 * ks);
#pragma unroll
        for (int nt = 0; nt < 4; ++nt) { const int wro = PAIRED ? ((nt >> 1) * 128 + (nt & 1) * 16) : 16 * nt; bfr[ks][nt] = *(const bf16x8*)(wp + (size_t)wro * D + 32 * ks); } }
    const int row = tid >> 4, c4 = (tid & 15) * 4; const size_t grow = (size_t)TP + 32 * rb + row;
    const int pcol = (cb >> 2) * 128 + (cb & 3) * 32 + (c4 & 31), col = 64 * cb + c4;
    f32x4 e0 = {0.f, 0.f, 0.f, 0.f}, e1 = {0.f, 0.f, 0.f, 0.f}; float ri = 0.f;
    if (MODE == SK_GLU) { e0 = *(const f32x4*)(a.xs + (size_t)(32 * rb + row) * D + pcol); e1 = *(const f32x4*)(a.gnext + pcol); }
    if (MODE == SK_RES) { e0 = *(const f32x4*)(a.xr + grow * D + col); e1 = *(const f32x4*)(a.gnext + col); }
    if (MODE == SK_B16) ri = row_rinv(a.ssq, grow, a.nslots);
#pragma unroll
    for (int ks = 0; ks < 4; ++ks)
#pragma unroll
        for (int nt = 0; nt < 4; ++nt)
#pragma unroll
            for (int mt = 0; mt < 2; ++mt) acc[mt][nt] = mfma16(bfr[ks][nt], af[ks][mt], acc[mt][nt]);
#pragma unroll
    for (int mt = 0; mt < 2; ++mt)
#pragma unroll
        for (int nt = 0; nt < 4; ++nt) *(LAS f32x4*)(P + (w * 32 + 16 * mt + tl) * 68 + 16 * nt + 4 * q4) = acc[mt][nt];
    __syncthreads();
    f32x4 v = {0.f, 0.f, 0.f, 0.f}, vb = {0.f, 0.f, 0.f, 0.f};
#pragma unroll
    for (int ww = 0; ww < 8; ++ww) v += *(const LAS f32x4*)(P + (ww * 32 + row) * 68 + c4);
    if (PAIRED && c4 < 32) {
#pragma unroll
        for (int ww = 0; ww < 8; ++ww) vb += *(const LAS f32x4*)(P + (ww * 32 + row) * 68 + c4 + 32); }
    if (MODE == SK_GLU) {
        float ss = 0.f;
        if (c4 < 32) { f32x4 o;
#pragma unroll
            for (int j = 0; j < 4; ++j) { o[j] = e0[j] + v[j] / (1.0f + __expf(-vb[j])); ss = fmaf(o[j], o[j], ss); }
            *(f32x4*)(a.xr + grow * D + pcol) = o; const f32x4 hg = o * e1; v2u wv; wv.x = pk2(hg[0], hg[1]); wv.y = pk2(hg[2], hg[3]); *(v2u*)(a.hbo + grow * D + pcol) = wv; }
        ss += __shfl_xor(ss, 1); ss += __shfl_xor(ss, 2); ss += __shfl_xor(ss, 4);
        if ((tid & 15) == 0) a.ssq[grow * 32 + cb] = ss;
    } else if (MODE == SK_RES) {
        const f32x4 o = e0 + v; *(f32x4*)(a.xr + grow * D + col) = o;
        float ss = o[0] * o[0] + o[1] * o[1] + o[2] * o[2] + o[3] * o[3];
        const f32x4 hg = o * e1; v2u wv; wv.x = pk2(hg[0], hg[1]); wv.y = pk2(hg[2], hg[3]); *(v2u*)(a.hbo + grow * D + col) = wv;
        ss += __shfl_xor(ss, 1); ss += __shfl_xor(ss, 2); ss += __shfl_xor(ss, 4); ss += __shfl_xor(ss, 8);
        if ((tid & 15) == 0) a.ssq[grow * 32 + cb] = ss;
    } else if (MODE == SK_B16) {
        const f32x4 o = v * ri; v2u wv; wv.x = pk2(o[0], o[1]); wv.y = pk2(o[2], o[3]);
        *(v2u*)(a.O + grow * a.ldc + col) = wv;
    } else if (MODE == SK_WINV) {
        if (c4 < 32) { const f32x4 vv = v * vb; v2u wv; wv.x = pk2(vv[0], vv[1]); wv.y = pk2(vv[2], vv[3]); *(v2u*)(a.v1 + grow * D + pcol) = wv;
            const int rs = 32 * rb + row, s = rs & 3; if (s >= 2) *(f32x4*)(a.out + O_CS + ((size_t)(rs >> 2) * 2 + (s - 2)) * D + pcol) = vv; }
    } else {
        v2u wv; wv.x = pk2(v[0], v[1]); wv.y = pk2(v[2], v[3]); *(v2u*)(a.b1 + grow * D + col) = wv;
    }
    __syncthreads();
}
#ifndef REP_P0
#define REP_P0 1
#endif
#ifndef REP_P1
#define REP_P1 1
#endif
#ifndef REP_GEMM
#define REP_GEMM 1
#endif
#ifndef REP_ATTN
#define REP_ATTN 1
#endif
#ifndef REP_PSEL
#define REP_PSEL 1
#endif
#ifndef REP_THIN
#define REP_THIN 1
#endif
#ifndef REP_SK
#define REP_SK 1
#endif
#ifndef REP_KV
#define REP_KV 1
#endif
#ifndef REP_S5P
#define REP_S5P 1
#endif
#ifndef REP_S5S
#define REP_S5S 1
#endif
struct Args { const float* in[N_IN]; float* out; unsigned char* ws; int ph_lo, ph_hi; };
__device__ __forceinline__ int opaque_idx(int k) { int r; asm volatile("s_mov_b32 %0, %1" : "=s"(r) : "s"(k)); return r; }
#define INP(k) ((const float*)(const GAS float*)(args.in[opaque_idx(k)]))
__device__ __forceinline__ unsigned char* opq_p(unsigned char* p) { GAS unsigned char* g = (GAS unsigned char*)p; asm volatile("" : "+s"(g)); return (unsigned char*)g; }
__device__ __forceinline__ float* opq_f(float* p) { GAS float* g = (GAS float*)p; asm volatile("" : "+s"(g)); return (float*)g; }
__device__ __forceinline__ int opq_i(int v) { asm volatile("" : "+s"(v)); return v; }
__device__ __forceinline__ int opq_v(int v) { asm volatile("" : "+v"(v)); return v; }
#define PH_LOCALS unsigned char* ws = opq_p(args.ws); float* out = opq_f(args.out); (void)ws; (void)out; \
    const int tid = opq_v(tid0), lane = tid & 63, wave = __builtin_amdgcn_readfirstlane(tid >> 6), G = opq_i((int)gridDim.x), bx = opq_i((int)blockIdx.x), gw = bx * NWAVES + wave, NGW = G * NWAVES; (void)lane; (void)gw; (void)NGW;
#define WALL ((bf16*)(ws + WS_WALL))
#define KEYS ((bf16*)(ws + WS_KEYS))
#define BBW ((bf16*)(ws + WS_BBW))
#define CCW ((bf16*)(ws + WS_CCW))
#define LBc ((float*)(ws + WS_LB))
#define MEMB ((bf16*)(ws + WS_MEMB))
#define KB ((bf16*)(ws + WS_KB))
#define VT ((bf16*)(ws + WS_VT))
#define EID ((int*)(ws + WS_EID))
#define EG ((float*)(ws + WS_EG))
#define HB ((bf16*)(ws + WS_HB))
#define ZB ((bf16*)(ws + WS_ZB))
#define QB ((bf16*)(ws + WS_QB))
#define QP ((bf16*)(ws + WS_QP))
#define B1 ((bf16*)(ws + WS_B1))
#define V1 ((bf16*)(ws + WS_V1))
#define UVT ((unsigned char*)(ws + WS_UV))
#define XR (out + O_Y)
#define SSQB ((float*)(ws + WS_SSQ))

constexpr int N_PHASES = 18;

#define TABLE_CONVERT(LAYER, W0, NW) do { const float* sU = INP(I_PU) + (size_t)(LAYER) * NEXP * D; const float* sV = INP(I_PV) + (size_t)(LAYER) * NEXP * D; unsigned char* dst = UVT + (size_t)(LAYER) * NEXP * 1536; \
            const size_t ng = (size_t)NEXP * 32; \
            for (size_t i = (size_t)(W0) * 64 + lane; i < 2 * ng; i += (size_t)(NW) * 64) { const bool isv = i >= ng; const size_t j = isv ? i - ng : i; const size_t row = j >> 5; const int c = (int)(j & 31); \
                const f32x4* s = (const f32x4*)((isv ? sV : sU) + row * D + 32 * c); const float sc = isv ? V6_SCALE : U6_SCALE; v16f a, b; \
                _Pragma("unroll") for (int q = 0; q < 8; ++q) { const f32x4 x0 = s[q] * sc; a[2 * q] = x0[0]; b[2 * q] = x0[1]; a[2 * q + 1] = x0[2]; b[2 * q + 1] = x0[3]; } \
                const v6u w = __builtin_amdgcn_cvt_scalef32_2xpk16_fp6_f32(a, b, 1.0f); \
                unsigned char* dp = dst + (row * 2 + (isv ? 1 : 0)) * 768 + 24 * c; \
                *(v2u*)dp = (v2u){w[0], w[1]}; *(v2u*)(dp + 8) = (v2u){w[2], w[3]}; *(v2u*)(dp + 16) = (v2u){w[4], w[5]}; } } while (0)
__global__ void __launch_bounds__(NWAVES * 64, 2) mk_fwd(Args args) {
    extern __shared__ __attribute__((aligned(16))) unsigned char lds[];
    LAS unsigned char* L = (LAS unsigned char*)lds;
    volatile LAS unsigned* MISC = (volatile LAS unsigned*)(L + MISC_OFF);
    const int tid0 = threadIdx.x;
    gu32* ctl = (gu32*)(args.ws + WS_CTL);

    for (int u = tid0; u < (LDS_BYTES - LDSCTL_OFF) / 4; u += NWAVES * 64) ((LAS unsigned*)(L + LDSCTL_OFF))[u] = 0u;
    __syncthreads();
    XcdBarrier bar = xcd_barrier_post((unsigned*)(ctl + CW_BAR), MISC + 8);
    const int lo = args.ph_lo, hi = args.ph_hi;
#define IN(k) (opq_i(lo) <= (k) && (k) < opq_i(hi))
#define SEAM(k) do { if (IN(k) && IN((k) + 1)) xcd_barrier(bar); } while (0)
#define GEMM_PHASE(EpiT, Aptr, Brow, Mrows, Ncols, Eobj) do { pg8::Gemm g_{(const pg8::bf16_t*)(Aptr), (const pg8::bf16_t*)(WALL + (size_t)(Brow) * D), (Mrows), (Ncols), D}; \
        pg8::StaticOrder S_; S_.init((Mrows), (Ncols), G, bx); pg8::gemm_phase<EpiT, pg8::StaticOrder, true, true>(L + RING_OFF, g_, S_, Eobj); } while (0)

    if (IN(0)) { PH_LOCALS
      for (int rep_ = 0; rep_ < REP_P0; ++rep_) {
        LAS float* scr = (LAS float*)(L + RING_OFF + wave * 16384);
        for (int it = gw; it < (R_END / 32) * 16; it += NGW) {
            const int nb = it >> 4, kb = it & 15; int r = nb * 32; const float* src; int N, sn0;
            if (r < R_GLU) { const int mat = r >> 10, l = mat >> 1; src = ((mat & 1) ? INP(I_WV) : INP(I_WK)) + (size_t)l * D * D; N = D; sn0 = r & 1023; }
            else if (r < R_Q) { r -= R_GLU; src = INP(I_WGLU); N = 2 * D; sn0 = ((r >> 7) & 1) * 1024 + (r >> 8) * 128 + (r & 127); }
            else if (r < R_O) { r -= R_Q; src = INP(I_WQ) + (size_t)(r >> 10) * D * D; N = D; sn0 = r & 1023; }
            else if (r < R_PQ) { r -= R_O; src = INP(I_WO) + (size_t)(r >> 10) * D * D; N = D; sn0 = r & 1023; }
            else if (r < R_WIN) { r -= R_PQ; src = INP(I_PWQ) + (size_t)(r >> 11) * D * 2048; N = 2048; sn0 = r & 2047; }
            else if (r < R_WOUT) { r -= R_WIN; src = INP(I_WIN); N = 3 * D; sn0 = (r < 2048) ? (1024 + ((r >> 7) & 1) * 1024 + (r >> 8) * 128 + (r & 127)) : (r - 2048); }
            else { r -= R_WOUT; src = INP(I_WOUT); N = D; sn0 = r; }
            p0_transpose_item(src, N, sn0, WALL + (size_t)(nb * 32) * D, kb * 64, scr, lane);
        }
        TABLE_CONVERT(0, gw, NGW);
        {
            const int gt = bx * 512 + tid, NT = G * 512;
            for (int i = gt; i < 2 * 2 * 128 * 128; i += NT) { const int l = i >> 15, hf = (i >> 14) & 1, r = i & 16383; const float* k1 = INP(I_K1); const float* k2 = INP(I_K2); KEYS[i] = (bf16)f2bf((hf ? k2 : k1)[(size_t)l * 16384 + r]); }
            for (int i = gt; i < MROWS * D / 4; i += NT) { const f32x4 a = ((const f32x4*)INP(I_MEM))[i]; v2u w; w.x = pk2(a[0], a[1]); w.y = pk2(a[2], a[3]); ((v2u*)MEMB)[i] = w; }
            for (int i = gt; i < 64 * 64; i += NT) { const int g = i >> 6, p = i & 63;
                const double are = INP(I_ARE)[i], aim = INP(I_AIM)[i], dt = exp((double)INP(I_LDT)[g]);
                const double mag = exp(are * dt), ang = aim * dt, lbr = mag * cos(ang), lbi = mag * sin(ang), den = are * are + aim * aim;
                const double fr = ((lbr - 1.0) * are + lbi * aim) / den, fi = (lbi * are - (lbr - 1.0) * aim) / den;
                LBc[2 * i] = (float)lbr; LBc[2 * i + 1] = (float)lbi;
                for (int c = 0; c < 16; ++c) { const double br = INP(I_BRE)[(size_t)i * 16 + c], bi = INP(I_BIM)[(size_t)i * 16 + c];
                    BBW[((size_t)g * 128 + p) * 16 + c] = (bf16)f2bf((float)(fr * br - fi * bi)); BBW[((size_t)g * 128 + 64 + p) * 16 + c] = (bf16)f2bf((float)(fr * bi + fi * br));
                    CCW[((size_t)g * 16 + c) * 128 + p] = (bf16)f2bf(INP(I_CRE)[((size_t)g * 16 + c) * 64 + p]); CCW[((size_t)g * 16 + c) * 128 + 64 + p] = (bf16)f2bf(-INP(I_CIM)[((size_t)g * 16 + c) * 64 + p]); } }
        }
        for (int m = gw; m < T; m += NGW) { const float* xp_ = INP(I_XP); const float* xs_ = INP(I_XS); rms_row_bf16(m < TP ? xp_ + (size_t)m * D : xs_ + (size_t)(m - TP) * D, INP(I_NMIX), HB + (size_t)m * D, lane); }
      }
    }
    SEAM(0);
    if (IN(1)) { PH_LOCALS
      for (int rep_ = 0; rep_ < REP_P1; ++rep_) {
        { EpiKV E{out, KB, VT}; for (int r2_ = 0; r2_ < REP_KV; ++r2_) GEMM_PHASE(EpiKV, MEMB, R_KV, MROWS, 4096, E); }
        {
            const int half = G / 2, per = (NB * 64 - half + (G - half) - 1) / (G - half);
            const int s_lo = (bx < half) ? bx : half + (bx - half) * per, s_hi = (bx < half) ? bx + 1 : min(NB * 64, s_lo + per);
            for (int r2_ = 0; r2_ < REP_S5P; ++r2_)
#pragma unroll 1
            for (int sq = s_lo; sq < s_hi; ++sq) s5_prompt_seq(HB, ZB, BBW, CCW, LBc, INP(I_SD), L + RING_OFF, tid, sq >> 6, sq & 63, out + O_SRP, out + O_SIP);
            if (bx < half) TABLE_CONVERT(1, bx * NWAVES + wave, half * NWAVES);
            LAS float* ST = (LAS float*)(L + RING_OFF + wave * S5_ST_BYTES);
            for (int r2_ = 0; r2_ < REP_S5S; ++r2_)
#pragma unroll 1
            for (int tk = gw; tk < (DB / 4) * 64; tk += NGW) { const int b0 = (tk >> 6) * 4, g = tk & 63; float sr = 0.f, si = 0.f;
                const float lbr = LBc[(g * 64 + lane) * 2], lbi = LBc[(g * 64 + lane) * 2 + 1];
                s5_run<true, true>(HB, ZB, BBW, CCW, INP(I_SD), ST, lane, g, TP + 4 * b0, 1, b0, INP(I_SRE), INP(I_SIM), out + O_SRS, out + O_SIS, lbr, lbi, sr, si); }
        }
        if (REP_P1 > 1) __syncthreads();
      }
    }
    SEAM(1);
    if (IN(2)) { PH_LOCALS
        { EpiGLU E{INP(I_XP), XR, HB, SSQB, INP(I_NMEM)}; for (int rep_ = 0; rep_ < REP_GEMM; ++rep_) GEMM_PHASE(EpiGLU, ZB, R_GLU, TP, 2048, E); }
        { SkArgs sa{}; sa.A = ZB; sa.W = WALL + (size_t)R_GLU * D; sa.xr = XR; sa.hbo = HB; sa.ssq = SSQB; sa.gnext = INP(I_NMEM); sa.xs = INP(I_XS);
for (int rep_ = 0; rep_ < REP_SK; ++rep_)
#pragma unroll 1
          for (int tk = bx; tk < 16 * 32; tk += G) skinny_tile<SK_GLU>(sa, tk & 15, tk >> 4, (LAS float*)(L + RING_OFF), tid); }
    }
    SEAM(2);
#pragma unroll 1
    for (int layer = 0; layer < 2; ++layer) {
        const int pb = layer == 0 ? 3 : 12;
        if (layer == 1) {
            if (IN(9)) { PH_LOCALS
                { EpiWin E{B1, V1, out}; for (int rep_ = 0; rep_ < REP_GEMM; ++rep_) GEMM_PHASE(EpiWin, HB, R_WIN, TP, 3072, E); }
                { SkArgs sa{}; sa.A = HB; sa.W = WALL + (size_t)R_WIN * D; sa.v1 = V1; sa.out = out;
for (int rep_ = 0; rep_ < REP_SK; ++rep_)
#pragma unroll 1
                  for (int tk = bx; tk < 16 * 32; tk += G) skinny_tile<SK_WINV>(sa, tk & 15, tk >> 4, (LAS float*)(L + RING_OFF), tid);
                  sa.W = WALL + (size_t)(R_WIN + 2048) * D; sa.b1 = B1;
for (int rep_ = 0; rep_ < REP_SK; ++rep_)
#pragma unroll 1
                  for (int tk = bx; tk < 16 * 16; tk += G) skinny_tile<SK_WINB>(sa, tk & 15, tk >> 4, (LAS float*)(L + RING_OFF), tid); }
            }
            SEAM(9);
            if (IN(10)) { PH_LOCALS
                const float* cw = INP(I_CW);
                for (int m = gw; m < T; m += NGW) {
                    const bool smp = m >= TP; const int s = smp ? ((m - TP) & 3) : (m & (SEQ - 1));
#pragma unroll
                    for (int hh = 0; hh < 2; ++hh) { const int c0 = hh * 512 + 8 * lane;
                        const v4u bw = *(const v4u*)(B1 + (size_t)m * D + c0), v0 = *(const v4u*)(V1 + (size_t)m * D + c0);
                        float vm1[8], vm2[8];
                        if (s >= 1) { const v4u t1 = *(const v4u*)(V1 + (size_t)(m - 1) * D + c0); vm1[0] = bflo(t1.x); vm1[1] = bfhi(t1.x); vm1[2] = bflo(t1.y); vm1[3] = bfhi(t1.y); vm1[4] = bflo(t1.z); vm1[5] = bfhi(t1.z); vm1[6] = bflo(t1.w); vm1[7] = bfhi(t1.w); }
                        else if (smp) { const float* sp = INP(I_SCONV) + ((size_t)((m - TP) >> 2) * 2 + 1) * D + c0; const f32x4 a = *(const f32x4*)sp, b = *(const f32x4*)(sp + 4); vm1[0] = a[0]; vm1[1] = a[1]; vm1[2] = a[2]; vm1[3] = a[3]; vm1[4] = b[0]; vm1[5] = b[1]; vm1[6] = b[2]; vm1[7] = b[3]; }
                        else {
#pragma unroll
                            for (int i = 0; i < 8; ++i) vm1[i] = 0.f; }
                        if (s >= 2) { const v4u t2 = *(const v4u*)(V1 + (size_t)(m - 2) * D + c0); vm2[0] = bflo(t2.x); vm2[1] = bfhi(t2.x); vm2[2] = bflo(t2.y); vm2[3] = bfhi(t2.y); vm2[4] = bflo(t2.z); vm2[5] = bfhi(t2.z); vm2[6] = bflo(t2.w); vm2[7] = bfhi(t2.w); }
                        else if (smp) { const float* sp = INP(I_SCONV) + ((size_t)((m - TP) >> 2) * 2 + s) * D + c0; const f32x4 a = *(const f32x4*)sp, b = *(const f32x4*)(sp + 4); vm2[0] = a[0]; vm2[1] = a[1]; vm2[2] = a[2]; vm2[3] = a[3]; vm2[4] = b[0]; vm2[5] = b[1]; vm2[6] = b[2]; vm2[7] = b[3]; }
                        else {
#pragma unroll
                            for (int i = 0; i < 8; ++i) vm2[i] = 0.f; }
                        float vc[8], bg[8], w0[8], w1[8], w2[8];
                        vc[0] = bflo(v0.x); vc[1] = bfhi(v0.x); vc[2] = bflo(v0.y); vc[3] = bfhi(v0.y); vc[4] = bflo(v0.z); vc[5] = bfhi(v0.z); vc[6] = bflo(v0.w); vc[7] = bfhi(v0.w);
                        bg[0] = bflo(bw.x); bg[1] = bfhi(bw.x); bg[2] = bflo(bw.y); bg[3] = bfhi(bw.y); bg[4] = bflo(bw.z); bg[5] = bfhi(bw.z); bg[6] = bflo(bw.w); bg[7] = bfhi(bw.w);
                        { const f32x4 a = *(const f32x4*)(cw + c0), b = *(const f32x4*)(cw + c0 + 4); w0[0] = a[0]; w0[1] = a[1]; w0[2] = a[2]; w0[3] = a[3]; w0[4] = b[0]; w0[5] = b[1]; w0[6] = b[2]; w0[7] = b[3]; }
                        { const f32x4 a = *(const f32x4*)(cw + D + c0), b = *(const f32x4*)(cw + D + c0 + 4); w1[0] = a[0]; w1[1] = a[1]; w1[2] = a[2]; w1[3] = a[3]; w1[4] = b[0]; w1[5] = b[1]; w1[6] = b[2]; w1[7] = b[3]; }
                        { const f32x4 a = *(const f32x4*)(cw + 2 * D + c0), b = *(const f32x4*)(cw + 2 * D + c0 + 4); w2[0] = a[0]; w2[1] = a[1]; w2[2] = a[2]; w2[3] = a[3]; w2[4] = b[0]; w2[5] = b[1]; w2[6] = b[2]; w2[7] = b[3]; }
                        float r[8];
#pragma unroll
                        for (int i = 0; i < 8; ++i) r[i] = bg[i] * (w0[i] * vm2[i] + w1[i] * vm1[i] + w2[i] * vc[i]);
                        v4u ow; ow.x = pk2(r[0], r[1]); ow.y = pk2(r[2], r[3]); ow.z = pk2(r[4], r[5]); ow.w = pk2(r[6], r[7]);
                        *(v4u*)(ZB + (size_t)m * D + c0) = ow; }
                }
            }
            SEAM(10);
            if (IN(11)) { PH_LOCALS
                { EpiRes E{XR, HB, SSQB, INP(I_NMEM) + D}; GEMM_PHASE(EpiRes, ZB, R_WOUT, TP, 1024, E); }
                { SkArgs sa{}; sa.A = ZB; sa.W = WALL + (size_t)R_WOUT * D; sa.xr = XR; sa.hbo = HB; sa.ssq = SSQB; sa.gnext = INP(I_NMEM) + D;
#pragma unroll 1
                  for (int tk = bx; tk < 16 * 16; tk += G) skinny_tile<SK_RES>(sa, tk & 15, tk >> 4, (LAS float*)(L + RING_OFF), tid); }
            }
            SEAM(11);
        }
        const int ns_q = layer == 0 ? 32 : 16;
        if (IN(pb + 0)) { PH_LOCALS
            { EpiB16 E{QB, D, SSQB, ns_q}; for (int rep_ = 0; rep_ < REP_GEMM; ++rep_) GEMM_PHASE(EpiB16, HB, R_Q + layer * 1024, TP, 1024, E); }
            { SkArgs sa{}; sa.A = HB; sa.W = WALL + (size_t)(R_Q + layer * 1024) * D; sa.ssq = SSQB; sa.nslots = ns_q; sa.O = QB; sa.ldc = D;
for (int rep_ = 0; rep_ < REP_SK; ++rep_)
#pragma unroll 1
              for (int tk = bx; tk < 16 * 16; tk += G) skinny_tile<SK_B16>(sa, tk & 15, tk >> 4, (LAS float*)(L + RING_OFF), tid); }
        }
        SEAM(pb + 0);
        if (IN(pb + 1)) { PH_LOCALS
          for (int rep_ = 0; rep_ < REP_ATTN; ++rep_) {
            const bf16* KBl = KB + (size_t)layer * MROWS * D; const bf16* VTl = VT + (size_t)layer * NB * NH * HD * MEMT;
#pragma unroll 1
            for (int pass = 0; pass < 2; ++pass) {
              if ((pass ^ (bx & 1)) == 0) {
#pragma unroll 1
                for (int tk = bx; tk < NB * NH * (SEQ / 256); tk += G) { const int rb = tk & 7, bh = tk >> 3; attn_prompt_wg(QB, KBl, VTl, ZB, bh >> 2, bh & 3, rb * 256, L + RING_OFF, tid); }
              } else {
#pragma unroll 1
                for (int tk = bx; tk < DB * NH; tk += G) attn_sample_task(QB, INP(I_CK), INP(I_CV), ZB, layer, tk >> 2, tk & 3, (LAS float*)(L + RING_OFF), tid);
              }
            }
          }
        }
        SEAM(pb + 1);
        if (IN(pb + 2)) { PH_LOCALS
            { EpiRes E{XR, HB, SSQB, INP(I_NFFN) + layer * D}; GEMM_PHASE(EpiRes, ZB, R_O + layer * 1024, TP, 1024, E); }
            { SkArgs sa{}; sa.A = ZB; sa.W = WALL + (size_t)(R_O + layer * 1024) * D; sa.xr = XR; sa.hbo = HB; sa.ssq = SSQB; sa.gnext = INP(I_NFFN) + layer * D;
#pragma unroll 1
              for (int tk = bx; tk < 16 * 16; tk += G) skinny_tile<SK_RES>(sa, tk & 15, tk >> 4, (LAS float*)(L + RING_OFF), tid); }
        }
        SEAM(pb + 2);
        if (IN(pb + 3)) { PH_LOCALS
            { EpiB16 E{QP, 2048, SSQB, 16}; for (int rep_ = 0; rep_ < REP_GEMM; ++rep_) GEMM_PHASE(EpiB16, HB, R_PQ + layer * 2048, TP, 2048, E); }
            { SkArgs sa{}; sa.A = HB; sa.W = WALL + (size_t)(R_PQ + layer * 2048) * D; sa.ssq = SSQB; sa.nslots = 16; sa.O = QP; sa.ldc = 2048;
for (int rep_ = 0; rep_ < REP_SK; ++rep_)
#pragma unroll 1
              for (int tk = bx; tk < 16 * 32; tk += G) skinny_tile<SK_B16>(sa, tk & 15, tk >> 4, (LAS float*)(L + RING_OFF), tid); }
        }
        SEAM(pb + 3);
        if (IN(pb + 4)) { PH_LOCALS
          peer_stage_keys(KEYS + (size_t)layer * 2 * 128 * 128, L + RING_OFF, tid);
          __syncthreads();
          LAS int* ti = (LAS int*)(L + RING_OFF + PSEL_KEYS + wave * PSEL_TI);
          for (int rep_ = 0; rep_ < REP_PSEL; ++rep_)
#pragma unroll 1
            for (int tk = gw; tk < (T / 16) * 8; tk += NGW) peer_select_task(QP, L + RING_OFF, EID, EG, (tk >> 3) * 16, tk & 7, ti, lane);
        }
        SEAM(pb + 4);
        if (IN(pb + 5)) { PH_LOCALS
            const unsigned char* UVl = UVT + (size_t)layer * NEXP * 1536;
            if (layer == 0) { peer_gather_wave6<false>(gw, NGW, TP, lane, HB, EID, EG, UVl, XR, INP(I_NMIX) + D, SSQB, L + RING_OFF + wave * 2048);
                __syncthreads();
#pragma unroll 1
                for (int tp = bx; tp < TS / 2; tp += G) peer_gather_wg2<false>(TP + 2 * tp, tid, HB, EID, EG, UVl, XR, INP(I_NMIX) + D, SSQB, (LAS float*)(L + RING_OFF)); }
            else { peer_gather_wave6<true>(gw, NGW, TP, lane, HB, EID, EG, UVl, XR, INP(I_NFIN), SSQB, L + RING_OFF + wave * 2048);
                __syncthreads();
#pragma unroll 1
                for (int tp = bx; tp < TS / 2; tp += G) peer_gather_wg2<true>(TP + 2 * tp, tid, HB, EID, EG, UVl, XR, INP(I_NFIN), SSQB, (LAS float*)(L + RING_OFF)); }
        }
        if (layer == 0) SEAM(pb + 5);
    }
#undef IN
#undef SEAM
#undef GEMM_PHASE
}

#ifndef MK_PER_PHASE
#define MK_PER_PHASE 0
#endif
extern "C" void kernel_launch(void* const* d_in, const int* in_sizes, int n_in, void* d_out, int out_size, void* d_ws, size_t ws_size, hipStream_t stream) {
    static int grid = 0;
    if (grid == 0) {
        if (n_in != N_IN || out_size != (int)O_END || ws_size < WS_END) { fprintf(stderr, "kernel_launch: unexpected shapes: n_in %d out %d ws %zu; nothing launched\n", n_in, out_size, ws_size); grid = -1; return; }
        int dev = 0, cus = 0, per_cu = 0;
        if (hipGetDevice(&dev) != hipSuccess || hipDeviceGetAttribute(&cus, hipDeviceAttributeMultiprocessorCount, dev) != hipSuccess) { fprintf(stderr, "kernel_launch: device query failed\n"); grid = -1; return; }
        if (hipFuncSetAttribute((const void*)mk_fwd, hipFuncAttributeMaxDynamicSharedMemorySize, LDS_BYTES) != hipSuccess) { fprintf(stderr, "kernel_launch: hipFuncSetAttribute failed\n"); grid = -1; return; }
        if (hipOccupancyMaxActiveBlocksPerMultiprocessor(&per_cu, (const void*)mk_fwd, NWAVES * 64, LDS_BYTES) != hipSuccess || per_cu < 1) { fprintf(stderr, "kernel_launch: occupancy query says %d blocks per CU\n", per_cu); per_cu = 1; }
        (void)hipGetLastError();
        grid = cus;
        if (grid > 256) grid = 256;
    }
    if (grid < 0) return;
    if (hipMemsetAsync((char*)d_ws + WS_CTL, 0, CTL_ZERO_BYTES, stream) != hipSuccess) { fprintf(stderr, "kernel_launch: memset failed\n"); return; }
    Args a{};
    for (int i = 0; i < N_IN; ++i) a.in[i] = (const float*)d_in[i];
    a.out = (float*)d_out; a.ws = (unsigned char*)d_ws;
#if MK_PER_PHASE
    for (int p = 0; p < N_PHASES; ++p) { a.ph_lo = p; a.ph_hi = p + 1; hipLaunchKernelGGL(mk_fwd, dim3(grid), dim3(NWAVES * 64), LDS_BYTES, stream, a); }
#else
    a.ph_lo = 0; a.ph_hi = N_PHASES;
    hipLaunchKernelGGL(mk_fwd, dim3(grid), dim3(NWAVES * 64), LDS_BYTES, stream, a);
#endif
    const hipError_t le = hipPeekAtLastError();
    if (le != hipSuccess) fprintf(stderr, "kernel_launch: launch failed: %s\n", hipGetErrorName(le));
}
```

```cpp
#include <hip/hip_runtime.h>
#include <cstdio>
#include <cstdint>
namespace pg8 {
#define PG8_LAS __attribute__((address_space(3)))
typedef unsigned short bf16_t;
typedef short bf16x8 __attribute__((ext_vector_type(8)));
typedef float f32x4 __attribute__((ext_vector_type(4)));
typedef unsigned u32x4 __attribute__((ext_vector_type(4)));
constexpr int BM = 256, BK = 64, HALF = 128, HTB = HALF * BK * 2  , STAGE_BYTES = 8 * HTB, NXCD = 8, WGM = 8;

__host__ __device__ __forceinline__ int lds_byte(int r, int c) { const int st = (r >> 4) * 2 + (c >> 5), rr = r & 15, cc = c & 31, ob = rr * 64 + cc * 2; return st * 1024 + (ob ^ (((ob >> 9) & 1) << 5)); }
__host__ __device__ __forceinline__ void stage_rc(int b, int& R, int& C) { const int st = b / 1024, sb = b % 1024, swz = sb ^ (((sb >> 9) & 1) << 5); R = (st >> 1) * 16 + swz / 64; C = (st & 1) * 32 + (swz % 64) / 2; }
__host__ __device__ __forceinline__ int perm32(int rho) { const int n = rho >> 4, i = rho & 15; return 8 * (i >> 2) + 4 * n + (i & 3); }

__device__ __forceinline__ const char* pg8_uni(const char* p) { asm volatile("" : "+s"(p)); return p; }
__device__ __forceinline__ unsigned pg8_vo(unsigned v) { asm volatile("" : "+v"(v)); return v; }
struct Unit { int pm, pn; };
struct Gemm { const bf16_t* A; const bf16_t* Bt; int M, N, K; };

struct StaticOrder {
    int nM, nN, nwg, G, c;
    __host__ __device__ void init(int M, int N, int G_, int c_) { nM = M / BM; nN = N / BM; nwg = nM * nN; G = G_; c = c_; }
    __host__ __device__ bool next(int i, Unit& u) const {
        const long L = (long)i * G + c; if (L >= nwg) return false;
        int wgid = (int)L; { const int q = nwg / NXCD, r = nwg % NXCD, xcd = wgid % NXCD, off = wgid / NXCD; wgid = (xcd < r ? xcd * (q + 1) : r * (q + 1) + (xcd - r) * q) + off; }
        const int nig = WGM * nN, gid = wgid / nig, fm = gid * WGM, gsz = (nM - fm) < WGM ? (nM - fm) : WGM;
        u.pm = fm + ((wgid % nig) % gsz); u.pn = (wgid % nig) / gsz; return true;
    }
    __device__ __forceinline__ void a_ready(const Unit&) const {}
    __device__ __forceinline__ void done(const Unit&) const {}
};

__device__ __forceinline__ unsigned cvt_pk_bf16(float lo, float hi) { unsigned r; asm volatile("v_cvt_pk_bf16_f32 %0, %1, %2" : "=v"(r) : "v"(lo), "v"(hi)); return r; }
typedef float f32x2 __attribute__((ext_vector_type(2)));
__device__ __forceinline__ f32x2 gelu_pk(f32x2 v) {
    const f32x2 av = __builtin_elementwise_abs(v), d = av * 0.2316418882f + 1.0f;
    f32x2 t; t.x = __builtin_amdgcn_rcpf(d.x); t.y = __builtin_amdgcn_rcpf(d.y);
    f32x2 q = t * 0.5307027145f + (-0.7265760135f); q = q * t + 0.7107068705f; q = q * t + (-0.142248368f); q = q * t + 0.127414796f; q = q * t;
    const f32x2 s = (v * v) * (-0.72134752044f);
    f32x2 e; e.x = __builtin_amdgcn_exp2f(s.x); e.y = __builtin_amdgcn_exp2f(s.y);
    const f32x2 m = v * (q * e), r = v - m;
    f32x2 o; o.x = v.x < 0.f ? m.x : r.x; o.y = v.y < 0.f ? m.y : r.y; return o;
}
template <class Epi, class Sched, bool ALIGN_EPI = false, bool SP2 = false>
__device__ __forceinline__ void gemm_phase(PG8_LAS unsigned char* lds, const Gemm g, const Sched& S, const Epi& E) {
    const int tid = (int)pg8_vo(threadIdx.x), wid = __builtin_amdgcn_readfirstlane(tid >> 6), lane = tid & 63, wr = wid >> 2, wc = wid & 3, fr = lane & 15, fq = lane >> 4;
    const int K = g.K, nt = K / BK;
    unsigned voffA[2], voffB[2];
#pragma unroll
    for (int i = 0; i < 2; ++i) { int R, C; stage_rc(tid * 16 + i * 8192, R, C); const int Rb = Epi::PERM ? ((R & ~31) + perm32(R & 31)) : R;
        voffA[i] = (unsigned)(R * K + C) * 2u; voffB[i] = (unsigned)(Rb * K + C) * 2u; }
    const size_t kstep = (size_t)(BK * 2);
    const size_t hstep = (size_t)HALF * K * 2;
    const size_t tstep = 2 * hstep;
    const unsigned ldsw = (unsigned)wid * 1024u;
    const int aoff = lds_byte(wr * 64 + fr, fq * 8), boff = lds_byte(wc * 32 + fr, fq * 8);
#define PG8_SA(b, h) (((b) * 2 + (h)) * HTB)
#define PG8_SB(b, h) ((4 + (b) * 2 + (h)) * HTB)
#define PG8_STAGE(bufoff, gbase, voff) do { _Pragma("unroll") for (int _i = 0; _i < 2; ++_i) \
        __builtin_amdgcn_global_load_lds((const unsigned*)(pg8_uni((const char*)(gbase)) + pg8_vo((voff)[_i])), (PG8_LAS unsigned*)(lds + (bufoff) + ldsw + _i * 8192), 16, 0, 0); } while (0)
#define PG8_LDA(dst, b, h) do { _Pragma("unroll") for (int m = 0; m < 4; ++m) _Pragma("unroll") for (int k = 0; k < 2; ++k) dst[m][k] = *(const PG8_LAS bf16x8*)(lds + PG8_SA(b, h) + aoff + m * 2048 + k * 1024); } while (0)
#define PG8_LDB(dst, b, h) do { _Pragma("unroll") for (int n = 0; n < 2; ++n) _Pragma("unroll") for (int k = 0; k < 2; ++k) dst[n][k] = *(const PG8_LAS bf16x8*)(lds + PG8_SB(b, h) + boff + n * 2048 + k * 1024); } while (0)
#define PG8_MMA(ai, bj, At, Bt) do { __builtin_amdgcn_s_setprio(1); _Pragma("unroll") for (int m = 0; m < 4; ++m) _Pragma("unroll") for (int n = 0; n < 2; ++n) _Pragma("unroll") for (int k = 0; k < 2; ++k) \
        acc[ai][bj][m][n] = __builtin_amdgcn_mfma_f32_16x16x32_bf16(Bt[n][k], At[m][k], acc[ai][bj][m][n], 0, 0, 0); __builtin_amdgcn_s_setprio(0); } while (0)
#define PG8_WAIT_V(n) asm volatile("s_waitcnt vmcnt(" #n ")" ::: "memory")
#define PG8_WAIT_L(n) asm volatile("s_waitcnt lgkmcnt(" #n ")" ::: "memory")
#define PG8_BAR __builtin_amdgcn_s_barrier()
#define PG8_SCHED __builtin_amdgcn_sched_barrier(0)
    Unit cur, nxt; int ui = 0;
    if (!S.next(0, cur)) return;
    f32x4 acc[2][2][4][2];
#pragma unroll
    for (int a = 0; a < 2; ++a)
#pragma unroll
        for (int b = 0; b < 2; ++b)
#pragma unroll
            for (int m = 0; m < 4; ++m)
#pragma unroll
                for (int n = 0; n < 2; ++n) acc[a][b][m][n] = (f32x4){0.f, 0.f, 0.f, 0.f};
    bf16x8 At[4][2], B0[2][2], B1[2][2];
    const char* cA = (const char*)g.A + (size_t)cur.pm * tstep; const char* cB = (const char*)g.Bt + (size_t)cur.pn * tstep;
    S.a_ready(cur);
    if constexpr (SP2) {
        PG8_STAGE(PG8_SB(0, 0), cB, voffB); PG8_STAGE(PG8_SB(0, 1), cB + hstep, voffB); PG8_STAGE(PG8_SA(0, 0), cA, voffA); PG8_STAGE(PG8_SA(0, 1), cA + hstep, voffA);
        if (wr == 1) PG8_BAR;
        PG8_WAIT_V(2); PG8_BAR;
        PG8_STAGE(PG8_SB(1, 0), cB + kstep, voffB); PG8_STAGE(PG8_SA(1, 0), cA + kstep, voffA); PG8_STAGE(PG8_SB(1, 1), cB + hstep + kstep, voffB);
        PG8_WAIT_V(6); PG8_BAR;
    } else {
        PG8_STAGE(PG8_SB(0, 0), cB, voffB); PG8_STAGE(PG8_SA(0, 0), cA, voffA); PG8_STAGE(PG8_SB(0, 1), cB + hstep, voffB); PG8_STAGE(PG8_SA(0, 1), cA + hstep, voffA);
        if (wr == 1) PG8_BAR;
        PG8_WAIT_V(4); PG8_BAR;
        PG8_STAGE(PG8_SB(1, 0), cB + kstep, voffB); PG8_STAGE(PG8_SA(1, 0), cA + kstep, voffA); PG8_STAGE(PG8_SB(1, 1), cB + hstep + kstep, voffB);
        PG8_WAIT_V(6); PG8_BAR;
    }
    for (;;) {
        const bool has_next = S.next(ui + 1, nxt);
        const char* nA = has_next ? (const char*)g.A + (size_t)nxt.pm * tstep : cA; const char* nB = has_next ? (const char*)g.Bt + (size_t)nxt.pn * tstep : cB;
        for (int t = 0; t < nt; t += 2) {
            const bool last = (t == nt - 2);
            const char* a1 = cA + (size_t)(t + 1) * kstep;
            const char* a2 = last ? nA : cA + (size_t)(t + 2) * kstep; const char* b2 = last ? nB : cB + (size_t)(t + 2) * kstep;
            const char* a3 = a2 + kstep; const char* b3 = b2 + kstep;
            if (last && has_next) S.a_ready(nxt);
            if constexpr (SP2) {
            PG8_LDB(B0, 0, 0); PG8_LDB(B1, 0, 1); PG8_SCHED; PG8_LDA(At, 0, 0); PG8_STAGE(PG8_SA(1, 1), a1 + hstep, voffA);
            PG8_WAIT_V(8); PG8_WAIT_L(0); PG8_BAR; PG8_MMA(0, 0, At, B0); PG8_MMA(0, 1, At, B1); PG8_BAR; PG8_SCHED;
            PG8_LDA(At, 0, 1); PG8_STAGE(PG8_SB(0, 0), b2, voffB); PG8_STAGE(PG8_SB(0, 1), b2 + hstep, voffB); PG8_STAGE(PG8_SA(0, 0), a2, voffA);
            PG8_WAIT_V(8); PG8_WAIT_L(0); PG8_BAR; PG8_MMA(1, 0, At, B0); PG8_MMA(1, 1, At, B1); PG8_BAR; PG8_SCHED;
            PG8_LDB(B0, 1, 0); PG8_LDB(B1, 1, 1); PG8_SCHED; PG8_LDA(At, 1, 0); PG8_STAGE(PG8_SA(0, 1), a2 + hstep, voffA);
            PG8_WAIT_V(8); PG8_WAIT_L(0); PG8_BAR; PG8_MMA(0, 0, At, B0); PG8_MMA(0, 1, At, B1); PG8_BAR; PG8_SCHED;
            PG8_LDA(At, 1, 1); PG8_STAGE(PG8_SB(1, 0), b3, voffB); PG8_STAGE(PG8_SB(1, 1), b3 + hstep, voffB); PG8_STAGE(PG8_SA(1, 0), a3, voffA);
            PG8_WAIT_V(8); PG8_WAIT_L(0); PG8_BAR; PG8_MMA(1, 0, At, B0); PG8_MMA(1, 1, At, B1); PG8_BAR; PG8_SCHED;
            } else {
            PG8_LDB(B0, 0, 0); PG8_SCHED; PG8_LDA(At, 0, 0); PG8_STAGE(PG8_SA(1, 1), a1 + hstep, voffA);
            PG8_WAIT_L(8); PG8_BAR; PG8_WAIT_L(0); PG8_MMA(0, 0, At, B0); PG8_BAR; PG8_SCHED;
            PG8_LDB(B1, 0, 1); PG8_STAGE(PG8_SB(0, 0), b2, voffB);
            PG8_BAR; PG8_WAIT_L(0); PG8_MMA(0, 1, At, B1); PG8_BAR;
            PG8_LDA(At, 0, 1); PG8_STAGE(PG8_SA(0, 0), a2, voffA);
            PG8_BAR; PG8_WAIT_L(0); PG8_MMA(1, 0, At, B0); PG8_BAR; PG8_SCHED;
            PG8_STAGE(PG8_SB(0, 1), b2 + hstep, voffB);
            PG8_WAIT_V(6); PG8_BAR; PG8_MMA(1, 1, At, B1); PG8_BAR;
            PG8_LDB(B0, 1, 0); PG8_SCHED; PG8_LDA(At, 1, 0); PG8_STAGE(PG8_SA(0, 1), a2 + hstep, voffA);
            PG8_WAIT_L(8); PG8_BAR; PG8_WAIT_L(0); PG8_MMA(0, 0, At, B0); PG8_BAR; PG8_SCHED;
            PG8_LDB(B1, 1, 1); PG8_STAGE(PG8_SB(1, 0), b3, voffB);
            PG8_BAR; PG8_WAIT_L(0); PG8_MMA(0, 1, At, B1); PG8_BAR;
            PG8_LDA(At, 1, 1); PG8_STAGE(PG8_SA(1, 0), a3, voffA);
            PG8_BAR; PG8_WAIT_L(0); PG8_MMA(1, 0, At, B0); PG8_BAR; PG8_SCHED;
            PG8_STAGE(PG8_SB(1, 1), b3 + hstep, voffB);
            PG8_WAIT_V(6); PG8_BAR; PG8_MMA(1, 1, At, B1); PG8_BAR;
            }
        }
        if constexpr (ALIGN_EPI) { if (wr == 0) PG8_BAR; }
        if constexpr (!Epi::AFTER_DRAIN) { E(acc, cur, wr, wc, fr, fq); S.done(cur); }
        if (!has_next) break;
#pragma unroll
        for (int a = 0; a < 2; ++a)
#pragma unroll
            for (int b = 0; b < 2; ++b)
#pragma unroll
                for (int m = 0; m < 4; ++m)
#pragma unroll
                    for (int n = 0; n < 2; ++n) acc[a][b][m][n] = (f32x4){0.f, 0.f, 0.f, 0.f};
        cur = nxt; cA = nA; cB = nB; ++ui;
        if constexpr (ALIGN_EPI) { if (wr == 1) PG8_BAR; }
    }
    PG8_WAIT_V(0);
    if constexpr (!ALIGN_EPI) { if (wr == 0) PG8_BAR; }
    PG8_BAR;
    if constexpr (Epi::AFTER_DRAIN) { E.fused(acc, cur, wr, wc, fr, fq, lds, wid, lane); S.done(cur); }
#undef PG8_SA
#undef PG8_SB
#undef PG8_STAGE
#undef PG8_LDA
#undef PG8_LDB
#undef PG8_MMA
#undef PG8_WAIT_V
#undef PG8_WAIT_L
#undef PG8_BAR
#undef PG8_SCHED
}
}
#define GAS __attribute__((address_space(1)))
#define LAS __attribute__((address_space(3)))
typedef unsigned short bf16;
typedef unsigned v4u __attribute__((ext_vector_type(4)));
typedef unsigned v2u __attribute__((ext_vector_type(2)));
typedef int v4i __attribute__((ext_vector_type(4)));
typedef float f32x4 __attribute__((ext_vector_type(4)));
typedef float f32x2 __attribute__((ext_vector_type(2)));
typedef short bf16x8 __attribute__((ext_vector_type(8)));
typedef __bf16 bf16x2_t __attribute__((ext_vector_type(2)));
typedef GAS unsigned gu32;
#define RLX_AGENT __ATOMIC_RELAXED, __HIP_MEMORY_SCOPE_AGENT
#define LDS_WAIT() asm volatile("s_waitcnt lgkmcnt(0)" ::: "memory")
#define VM_WAIT() asm volatile("s_waitcnt vmcnt(0)" ::: "memory")
__device__ __forceinline__ unsigned f2bf(float f) { unsigned u = __builtin_bit_cast(unsigned, f); return (u + 0x7fffu + ((u >> 16) & 1u)) >> 16; }
__device__ __forceinline__ unsigned pk2(float lo, float hi) { return pg8::cvt_pk_bf16(lo, hi); }
__device__ __forceinline__ float bflo(unsigned w) { return __builtin_bit_cast(float, w << 16); }
__device__ __forceinline__ float bfhi(unsigned w) { return __builtin_bit_cast(float, w & 0xffff0000u); }
__device__ __forceinline__ float wave_sum(float v) {
#pragma unroll
    for (int o = 1; o < 64; o <<= 1) v += __shfl_xor(v, o);
    return v;
}
__device__ __forceinline__ float wave_max(float v) {
#pragma unroll
    for (int o = 1; o < 64; o <<= 1) v = fmaxf(v, __shfl_xor(v, o));
    return v;
}
__device__ __forceinline__ float gelu1(float v) { const f32x2 r = pg8::gelu_pk((f32x2){v, 0.f}); return r.x; }
#define XB_TMO      128
#define XB_XCNT(j)  (256  + 64 * (j))
#define XB_XSUB(j)  (1280 + 64 * (j))
#define XB_XGEN(j)  (2304 + 64 * (j))
#define XB_TOP      3328
#define XB_TOPGEN   3392
#define XCD_BAR_WORDS 3456
#define XB_SPIN_CAP (1u << 21)

__device__ __forceinline__ unsigned xb_ld(unsigned* p)              { return __hip_atomic_load(p, __ATOMIC_RELAXED, __HIP_MEMORY_SCOPE_AGENT); }
__device__ __forceinline__ unsigned xb_add(unsigned* p, unsigned v) { return __hip_atomic_fetch_add(p, v, __ATOMIC_RELAXED, __HIP_MEMORY_SCOPE_AGENT); }
__device__ __forceinline__ unsigned xb_xcc_id() { return (unsigned)__builtin_amdgcn_s_getreg((3 << 11) | 20) & 0xFu; }
#define XB_SPIN(cond, bar) do { unsigned _sp = 0; while (cond) { __builtin_amdgcn_s_sleep(1); \
    if ((++_sp & 255u) == 0u) { if (xb_ld(&(bar)[XB_TMO])) break; if (_sp > XB_SPIN_CAP) { atomicAdd(&(bar)[XB_TMO], 1u); break; } } } } while (0)

struct XcdBarrier {
    unsigned* bar; unsigned x;
    volatile LAS unsigned* st;
};

__device__ __forceinline__ XcdBarrier xcd_barrier_post(unsigned* bar, volatile LAS unsigned* st) {
    XcdBarrier b; b.bar = bar; b.x = xb_xcc_id(); b.st = st;
    if (threadIdx.x == 0) (void)xb_add(&bar[XB_XCNT(b.x)], 1u);
    return b;
}
__device__ __forceinline__ void xcd_barrier_complete(unsigned* bar, unsigned x, unsigned& nloc, unsigned& nx) {
    const unsigned G = gridDim.x * gridDim.y * gridDim.z;
    unsigned sum, cnt, mine, sp = 0u;
    for (;;) {
        sum = 0u; cnt = 0u; mine = 0u;
#pragma unroll
        for (unsigned j = 0; j < 16; ++j) { const unsigned c = xb_ld(&bar[XB_XCNT(j)]); sum += c; cnt += (c > 0u) ? 1u : 0u; mine = (j == x) ? c : mine; }
        if (sum == G) break;
        __builtin_amdgcn_s_sleep(1);
        if ((++sp & 255u) == 0u) { if (xb_ld(&bar[XB_TMO])) break; if (sp > XB_SPIN_CAP) { atomicAdd(&bar[XB_TMO], 1u); break; } }
    }
    nloc = mine > 0u ? mine : 1u; nx = cnt > 0u ? cnt : 1u;
}

__device__ __forceinline__ void xcd_barrier(const XcdBarrier& b) {
    asm volatile("s_waitcnt vmcnt(0)" ::: "memory");
    __syncthreads();
    if (threadIdx.x == 0) {
        unsigned* bar = b.bar;
        __builtin_amdgcn_s_waitcnt(0);
        unsigned nloc = b.st[0], nx = b.st[1];
        if (nloc == 0u) { xcd_barrier_complete(bar, b.x, nloc, nx); b.st[0] = nloc; b.st[1] = nx; }
        const unsigned old = xb_add(&bar[XB_XSUB(b.x)], 1u);
        const unsigned gen = old / nloc;
        if (old + 1u == (gen + 1u) * nloc) {
            __builtin_amdgcn_fence(__ATOMIC_RELEASE, "agent");
            asm volatile("s_waitcnt vmcnt(0)" ::: "memory");
            const unsigned og = xb_add(&bar[XB_TOP], 1u);
            const unsigned tg = og / nx;
            if (og + 1u == (tg + 1u) * nx) xb_add(&bar[XB_TOPGEN], 1u);
            else XB_SPIN(xb_ld(&bar[XB_TOPGEN]) == tg, bar);
            __builtin_amdgcn_fence(__ATOMIC_ACQUIRE, "agent");
            xb_add(&bar[XB_XGEN(b.x)], 1u);
            asm volatile("s_waitcnt vmcnt(0)" ::: "memory");
        } else {
            XB_SPIN(xb_ld(&bar[XB_XGEN(b.x)]) == gen, bar);
            __builtin_amdgcn_fence(__ATOMIC_ACQUIRE, "agent");
            asm volatile("s_waitcnt vmcnt(0)" ::: "memory");
        }
    }
    __syncthreads();
}
constexpr int NWAVES = 8;
constexpr int D = 1024, NB = 8, SEQ = 2048, TP = NB * SEQ, DB = 128, DSQ = 4, TS = DB * DSQ, T = TP + TS;
constexpr int MEMT = 256, NH = 4, HD = 256, MROWS = NB * MEMT;
constexpr int NEXP = 16384;
constexpr float RMS_EPS = 1e-6f;
constexpr size_t O_Y = 0, O_SRP = 17301504, O_SIP = 17334272, O_CP = 17367040, O_MK = 17383424, O_MV = 21577728, O_SRS = 25772032, O_SIS = 26296320, O_CS = 26820608, O_END = 27082752;
enum { I_XP = 0, I_XS, I_MEM, I_SRE, I_SIM, I_SCONV, I_CK, I_CV, I_NMIX, I_NMEM, I_NFFN, I_NFIN, I_ARE, I_AIM, I_LDT, I_BRE, I_BIM, I_CRE, I_CIM, I_SD, I_WGLU, I_WIN, I_CW, I_WOUT,
       I_WQ, I_WK, I_WV, I_WO, I_PWQ, I_K1, I_K2, I_PU, I_PV, N_IN };
constexpr int R_KV = 0, R_GLU = 4096, R_Q = 6144, R_O = 8192, R_PQ = 10240, R_WIN = 14336, R_WOUT = 17408, R_END = 18432;
constexpr size_t MiB = 1u << 20;
constexpr size_t WS_CTL = 0, CTL_ZERO_BYTES = 1 * MiB;
constexpr size_t WS_WALL = 2 * MiB;
constexpr size_t WS_KEYS = 38 * MiB;
constexpr size_t WS_BBW = 39 * MiB;
constexpr size_t WS_CCW = 39 * MiB + 512 * 1024;
constexpr size_t WS_LB = 40 * MiB;
constexpr size_t WS_MEMB = 41 * MiB;
constexpr size_t WS_KB = 45 * MiB;
constexpr size_t WS_VT = 53 * MiB;
constexpr size_t WS_EID = 61 * MiB;
constexpr size_t WS_EG = 70 * MiB;
constexpr size_t WS_HB = 80 * MiB;
constexpr size_t WS_ZB = 114 * MiB;
constexpr size_t WS_QB = 148 * MiB;
constexpr size_t WS_QP = 182 * MiB;
constexpr size_t WS_B1 = 249 * MiB;
constexpr size_t WS_V1 = 283 * MiB;
constexpr size_t WS_UV = 320 * MiB;
constexpr size_t WS_SSQ = 384 * MiB;
constexpr size_t WS_END = 388 * MiB;
constexpr int CW_BAR = 4096;
constexpr int RING_OFF = 0, RING_BYTES = 131072;
constexpr int LDSCTL_OFF = 146432, MISC_OFF = LDSCTL_OFF + 320;
constexpr int LDS_BYTES = 147456;
using pg8::Unit;
struct EpiKV {
    static constexpr bool PERM = false, AFTER_DRAIN = false;
    float* out; bf16* KB; bf16* VT;
    __device__ __forceinline__ void operator()(const f32x4 (&acc)[2][2][4][2], const Unit& u, int wr, int wc, int fr, int fq) const {
        fr = (int)pg8::pg8_vo((unsigned)fr); fq = (int)pg8::pg8_vo((unsigned)fq);
        const int b = u.pm, mat = u.pn >> 2, l = mat >> 1, isv = mat & 1, h = u.pn & 3;
        float* ob = out + (isv ? O_MV : O_MK) + (size_t)(l * NB + b) * MEMT * D + h * HD;
#pragma unroll
        for (int ai = 0; ai < 2; ++ai)
#pragma unroll
            for (int m = 0; m < 4; ++m) { const int mm = ai * 128 + wr * 64 + m * 16 + fr;
#pragma unroll
                for (int bj = 0; bj < 2; ++bj)
#pragma unroll
                    for (int n = 0; n < 2; ++n) { const int dl = bj * 128 + wc * 32 + n * 16 + 4 * fq; const f32x4 v = acc[ai][bj][m][n];
                        *(f32x4*)(ob + (size_t)mm * D + dl) = v;
                        if (!isv) { v2u w; w.x = pk2(v[0], v[1]); w.y = pk2(v[2], v[3]); *(v2u*)(KB + ((size_t)l * MROWS + b * MEMT + mm) * D + h * HD + dl) = w; }
                        else { bf16* vp = VT + ((((size_t)l * NB + b) * NH + h) * HD + dl) * MEMT + ((mm & ~31) | (((mm >> 2) & 3) << 3) | (((mm >> 4) & 1) << 2) | (mm & 3));
#pragma unroll
                            for (int j = 0; j < 4; ++j) vp[(size_t)j * MEMT] = (bf16)f2bf(v[j]); } } }
    }
};
struct EpiGLU {
    static constexpr bool PERM = false, AFTER_DRAIN = false;
    const float* xp; float* XR; bf16* HBo; float* SSQ; const float* gnext;
    __device__ __forceinline__ void operator()(const f32x4 (&acc)[2][2][4][2], const Unit& u, int wr, int wc, int fr, int fq) const {
        fr = (int)pg8::pg8_vo((unsigned)fr); fq = (int)pg8::pg8_vo((unsigned)fq);
        const int row0 = u.pm * 256 + wr * 64 + fr, col0 = u.pn * 128 + wc * 32 + 4 * fq;
        const f32x4 g0 = *(const f32x4*)(gnext + col0), g1 = *(const f32x4*)(gnext + col0 + 16);
#pragma unroll
        for (int ai = 0; ai < 2; ++ai)
#pragma unroll
            for (int mp = 0; mp < 2; ++mp) { f32x4 xv[2][2];
#pragma unroll
                for (int mm = 0; mm < 2; ++mm)
#pragma unroll
                    for (int n = 0; n < 2; ++n) xv[mm][n] = *(const f32x4*)(xp + (size_t)(row0 + ai * 128 + (2 * mp + mm) * 16) * D + col0 + n * 16);
#pragma unroll
                for (int mm = 0; mm < 2; ++mm) { const int m = 2 * mp + mm, row = row0 + ai * 128 + m * 16; const size_t ro = (size_t)row * D + col0; float ss = 0.f;
#pragma unroll
                    for (int n = 0; n < 2; ++n) { const f32x4 a = acc[ai][0][m][n], b = acc[ai][1][m][n]; f32x4 o;
#pragma unroll
                        for (int j = 0; j < 4; ++j) { o[j] = xv[mm][n][j] + a[j] / (1.0f + __expf(-b[j])); ss = fmaf(o[j], o[j], ss); }
                        *(f32x4*)(XR + ro + n * 16) = o; const f32x4 hg = o * (n ? g1 : g0); v2u w; w.x = pk2(hg[0], hg[1]); w.y = pk2(hg[2], hg[3]); *(v2u*)(HBo + ro + n * 16) = w; }
                    ss += __shfl_xor(ss, 16); ss += __shfl_xor(ss, 32);
                    if (fq == 0) SSQ[(size_t)row * 32 + u.pn * 4 + wc] = ss; }
                asm volatile("" ::: "memory"); }
    }
};
__device__ __forceinline__ float row_rinv(const float* SSQ, size_t row, int nslots) {
    const f32x4* p = (const f32x4*)(SSQ + row * 32); f32x4 s = p[0] + p[1] + p[2] + p[3];
    if (nslots > 16) s += p[4] + p[5] + p[6] + p[7];
    return 1.0f / sqrtf(((s[0] + s[1]) + (s[2] + s[3])) * (1.0f / D) + RMS_EPS);
}
struct EpiB16 {
    static constexpr bool PERM = true, AFTER_DRAIN = false;
    bf16* O; int ldc; const float* SSQ; int nslots;
    __device__ __forceinline__ void operator()(const f32x4 (&acc)[2][2][4][2], const Unit& u, int wr, int wc, int fr, int fq) const {
        fr = (int)pg8::pg8_vo((unsigned)fr); fq = (int)pg8::pg8_vo((unsigned)fq);
        const int rb = u.pm * 256 + wr * 64, row0 = rb + fr, col0 = u.pn * 256 + wc * 32 + 8 * fq, ln = fq * 16 + fr;
        const float r0 = row_rinv(SSQ, (size_t)(rb + ln), nslots), r1 = row_rinv(SSQ, (size_t)(rb + 128 + ln), nslots);
#pragma unroll
        for (int ai = 0; ai < 2; ++ai)
#pragma unroll
            for (int m = 0; m < 4; ++m) { const size_t row = (size_t)(row0 + ai * 128 + m * 16); bf16* rowp = O + row * ldc + col0; const float ri = __shfl(ai ? r1 : r0, m * 16 + fr);
#pragma unroll
                for (int bj = 0; bj < 2; ++bj) { const f32x4 v0 = acc[ai][bj][m][0] * ri, v1 = acc[ai][bj][m][1] * ri;
                    v4u w; w.x = pk2(v0[0], v0[1]); w.y = pk2(v0[2], v0[3]); w.z = pk2(v1[0], v1[1]); w.w = pk2(v1[2], v1[3]);
                    *(v4u*)(rowp + bj * 128) = w; } }
    }
};
struct EpiRes {
    static constexpr bool PERM = false, AFTER_DRAIN = false;
    float* XR; bf16* HBo; float* SSQ; const float* gnext;
    __device__ __forceinline__ void operator()(const f32x4 (&acc)[2][2][4][2], const Unit& u, int wr, int wc, int fr, int fq) const {
        fr = (int)pg8::pg8_vo((unsigned)fr); fq = (int)pg8::pg8_vo((unsigned)fq);
        const int row0 = u.pm * 256 + wr * 64 + fr, col0 = u.pn * 256 + wc * 32 + 4 * fq;
        f32x4 gv[2][2];
#pragma unroll
        for (int bj = 0; bj < 2; ++bj)
#pragma unroll
            for (int n = 0; n < 2; ++n) gv[bj][n] = *(const f32x4*)(gnext + col0 + bj * 128 + n * 16);
#pragma unroll
        for (int ai = 0; ai < 2; ++ai)
#pragma unroll
            for (int mp = 0; mp < 2; ++mp) { f32x4 xv[2][2][2];
#pragma unroll
                for (int mm = 0; mm < 2; ++mm)
#pragma unroll
                    for (int bj = 0; bj < 2; ++bj)
#pragma unroll
                        for (int n = 0; n < 2; ++n) xv[mm][bj][n] = *(const f32x4*)(XR + (size_t)(row0 + ai * 128 + (2 * mp + mm) * 16) * D + col0 + bj * 128 + n * 16);
#pragma unroll
                for (int mm = 0; mm < 2; ++mm) { const int m = 2 * mp + mm, row = row0 + ai * 128 + m * 16; const size_t ro = (size_t)row * D + col0; float ss = 0.f;
#pragma unroll
                    for (int bj = 0; bj < 2; ++bj)
#pragma unroll
                        for (int n = 0; n < 2; ++n) { const f32x4 o = xv[mm][bj][n] + acc[ai][bj][m][n]; *(f32x4*)(XR + ro + bj * 128 + n * 16) = o;
                            ss = fmaf(o[0], o[0], fmaf(o[1], o[1], fmaf(o[2], o[2], fmaf(o[3], o[3], ss))));
                            const f32x4 hg = o * gv[bj][n]; v2u w; w.x = pk2(hg[0], hg[1]); w.y = pk2(hg[2], hg[3]); *(v2u*)(HBo + ro + bj * 128 + n * 16) = w; }
                    ss += __shfl_xor(ss, 16); ss += __shfl_xor(ss, 32);
                    if (fq == 0) SSQ[(size_t)row * 32 + u.pn * 4 + wc] = ss; }
                asm volatile("" ::: "memory"); }
    }
};
struct EpiWin {
    static constexpr bool PERM = false, AFTER_DRAIN = false;
    bf16* B1; bf16* V1; float* out;
    __device__ __forceinline__ void operator()(const f32x4 (&acc)[2][2][4][2], const Unit& u, int wr, int wc, int fr, int fq) const {
        fr = (int)pg8::pg8_vo((unsigned)fr); fq = (int)pg8::pg8_vo((unsigned)fq);
        const int row0 = u.pm * 256 + wr * 64 + fr;
        if (u.pn < 8) {
#pragma unroll
            for (int ai = 0; ai < 2; ++ai)
#pragma unroll
                for (int m = 0; m < 4; ++m) { const int row = row0 + ai * 128 + m * 16; const int col0 = u.pn * 128 + wc * 32 + 4 * fq;
                    float* cs = nullptr;
                    { const int s = row & (SEQ - 1); if (s >= SEQ - 2) cs = out + O_CP + ((size_t)(row >> 11) * 2 + (s - (SEQ - 2))) * D; }
#pragma unroll
                    for (int n = 0; n < 2; ++n) { const f32x4 v = acc[ai][0][m][n] * acc[ai][1][m][n];
                        v2u w; w.x = pk2(v[0], v[1]); w.y = pk2(v[2], v[3]); *(v2u*)(V1 + (size_t)row * D + col0 + n * 16) = w;
                        if (cs) *(f32x4*)(cs + col0 + n * 16) = v; } }
        } else {
#pragma unroll
            for (int ai = 0; ai < 2; ++ai)
#pragma unroll
                for (int m = 0; m < 4; ++m) { bf16* rowp = B1 + (size_t)(row0 + ai * 128 + m * 16) * D + (u.pn - 8) * 256 + wc * 32 + 4 * fq;
#pragma unroll
                    for (int bj = 0; bj < 2; ++bj)
#pragma unroll
                        for (int n = 0; n < 2; ++n) { const f32x4 v = acc[ai][bj][m][n]; v2u w; w.x = pk2(v[0], v[1]); w.y = pk2(v[2], v[3]); *(v2u*)(rowp + bj * 128 + n * 16) = w; } }
        }
    }
};
__device__ __forceinline__ bf16x8 mk8(v4u w) { return __builtin_bit_cast(bf16x8, w); }
__device__ __forceinline__ f32x4 mfma16(bf16x8 a, bf16x8 b, f32x4 c) { return __builtin_amdgcn_mfma_f32_16x16x32_bf16(a, b, c, 0, 0, 0); }

__device__ __forceinline__ void p0_transpose_item(const float* W, int N, int src_n0, bf16* WTrows, int k0, LAS float* scr, int lane) {
#pragma unroll
    for (int i = 0; i < 8; ++i) { const int kk = 8 * i + (lane >> 3), n4 = (lane & 7) * 4; const f32x4 v = *(const f32x4*)(W + (size_t)(k0 + kk) * N + src_n0 + n4);
        scr[kk * 33 + n4] = v[0]; scr[kk * 33 + n4 + 1] = v[1]; scr[kk * 33 + n4 + 2] = v[2]; scr[kk * 33 + n4 + 3] = v[3]; }
    LDS_WAIT();
    const int c = lane & 7;
#pragma unroll
    for (int j = 0; j < 4; ++j) { const int n = (lane >> 3) + 8 * j; const LAS float* s = scr + (8 * c) * 33 + n;
        v4u o; o.x = pk2(s[0 * 33], s[1 * 33]); o.y = pk2(s[2 * 33], s[3 * 33]); o.z = pk2(s[4 * 33], s[5 * 33]); o.w = pk2(s[6 * 33], s[7 * 33]);
        *(v4u*)(WTrows + (size_t)n * D + k0 + 8 * c) = o; }
    LDS_WAIT();
}
__device__ __forceinline__ void p0_transpose_item2(const float* W0, int N0, int sn0, bf16* WT0, int k0, bool two, const float* W1, int N1, int sn1, bf16* WT1, int k1, LAS float* scr, int lane) {
    f32x4 v0[8], v1[8];
#pragma unroll
    for (int i = 0; i < 8; ++i) { const int kk = 8 * i + (lane >> 3), n4 = (lane & 7) * 4; v0[i] = *(const f32x4*)(W0 + (size_t)(k0 + kk) * N0 + sn0 + n4); v1[i] = two ? *(const f32x4*)(W1 + (size_t)(k1 + kk) * N1 + sn1 + n4) : v0[i]; }
#pragma unroll
    for (int i = 0; i < 8; ++i) { const int kk = 8 * i + (lane >> 3), n4 = (lane & 7) * 4;
#pragma unroll
        for (int j = 0; j < 4; ++j) { scr[kk * 33 + n4 + j] = v0[i][j]; scr[2112 + kk * 33 + n4 + j] = v1[i][j]; } }
    LDS_WAIT();
    const int c = lane & 7;
#pragma unroll
    for (int j = 0; j < 4; ++j) { const int n = (lane >> 3) + 8 * j; const LAS float* s = scr + (8 * c) * 33 + n;
        v4u o; o.x = pk2(s[0 * 33], s[1 * 33]); o.y = pk2(s[2 * 33], s[3 * 33]); o.z = pk2(s[4 * 33], s[5 * 33]); o.w = pk2(s[6 * 33], s[7 * 33]);
        *(v4u*)(WT0 + (size_t)n * D + k0 + 8 * c) = o;
        if (two) { const LAS float* s2 = s + 2112; v4u o2; o2.x = pk2(s2[0 * 33], s2[1 * 33]); o2.y = pk2(s2[2 * 33], s2[3 * 33]); o2.z = pk2(s2[4 * 33], s2[5 * 33]); o2.w = pk2(s2[6 * 33], s2[7 * 33]);
            *(v4u*)(WT1 + (size_t)n * D + k1 + 8 * c) = o2; } }
    LDS_WAIT();
}
__device__ __forceinline__ void rms_row_bf16(const float* xrow, const float* g, bf16* orow, int lane) {
    const f32x4* xr = (const f32x4*)xrow + lane; f32x4 v[4]; float s = 0.f;
#pragma unroll
    for (int j = 0; j < 4; ++j) { v[j] = xr[64 * j]; s += (v[j].x * v[j].x + v[j].y * v[j].y) + (v[j].z * v[j].z + v[j].w * v[j].w); }
    const float r = 1.0f / sqrtf(wave_sum(s) * (1.0f / D) + RMS_EPS);
#pragma unroll
    for (int j = 0; j < 4; ++j) { const f32x4 gv = ((const f32x4*)g)[lane + 64 * j]; v2u w; w.x = pk2(v[j].x * r * gv.x, v[j].y * r * gv.y); w.y = pk2(v[j].z * r * gv.z, v[j].w * r * gv.w);
        *(v2u*)(orow + 4 * lane + 256 * j) = w; }
}

__device__ __forceinline__ void rms_row2_bf16(const float* x0, const float* x1, const float* g, bf16* o0, bf16* o1, int lane) {
    f32x4 v[2][4]; float s[2] = {0.f, 0.f}; const bool two = x1 != nullptr;
#pragma unroll
    for (int j = 0; j < 4; ++j) { v[0][j] = ((const f32x4*)x0)[lane + 64 * j]; if (two) v[1][j] = ((const f32x4*)x1)[lane + 64 * j]; else v[1][j] = (f32x4){0.f, 0.f, 0.f, 0.f}; }
#pragma unroll
    for (int h = 0; h < 2; ++h)
#pragma unroll
        for (int j = 0; j < 4; ++j) s[h] += (v[h][j].x * v[h][j].x + v[h][j].y * v[h][j].y) + (v[h][j].z * v[h][j].z + v[h][j].w * v[h][j].w);
    const float r0 = 1.0f / sqrtf(wave_sum(s[0]) * (1.0f / D) + RMS_EPS), r1 = 1.0f / sqrtf(wave_sum(s[1]) * (1.0f / D) + RMS_EPS);
#pragma unroll
    for (int j = 0; j < 4; ++j) { const f32x4 gv = ((const f32x4*)g)[lane + 64 * j];
        v2u w; w.x = pk2(v[0][j].x * r0 * gv.x, v[0][j].y * r0 * gv.y); w.y = pk2(v[0][j].z * r0 * gv.z, v[0][j].w * r0 * gv.w); *(v2u*)(o0 + 4 * lane + 256 * j) = w;
        if (two) { v2u w2; w2.x = pk2(v[1][j].x * r1 * gv.x, v[1][j].y * r1 * gv.y); w2.y = pk2(v[1][j].z * r1 * gv.z, v[1][j].w * r1 * gv.w); *(v2u*)(o1 + 4 * lane + 256 * j) = w2; } }
}
template <bool SAMPLE, bool WITH_Y>
__device__ __forceinline__ void s5_run(const bf16* HB, bf16* ZB, const bf16* BBW, const bf16* CCW, const float* dsk, LAS float* ST, int lane,
                                       int g, int row0, int nchunks, int b0, const float* s0re, const float* s0im, float* ore, float* oim, float lbr, float lbi, float& sr, float& si) {
    const int tl = lane & 15, q4 = lane >> 4;
    const bf16x8 zero8 = {0, 0, 0, 0, 0, 0, 0, 0};
    bf16x8 Abb[8], Acc[4];
#pragma unroll
    for (int tt = 0; tt < 8; ++tt) Abb[tt] = (q4 < 2) ? *(const bf16x8*)(BBW + ((size_t)(g * 128 + 16 * tt + tl)) * 16 + 8 * q4) : zero8;
    if (WITH_Y) {
#pragma unroll
        for (int s = 0; s < 4; ++s) Acc[s] = *(const bf16x8*)(CCW + ((size_t)(g * 16 + tl)) * 128 + 32 * s + 8 * q4); }
    const f32x4 dv = WITH_Y ? *(const f32x4*)(dsk + 16 * g + 4 * q4) : (f32x4){0.f, 0.f, 0.f, 0.f};
    const bf16* hp = HB + (size_t)(row0 + tl) * D + 16 * g;
    bf16x8 Bn = (q4 < 2) ? *(const bf16x8*)(hp + 8 * q4) : zero8; v2u hn = WITH_Y ? *(const v2u*)(hp + 4 * q4) : (v2u){0u, 0u};
    for (int ch = 0; ch < nchunks; ++ch) {
        const int rowc = row0 + 16 * ch;
        const bf16x8 Bu = Bn; const v2u hw = hn;
        if (ch + 1 < nchunks) { const bf16* hq = hp + (size_t)(16 * (ch + 1)) * D; Bn = (q4 < 2) ? *(const bf16x8*)(hq + 8 * q4) : zero8; if (WITH_Y) hn = *(const v2u*)(hq + 4 * q4); }
#pragma unroll
        for (int tt = 0; tt < 8; ++tt) { const f32x4 a = mfma16(Abb[tt], Bu, (f32x4){0.f, 0.f, 0.f, 0.f}); *(LAS f32x4*)(ST + tl * 132 + 16 * tt + 4 * q4) = a; }
        LDS_WAIT();
        float br[16], bi[16];
#pragma unroll
        for (int t = 0; t < 16; ++t) { br[t] = ST[t * 132 + lane]; bi[t] = ST[t * 132 + 64 + lane]; }
#pragma unroll
        for (int t = 0; t < 16; ++t) {
            if (SAMPLE && (t & 3) == 0) { const size_t si0 = ((size_t)(b0 + (t >> 2)) * 64 + g) * 64 + lane; sr = s0re[si0]; si = s0im[si0]; }
            const float nr = fmaf(-lbi, si, fmaf(lbr, sr, br[t])), ni = fmaf(lbi, sr, fmaf(lbr, si, bi[t]));
            sr = nr; si = ni;
            if (WITH_Y) { ST[t * 132 + lane] = sr; ST[t * 132 + 64 + lane] = si; }
            if (SAMPLE && (t & 3) == 3) { const size_t so = ((size_t)(b0 + (t >> 2)) * 64 + g) * 64 + lane; ore[so] = sr; oim[so] = si; }
        }
        LDS_WAIT();
        if (WITH_Y) {
            f32x4 y = {0.f, 0.f, 0.f, 0.f};
#pragma unroll
            for (int s = 0; s < 4; ++s) { const f32x4 lo = *(const LAS f32x4*)(ST + tl * 132 + 32 * s + 8 * q4), hi = *(const LAS f32x4*)(ST + tl * 132 + 32 * s + 8 * q4 + 4);
                v4u w; w.x = pk2(lo[0], lo[1]); w.y = pk2(lo[2], lo[3]); w.z = pk2(hi[0], hi[1]); w.w = pk2(hi[2], hi[3]);
                y = mfma16(Acc[s], mk8(w), y); }
            LDS_WAIT();
            y[0] = fmaf(dv[0], bflo(hw.x), y[0]); y[1] = fmaf(dv[1], bfhi(hw.x), y[1]); y[2] = fmaf(dv[2], bflo(hw.y), y[2]); y[3] = fmaf(dv[3], bfhi(hw.y), y[3]);
            const f32x2 g0 = pg8::gelu_pk((f32x2){y[0], y[1]}), g1 = pg8::gelu_pk((f32x2){y[2], y[3]});
            v2u zo; zo.x = pk2(g0.x, g0.y); zo.y = pk2(g1.x, g1.y);
            *(v2u*)(ZB + (size_t)(rowc + tl) * D + 16 * g + 4 * q4) = zo;
        }
    }
}
constexpr int S5_ST_BYTES = 8448, S5_XE_OFF = 8 * S5_ST_BYTES;
__device__ __forceinline__ void s5_prompt_seq(const bf16* HB, bf16* ZB, const bf16* BBW, const bf16* CCW, const float* LB, const float* dsk, LAS unsigned char* lds, int tid, int b, int g, float* ore, float* oim) {
    const int lane = tid & 63, seg = tid >> 6;
    LAS float* ST = (LAS float*)(lds + seg * S5_ST_BYTES); LAS float* XE = (LAS float*)(lds + S5_XE_OFF);
    const float lbr = LB[(g * 64 + lane) * 2], lbi = LB[(g * 64 + lane) * 2 + 1];
    const int row0 = b * SEQ + seg * 256;
    float sr = 0.f, si = 0.f;
    s5_run<false, false>(HB, ZB, BBW, CCW, dsk, ST, lane, g, row0, 16, b, nullptr, nullptr, nullptr, nullptr, lbr, lbi, sr, si);
    XE[(seg * 64 + lane) * 2] = sr; XE[(seg * 64 + lane) * 2 + 1] = si;
    float pr = lbr, pi = lbi;
#pragma unroll
    for (int k = 0; k < 8; ++k) { const float nr = pr * pr - pi * pi, ni = 2.f * pr * pi; pr = nr; pi = ni; }
    __syncthreads();
    float cr = 0.f, ci = 0.f;
    for (int sp = 0; sp < seg; ++sp) { const float er = XE[(sp * 64 + lane) * 2], ei = XE[(sp * 64 + lane) * 2 + 1]; const float nr = pr * cr - pi * ci + er, ni = pr * ci + pi * cr + ei; cr = nr; ci = ni; }
    __syncthreads();
    sr = cr; si = ci;
    s5_run<false, true>(HB, ZB, BBW, CCW, dsk, ST, lane, g, row0, 16, b, nullptr, nullptr, nullptr, nullptr, lbr, lbi, sr, si);
    if (seg == 7) { const size_t so = ((size_t)b * 64 + g) * 64 + lane; ore[so] = sr; oim[so] = si; }
}

__device__ __forceinline__ float xreduce16(const float (&p)[16], int lane) {
    float q[8], r[4], s[2];
    const bool b5 = (lane & 32) != 0, b4 = (lane & 16) != 0, b3 = (lane & 8) != 0, b2 = (lane & 4) != 0;
#pragma unroll
    for (int k = 0; k < 8; ++k) { const float send = b5 ? p[k] : p[k + 8], keep = b5 ? p[k + 8] : p[k]; q[k] = keep + __shfl_xor(send, 32); }
#pragma unroll
    for (int k = 0; k < 4; ++k) { const float send = b4 ? q[k] : q[k + 4], keep = b4 ? q[k + 4] : q[k]; r[k] = keep + __shfl_xor(send, 16); }
#pragma unroll
    for (int k = 0; k < 2; ++k) { const float send = b3 ? r[k] : r[k + 2], keep = b3 ? r[k + 2] : r[k]; s[k] = keep + __shfl_xor(send, 8); }
    const float send = b2 ? s[0] : s[1], keep = b2 ? s[1] : s[0]; float t = keep + __shfl_xor(send, 4);
    t += __shfl_xor(t, 2); t += __shfl_xor(t, 1);
    return t;
}

__host__ __device__ __forceinline__ int vt_pos(int m) { return (m & ~31) | (((m >> 2) & 3) << 3) | (((m >> 4) & 1) << 2) | (m & 3); }
__device__ __forceinline__ void stage_tile256(const bf16* src, int ldsrc, LAS unsigned char* tb, int tid) {
#pragma unroll 1
    for (int hp = 0; hp < 2; ++hp) { v4u r[8];
#pragma unroll
        for (int i = 0; i < 8; ++i) { const int c = tid + 512 * (8 * hp + i), row = c >> 5, ch = c & 31; r[i] = *(const v4u*)(src + (size_t)row * ldsrc + ch * 8); }
#pragma unroll
        for (int i = 0; i < 8; ++i) { const int c = tid + 512 * (8 * hp + i), row = c >> 5, ch = c & 31; *(LAS v4u*)(tb + row * 512 + ((ch ^ (row & 15)) << 4)) = r[i]; } }
}
__device__ __forceinline__ float attn_softmax(f32x4 (&S)[16], bf16x8 (&Pf)[8]) {
    float mx = -3.0e38f;
#pragma unroll
    for (int mt = 0; mt < 16; ++mt) mx = fmaxf(fmaxf(mx, fmaxf(S[mt][0], S[mt][1])), fmaxf(S[mt][2], S[mt][3]));
    mx = fmaxf(mx, __shfl_xor(mx, 16)); mx = fmaxf(mx, __shfl_xor(mx, 32));
    const float sc2 = 0.0625f * 1.4426950408889634f; float sum = 0.f;
#pragma unroll
    for (int mt = 0; mt < 16; ++mt)
#pragma unroll
        for (int i = 0; i < 4; ++i) { const float p = __builtin_amdgcn_exp2f((S[mt][i] - mx) * sc2); S[mt][i] = p; sum += p; }
    sum += __shfl_xor(sum, 16); sum += __shfl_xor(sum, 32);
#pragma unroll
    for (int ks = 0; ks < 8; ++ks) { v4u w; w.x = pk2(S[2 * ks][0], S[2 * ks][1]); w.y = pk2(S[2 * ks][2], S[2 * ks][3]); w.z = pk2(S[2 * ks + 1][0], S[2 * ks + 1][1]); w.w = pk2(S[2 * ks + 1][2], S[2 * ks + 1][3]); Pf[ks] = mk8(w); }
    return 1.0f / sum;
}
__device__ __forceinline__ void attn_prompt_wg(const bf16* QB, const bf16* KBl, const bf16* VTl, bf16* OB, int b, int h, int r0, LAS unsigned char* tb, int tid) {
    const int lane = tid & 63, w = tid >> 6, tl = lane & 15, q4 = lane >> 4;
    const size_t rowA = (size_t)b * SEQ + r0 + 16 * w + tl, rowB = rowA + 128;
    stage_tile256(KBl + (size_t)b * MEMT * D + h * HD, D, tb, tid);
    __syncthreads();
    f32x4 SA[16], SB[16];
#pragma unroll
    for (int mt = 0; mt < 16; ++mt) { SA[mt] = (f32x4){0.f, 0.f, 0.f, 0.f}; SB[mt] = (f32x4){0.f, 0.f, 0.f, 0.f}; }
    const bf16* qa = QB + rowA * D + h * HD + 8 * q4; const bf16* qb = QB + rowB * D + h * HD + 8 * q4;
    const LAS unsigned char* fb = tb + tl * 512;
#pragma unroll 2
    for (int ks = 0; ks < 8; ++ks) { const bf16x8 fa = *(const bf16x8*)(qa + 32 * ks), fbq = *(const bf16x8*)(qb + 32 * ks); const int co = ((4 * ks + q4) ^ tl) << 4;
#pragma unroll
        for (int mt = 0; mt < 16; ++mt) { const bf16x8 kf = *(const LAS bf16x8*)(fb + mt * 8192 + co); SA[mt] = mfma16(kf, fa, SA[mt]); SB[mt] = mfma16(kf, fbq, SB[mt]); } }
    bf16x8 PA[8], PB[8];
    const float invA = attn_softmax(SA, PA), invB = attn_softmax(SB, PB);
    __syncthreads();
    stage_tile256(VTl + ((size_t)b * NH + h) * HD * MEMT, MEMT, tb, tid);
    __syncthreads();
#pragma unroll 2
    for (int dt = 0; dt < 16; ++dt) { f32x4 oa = {0.f, 0.f, 0.f, 0.f}, ob = {0.f, 0.f, 0.f, 0.f};
#pragma unroll
        for (int ks = 0; ks < 8; ++ks) { const bf16x8 vf = *(const LAS bf16x8*)(fb + dt * 8192 + (((4 * ks + q4) ^ tl) << 4)); oa = mfma16(vf, PA[ks], oa); ob = mfma16(vf, PB[ks], ob); }
        v2u wa, wb; wa.x = pk2(oa[0] * invA, oa[1] * invA); wa.y = pk2(oa[2] * invA, oa[3] * invA); wb.x = pk2(ob[0] * invB, ob[1] * invB); wb.y = pk2(ob[2] * invB, ob[3] * invB);
        *(v2u*)(OB + rowA * D + h * HD + 16 * dt + 4 * q4) = wa; *(v2u*)(OB + rowB * D + h * HD + 16 * dt + 4 * q4) = wb; }
    __syncthreads();
}
__device__ __forceinline__ void attn_sample_task(const bf16* QB, const float* ck, const float* cv, bf16* OB, int l, int b, int h, LAS float* lds, int tid) {
    const int lane = tid & 63, w = tid >> 6;
    LAS float* sc = lds; LAS float* red = lds + 1024;
    const size_t cbase = ((((size_t)l * DB + b) * MEMT) * NH + h) * HD;
    const float* kp = ck + cbase + (size_t)(32 * w) * (NH * HD) + 4 * lane; const float* vp = cv + cbase + (size_t)(32 * w) * (NH * HD) + 4 * lane;
    f32x4 kr[32];
#pragma unroll
    for (int mi = 0; mi < 32; ++mi) kr[mi] = __builtin_nontemporal_load((const f32x4*)(kp + (size_t)mi * (NH * HD)));
    float qf[4][4];
#pragma unroll
    for (int s = 0; s < 4; ++s) { const v2u qw = *(const v2u*)(QB + (size_t)(TP + 4 * b + s) * D + h * HD + 4 * lane); qf[s][0] = bflo(qw.x); qf[s][1] = bfhi(qw.x); qf[s][2] = bflo(qw.y); qf[s][3] = bfhi(qw.y); }
#pragma unroll
    for (int gi = 0; gi < 8; ++gi) { float pd[16];
#pragma unroll
        for (int ri = 0; ri < 4; ++ri) { const f32x4 kv = kr[4 * gi + ri];
#pragma unroll
            for (int s = 0; s < 4; ++s) pd[4 * ri + s] = kv[0] * qf[s][0] + kv[1] * qf[s][1] + kv[2] * qf[s][2] + kv[3] * qf[s][3]; }
        const float tot = xreduce16(pd, lane); const int k = lane >> 2;
        if ((lane & 3) == 0) sc[(k & 3) * 256 + 32 * w + 4 * gi + (k >> 2)] = tot * 0.0625f; }
    f32x4 vr[32];
#pragma unroll
    for (int mi = 0; mi < 32; ++mi) vr[mi] = __builtin_nontemporal_load((const f32x4*)(vp + (size_t)mi * (NH * HD)));
    __syncthreads();
    if (w < 4) { float v[4]; float mx = -3.0e38f;
#pragma unroll
        for (int j = 0; j < 4; ++j) { v[j] = sc[w * 256 + lane + 64 * j]; mx = fmaxf(mx, v[j]); }
        mx = wave_max(mx); float sum = 0.f;
#pragma unroll
        for (int j = 0; j < 4; ++j) { v[j] = __expf(v[j] - mx); sum += v[j]; }
        sum = wave_sum(sum); const float inv = 1.0f / sum;
#pragma unroll
        for (int j = 0; j < 4; ++j) sc[w * 256 + lane + 64 * j] = v[j] * inv; }
    __syncthreads();
    f32x4 o[4];
#pragma unroll
    for (int s = 0; s < 4; ++s) o[s] = (f32x4){0.f, 0.f, 0.f, 0.f};
#pragma unroll
    for (int mi = 0; mi < 32; ++mi) {
#pragma unroll
        for (int s = 0; s < 4; ++s) { const float p = sc[s * 256 + 32 * w + mi]; o[s] += vr[mi] * p; } }
#pragma unroll
    for (int s = 0; s < 4; ++s) *(LAS f32x4*)(red + (w * 4 + s) * 256 + 4 * lane) = o[s];
    __syncthreads();
    { const int idx = tid * 2, s = idx >> 8, d = idx & 255; float a0 = 0.f, a1 = 0.f;
#pragma unroll
        for (int ww = 0; ww < 8; ++ww) { a0 += red[(ww * 4 + s) * 256 + d]; a1 += red[(ww * 4 + s) * 256 + d + 1]; }
        *(unsigned*)(OB + (size_t)(TP + 4 * b + s) * D + h * HD + d) = pk2(a0, a1); }
    __syncthreads();
}

__device__ __forceinline__ unsigned ord_of(float x) { const unsigned u = __builtin_bit_cast(unsigned, x); return u ^ ((u >> 31) ? 0xFFFFFFFFu : 0x80000000u); }
__device__ __forceinline__ float ord_inv(unsigned k) { const unsigned u = (k & 0x80000000u) ? (k ^ 0x80000000u) : ~k; return __builtin_bit_cast(float, u); }
__device__ __forceinline__ unsigned umax2(unsigned a, unsigned b) { return a > b ? a : b; }
__device__ __forceinline__ unsigned umax_x4(unsigned v) { v = umax2(v, (unsigned)__shfl_xor((int)v, 16)); return umax2(v, (unsigned)__shfl_xor((int)v, 32)); }
constexpr int PSEL_KEYS = 65536, PSEL_TI = 2048;
__device__ __forceinline__ void peer_stage_keys(const bf16* KEYl, LAS unsigned char* kl, int tid) {
#pragma unroll
    for (int i = 0; i < 8; ++i) { const int c = tid + 512 * i, hr = c >> 4, ch = c & 15; *(LAS v4u*)(kl + hr * 256 + ((ch ^ (hr & 15)) << 4)) = *(const v4u*)(KEYl + (size_t)hr * 128 + ch * 8); }
}
__device__ __forceinline__ unsigned umin2(unsigned a, unsigned b) { return a < b ? a : b; }
__device__ __forceinline__ void ce_desc(unsigned& a, unsigned& b) { const unsigned hi = umax2(a, b), lo = umin2(a, b); a = hi; b = lo; }
template <int N> __device__ __forceinline__ void bitonic_sort_desc(unsigned (&a)[N]) {
#pragma unroll
    for (int k = 2; k <= N; k <<= 1)
#pragma unroll
        for (int j = k >> 1; j > 0; j >>= 1)
#pragma unroll
            for (int i = 0; i < N; ++i) { const int l = i ^ j; if (l > i) { if ((i & k) == 0) ce_desc(a[i], a[l]); else ce_desc(a[l], a[i]); } }
}
__device__ __forceinline__ void merge_top16(unsigned (&a)[16], int mask) {
    unsigned c[16];
#pragma unroll
    for (int i = 0; i < 16; ++i) c[i] = umax2(a[i], (unsigned)__shfl_xor((int)a[15 - i], mask));
#pragma unroll
    for (int j = 8; j > 0; j >>= 1)
#pragma unroll
        for (int i = 0; i < 16; ++i) { const int l = i ^ j; if (l > i) ce_desc(c[i], c[l]); }
#pragma unroll
    for (int i = 0; i < 16; ++i) a[i] = c[i];
}
__device__ __forceinline__ void peer_select_task(const bf16* QP, const LAS unsigned char* kl, int* EID, float* EG, int row0, int hh, LAS int* TI, int lane) {
    const int tl = lane & 15, q4 = lane >> 4;
    unsigned bk[2][16];
#pragma unroll
    for (int half = 0; half < 2; ++half) {
        f32x4 acc[8];
#pragma unroll
        for (int nt = 0; nt < 8; ++nt) acc[nt] = (f32x4){0.f, 0.f, 0.f, 0.f};
        const bf16* qb = QP + (size_t)(row0 + tl) * 2048 + hh * 256 + half * 128 + 8 * q4;
        const LAS unsigned char* kb = kl + (half * 128 + tl) * 256;
#pragma unroll
        for (int ks = 0; ks < 4; ++ks) { const bf16x8 qf = *(const bf16x8*)(qb + 32 * ks); const int co = ((4 * ks + q4) ^ tl) << 4;
#pragma unroll
            for (int nt = 0; nt < 8; ++nt) { const bf16x8 kf = *(const LAS bf16x8*)(kb + nt * 4096 + co); acc[nt] = mfma16(kf, qf, acc[nt]); } }
        unsigned kx[32];
#pragma unroll
        for (int nt = 0; nt < 8; ++nt)
#pragma unroll
            for (int i = 0; i < 4; ++i) kx[4 * nt + i] = (ord_of(acc[nt][i]) & 0xFFFFFF80u) | (unsigned)(16 * nt + 4 * q4 + i);
        bitonic_sort_desc<32>(kx);
        unsigned top[16];
#pragma unroll
        for (int r = 0; r < 16; ++r) top[r] = kx[r];
        merge_top16(top, 16); merge_top16(top, 32);
#pragma unroll
        for (int r = 0; r < 16; ++r) bk[half][r] = top[r];
    }
    if (q4 == 0) {
#pragma unroll
        for (int r = 0; r < 16; r += 4) { *(LAS v4i*)(TI + tl * 32 + r) = (v4i){(int)(bk[0][r] & 127u), (int)(bk[0][r + 1] & 127u), (int)(bk[0][r + 2] & 127u), (int)(bk[0][r + 3] & 127u)};
            *(LAS v4i*)(TI + tl * 32 + 16 + r) = (v4i){(int)(bk[1][r] & 127u), (int)(bk[1][r + 1] & 127u), (int)(bk[1][r + 2] & 127u), (int)(bk[1][r + 3] & 127u)}; } }
    float v2[16];
#pragma unroll
    for (int j = 0; j < 16; ++j) v2[j] = ord_inv(bk[1][j] & 0xFFFFFF80u);
    unsigned cx[32];
    { int sl = 0;
#pragma unroll
      for (int a = 0; a < 4; ++a) { const unsigned b0 = bk[0][4 * a], b1 = bk[0][4 * a + 1], b2 = bk[0][4 * a + 2], b3 = bk[0][4 * a + 3];
          const float v1s = ord_inv((q4 == 0 ? b0 : q4 == 1 ? b1 : q4 == 2 ? b2 : b3) & 0xFFFFFF80u); const int i = 4 * a + q4;
#pragma unroll
          for (int j = 0; j < 16 / (4 * a + 1); ++j) { const bool ok = (i + 1) * (j + 1) <= 16; cx[sl] = ok ? ((ord_of(v1s + v2[j]) & 0xFFFFFF00u) | (unsigned)(i * 16 + j)) : 0u; ++sl; } }
#pragma unroll
      for (int c = 21; c < 32; ++c) cx[c] = 0u; }
    bitonic_sort_desc<32>(cx);
    unsigned ct[16];
#pragma unroll
    for (int r = 0; r < 16; ++r) ct[r] = cx[r];
    merge_top16(ct, 16); merge_top16(ct, 32);
    LDS_WAIT();
    float sv[16]; float sum = 0.f; const float smax = ord_inv(ct[0] & 0xFFFFFF00u);
#pragma unroll
    for (int r = 0; r < 16; ++r) { sv[r] = __expf(ord_inv(ct[r] & 0xFFFFFF00u) - smax); sum += sv[r]; }
    const float inv = 1.0f / sum;
    unsigned c0, c1, c2, c3; f32x4 go;
    if (q4 == 0) { c0 = ct[0]; c1 = ct[1]; c2 = ct[2]; c3 = ct[3]; go = (f32x4){sv[0], sv[1], sv[2], sv[3]}; }
    else if (q4 == 1) { c0 = ct[4]; c1 = ct[5]; c2 = ct[6]; c3 = ct[7]; go = (f32x4){sv[4], sv[5], sv[6], sv[7]}; }
    else if (q4 == 2) { c0 = ct[8]; c1 = ct[9]; c2 = ct[10]; c3 = ct[11]; go = (f32x4){sv[8], sv[9], sv[10], sv[11]}; }
    else { c0 = ct[12]; c1 = ct[13]; c2 = ct[14]; c3 = ct[15]; go = (f32x4){sv[12], sv[13], sv[14], sv[15]}; }
    const LAS int* ti = TI + tl * 32;
    v4i eo;
    eo[0] = ti[(c0 >> 4) & 15] * 128 + ti[16 + (c0 & 15)]; eo[1] = ti[(c1 >> 4) & 15] * 128 + ti[16 + (c1 & 15)];
    eo[2] = ti[(c2 >> 4) & 15] * 128 + ti[16 + (c2 & 15)]; eo[3] = ti[(c3 >> 4) & 15] * 128 + ti[16 + (c3 & 15)];
    *(v4i*)(EID + (size_t)(row0 + tl) * 128 + hh * 16 + 4 * q4) = eo; *(f32x4*)(EG + (size_t)(row0 + tl) * 128 + hh * 16 + 4 * q4) = go * inv;
    LDS_WAIT();
}

constexpr float U_SCALE = 32.f, V_SCALE = 8.f;
__device__ __forceinline__ void cvt16(const v4u w, float (&f)[16]) {
#pragma unroll
    for (int q = 0; q < 4; ++q) { const f32x2 a = __builtin_amdgcn_cvt_pk_f32_fp8((int)w[q], false), b = __builtin_amdgcn_cvt_pk_f32_fp8((int)w[q], true); f[4 * q] = a.x; f[4 * q + 1] = a.y; f[4 * q + 2] = b.x; f[4 * q + 3] = b.y; }
}
__device__ __forceinline__ float xreduce8(const float (&p)[8], int lane) {
    float q[4], r[2];
    const bool b5 = (lane & 32) != 0, b4 = (lane & 16) != 0, b3 = (lane & 8) != 0;
#pragma unroll
    for (int k = 0; k < 4; ++k) { const float send = b5 ? p[k] : p[k + 4], keep = b5 ? p[k + 4] : p[k]; q[k] = keep + __shfl_xor(send, 32); }
#pragma unroll
    for (int k = 0; k < 2; ++k) { const float send = b4 ? q[k] : q[k + 2], keep = b4 ? q[k + 2] : q[k]; r[k] = keep + __shfl_xor(send, 16); }
    const float send = b3 ? r[0] : r[1], keep = b3 ? r[1] : r[0]; float t = keep + __shfl_xor(send, 8);
    t += __shfl_xor(t, 4); t += __shfl_xor(t, 2); t += __shfl_xor(t, 1);
    return t;
}
template <bool FINAL, int EMASK = 0x3FFF>
__device__ __forceinline__ void peer_gather_wave(int m0, int step, int lane, bf16* HB, const int* EID, const float* EG, const unsigned char* UV, float* XR, const float* gnext, const float* SSQ) {
    int t = m0; if (t >= T) return;
    const unsigned char* uvl = UV + 16 * lane;
    int eid = EID[(size_t)t * 128 + (lane >> 3)]; float gt = EG[(size_t)t * 128 + (lane >> 3)];
    v4u ub[8];
#pragma unroll
    for (int k = 0; k < 8; ++k) { const int e = __builtin_amdgcn_readlane(eid, 8 * k) & EMASK; ub[k] = *(const v4u*)(uvl + (size_t)e * 2048); }
    for (;;) {
        const int tn = t + step; const bool more = tn < T;
        const float rin = row_rinv(SSQ, (size_t)t, 16) * (1.0f / U_SCALE);
        float hf[16], acc[16];
        { const v4u hr0 = *(const v4u*)(HB + (size_t)t * D + 16 * lane), hr1 = *(const v4u*)(HB + (size_t)t * D + 16 * lane + 8);
          hf[0] = bflo(hr0.x); hf[1] = bfhi(hr0.x); hf[2] = bflo(hr0.y); hf[3] = bfhi(hr0.y); hf[4] = bflo(hr0.z); hf[5] = bfhi(hr0.z); hf[6] = bflo(hr0.w); hf[7] = bfhi(hr0.w);
          hf[8] = bflo(hr1.x); hf[9] = bfhi(hr1.x); hf[10] = bflo(hr1.y); hf[11] = bfhi(hr1.y); hf[12] = bflo(hr1.z); hf[13] = bfhi(hr1.z); hf[14] = bflo(hr1.w); hf[15] = bfhi(hr1.w); }
#pragma unroll
        for (int i = 0; i < 16; ++i) acc[i] = 0.f;
#pragma unroll 1
        for (int st = 0; st < 16; ++st) {
            v4u vb[8];
#pragma unroll
            for (int k = 0; k < 8; ++k) { const int e = __builtin_amdgcn_readlane(eid, 8 * k) & EMASK; vb[k] = *(const v4u*)(uvl + (size_t)e * 2048 + 1024); }
            const bool nx = (st < 15) || more; const size_t ni = (st < 15) ? ((size_t)t * 128 + (st + 1) * 8) : ((size_t)tn * 128);
            int eid_n = 0; float gt_n = 0.f;
            if (nx) { eid_n = EID[ni + (lane >> 3)]; gt_n = EG[ni + (lane >> 3)]; }
            float pd[8];
#pragma unroll
            for (int k = 0; k < 8; ++k) { float f[16]; cvt16(ub[k], f); float d = f[0] * hf[0];
#pragma unroll
                for (int i = 1; i < 16; ++i) d = fmaf(f[i], hf[i], d);
                pd[k] = d; }
            const float tot = xreduce8(pd, lane);
            const float wv = gt * gelu1(tot * rin) * (1.0f / V_SCALE);
            if (nx) {
#pragma unroll
                for (int k = 0; k < 8; ++k) { const int e = __builtin_amdgcn_readlane(eid_n, 8 * k) & EMASK; ub[k] = *(const v4u*)(uvl + (size_t)e * 2048); } }
#pragma unroll
            for (int k = 0; k < 8; ++k) { const float wk = __builtin_bit_cast(float, __builtin_amdgcn_readlane(__builtin_bit_cast(int, wv), 8 * k)); float f[16]; cvt16(vb[k], f);
#pragma unroll
                for (int i = 0; i < 16; ++i) acc[i] = fmaf(wk, f[i], acc[i]); }
            eid = eid_n; gt = gt_n;
        }
        float* xr = XR + (size_t)t * D + 16 * lane;
        f32x4 x[4];
#pragma unroll
        for (int j = 0; j < 4; ++j) x[j] = *(const f32x4*)(xr + 4 * j);
        float ss = 0.f;
#pragma unroll
        for (int j = 0; j < 4; ++j)
#pragma unroll
            for (int i = 0; i < 4; ++i) { x[j][i] += acc[4 * j + i]; ss = fmaf(x[j][i], x[j][i], ss); }
        const float r = 1.0f / sqrtf(wave_sum(ss) * (1.0f / D) + RMS_EPS);
        f32x4 gv[4];
#pragma unroll
        for (int j = 0; j < 4; ++j) gv[j] = *(const f32x4*)(gnext + 16 * lane + 4 * j);
        if (FINAL) {
#pragma unroll
            for (int j = 0; j < 4; ++j) *(f32x4*)(xr + 4 * j) = x[j] * r * gv[j];
        } else {
#pragma unroll
            for (int j = 0; j < 4; ++j) *(f32x4*)(xr + 4 * j) = x[j];
            const f32x4 a = x[0] * r * gv[0], bq = x[1] * r * gv[1], c = x[2] * r * gv[2], dq = x[3] * r * gv[3];
            v4u w0, w1;
            w0.x = pk2(a[0], a[1]); w0.y = pk2(a[2], a[3]); w0.z = pk2(bq[0], bq[1]); w0.w = pk2(bq[2], bq[3]);
            w1.x = pk2(c[0], c[1]); w1.y = pk2(c[2], c[3]); w1.z = pk2(dq[0], dq[1]); w1.w = pk2(dq[2], dq[3]);
            *(v4u*)(HB + (size_t)t * D + 16 * lane) = w0; *(v4u*)(HB + (size_t)t * D + 16 * lane + 8) = w1;
        }
        if (!more) break;
        t = tn;
    }
}

constexpr float U6_SCALE = 64.f, V6_SCALE = 16.f;
typedef float v32f __attribute__((ext_vector_type(32)));
typedef float v16f __attribute__((ext_vector_type(16)));
typedef unsigned v6u __attribute__((ext_vector_type(6)));
typedef unsigned v3u __attribute__((ext_vector_type(3)));
__device__ __forceinline__ v6u load6(const unsigned char* p) { const v3u a = *(const v3u*)p, b = *(const v3u*)(p + 12); v6u r; r[0] = a[0]; r[1] = a[1]; r[2] = a[2]; r[3] = b[0]; r[4] = b[1]; r[5] = b[2]; return r; }
__device__ __forceinline__ int mbcnt64(unsigned long long m) { return (int)__builtin_amdgcn_mbcnt_hi((unsigned)(m >> 32), __builtin_amdgcn_mbcnt_lo((unsigned)m, 0u)); }
template <bool FINAL>
__device__ __forceinline__ void peer_gather_wave6(int m0, int step, int tlim, int lane, bf16* HB, const int* EID, const float* EG, const unsigned char* UV, float* XR, const float* gnext, const float* SSQ, LAS unsigned char* lw) {
    int t = m0; if (t >= tlim) return;
    int buf = 0;
#define PG6_SORT(TOK, BUF, FLIP) do { const size_t tb_ = (size_t)(TOK) * 128; const int e0_ = EID[tb_ + lane], e1_ = EID[tb_ + 64 + lane]; const float g0_ = EG[tb_ + lane], g1_ = EG[tb_ + 64 + lane]; \
        const int b0_ = (e0_ >> 10) ^ (FLIP), b1_ = (e1_ >> 10) ^ (FLIP); int off_ = 0, p0_ = 0, p1_ = 0; \
        _Pragma("unroll") for (int k_ = 0; k_ < 16; ++k_) { const unsigned long long m0_ = __ballot(b0_ == k_), m1_ = __ballot(b1_ == k_); const int c0_ = __popcll(m0_), c1_ = __popcll(m1_); \
            p0_ = (b0_ == k_) ? off_ + mbcnt64(m0_) : p0_; p1_ = (b1_ == k_) ? off_ + c0_ + mbcnt64(m1_) : p1_; off_ += c0_ + c1_; } \
        LAS int* se_ = (LAS int*)(lw + (BUF) * 1024); LAS float* sg_ = (LAS float*)(lw + (BUF) * 1024 + 512); se_[p0_] = e0_; sg_[p0_] = g0_; se_[p1_] = e1_; sg_[p1_] = g1_; } while (0)
#define PG6_IDS(BUF, ST, E_, G_) do { E_ = ((const LAS int*)(lw + (BUF) * 1024))[(ST) * 8 + xl]; G_ = ((const LAS float*)(lw + (BUF) * 1024 + 512))[(ST) * 8 + xl]; } while (0)
    const int hw = lane >> 5, li = lane & 31; const bool b4 = (lane & 16) != 0, b3 = (lane & 8) != 0;
    const int xl = 4 * ((lane >> 4) & 1) + 2 * ((lane >> 3) & 1) + hw;
    const unsigned char* uvl = UV + 24 * li;
    int flip = 0;
    PG6_SORT(t, 0, 0); LDS_WAIT();
    int eid; float gt; PG6_IDS(0, 0, eid, gt);
    v6u ub[4];
#pragma unroll
    for (int k = 0; k < 4; ++k) { const int ea = __builtin_amdgcn_readlane(eid, 8 * k), eb = __builtin_amdgcn_readlane(eid, 32 + 8 * k); ub[k] = load6(uvl + (size_t)(hw ? eb : ea) * 1536); }
    for (;;) {
        const int tn = t + step; const bool more = tn < tlim;
        const float rin = row_rinv(SSQ, (size_t)t, 16) * (1.0f / U6_SCALE);
        float hf[32], acc[32];
        { const v4u* hp = (const v4u*)(HB + (size_t)t * D + 32 * li);
#pragma unroll
          for (int q = 0; q < 4; ++q) { const v4u h = hp[q]; hf[8 * q] = bflo(h.x); hf[8 * q + 1] = bfhi(h.x); hf[8 * q + 2] = bflo(h.y); hf[8 * q + 3] = bfhi(h.y); hf[8 * q + 4] = bflo(h.z); hf[8 * q + 5] = bfhi(h.z); hf[8 * q + 6] = bflo(h.w); hf[8 * q + 7] = bfhi(h.w); } }
#pragma unroll
        for (int i = 0; i < 32; ++i) acc[i] = 0.f;
#pragma unroll 1
        for (int st = 0; st < 16; ++st) {
            v6u vb[4];
#pragma unroll
            for (int k = 0; k < 4; ++k) { const int ea = __builtin_amdgcn_readlane(eid, 8 * k), eb = __builtin_amdgcn_readlane(eid, 32 + 8 * k); vb[k] = load6(uvl + (size_t)(hw ? eb : ea) * 1536 + 768); }
            const bool nx = (st < 15) || more;
            if (st == 10 && more) PG6_SORT(tn, buf ^ 1, flip ^ 15);
            int eid_n = 0; float gt_n = 0.f;
            if (st < 15) PG6_IDS(buf, st + 1, eid_n, gt_n); else if (more) PG6_IDS(buf ^ 1, 0, eid_n, gt_n);
            float pd[4];
#pragma unroll
            for (int k = 0; k < 4; ++k) { const v32f f = __builtin_amdgcn_cvt_scalef32_pk32_f32_fp6(ub[k], 1.0f); float d = f[0] * hf[0];
#pragma unroll
                for (int i = 1; i < 32; ++i) d = fmaf(f[i], hf[i], d);
                pd[k] = d; }
            float q0, q1;
            { const float s0 = b4 ? pd[0] : pd[2], k0 = b4 ? pd[2] : pd[0]; q0 = k0 + __shfl_xor(s0, 16); const float s1 = b4 ? pd[1] : pd[3], k1 = b4 ? pd[3] : pd[1]; q1 = k1 + __shfl_xor(s1, 16); }
            float tot; { const float sd = b3 ? q0 : q1, kp = b3 ? q1 : q0; tot = kp + __shfl_xor(sd, 8); }
            tot += __shfl_xor(tot, 4); tot += __shfl_xor(tot, 2); tot += __shfl_xor(tot, 1);
            const float wv = gt * gelu1(tot * rin) * (1.0f / V6_SCALE);
            if (nx) {
#pragma unroll
                for (int k = 0; k < 4; ++k) { const int ea = __builtin_amdgcn_readlane(eid_n, 8 * k), eb = __builtin_amdgcn_readlane(eid_n, 32 + 8 * k); ub[k] = load6(uvl + (size_t)(hw ? eb : ea) * 1536); } }
#pragma unroll
            for (int k = 0; k < 4; ++k) { const float wa = __builtin_bit_cast(float, __builtin_amdgcn_readlane(__builtin_bit_cast(int, wv), 8 * k)), wb = __builtin_bit_cast(float, __builtin_amdgcn_readlane(__builtin_bit_cast(int, wv), 32 + 8 * k));
                const float wk = hw ? wb : wa; const v32f f = __builtin_amdgcn_cvt_scalef32_pk32_f32_fp6(vb[k], 1.0f);
#pragma unroll
                for (int i = 0; i < 32; ++i) acc[i] = fmaf(wk, f[i], acc[i]); }
            eid = eid_n; gt = gt_n;
        }
        float av[16];
#pragma unroll
        for (int i = 0; i < 16; ++i) { const float lo = acc[i] + __shfl_xor(acc[i], 32), hi = acc[16 + i] + __shfl_xor(acc[16 + i], 32); av[i] = hw ? hi : lo; }
        float* xr = XR + (size_t)t * D + 32 * li + 16 * hw;
        f32x4 x[4];
#pragma unroll
        for (int j = 0; j < 4; ++j) x[j] = *(const f32x4*)(xr + 4 * j);
        float ss = 0.f;
#pragma unroll
        for (int j = 0; j < 4; ++j)
#pragma unroll
            for (int i = 0; i < 4; ++i) { x[j][i] += av[4 * j + i]; ss = fmaf(x[j][i], x[j][i], ss); }
        const float r = 1.0f / sqrtf(wave_sum(ss) * (1.0f / D) + RMS_EPS);
        f32x4 gv[4];
#pragma unroll
        for (int j = 0; j < 4; ++j) gv[j] = *(const f32x4*)(gnext + 32 * li + 16 * hw + 4 * j);
        if (FINAL) {
#pragma unroll
            for (int j = 0; j < 4; ++j) *(f32x4*)(xr + 4 * j) = x[j] * r * gv[j];
        } else {
#pragma unroll
            for (int j = 0; j < 4; ++j) *(f32x4*)(xr + 4 * j) = x[j];
            const f32x4 a = x[0] * r * gv[0], bq = x[1] * r * gv[1], c = x[2] * r * gv[2], dq = x[3] * r * gv[3];
            v4u w0, w1;
            w0.x = pk2(a[0], a[1]); w0.y = pk2(a[2], a[3]); w0.z = pk2(bq[0], bq[1]); w0.w = pk2(bq[2], bq[3]);
            w1.x = pk2(c[0], c[1]); w1.y = pk2(c[2], c[3]); w1.z = pk2(dq[0], dq[1]); w1.w = pk2(dq[2], dq[3]);
            *(v4u*)(HB + (size_t)t * D + 32 * li + 16 * hw) = w0; *(v4u*)(HB + (size_t)t * D + 32 * li + 16 * hw + 8) = w1;
        }
        if (!more) break;
        t = tn; buf ^= 1; flip ^= 15;
    }
#undef PG6_SORT
#undef PG6_IDS
}

template <bool FINAL>
__device__ __forceinline__ void peer_gather_wg2(int t0, int tid, bf16* HB, const int* EID, const float* EG, const unsigned char* UV, float* XR, const float* gnext, const float* SSQ, LAS float* PL) {
    const int lane = tid & 63, w = tid >> 6;
    const int hw = lane >> 5, li = lane & 31; const bool b4 = (lane & 16) != 0, b3 = (lane & 8) != 0;
    const int xl = 4 * ((lane >> 4) & 1) + 2 * ((lane >> 3) & 1) + hw;
    const unsigned char* uvl = UV + 24 * li;
#pragma unroll 1
    for (int k = 0; k < 2; ++k) { const int t = t0 + k;
        const float rin = row_rinv(SSQ, (size_t)t, 16) * (1.0f / U6_SCALE);
        float hf[32], acc[32];
        { const v4u* hp = (const v4u*)(HB + (size_t)t * D + 32 * li);
#pragma unroll
          for (int q = 0; q < 4; ++q) { const v4u h = hp[q]; hf[8 * q] = bflo(h.x); hf[8 * q + 1] = bfhi(h.x); hf[8 * q + 2] = bflo(h.y); hf[8 * q + 3] = bfhi(h.y); hf[8 * q + 4] = bflo(h.z); hf[8 * q + 5] = bfhi(h.z); hf[8 * q + 6] = bflo(h.w); hf[8 * q + 7] = bfhi(h.w); } }
#pragma unroll
        for (int i = 0; i < 32; ++i) acc[i] = 0.f;
#pragma unroll 1
        for (int st = 0; st < 2; ++st) {
            const size_t ib = (size_t)t * 128 + w * 16 + st * 8;
            const int eid = EID[ib + xl]; const float gt = EG[ib + xl];
            v6u ub[4], vb[4];
#pragma unroll
            for (int kk = 0; kk < 4; ++kk) { const int ea = __builtin_amdgcn_readlane(eid, 8 * kk), eb = __builtin_amdgcn_readlane(eid, 32 + 8 * kk); const unsigned char* p = uvl + (size_t)(hw ? eb : ea) * 1536; ub[kk] = load6(p); vb[kk] = load6(p + 768); }
            float pd[4];
#pragma unroll
            for (int kk = 0; kk < 4; ++kk) { const v32f f = __builtin_amdgcn_cvt_scalef32_pk32_f32_fp6(ub[kk], 1.0f); float d = f[0] * hf[0];
#pragma unroll
                for (int i = 1; i < 32; ++i) d = fmaf(f[i], hf[i], d);
                pd[kk] = d; }
            float q0, q1;
            { const float s0 = b4 ? pd[0] : pd[2], k0 = b4 ? pd[2] : pd[0]; q0 = k0 + __shfl_xor(s0, 16); const float s1 = b4 ? pd[1] : pd[3], k1 = b4 ? pd[3] : pd[1]; q1 = k1 + __shfl_xor(s1, 16); }
            float tot; { const float sd = b3 ? q0 : q1, kp = b3 ? q1 : q0; tot = kp + __shfl_xor(sd, 8); }
            tot += __shfl_xor(tot, 4); tot += __shfl_xor(tot, 2); tot += __shfl_xor(tot, 1);
            const float wv = gt * gelu1(tot * rin) * (1.0f / V6_SCALE);
#pragma unroll
            for (int kk = 0; kk < 4; ++kk) { const float wa = __builtin_bit_cast(float, __builtin_amdgcn_readlane(__builtin_bit_cast(int, wv), 8 * kk)), wb = __builtin_bit_cast(float, __builtin_amdgcn_readlane(__builtin_bit_cast(int, wv), 32 + 8 * kk));
                const float wk = hw ? wb : wa; const v32f f = __builtin_amdgcn_cvt_scalef32_pk32_f32_fp6(vb[kk], 1.0f);
#pragma unroll
                for (int i = 0; i < 32; ++i) acc[i] = fmaf(wk, f[i], acc[i]); }
        }
        LAS float* pl = PL + ((k * 8 + w) * D + 32 * li + 16 * hw);
#pragma unroll
        for (int j = 0; j < 4; ++j) { f32x4 o;
#pragma unroll
            for (int i = 0; i < 4; ++i) { const int c = 4 * j + i; const float lo = acc[c] + __shfl_xor(acc[c], 32), hi = acc[16 + c] + __shfl_xor(acc[16 + c], 32); o[i] = hw ? hi : lo; }
            *(LAS f32x4*)(pl + 4 * j) = o; }
    }
    __syncthreads();
    LAS float* ssw = PL + 2 * 8 * D;
    float xs[2][2];
#pragma unroll
    for (int k = 0; k < 2; ++k) { const int c0 = 128 * w + 2 * lane; const f32x2 xv = *(const f32x2*)(XR + (size_t)(t0 + k) * D + c0); float a0 = xv.x, a1 = xv.y;
#pragma unroll
        for (int ww = 0; ww < 8; ++ww) { const f32x2 pv = *(const LAS f32x2*)(PL + (k * 8 + ww) * D + c0); a0 += pv.x; a1 += pv.y; }
        xs[k][0] = a0; xs[k][1] = a1; const float ss = wave_sum(a0 * a0 + a1 * a1); if (lane == 0) ssw[k * 8 + w] = ss; }
    __syncthreads();
#pragma unroll
    for (int k = 0; k < 2; ++k) { const int c0 = 128 * w + 2 * lane; float tot = 0.f;
#pragma unroll
        for (int ww = 0; ww < 8; ++ww) tot += ssw[k * 8 + ww];
        const float r = 1.0f / sqrtf(tot * (1.0f / D) + RMS_EPS); const f32x2 gv = *(const f32x2*)(gnext + c0);
        float* xr = XR + (size_t)(t0 + k) * D + c0;
        if (FINAL) { *(f32x2*)xr = (f32x2){xs[k][0] * r * gv.x, xs[k][1] * r * gv.y}; }
        else { *(f32x2*)xr = (f32x2){xs[k][0], xs[k][1]}; *(unsigned*)(HB + (size_t)(t0 + k) * D + c0) = pk2(xs[k][0] * r * gv.x, xs[k][1] * r * gv.y); } }
    __syncthreads();
}

enum { SK_GLU = 0, SK_RES = 1, SK_B16 = 2, SK_WINV = 3, SK_WINB = 4 };
struct SkArgs { const bf16* A; const bf16* W; float* xr; bf16* hbo; float* ssq; const float* gnext; const float* xs; bf16* O; int ldc; int nslots; bf16* v1; bf16* b1; float* out; };
constexpr int SK_LDS_FLOATS = 8 * 32 * 68;
template <int MODE>
__device__ __forceinline__ void skinny_tile(const SkArgs& a, int rb, int cb, LAS float* P, int tid) {
    constexpr bool PAIRED = (MODE == SK_GLU || MODE == SK_WINV);
    const int lane = tid & 63, w = tid >> 6, tl = lane & 15, q4 = lane >> 4;
    const int g0 = PAIRED ? ((cb >> 2) * 256 + (cb & 3) * 32) : 64 * cb;
    f32x4 acc[2][4];
#pragma unroll
    for (int mt = 0; mt < 2; ++mt)
#pragma unroll
        for (int nt = 0; nt < 4; ++nt) acc[mt][nt] = (f32x4){0.f, 0.f, 0.f, 0.f};
    const bf16* ap = a.A + (size_t)(TP + 32 * rb + tl) * D + 128 * w + 8 * q4;
    const bf16* wp = a.W + (size_t)(g0 + tl) * D + 128 * w + 8 * q4;
    bf16x8 af[4][2], bfr[4][4];
#pragma unroll
    for (int ks = 0; ks < 4; ++ks) {
#pragma unroll
        for (int mt = 0; mt < 2; ++mt) af[ks][mt] = *(const bf16x8*)(ap + (size_t)(16 * mt) * D + 32 * ks);
#pragma unroll
        for (int nt = 0; nt < 4; ++nt) { const int wro = PAIRED ? ((nt >> 1) * 128 + (nt & 1) * 16) : 16 * nt; bfr[ks][nt] = *(const bf16x8*)(wp + (size_t)wro * D + 32 * ks); } }
    const int row = tid >> 4, c4 = (tid & 15) * 4; const size_t grow = (size_t)TP + 32 * rb + row;
    const int pcol = (cb >> 2) * 128 + (cb & 3) * 32 + (c4 & 31), col = 64 * cb + c4;
    f32x4 e0 = {0.f, 0.f, 0.f, 0.f}, e1 = {0.f, 0.f, 0.f, 0.f}; float ri = 0.f;
    if (MODE == SK_GLU) { e0 = *(const f32x4*)(a.xs + (size_t)(32 * rb + row) * D + pcol); e1 = *(const f32x4*)(a.gnext + pcol); }
    if (MODE == SK_RES) { e0 = *(const f32x4*)(a.xr + grow * D + col); e1 = *(const f32x4*)(a.gnext + col); }
    if (MODE == SK_B16) ri = row_rinv(a.ssq, grow, a.nslots);
#pragma unroll
    for (int ks = 0; ks < 4; ++ks)
#pragma unroll
        for (int nt = 0; nt < 4; ++nt)
#pragma unroll
            for (int mt = 0; mt < 2; ++mt) acc[mt][nt] = mfma16(bfr[ks][nt], af[ks][mt], acc[mt][nt]);
#pragma unroll
    for (int mt = 0; mt < 2; ++mt)
#pragma unroll
        for (int nt = 0; nt < 4; ++nt) *(LAS f32x4*)(P + (w * 32 + 16 * mt + tl) * 68 + 16 * nt + 4 * q4) = acc[mt][nt];
    __syncthreads();
    f32x4 v = {0.f, 0.f, 0.f, 0.f}, vb = {0.f, 0.f, 0.f, 0.f};
#pragma unroll
    for (int ww = 0; ww < 8; ++ww) v += *(const LAS f32x4*)(P + (ww * 32 + row) * 68 + c4);
    if (PAIRED && c4 < 32) {
#pragma unroll
        for (int ww = 0; ww < 8; ++ww) vb += *(const LAS f32x4*)(P + (ww * 32 + row) * 68 + c4 + 32); }
    if (MODE == SK_GLU) {
        float ss = 0.f;
        if (c4 < 32) { f32x4 o;
#pragma unroll
            for (int j = 0; j < 4; ++j) { o[j] = e0[j] + v[j] / (1.0f + __expf(-vb[j])); ss = fmaf(o[j], o[j], ss); }
            *(f32x4*)(a.xr + grow * D + pcol) = o; const f32x4 hg = o * e1; v2u wv; wv.x = pk2(hg[0], hg[1]); wv.y = pk2(hg[2], hg[3]); *(v2u*)(a.hbo + grow * D + pcol) = wv; }
        ss += __shfl_xor(ss, 1); ss += __shfl_xor(ss, 2); ss += __shfl_xor(ss, 4);
        if ((tid & 15) == 0) a.ssq[grow * 32 + cb] = ss;
    } else if (MODE == SK_RES) {
        const f32x4 o = e0 + v; *(f32x4*)(a.xr + grow * D + col) = o;
        float ss = o[0] * o[0] + o[1] * o[1] + o[2] * o[2] + o[3] * o[3];
        const f32x4 hg = o * e1; v2u wv; wv.x = pk2(hg[0], hg[1]); wv.y = pk2(hg[2], hg[3]); *(v2u*)(a.hbo + grow * D + col) = wv;
        ss += __shfl_xor(ss, 1); ss += __shfl_xor(ss, 2); ss += __shfl_xor(ss, 4); ss += __shfl_xor(ss, 8);
        if ((tid & 15) == 0) a.ssq[grow * 32 + cb] = ss;
    } else if (MODE == SK_B16) {
        const f32x4 o = v * ri; v2u wv; wv.x = pk2(o[0], o[1]); wv.y = pk2(o[2], o[3]);
        *(v2u*)(a.O + grow * a.ldc + col) = wv;
    } else if (MODE == SK_WINV) {
        if (c4 < 32) { const f32x4 vv = v * vb; v2u wv; wv.x = pk2(vv[0], vv[1]); wv.y = pk2(vv[2], vv[3]); *(v2u*)(a.v1 + grow * D + pcol) = wv;
            const int rs = 32 * rb + row, s = rs & 3; if (s >= 2) *(f32x4*)(a.out + O_CS + ((size_t)(rs >> 2) * 2 + (s - 2)) * D + pcol) = vv; }
    } else {
        v2u wv; wv.x = pk2(v[0], v[1]); wv.y = pk2(v[2], v[3]); *(v2u*)(a.b1 + grow * D + col) = wv;
    }
    __syncthreads();
}
#ifndef REP_P0
#define REP_P0 1
#endif
#ifndef REP_P1
#define REP_P1 1
#endif
#ifndef REP_GEMM
#define REP_GEMM 1
#endif
#ifndef REP_ATTN
#define REP_ATTN 1
#endif
#ifndef REP_PSEL
#define REP_PSEL 1
#endif
#ifndef REP_THIN
#define REP_THIN 1
#endif
#ifndef REP_SK
#define REP_SK 1
#endif
#ifndef REP_KV
#define REP_KV 1
#endif
#ifndef REP_S5P
#define REP_S5P 1
#endif
#ifndef REP_S5S
#define REP_S5S 1
#endif
struct Args { const float* in[N_IN]; float* out; unsigned char* ws; int ph_lo, ph_hi; };
__device__ __forceinline__ int opaque_idx(int k) { int r; asm volatile("s_mov_b32 %0, %1" : "=s"(r) : "s"(k)); return r; }
#define INP(k) ((const float*)(const GAS float*)(args.in[opaque_idx(k)]))
__device__ __forceinline__ unsigned char* opq_p(unsigned char* p) { GAS unsigned char* g = (GAS unsigned char*)p; asm volatile("" : "+s"(g)); return (unsigned char*)g; }
__device__ __forceinline__ float* opq_f(float* p) { GAS float* g = (GAS float*)p; asm volatile("" : "+s"(g)); return (float*)g; }
__device__ __forceinline__ int opq_i(int v) { asm volatile("" : "+s"(v)); return v; }
__device__ __forceinline__ int opq_v(int v) { asm volatile("" : "+v"(v)); return v; }
#define PH_LOCALS unsigned char* ws = opq_p(args.ws); float* out = opq_f(args.out); (void)ws; (void)out; \
    const int tid = opq_v(tid0), lane = tid & 63, wave = __builtin_amdgcn_readfirstlane(tid >> 6), G = opq_i((int)gridDim.x), bx = opq_i((int)blockIdx.x), gw = bx * NWAVES + wave, NGW = G * NWAVES; (void)lane; (void)gw; (void)NGW;
#define WALL ((bf16*)(ws + WS_WALL))
#define KEYS ((bf16*)(ws + WS_KEYS))
#define BBW ((bf16*)(ws + WS_BBW))
#define CCW ((bf16*)(ws + WS_CCW))
#define LBc ((float*)(ws + WS_LB))
#define MEMB ((bf16*)(ws + WS_MEMB))
#define KB ((bf16*)(ws + WS_KB))
#define VT ((bf16*)(ws + WS_VT))
#define EID ((int*)(ws + WS_EID))
#define EG ((float*)(ws + WS_EG))
#define HB ((bf16*)(ws + WS_HB))
#define ZB ((bf16*)(ws + WS_ZB))
#define QB ((bf16*)(ws + WS_QB))
#define QP ((bf16*)(ws + WS_QP))
#define B1 ((bf16*)(ws + WS_B1))
#define V1 ((bf16*)(ws + WS_V1))
#define UVT ((unsigned char*)(ws + WS_UV))
#define XR (out + O_Y)
#define SSQB ((float*)(ws + WS_SSQ))

constexpr int N_PHASES = 18;

#define TABLE_CONVERT(LAYER, W0, NW) do { const float* sU = INP(I_PU) + (size_t)(LAYER) * NEXP * D; const float* sV = INP(I_PV) + (size_t)(LAYER) * NEXP * D; unsigned char* dst = UVT + (size_t)(LAYER) * NEXP * 1536; \
            const size_t ng = (size_t)NEXP * 32, st_ = (size_t)(NW) * 64; \
            for (size_t i0 = (size_t)(W0) * 64 + lane; i0 < 2 * ng; i0 += 4 * st_) { f32x4 xa[4][8]; bool ok[4]; \
                _Pragma("unroll") for (int h = 0; h < 4; ++h) { const size_t i = i0 + h * st_; ok[h] = i < 2 * ng; if (ok[h]) { const bool isv = i >= ng; const size_t j = isv ? i - ng : i; const f32x4* s = (const f32x4*)((isv ? sV : sU) + (j >> 5) * D + 32 * (int)(j & 31)); \
                    _Pragma("unroll") for (int q = 0; q < 8; ++q) xa[h][q] = s[q]; } } \
                _Pragma("unroll") for (int h = 0; h < 4; ++h) if (ok[h]) { const size_t i = i0 + h * st_; const bool isv = i >= ng; const size_t j = isv ? i - ng : i; const size_t row = j >> 5; const int c = (int)(j & 31); const float sc = isv ? V6_SCALE : U6_SCALE; v16f a, b; \
                    _Pragma("unroll") for (int q = 0; q < 8; ++q) { const f32x4 x0 = xa[h][q] * sc; a[2 * q] = x0[0]; b[2 * q] = x0[1]; a[2 * q + 1] = x0[2]; b[2 * q + 1] = x0[3]; } \
                    const v6u w = __builtin_amdgcn_cvt_scalef32_2xpk16_fp6_f32(a, b, 1.0f); \
                    unsigned char* dp = dst + (row * 2 + (isv ? 1 : 0)) * 768 + 24 * c; \
                    *(v2u*)dp = (v2u){w[0], w[1]}; *(v2u*)(dp + 8) = (v2u){w[2], w[3]}; *(v2u*)(dp + 16) = (v2u){w[4], w[5]}; } } } while (0)
__global__ void __launch_bounds__(NWAVES * 64, 2) mk_fwd(Args args) {
    extern __shared__ __attribute__((aligned(16))) unsigned char lds[];
    LAS unsigned char* L = (LAS unsigned char*)lds;
    volatile LAS unsigned* MISC = (volatile LAS unsigned*)(L + MISC_OFF);
    const int tid0 = threadIdx.x;
    gu32* ctl = (gu32*)(args.ws + WS_CTL);

    for (int u = tid0; u < (LDS_BYTES - LDSCTL_OFF) / 4; u += NWAVES * 64) ((LAS unsigned*)(L + LDSCTL_OFF))[u] = 0u;
    __syncthreads();
    XcdBarrier bar = xcd_barrier_post((unsigned*)(ctl + CW_BAR), MISC + 8);
    const int lo = args.ph_lo, hi = args.ph_hi;
#define IN(k) (opq_i(lo) <= (k) && (k) < opq_i(hi))
#ifdef PROBE_SUB
    unsigned long long ps_prev = 0ull, ps_dt = 0ull;
#define PS_STAMP(k) do { const unsigned long long now_ = __builtin_amdgcn_s_memrealtime(); if ((k) == (PROBE_SUB)) ps_dt = now_ - ps_prev; ps_prev = now_; } while (0)
#else
#define PS_STAMP(k) do { } while (0)
#endif
#ifdef PROBE_PHASE
    unsigned long long pp_prev = __builtin_amdgcn_s_memrealtime(), pp_dt = 0ull;
#define PP_STAMP(k) do { const unsigned long long now_ = __builtin_amdgcn_s_memrealtime(); if ((k) == (PROBE_PHASE)) pp_dt = now_ - pp_prev; pp_prev = now_; } while (0)
#else
#define PP_STAMP(k) do { } while (0)
#endif
#define SEAM(k) do { if (IN(k) && IN((k) + 1)) xcd_barrier(bar); PP_STAMP(k); } while (0)
#define GEMM_PHASE(EpiT, Aptr, Brow, Mrows, Ncols, Eobj) do { pg8::Gemm g_{(const pg8::bf16_t*)(Aptr), (const pg8::bf16_t*)(WALL + (size_t)(Brow) * D), (Mrows), (Ncols), D}; \
        pg8::StaticOrder S_; S_.init((Mrows), (Ncols), G, bx); pg8::gemm_phase<EpiT, pg8::StaticOrder, true, true>(L + RING_OFF, g_, S_, Eobj); } while (0)

    if (IN(0)) { PH_LOCALS
      for (int rep_ = 0; rep_ < REP_P0; ++rep_) {
        PS_STAMP(-1);
        LAS float* scr = (LAS float*)(L + RING_OFF + wave * 16896);
#define TR_DECODE(IT, SRC, NN, SN0) do { int r = ((IT) >> 4) * 32; \
            if (r < R_GLU) { const int mat = r >> 10, l = mat >> 1; SRC = ((mat & 1) ? INP(I_WV) : INP(I_WK)) + (size_t)l * D * D; NN = D; SN0 = r & 1023; } \
            else if (r < R_Q) { r -= R_GLU; SRC = INP(I_WGLU); NN = 2 * D; SN0 = ((r >> 7) & 1) * 1024 + (r >> 8) * 128 + (r & 127); } \
            else if (r < R_O) { r -= R_Q; SRC = INP(I_WQ) + (size_t)(r >> 10) * D * D; NN = D; SN0 = r & 1023; } \
            else if (r < R_PQ) { r -= R_O; SRC = INP(I_WO) + (size_t)(r >> 10) * D * D; NN = D; SN0 = r & 1023; } \
            else if (r < R_WIN) { r -= R_PQ; SRC = INP(I_PWQ) + (size_t)(r >> 11) * D * 2048; NN = 2048; SN0 = r & 2047; } \
            else if (r < R_WOUT) { r -= R_WIN; SRC = INP(I_WIN); NN = 3 * D; SN0 = (r < 2048) ? (1024 + ((r >> 7) & 1) * 1024 + (r >> 8) * 128 + (r & 127)) : (r - 2048); } \
            else { r -= R_WOUT; SRC = INP(I_WOUT); NN = D; SN0 = r; } } while (0)
        for (int it = gw; it < (R_END / 32) * 16; it += 2 * NGW) { const int it2 = it + NGW; const bool two = it2 < (R_END / 32) * 16;
            const float* s0; int n0, c0; TR_DECODE(it, s0, n0, c0); const float* s1 = s0; int n1 = n0, c1 = c0; if (two) TR_DECODE(it2, s1, n1, c1);
            p0_transpose_item2(s0, n0, c0, WALL + (size_t)((it >> 4) * 32) * D, (it & 15) * 64, two, s1, n1, c1, WALL + (size_t)((it2 >> 4) * 32) * D, (it2 & 15) * 64, scr, lane);
        }
#undef TR_DECODE
        PS_STAMP(0);
        TABLE_CONVERT(0, gw, NGW);
        PS_STAMP(1);
        {
            const int gt = bx * 512 + tid, NT = G * 512;
            for (int i = gt; i < 2 * 2 * 128 * 128; i += NT) { const int l = i >> 15, hf = (i >> 14) & 1, r = i & 16383; const float* k1 = INP(I_K1); const float* k2 = INP(I_K2); KEYS[i] = (bf16)f2bf((hf ? k2 : k1)[(size_t)l * 16384 + r]); }
            { const f32x4* mp = (const f32x4*)INP(I_MEM); for (int i = gt; i < MROWS * D / 4; i += 2 * NT) { const int i2 = i + NT; const f32x4 a = mp[i], b = (i2 < MROWS * D / 4) ? mp[i2] : a; v2u w; w.x = pk2(a[0], a[1]); w.y = pk2(a[2], a[3]); ((v2u*)MEMB)[i] = w;
                if (i2 < MROWS * D / 4) { v2u w2; w2.x = pk2(b[0], b[1]); w2.y = pk2(b[2], b[3]); ((v2u*)MEMB)[i2] = w2; } } }
            { const float* pare = INP(I_ARE); const float* paim = INP(I_AIM); const float* pldt = INP(I_LDT); const float* pbre = INP(I_BRE); const float* pbim = INP(I_BIM); const float* pcre = INP(I_CRE); const float* pcim = INP(I_CIM);
              for (int j = gt; j < 64 * 64 * 16; j += NT) { const int c = j >> 12, i = j & 4095, g = i >> 6, p = i & 63;
                const double are = pare[i], aim = paim[i], dt = exp((double)pldt[g]);
                const double mag = exp(are * dt), ang = aim * dt, lbr = mag * cos(ang), lbi = mag * sin(ang), den = are * are + aim * aim;
                const double fr = ((lbr - 1.0) * are + lbi * aim) / den, fi = (lbi * are - (lbr - 1.0) * aim) / den;
                if (c == 0) { LBc[2 * i] = (float)lbr; LBc[2 * i + 1] = (float)lbi; }
                const double br = pbre[(size_t)i * 16 + c], bi = pbim[(size_t)i * 16 + c];
                BBW[((size_t)g * 128 + p) * 16 + c] = (bf16)f2bf((float)(fr * br - fi * bi)); BBW[((size_t)g * 128 + 64 + p) * 16 + c] = (bf16)f2bf((float)(fr * bi + fi * br));
                CCW[((size_t)g * 16 + c) * 128 + p] = (bf16)f2bf(pcre[((size_t)g * 16 + c) * 64 + p]); CCW[((size_t)g * 16 + c) * 128 + 64 + p] = (bf16)f2bf(-pcim[((size_t)g * 16 + c) * 64 + p]); } }
        }
        PS_STAMP(2);
        { const float* xp_ = INP(I_XP); const float* xs_ = INP(I_XS); const float* gm_ = INP(I_NMIX);
          for (int m = gw; m < T; m += 2 * NGW) { const int m2 = m + NGW; const bool two = m2 < T;
              rms_row2_bf16(m < TP ? xp_ + (size_t)m * D : xs_ + (size_t)(m - TP) * D, two ? (m2 < TP ? xp_ + (size_t)m2 * D : xs_ + (size_t)(m2 - TP) * D) : nullptr, gm_, HB + (size_t)m * D, HB + (size_t)m2 * D, lane); } }
        PS_STAMP(3);
      }
    }
    SEAM(0);
    if (IN(1)) { PH_LOCALS
      for (int rep_ = 0; rep_ < REP_P1; ++rep_) {
        { EpiKV E{out, KB, VT}; for (int r2_ = 0; r2_ < REP_KV; ++r2_) GEMM_PHASE(EpiKV, MEMB, R_KV, MROWS, 4096, E); }
        {
            const int half = G / 2, per = (NB * 64 - half + (G - half) - 1) / (G - half);
            const int s_lo = (bx < half) ? bx : half + (bx - half) * per, s_hi = (bx < half) ? bx + 1 : min(NB * 64, s_lo + per);
            for (int r2_ = 0; r2_ < REP_S5P; ++r2_)
#pragma unroll 1
            for (int sq = s_lo; sq < s_hi; ++sq) s5_prompt_seq(HB, ZB, BBW, CCW, LBc, INP(I_SD), L + RING_OFF, tid, sq >> 6, sq & 63, out + O_SRP, out + O_SIP);
            if (bx < half) TABLE_CONVERT(1, bx * NWAVES + wave, half * NWAVES);
            LAS float* ST = (LAS float*)(L + RING_OFF + wave * S5_ST_BYTES);
            for (int r2_ = 0; r2_ < REP_S5S; ++r2_)
#pragma unroll 1
            for (int tk = gw; tk < (DB / 4) * 64; tk += NGW) { const int b0 = (tk >> 6) * 4, g = tk & 63; float sr = 0.f, si = 0.f;
                const float lbr = LBc[(g * 64 + lane) * 2], lbi = LBc[(g * 64 + lane) * 2 + 1];
                s5_run<true, true>(HB, ZB, BBW, CCW, INP(I_SD), ST, lane, g, TP + 4 * b0, 1, b0, INP(I_SRE), INP(I_SIM), out + O_SRS, out + O_SIS, lbr, lbi, sr, si); }
        }
        if (REP_P1 > 1) __syncthreads();
      }
    }
    SEAM(1);
    if (IN(2)) { PH_LOCALS
        { EpiGLU E{INP(I_XP), XR, HB, SSQB, INP(I_NMEM)}; for (int rep_ = 0; rep_ < REP_GEMM; ++rep_) GEMM_PHASE(EpiGLU, ZB, R_GLU, TP, 2048, E); }
        { SkArgs sa{}; sa.A = ZB; sa.W = WALL + (size_t)R_GLU * D; sa.xr = XR; sa.hbo = HB; sa.ssq = SSQB; sa.gnext = INP(I_NMEM); sa.xs = INP(I_XS);
for (int rep_ = 0; rep_ < REP_SK; ++rep_)
#pragma unroll 1
          for (int tk = bx; tk < 16 * 32; tk += G) skinny_tile<SK_GLU>(sa, tk & 15, tk >> 4, (LAS float*)(L + RING_OFF), tid); }
    }
    SEAM(2);
#pragma unroll 1
    for (int layer = 0; layer < 2; ++layer) {
        const int pb = layer == 0 ? 3 : 12;
        if (layer == 1) {
            if (IN(9)) { PH_LOCALS
                { EpiWin E{B1, V1, out}; for (int rep_ = 0; rep_ < REP_GEMM; ++rep_) GEMM_PHASE(EpiWin, HB, R_WIN, TP, 3072, E); }
                { SkArgs sa{}; sa.A = HB; sa.W = WALL + (size_t)R_WIN * D; sa.v1 = V1; sa.out = out;
for (int rep_ = 0; rep_ < REP_SK; ++rep_)
#pragma unroll 1
                  for (int tk = bx; tk < 16 * 32; tk += G) skinny_tile<SK_WINV>(sa, tk & 15, tk >> 4, (LAS float*)(L + RING_OFF), tid);
                  sa.W = WALL + (size_t)(R_WIN + 2048) * D; sa.b1 = B1;
for (int rep_ = 0; rep_ < REP_SK; ++rep_)
#pragma unroll 1
                  for (int tk = bx; tk < 16 * 16; tk += G) skinny_tile<SK_WINB>(sa, tk & 15, tk >> 4, (LAS float*)(L + RING_OFF), tid); }
            }
            SEAM(9);
            if (IN(10)) { PH_LOCALS
                const float* cw = INP(I_CW);
                for (int m = gw; m < T; m += NGW) {
                    const bool smp = m >= TP; const int s = smp ? ((m - TP) & 3) : (m & (SEQ - 1));
#pragma unroll
                    for (int hh = 0; hh < 2; ++hh) { const int c0 = hh * 512 + 8 * lane;
                        const v4u bw = *(const v4u*)(B1 + (size_t)m * D + c0), v0 = *(const v4u*)(V1 + (size_t)m * D + c0);
                        float vm1[8], vm2[8];
                        if (s >= 1) { const v4u t1 = *(const v4u*)(V1 + (size_t)(m - 1) * D + c0); vm1[0] = bflo(t1.x); vm1[1] = bfhi(t1.x); vm1[2] = bflo(t1.y); vm1[3] = bfhi(t1.y); vm1[4] = bflo(t1.z); vm1[5] = bfhi(t1.z); vm1[6] = bflo(t1.w); vm1[7] = bfhi(t1.w); }
                        else if (smp) { const float* sp = INP(I_SCONV) + ((size_t)((m - TP) >> 2) * 2 + 1) * D + c0; const f32x4 a = *(const f32x4*)sp, b = *(const f32x4*)(sp + 4); vm1[0] = a[0]; vm1[1] = a[1]; vm1[2] = a[2]; vm1[3] = a[3]; vm1[4] = b[0]; vm1[5] = b[1]; vm1[6] = b[2]; vm1[7] = b[3]; }
                        else {
#pragma unroll
                            for (int i = 0; i < 8; ++i) vm1[i] = 0.f; }
                        if (s >= 2) { const v4u t2 = *(const v4u*)(V1 + (size_t)(m - 2) * D + c0); vm2[0] = bflo(t2.x); vm2[1] = bfhi(t2.x); vm2[2] = bflo(t2.y); vm2[3] = bfhi(t2.y); vm2[4] = bflo(t2.z); vm2[5] = bfhi(t2.z); vm2[6] = bflo(t2.w); vm2[7] = bfhi(t2.w); }
                        else if (smp) { const float* sp = INP(I_SCONV) + ((size_t)((m - TP) >> 2) * 2 + s) * D + c0; const f32x4 a = *(const f32x4*)sp, b = *(const f32x4*)(sp + 4); vm2[0] = a[0]; vm2[1] = a[1]; vm2[2] = a[2]; vm2[3] = a[3]; vm2[4] = b[0]; vm2[5] = b[1]; vm2[6] = b[2]; vm2[7] = b[3]; }
                        else {
#pragma unroll
                            for (int i = 0; i < 8; ++i) vm2[i] = 0.f; }
                        float vc[8], bg[8], w0[8], w1[8], w2[8];
                        vc[0] = bflo(v0.x); vc[1] = bfhi(v0.x); vc[2] = bflo(v0.y); vc[3] = bfhi(v0.y); vc[4] = bflo(v0.z); vc[5] = bfhi(v0.z); vc[6] = bflo(v0.w); vc[7] = bfhi(v0.w);
                        bg[0] = bflo(bw.x); bg[1] = bfhi(bw.x); bg[2] = bflo(bw.y); bg[3] = bfhi(bw.y); bg[4] = bflo(bw.z); bg[5] = bfhi(bw.z); bg[6] = bflo(bw.w); bg[7] = bfhi(bw.w);
                        { const f32x4 a = *(const f32x4*)(cw + c0), b = *(const f32x4*)(cw + c0 + 4); w0[0] = a[0]; w0[1] = a[1]; w0[2] = a[2]; w0[3] = a[3]; w0[4] = b[0]; w0[5] = b[1]; w0[6] = b[2]; w0[7] = b[3]; }
                        { const f32x4 a = *(const f32x4*)(cw + D + c0), b = *(const f32x4*)(cw + D + c0 + 4); w1[0] = a[0]; w1[1] = a[1]; w1[2] = a[2]; w1[3] = a[3]; w1[4] = b[0]; w1[5] = b[1]; w1[6] = b[2]; w1[7] = b[3]; }
                        { const f32x4 a = *(const f32x4*)(cw + 2 * D + c0), b = *(const f32x4*)(cw + 2 * D + c0 + 4); w2[0] = a[0]; w2[1] = a[1]; w2[2] = a[2]; w2[3] = a[3]; w2[4] = b[0]; w2[5] = b[1]; w2[6] = b[2]; w2[7] = b[3]; }
                        float r[8];
#pragma unroll
                        for (int i = 0; i < 8; ++i) r[i] = bg[i] * (w0[i] * vm2[i] + w1[i] * vm1[i] + w2[i] * vc[i]);
                        v4u ow; ow.x = pk2(r[0], r[1]); ow.y = pk2(r[2], r[3]); ow.z = pk2(r[4], r[5]); ow.w = pk2(r[6], r[7]);
                        *(v4u*)(ZB + (size_t)m * D + c0) = ow; }
                }
            }
            SEAM(10);
            if (IN(11)) { PH_LOCALS
                { EpiRes E{XR, HB, SSQB, INP(I_NMEM) + D}; GEMM_PHASE(EpiRes, ZB, R_WOUT, TP, 1024, E); }
                { SkArgs sa{}; sa.A = ZB; sa.W = WALL + (size_t)R_WOUT * D; sa.xr = XR; sa.hbo = HB; sa.ssq = SSQB; sa.gnext = INP(I_NMEM) + D;
#pragma unroll 1
                  for (int tk = bx; tk < 16 * 16; tk += G) skinny_tile<SK_RES>(sa, tk & 15, tk >> 4, (LAS float*)(L + RING_OFF), tid); }
            }
            SEAM(11);
        }
        const int ns_q = layer == 0 ? 32 : 16;
        if (IN(pb + 0)) { PH_LOCALS
            { EpiB16 E{QB, D, SSQB, ns_q}; for (int rep_ = 0; rep_ < REP_GEMM; ++rep_) GEMM_PHASE(EpiB16, HB, R_Q + layer * 1024, TP, 1024, E); }
            { SkArgs sa{}; sa.A = HB; sa.W = WALL + (size_t)(R_Q + layer * 1024) * D; sa.ssq = SSQB; sa.nslots = ns_q; sa.O = QB; sa.ldc = D;
for (int rep_ = 0; rep_ < REP_SK; ++rep_)
#pragma unroll 1
              for (int tk = bx; tk < 16 * 16; tk += G) skinny_tile<SK_B16>(sa, tk & 15, tk >> 4, (LAS float*)(L + RING_OFF), tid); }
        }
        SEAM(pb + 0);
        if (IN(pb + 1)) { PH_LOCALS
          for (int rep_ = 0; rep_ < REP_ATTN; ++rep_) {
            const bf16* KBl = KB + (size_t)layer * MROWS * D; const bf16* VTl = VT + (size_t)layer * NB * NH * HD * MEMT;
#pragma unroll 1
            for (int pass = 0; pass < 2; ++pass) {
              if ((pass ^ (bx & 1)) == 0) {
#pragma unroll 1
                for (int tk = bx; tk < NB * NH * (SEQ / 256); tk += G) { const int rb = tk & 7, bh = tk >> 3; attn_prompt_wg(QB, KBl, VTl, ZB, bh >> 2, bh & 3, rb * 256, L + RING_OFF, tid); }
              } else {
#pragma unroll 1
                for (int tk = bx; tk < DB * NH; tk += G) attn_sample_task(QB, INP(I_CK), INP(I_CV), ZB, layer, tk >> 2, tk & 3, (LAS float*)(L + RING_OFF), tid);
              }
            }
          }
        }
        SEAM(pb + 1);
        if (IN(pb + 2)) { PH_LOCALS
            { EpiRes E{XR, HB, SSQB, INP(I_NFFN) + layer * D}; GEMM_PHASE(EpiRes, ZB, R_O + layer * 1024, TP, 1024, E); }
            { SkArgs sa{}; sa.A = ZB; sa.W = WALL + (size_t)(R_O + layer * 1024) * D; sa.xr = XR; sa.hbo = HB; sa.ssq = SSQB; sa.gnext = INP(I_NFFN) + layer * D;
#pragma unroll 1
              for (int tk = bx; tk < 16 * 16; tk += G) skinny_tile<SK_RES>(sa, tk & 15, tk >> 4, (LAS float*)(L + RING_OFF), tid); }
        }
        SEAM(pb + 2);
        if (IN(pb + 3)) { PH_LOCALS
            { EpiB16 E{QP, 2048, SSQB, 16}; for (int rep_ = 0; rep_ < REP_GEMM; ++rep_) GEMM_PHASE(EpiB16, HB, R_PQ + layer * 2048, TP, 2048, E); }
            { SkArgs sa{}; sa.A = HB; sa.W = WALL + (size_t)(R_PQ + layer * 2048) * D; sa.ssq = SSQB; sa.nslots = 16; sa.O = QP; sa.ldc = 2048;
for (int rep_ = 0; rep_ < REP_SK; ++rep_)
#pragma unroll 1
              for (int tk = bx; tk < 16 * 32; tk += G) skinny_tile<SK_B16>(sa, tk & 15, tk >> 4, (LAS float*)(L + RING_OFF), tid); }
        }
        SEAM(pb + 3);
        if (IN(pb + 4)) { PH_LOCALS
          peer_stage_keys(KEYS + (size_t)layer * 2 * 128 * 128, L + RING_OFF, tid);
          __syncthreads();
          LAS int* ti = (LAS int*)(L + RING_OFF + PSEL_KEYS + wave * PSEL_TI);
          for (int rep_ = 0; rep_ < REP_PSEL; ++rep_)
#pragma unroll 1
            for (int tk = gw; tk < (T / 16) * 8; tk += NGW) peer_select_task(QP, L + RING_OFF, EID, EG, (tk >> 3) * 16, tk & 7, ti, lane);
        }
        SEAM(pb + 4);
        if (IN(pb + 5)) { PH_LOCALS
            const unsigned char* UVl = UVT + (size_t)layer * NEXP * 1536;
            if (layer == 0) { peer_gather_wave6<false>(gw, NGW, TP, lane, HB, EID, EG, UVl, XR, INP(I_NMIX) + D, SSQB, L + RING_OFF + wave * 2048);
                __syncthreads();
#pragma unroll 1
                for (int tp = bx; tp < TS / 2; tp += G) peer_gather_wg2<false>(TP + 2 * tp, tid, HB, EID, EG, UVl, XR, INP(I_NMIX) + D, SSQB, (LAS float*)(L + RING_OFF)); }
            else { peer_gather_wave6<true>(gw, NGW, TP, lane, HB, EID, EG, UVl, XR, INP(I_NFIN), SSQB, L + RING_OFF + wave * 2048);
                __syncthreads();
#pragma unroll 1
                for (int tp = bx; tp < TS / 2; tp += G) peer_gather_wg2<true>(TP + 2 * tp, tid, HB, EID, EG, UVl, XR, INP(I_NFIN), SSQB, (LAS float*)(L + RING_OFF)); }
        }
        if (layer == 0) SEAM(pb + 5);
    }
#ifdef PROBE_SUB
    if (blockIdx.x == 0 && tid0 == 0) { const unsigned long long t0_ = __builtin_amdgcn_s_memrealtime(); while (__builtin_amdgcn_s_memrealtime() - t0_ < 4ull * ps_dt) __builtin_amdgcn_s_sleep(8); }
#endif
#ifdef PROBE_PHASE
    PP_STAMP(17);
    if (blockIdx.x == 0 && tid0 == 0) { const unsigned long long t0_ = __builtin_amdgcn_s_memrealtime(); while (__builtin_amdgcn_s_memrealtime() - t0_ < 4ull * pp_dt) __builtin_amdgcn_s_sleep(8); }
#endif
#undef IN
#undef SEAM
#undef GEMM_PHASE
}

#ifndef MK_PER_PHASE
#define MK_PER_PHASE 0
#endif
extern "C" void kernel_launch(void* const* d_in, const int* in_sizes, int n_in, void* d_out, int out_size, void* d_ws, size_t ws_size, hipStream_t stream) {
    static int grid = 0;
    if (grid == 0) {
        if (n_in != N_IN || out_size != (int)O_END || ws_size < WS_END) { fprintf(stderr, "kernel_launch: unexpected shapes: n_in %d out %d ws %zu; nothing launched\n", n_in, out_size, ws_size); grid = -1; return; }
        int dev = 0, cus = 0, per_cu = 0;
        if (hipGetDevice(&dev) != hipSuccess || hipDeviceGetAttribute(&cus, hipDeviceAttributeMultiprocessorCount, dev) != hipSuccess) { fprintf(stderr, "kernel_launch: device query failed\n"); grid = -1; return; }
        if (hipFuncSetAttribute((const void*)mk_fwd, hipFuncAttributeMaxDynamicSharedMemorySize, LDS_BYTES) != hipSuccess) { fprintf(stderr, "kernel_launch: hipFuncSetAttribute failed\n"); grid = -1; return; }
        if (hipOccupancyMaxActiveBlocksPerMultiprocessor(&per_cu, (const void*)mk_fwd, NWAVES * 64, LDS_BYTES) != hipSuccess || per_cu < 1) { fprintf(stderr, "kernel_launch: occupancy query says %d blocks per CU\n", per_cu); per_cu = 1; }
        (void)hipGetLastError();
        grid = cus;
        if (grid > 256) grid = 256;
    }
    if (grid < 0) return;
    if (hipMemsetAsync((char*)d_ws + WS_CTL, 0, CTL_ZERO_BYTES, stream) != hipSuccess) { fprintf(stderr, "kernel_launch: memset failed\n"); return; }
    Args a{};
    for (int i = 0; i < N_IN; ++i) a.in[i] = (const float*)d_in[i];
    a.out = (float*)d_out; a.ws = (unsigned char*)d_ws;
#if MK_PER_PHASE
    for (int p = 0; p < N_PHASES; ++p) { a.ph_lo = p; a.ph_hi = p + 1; hipLaunchKernelGGL(mk_fwd, dim3(grid), dim3(NWAVES * 64), LDS_BYTES, stream, a); }
#else
    a.ph_lo = 0; a.ph_hi = N_PHASES;
    hipLaunchKernelGGL(mk_fwd, dim3(grid), dim3(NWAVES * 64), LDS_BYTES, stream, a);
#endif
    const hipError_t le = hipPeekAtLastError();
    if (le != hipSuccess) fprintf(stderr, "kernel_launch: launch failed: %s\n", hipGetErrorName(le));
}
```

```cpp
#include <hip/hip_runtime.h>
#include <cstdio>
#include <cstdint>
namespace pg8 {
#define PG8_LAS __attribute__((address_space(3)))
typedef unsigned short bf16_t;
typedef short bf16x8 __attribute__((ext_vector_type(8)));
typedef float f32x4 __attribute__((ext_vector_type(4)));
typedef unsigned u32x4 __attribute__((ext_vector_type(4)));
constexpr int BM = 256, BK = 64, HALF = 128, HTB = HALF * BK * 2  , STAGE_BYTES = 8 * HTB, NXCD = 8, WGM = 8;

__host__ __device__ __forceinline__ int lds_byte(int r, int c) { const int st = (r >> 4) * 2 + (c >> 5), rr = r & 15, cc = c & 31, ob = rr * 64 + cc * 2; return st * 1024 + (ob ^ (((ob >> 9) & 1) << 5)); }
__host__ __device__ __forceinline__ void stage_rc(int b, int& R, int& C) { const int st = b / 1024, sb = b % 1024, swz = sb ^ (((sb >> 9) & 1) << 5); R = (st >> 1) * 16 + swz / 64; C = (st & 1) * 32 + (swz % 64) / 2; }
__host__ __device__ __forceinline__ int perm32(int rho) { const int n = rho >> 4, i = rho & 15; return 8 * (i >> 2) + 4 * n + (i & 3); }

__device__ __forceinline__ const char* pg8_uni(const char* p) { asm volatile("" : "+s"(p)); return p; }
__device__ __forceinline__ unsigned pg8_vo(unsigned v) { asm volatile("" : "+v"(v)); return v; }
struct Unit { int pm, pn; };
struct Gemm { const bf16_t* A; const bf16_t* Bt; int M, N, K; };

struct StaticOrder {
    int nM, nN, nwg, G, c;
    __host__ __device__ void init(int M, int N, int G_, int c_) { nM = M / BM; nN = N / BM; nwg = nM * nN; G = G_; c = c_; }
    __host__ __device__ bool next(int i, Unit& u) const {
        const long L = (long)i * G + c; if (L >= nwg) return false;
        int wgid = (int)L; { const int q = nwg / NXCD, r = nwg % NXCD, xcd = wgid % NXCD, off = wgid / NXCD; wgid = (xcd < r ? xcd * (q + 1) : r * (q + 1) + (xcd - r) * q) + off; }
        const int nig = WGM * nN, gid = wgid / nig, fm = gid * WGM, gsz = (nM - fm) < WGM ? (nM - fm) : WGM;
        u.pm = fm + ((wgid % nig) % gsz); u.pn = (wgid % nig) / gsz; return true;
    }
    __device__ __forceinline__ void a_ready(const Unit&) const {}
    __device__ __forceinline__ void done(const Unit&) const {}
};

__device__ __forceinline__ unsigned cvt_pk_bf16(float lo, float hi) { unsigned r; asm volatile("v_cvt_pk_bf16_f32 %0, %1, %2" : "=v"(r) : "v"(lo), "v"(hi)); return r; }
typedef float f32x2 __attribute__((ext_vector_type(2)));
__device__ __forceinline__ f32x2 gelu_pk(f32x2 v) {
    const f32x2 av = __builtin_elementwise_abs(v), d = av * 0.2316418882f + 1.0f;
    f32x2 t; t.x = __builtin_amdgcn_rcpf(d.x); t.y = __builtin_amdgcn_rcpf(d.y);
    f32x2 q = t * 0.5307027145f + (-0.7265760135f); q = q * t + 0.7107068705f; q = q * t + (-0.142248368f); q = q * t + 0.127414796f; q = q * t;
    const f32x2 s = (v * v) * (-0.72134752044f);
    f32x2 e; e.x = __builtin_amdgcn_exp2f(s.x); e.y = __builtin_amdgcn_exp2f(s.y);
    const f32x2 m = v * (q * e), r = v - m;
    f32x2 o; o.x = v.x < 0.f ? m.x : r.x; o.y = v.y < 0.f ? m.y : r.y; return o;
}
template <class Epi, class Sched, bool ALIGN_EPI = false, bool SP2 = false>
__device__ __forceinline__ void gemm_phase(PG8_LAS unsigned char* lds, const Gemm g, const Sched& S, const Epi& E) {
    const int tid = (int)pg8_vo(threadIdx.x), wid = __builtin_amdgcn_readfirstlane(tid >> 6), lane = tid & 63, wr = wid >> 2, wc = wid & 3, fr = lane & 15, fq = lane >> 4;
    const int K = g.K, nt = K / BK;
    unsigned voffA[2], voffB[2];
#pragma unroll
    for (int i = 0; i < 2; ++i) { int R, C; stage_rc(tid * 16 + i * 8192, R, C); const int Rb = Epi::PERM ? ((R & ~31) + perm32(R & 31)) : R;
        voffA[i] = (unsigned)(R * K + C) * 2u; voffB[i] = (unsigned)(Rb * K + C) * 2u; }
    const size_t kstep = (size_t)(BK * 2);
    const size_t hstep = (size_t)HALF * K * 2;
    const size_t tstep = 2 * hstep;
    const unsigned ldsw = (unsigned)wid * 1024u;
    const int aoff = lds_byte(wr * 64 + fr, fq * 8), boff = lds_byte(wc * 32 + fr, fq * 8);
#define PG8_SA(b, h) (((b) * 2 + (h)) * HTB)
#define PG8_SB(b, h) ((4 + (b) * 2 + (h)) * HTB)
#define PG8_STAGE(bufoff, gbase, voff) do { _Pragma("unroll") for (int _i = 0; _i < 2; ++_i) \
        __builtin_amdgcn_global_load_lds((const unsigned*)(pg8_uni((const char*)(gbase)) + pg8_vo((voff)[_i])), (PG8_LAS unsigned*)(lds + (bufoff) + ldsw + _i * 8192), 16, 0, 0); } while (0)
#define PG8_LDA(dst, b, h) do { _Pragma("unroll") for (int m = 0; m < 4; ++m) _Pragma("unroll") for (int k = 0; k < 2; ++k) dst[m][k] = *(const PG8_LAS bf16x8*)(lds + PG8_SA(b, h) + aoff + m * 2048 + k * 1024); } while (0)
#define PG8_LDB(dst, b, h) do { _Pragma("unroll") for (int n = 0; n < 2; ++n) _Pragma("unroll") for (int k = 0; k < 2; ++k) dst[n][k] = *(const PG8_LAS bf16x8*)(lds + PG8_SB(b, h) + boff + n * 2048 + k * 1024); } while (0)
#define PG8_MMA(ai, bj, At, Bt) do { __builtin_amdgcn_s_setprio(1); _Pragma("unroll") for (int m = 0; m < 4; ++m) _Pragma("unroll") for (int n = 0; n < 2; ++n) _Pragma("unroll") for (int k = 0; k < 2; ++k) \
        acc[ai][bj][m][n] = __builtin_amdgcn_mfma_f32_16x16x32_bf16(Bt[n][k], At[m][k], acc[ai][bj][m][n], 0, 0, 0); __builtin_amdgcn_s_setprio(0); } while (0)
#define PG8_WAIT_V(n) asm volatile("s_waitcnt vmcnt(" #n ")" ::: "memory")
#define PG8_WAIT_L(n) asm volatile("s_waitcnt lgkmcnt(" #n ")" ::: "memory")
#define PG8_BAR __builtin_amdgcn_s_barrier()
#define PG8_SCHED __builtin_amdgcn_sched_barrier(0)
    Unit cur, nxt; int ui = 0;
    if (!S.next(0, cur)) return;
    f32x4 acc[2][2][4][2];
#pragma unroll
    for (int a = 0; a < 2; ++a)
#pragma unroll
        for (int b = 0; b < 2; ++b)
#pragma unroll
            for (int m = 0; m < 4; ++m)
#pragma unroll
                for (int n = 0; n < 2; ++n) acc[a][b][m][n] = (f32x4){0.f, 0.f, 0.f, 0.f};
    bf16x8 At[4][2], B0[2][2], B1[2][2];
    const char* cA = (const char*)g.A + (size_t)cur.pm * tstep; const char* cB = (const char*)g.Bt + (size_t)cur.pn * tstep;
    S.a_ready(cur);
    if constexpr (SP2) {
        PG8_STAGE(PG8_SB(0, 0), cB, voffB); PG8_STAGE(PG8_SB(0, 1), cB + hstep, voffB); PG8_STAGE(PG8_SA(0, 0), cA, voffA); PG8_STAGE(PG8_SA(0, 1), cA + hstep, voffA);
        if (wr == 1) PG8_BAR;
        PG8_WAIT_V(2); PG8_BAR;
        PG8_STAGE(PG8_SB(1, 0), cB + kstep, voffB); PG8_STAGE(PG8_SA(1, 0), cA + kstep, voffA); PG8_STAGE(PG8_SB(1, 1), cB + hstep + kstep, voffB);
        PG8_WAIT_V(6); PG8_BAR;
    } else {
        PG8_STAGE(PG8_SB(0, 0), cB, voffB); PG8_STAGE(PG8_SA(0, 0), cA, voffA); PG8_STAGE(PG8_SB(0, 1), cB + hstep, voffB); PG8_STAGE(PG8_SA(0, 1), cA + hstep, voffA);
        if (wr == 1) PG8_BAR;
        PG8_WAIT_V(4); PG8_BAR;
        PG8_STAGE(PG8_SB(1, 0), cB + kstep, voffB); PG8_STAGE(PG8_SA(1, 0), cA + kstep, voffA); PG8_STAGE(PG8_SB(1, 1), cB + hstep + kstep, voffB);
        PG8_WAIT_V(6); PG8_BAR;
    }
    for (;;) {
        const bool has_next = S.next(ui + 1, nxt);
        const char* nA = has_next ? (const char*)g.A + (size_t)nxt.pm * tstep : cA; const char* nB = has_next ? (const char*)g.Bt + (size_t)nxt.pn * tstep : cB;
        for (int t = 0; t < nt; t += 2) {
            const bool last = (t == nt - 2);
            const char* a1 = cA + (size_t)(t + 1) * kstep;
            const char* a2 = last ? nA : cA + (size_t)(t + 2) * kstep; const char* b2 = last ? nB : cB + (size_t)(t + 2) * kstep;
            const char* a3 = a2 + kstep; const char* b3 = b2 + kstep;
            if (last && has_next) S.a_ready(nxt);
            if constexpr (SP2) {
            PG8_LDB(B0, 0, 0); PG8_LDB(B1, 0, 1); PG8_SCHED; PG8_LDA(At, 0, 0); PG8_STAGE(PG8_SA(1, 1), a1 + hstep, voffA);
            PG8_WAIT_V(8); PG8_WAIT_L(0); PG8_BAR; PG8_MMA(0, 0, At, B0); PG8_MMA(0, 1, At, B1); PG8_BAR; PG8_SCHED;
            PG8_LDA(At, 0, 1); PG8_STAGE(PG8_SB(0, 0), b2, voffB); PG8_STAGE(PG8_SB(0, 1), b2 + hstep, voffB); PG8_STAGE(PG8_SA(0, 0), a2, voffA);
            PG8_WAIT_V(8); PG8_WAIT_L(0); PG8_BAR; PG8_MMA(1, 0, At, B0); PG8_MMA(1, 1, At, B1); PG8_BAR; PG8_SCHED;
            PG8_LDB(B0, 1, 0); PG8_LDB(B1, 1, 1); PG8_SCHED; PG8_LDA(At, 1, 0); PG8_STAGE(PG8_SA(0, 1), a2 + hstep, voffA);
            PG8_WAIT_V(8); PG8_WAIT_L(0); PG8_BAR; PG8_MMA(0, 0, At, B0); PG8_MMA(0, 1, At, B1); PG8_BAR; PG8_SCHED;
            PG8_LDA(At, 1, 1); PG8_STAGE(PG8_SB(1, 0), b3, voffB); PG8_STAGE(PG8_SB(1, 1), b3 + hstep, voffB); PG8_STAGE(PG8_SA(1, 0), a3, voffA);
            PG8_WAIT_V(8); PG8_WAIT_L(0); PG8_BAR; PG8_MMA(1, 0, At, B0); PG8_MMA(1, 1, At, B1); PG8_BAR; PG8_SCHED;
            } else {
            PG8_LDB(B0, 0, 0); PG8_SCHED; PG8_LDA(At, 0, 0); PG8_STAGE(PG8_SA(1, 1), a1 + hstep, voffA);
            PG8_WAIT_L(8); PG8_BAR; PG8_WAIT_L(0); PG8_MMA(0, 0, At, B0); PG8_BAR; PG8_SCHED;
            PG8_LDB(B1, 0, 1); PG8_STAGE(PG8_SB(0, 0), b2, voffB);
            PG8_BAR; PG8_WAIT_L(0); PG8_MMA(0, 1, At, B1); PG8_BAR;
            PG8_LDA(At, 0, 1); PG8_STAGE(PG8_SA(0, 0), a2, voffA);
            PG8_BAR; PG8_WAIT_L(0); PG8_MMA(1, 0, At, B0); PG8_BAR; PG8_SCHED;
            PG8_STAGE(PG8_SB(0, 1), b2 + hstep, voffB);
            PG8_WAIT_V(6); PG8_BAR; PG8_MMA(1, 1, At, B1); PG8_BAR;
            PG8_LDB(B0, 1, 0); PG8_SCHED; PG8_LDA(At, 1, 0); PG8_STAGE(PG8_SA(0, 1), a2 + hstep, voffA);
            PG8_WAIT_L(8); PG8_BAR; PG8_WAIT_L(0); PG8_MMA(0, 0, At, B0); PG8_BAR; PG8_SCHED;
            PG8_LDB(B1, 1, 1); PG8_STAGE(PG8_SB(1, 0), b3, voffB);
            PG8_BAR; PG8_WAIT_L(0); PG8_MMA(0, 1, At, B1); PG8_BAR;
            PG8_LDA(At, 1, 1); PG8_STAGE(PG8_SA(1, 0), a3, voffA);
            PG8_BAR; PG8_WAIT_L(0); PG8_MMA(1, 0, At, B0); PG8_BAR; PG8_SCHED;
            PG8_STAGE(PG8_SB(1, 1), b3 + hstep, voffB);
            PG8_WAIT_V(6); PG8_BAR; PG8_MMA(1, 1, At, B1); PG8_BAR;
            }
        }
        if constexpr (ALIGN_EPI) { if (wr == 0) PG8_BAR; }
        if constexpr (!Epi::AFTER_DRAIN) { E(acc, cur, wr, wc, fr, fq); S.done(cur); }
        if (!has_next) break;
#pragma unroll
        for (int a = 0; a < 2; ++a)
#pragma unroll
            for (int b = 0; b < 2; ++b)
#pragma unroll
                for (int m = 0; m < 4; ++m)
#pragma unroll
                    for (int n = 0; n < 2; ++n) acc[a][b][m][n] = (f32x4){0.f, 0.f, 0.f, 0.f};
        cur = nxt; cA = nA; cB = nB; ++ui;
        if constexpr (ALIGN_EPI) { if (wr == 1) PG8_BAR; }
    }
    PG8_WAIT_V(0);
    if constexpr (!ALIGN_EPI) { if (wr == 0) PG8_BAR; }
    PG8_BAR;
    if constexpr (Epi::AFTER_DRAIN) { E.fused(acc, cur, wr, wc, fr, fq, lds, wid, lane); S.done(cur); }
#undef PG8_SA
#undef PG8_SB
#undef PG8_STAGE
#undef PG8_LDA
#undef PG8_LDB
#undef PG8_MMA
#undef PG8_WAIT_V
#undef PG8_WAIT_L
#undef PG8_BAR
#undef PG8_SCHED
}
}
#define GAS __attribute__((address_space(1)))
#define LAS __attribute__((address_space(3)))
typedef unsigned short bf16;
typedef unsigned v4u __attribute__((ext_vector_type(4)));
typedef unsigned v2u __attribute__((ext_vector_type(2)));
typedef int v4i __attribute__((ext_vector_type(4)));
typedef float f32x4 __attribute__((ext_vector_type(4)));
typedef float f32x2 __attribute__((ext_vector_type(2)));
typedef short bf16x8 __attribute__((ext_vector_type(8)));
typedef __bf16 bf16x2_t __attribute__((ext_vector_type(2)));
typedef GAS unsigned gu32;
#define RLX_AGENT __ATOMIC_RELAXED, __HIP_MEMORY_SCOPE_AGENT
#define LDS_WAIT() asm volatile("s_waitcnt lgkmcnt(0)" ::: "memory")
#define VM_WAIT() asm volatile("s_waitcnt vmcnt(0)" ::: "memory")
__device__ __forceinline__ unsigned f2bf(float f) { unsigned u = __builtin_bit_cast(unsigned, f); return (u + 0x7fffu + ((u >> 16) & 1u)) >> 16; }
__device__ __forceinline__ unsigned pk2(float lo, float hi) { return pg8::cvt_pk_bf16(lo, hi); }
__device__ __forceinline__ float bflo(unsigned w) { return __builtin_bit_cast(float, w << 16); }
__device__ __forceinline__ float bfhi(unsigned w) { return __builtin_bit_cast(float, w & 0xffff0000u); }

__device__ __forceinline__ int mk_lane_id() { int r; asm volatile("v_mbcnt_lo_u32_b32 %0, -1, 0\n\tv_mbcnt_hi_u32_b32 %0, -1, %0" : "=v"(r)); return r; }
__device__ __forceinline__ int mk_bperm(int idx4, int v) { return __builtin_amdgcn_ds_bpermute(idx4, v); }
__device__ __forceinline__ float mk_shfl_xor(float v, int m) { return __builtin_bit_cast(float, mk_bperm((mk_lane_id() ^ m) << 2, __builtin_bit_cast(int, v))); }
__device__ __forceinline__ int mk_shfl_xor(int v, int m) { return mk_bperm((mk_lane_id() ^ m) << 2, v); }
__device__ __forceinline__ unsigned mk_shfl_xor(unsigned v, int m) { return (unsigned)mk_bperm((mk_lane_id() ^ m) << 2, (int)v); }
__device__ __forceinline__ float mk_shfl(float v, int src) { return __builtin_bit_cast(float, mk_bperm(src << 2, __builtin_bit_cast(int, v))); }
__device__ __forceinline__ float mk_shx(float v, int m, int l4) { return __builtin_bit_cast(float, mk_bperm(l4 ^ (m << 2), __builtin_bit_cast(int, v))); }
__device__ __forceinline__ unsigned mk_shx(unsigned v, int m, int l4) { return (unsigned)mk_bperm(l4 ^ (m << 2), (int)v); }
#define __shfl_xor(v, m) mk_shfl_xor((v), (m))
#define __shfl(v, s) mk_shfl((v), (s))
__device__ __forceinline__ float wave_sum(float v) {
#pragma unroll
    for (int o = 1; o < 64; o <<= 1) v += __shfl_xor(v, o);
    return v;
}
__device__ __forceinline__ float wave_max(float v) {
#pragma unroll
    for (int o = 1; o < 64; o <<= 1) v = fmaxf(v, __shfl_xor(v, o));
    return v;
}
__device__ __forceinline__ float gelu1(float v) { const f32x2 r = pg8::gelu_pk((f32x2){v, 0.f}); return r.x; }
#define XB_TMO      128
#define XB_XCNT(j)  (256  + 64 * (j))
#define XB_XSUB(j)  (1280 + 64 * (j))
#define XB_XGEN(j)  (2304 + 64 * (j))
#define XB_TOP      3328
#define XB_TOPGEN   3392
#define XCD_BAR_WORDS 3456
#define XB_SPIN_CAP (1u << 21)

__device__ __forceinline__ unsigned xb_ld(unsigned* p)              { return __hip_atomic_load(p, __ATOMIC_RELAXED, __HIP_MEMORY_SCOPE_AGENT); }
__device__ __forceinline__ unsigned xb_add(unsigned* p, unsigned v) { return __hip_atomic_fetch_add(p, v, __ATOMIC_RELAXED, __HIP_MEMORY_SCOPE_AGENT); }
__device__ __forceinline__ unsigned xb_xcc_id() { return (unsigned)__builtin_amdgcn_s_getreg((3 << 11) | 20) & 0xFu; }
#define XB_SPIN(cond, bar) do { unsigned _sp = 0; while (cond) { __builtin_amdgcn_s_sleep(1); \
    if ((++_sp & 255u) == 0u) { if (xb_ld(&(bar)[XB_TMO])) break; if (_sp > XB_SPIN_CAP) { atomicAdd(&(bar)[XB_TMO], 1u); break; } } } } while (0)

struct XcdBarrier {
    unsigned* bar; unsigned x;
    volatile LAS unsigned* st;
};

__device__ __forceinline__ XcdBarrier xcd_barrier_post(unsigned* bar, volatile LAS unsigned* st) {
    XcdBarrier b; b.bar = bar; b.x = xb_xcc_id(); b.st = st;
    if (threadIdx.x == 0) (void)xb_add(&bar[XB_XCNT(b.x)], 1u);
    return b;
}
__device__ __forceinline__ void xcd_barrier_complete(unsigned* bar, unsigned x, unsigned& nloc, unsigned& nx) {
    const unsigned G = gridDim.x * gridDim.y * gridDim.z;
    unsigned sum, cnt, mine, sp = 0u;
    for (;;) {
        sum = 0u; cnt = 0u; mine = 0u;
#pragma unroll
        for (unsigned j = 0; j < 16; ++j) { const unsigned c = xb_ld(&bar[XB_XCNT(j)]); sum += c; cnt += (c > 0u) ? 1u : 0u; mine = (j == x) ? c : mine; }
        if (sum == G) break;
        __builtin_amdgcn_s_sleep(1);
        if ((++sp & 255u) == 0u) { if (xb_ld(&bar[XB_TMO])) break; if (sp > XB_SPIN_CAP) { atomicAdd(&bar[XB_TMO], 1u); break; } }
    }
    nloc = mine > 0u ? mine : 1u; nx = cnt > 0u ? cnt : 1u;
}

__device__ __forceinline__ void xcd_barrier(const XcdBarrier& b) {
    asm volatile("s_waitcnt vmcnt(0)" ::: "memory");
    __syncthreads();
    if (threadIdx.x == 0) {
        unsigned* bar = b.bar;
        __builtin_amdgcn_s_waitcnt(0);
        unsigned nloc = b.st[0], nx = b.st[1];
        if (nloc == 0u) { xcd_barrier_complete(bar, b.x, nloc, nx); b.st[0] = nloc; b.st[1] = nx; }
        const unsigned old = xb_add(&bar[XB_XSUB(b.x)], 1u);
        const unsigned gen = old / nloc;
        if (old + 1u == (gen + 1u) * nloc) {
            __builtin_amdgcn_fence(__ATOMIC_RELEASE, "agent");
            asm volatile("s_waitcnt vmcnt(0)" ::: "memory");
            const unsigned og = xb_add(&bar[XB_TOP], 1u);
            const unsigned tg = og / nx;
            if (og + 1u == (tg + 1u) * nx) xb_add(&bar[XB_TOPGEN], 1u);
            else XB_SPIN(xb_ld(&bar[XB_TOPGEN]) == tg, bar);
            __builtin_amdgcn_fence(__ATOMIC_ACQUIRE, "agent");
            xb_add(&bar[XB_XGEN(b.x)], 1u);
            asm volatile("s_waitcnt vmcnt(0)" ::: "memory");
        } else {
            XB_SPIN(xb_ld(&bar[XB_XGEN(b.x)]) == gen, bar);
            __builtin_amdgcn_fence(__ATOMIC_ACQUIRE, "agent");
            asm volatile("s_waitcnt vmcnt(0)" ::: "memory");
        }
    }
    __syncthreads();
}
constexpr int NWAVES = 8;
constexpr int D = 1024, NB = 8, SEQ = 2048, TP = NB * SEQ, DB = 128, DSQ = 4, TS = DB * DSQ, T = TP + TS;
constexpr int MEMT = 256, NH = 4, HD = 256, MROWS = NB * MEMT;
constexpr int NEXP = 16384;
constexpr float RMS_EPS = 1e-6f;
constexpr size_t O_Y = 0, O_SRP = 17301504, O_SIP = 17334272, O_CP = 17367040, O_MK = 17383424, O_MV = 21577728, O_SRS = 25772032, O_SIS = 26296320, O_CS = 26820608, O_END = 27082752;
enum { I_XP = 0, I_XS, I_MEM, I_SRE, I_SIM, I_SCONV, I_CK, I_CV, I_NMIX, I_NMEM, I_NFFN, I_NFIN, I_ARE, I_AIM, I_LDT, I_BRE, I_BIM, I_CRE, I_CIM, I_SD, I_WGLU, I_WIN, I_CW, I_WOUT,
       I_WQ, I_WK, I_WV, I_WO, I_PWQ, I_K1, I_K2, I_PU, I_PV, N_IN };
constexpr int R_KV = 0, R_GLU = 4096, R_Q = 6144, R_O = 8192, R_PQ = 10240, R_WIN = 14336, R_WOUT = 17408, R_END = 18432;
constexpr size_t MiB = 1u << 20;
constexpr size_t WS_CTL = 0, CTL_ZERO_BYTES = 1 * MiB;
constexpr size_t WS_WALL = 2 * MiB;
constexpr size_t WS_KEYS = 38 * MiB;
constexpr size_t WS_BBW = 39 * MiB;
constexpr size_t WS_CCW = 39 * MiB + 512 * 1024;
constexpr size_t WS_LB = 40 * MiB;
constexpr size_t WS_MEMB = 41 * MiB;
constexpr size_t WS_KB = 45 * MiB;
constexpr size_t WS_VT = 53 * MiB;
constexpr size_t WS_EID = 61 * MiB;
constexpr size_t WS_EG = 70 * MiB;
constexpr size_t WS_HB = 80 * MiB;
constexpr size_t WS_ZB = 114 * MiB;
constexpr size_t WS_QB = 148 * MiB;
constexpr size_t WS_QP = 182 * MiB;
constexpr size_t WS_B1 = 249 * MiB;
constexpr size_t WS_V1 = 283 * MiB;
constexpr size_t WS_UV = 320 * MiB;
constexpr size_t WS_SSQ = 384 * MiB;
constexpr size_t WS_RROW = 388 * MiB;
constexpr size_t WS_END = 389 * MiB;
constexpr int CW_BAR = 4096;
constexpr int RING_OFF = 0, RING_BYTES = 131072;
constexpr int LDSCTL_OFF = 146432, MISC_OFF = LDSCTL_OFF + 320;
constexpr int LDS_BYTES = 147456;
using pg8::Unit;
struct EpiKV {
    static constexpr bool PERM = false, AFTER_DRAIN = false;
    float* out; bf16* KB; bf16* VT;
    __device__ __forceinline__ void operator()(const f32x4 (&acc)[2][2][4][2], const Unit& u, int wr, int wc, int fr, int fq) const {
        fr = (int)pg8::pg8_vo((unsigned)fr); fq = (int)pg8::pg8_vo((unsigned)fq);
        const int b = u.pm, mat = u.pn >> 2, l = mat >> 1, isv = mat & 1, h = u.pn & 3;
        float* ob = out + (isv ? O_MV : O_MK) + (size_t)(l * NB + b) * MEMT * D + h * HD;
#pragma unroll
        for (int ai = 0; ai < 2; ++ai)
#pragma unroll
            for (int m = 0; m < 4; ++m) { const int mm = ai * 128 + wr * 64 + m * 16 + fr;
#pragma unroll
                for (int bj = 0; bj < 2; ++bj)
#pragma unroll
                    for (int n = 0; n < 2; ++n) { const int dl = bj * 128 + wc * 32 + n * 16 + 4 * fq; const f32x4 v = acc[ai][bj][m][n];
                        *(f32x4*)(ob + (size_t)mm * D + dl) = v;
                        if (!isv) { v2u w; w.x = pk2(v[0], v[1]); w.y = pk2(v[2], v[3]); *(v2u*)(KB + ((size_t)l * MROWS + b * MEMT + mm) * D + h * HD + dl) = w; }
                        else { bf16* vp = VT + ((((size_t)l * NB + b) * NH + h) * HD + dl) * MEMT + ((mm & ~31) | (((mm >> 2) & 3) << 3) | (((mm >> 4) & 1) << 2) | (mm & 3));
#pragma unroll
                            for (int j = 0; j < 4; ++j) vp[(size_t)j * MEMT] = (bf16)f2bf(v[j]); } } }
    }
};
struct EpiGLU {
    static constexpr bool PERM = false, AFTER_DRAIN = false;
    const float* xp; bf16* HBo; float* SSQ; const float* gnext;
    __device__ __forceinline__ void operator()(const f32x4 (&acc)[2][2][4][2], const Unit& u, int wr, int wc, int fr, int fq) const {
        fr = (int)pg8::pg8_vo((unsigned)fr); fq = (int)pg8::pg8_vo((unsigned)fq);
        const int row0 = u.pm * 256 + wr * 64 + fr, col0 = u.pn * 128 + wc * 32 + 4 * fq;
        const f32x4 g0 = *(const f32x4*)(gnext + col0), g1 = *(const f32x4*)(gnext + col0 + 16);
#pragma unroll
        for (int ai = 0; ai < 2; ++ai)
#pragma unroll
            for (int mp = 0; mp < 2; ++mp) { f32x4 xv[2][2];
#pragma unroll
                for (int mm = 0; mm < 2; ++mm)
#pragma unroll
                    for (int n = 0; n < 2; ++n) xv[mm][n] = *(const f32x4*)(xp + (size_t)(row0 + ai * 128 + (2 * mp + mm) * 16) * D + col0 + n * 16);
#pragma unroll
                for (int mm = 0; mm < 2; ++mm) { const int m = 2 * mp + mm, row = row0 + ai * 128 + m * 16; const size_t ro = (size_t)row * D + col0; float ss = 0.f;
#pragma unroll
                    for (int n = 0; n < 2; ++n) { const f32x4 a = acc[ai][0][m][n], b = acc[ai][1][m][n]; f32x4 o;
#pragma unroll
                        for (int j = 0; j < 4; ++j) { o[j] = xv[mm][n][j] + a[j] / (1.0f + __expf(-b[j])); ss = fmaf(o[j], o[j], ss); }
                        const f32x4 hg = o * (n ? g1 : g0); v2u w; w.x = pk2(hg[0], hg[1]); w.y = pk2(hg[2], hg[3]); *(v2u*)(HBo + ro + n * 16) = w; }
                    ss += __shfl_xor(ss, 16); ss += __shfl_xor(ss, 32);
                    if (fq == 0) SSQ[(size_t)row * 32 + u.pn * 4 + wc] = ss; }
                asm volatile("" ::: "memory"); }
    }
};
__device__ __forceinline__ float row_rinv(const float* SSQ, size_t row, int nslots) {
    const f32x4* p = (const f32x4*)(SSQ + row * 32); f32x4 s = p[0] + p[1] + p[2] + p[3];
    if (nslots > 16) s += p[4] + p[5] + p[6] + p[7];
    return 1.0f / sqrtf(((s[0] + s[1]) + (s[2] + s[3])) * (1.0f / D) + RMS_EPS);
}
struct EpiB16 {
    static constexpr bool PERM = true, AFTER_DRAIN = false;
    bf16* O; int ldc; const float* SSQ; int nslots;
    __device__ __forceinline__ void operator()(const f32x4 (&acc)[2][2][4][2], const Unit& u, int wr, int wc, int fr, int fq) const {
        fr = (int)pg8::pg8_vo((unsigned)fr); fq = (int)pg8::pg8_vo((unsigned)fq);
        const int rb = u.pm * 256 + wr * 64, row0 = rb + fr, col0 = u.pn * 256 + wc * 32 + 8 * fq, ln = fq * 16 + fr;
        const float r0 = row_rinv(SSQ, (size_t)(rb + ln), nslots), r1 = row_rinv(SSQ, (size_t)(rb + 128 + ln), nslots);
#pragma unroll
        for (int ai = 0; ai < 2; ++ai)
#pragma unroll
            for (int m = 0; m < 4; ++m) { const size_t row = (size_t)(row0 + ai * 128 + m * 16); bf16* rowp = O + row * ldc + col0; const float ri = __shfl(ai ? r1 : r0, m * 16 + fr);
#pragma unroll
                for (int bj = 0; bj < 2; ++bj) { const f32x4 v0 = acc[ai][bj][m][0] * ri, v1 = acc[ai][bj][m][1] * ri;
                    v4u w; w.x = pk2(v0[0], v0[1]); w.y = pk2(v0[2], v0[3]); w.z = pk2(v1[0], v1[1]); w.w = pk2(v1[2], v1[3]);
                    *(v4u*)(rowp + bj * 128) = w; } }
    }
};
struct EpiRes {
    static constexpr bool PERM = false, AFTER_DRAIN = false;
    bf16* HBo; float* SSQ; const float* gnext; const float* gprev; const float* rprev;
    __device__ __forceinline__ void operator()(const f32x4 (&acc)[2][2][4][2], const Unit& u, int wr, int wc, int fr, int fq) const {
        fr = (int)pg8::pg8_vo((unsigned)fr); fq = (int)pg8::pg8_vo((unsigned)fq);
        const int row0 = u.pm * 256 + wr * 64 + fr, col0 = u.pn * 256 + wc * 32 + 4 * fq;
#pragma unroll
        for (int ai = 0; ai < 2; ++ai)
#pragma unroll
            for (int m = 0; m < 4; ++m) { const int row = row0 + ai * 128 + m * 16; const size_t ro = (size_t)row * D + col0; float ss = 0.f;
                const float rr = rprev ? 1.0f / rprev[row] : 1.0f; v2u hv[2][2];
#pragma unroll
                for (int bj = 0; bj < 2; ++bj)
#pragma unroll
                    for (int n = 0; n < 2; ++n) hv[bj][n] = *(const v2u*)(HBo + ro + bj * 128 + n * 16);
#pragma unroll
                for (int bj = 0; bj < 2; ++bj)
#pragma unroll
                    for (int n = 0; n < 2; ++n) { const v2u h = hv[bj][n]; const f32x4 gp = *(const f32x4*)(gprev + col0 + bj * 128 + n * 16), gn = *(const f32x4*)(gnext + col0 + bj * 128 + n * 16);
                        const f32x4 t = (f32x4){bflo(h.x), bfhi(h.x), bflo(h.y), bfhi(h.y)} * rr + acc[ai][bj][m][n] * gp;
                        const f32x4 o = (f32x4){t[0] / gp[0], t[1] / gp[1], t[2] / gp[2], t[3] / gp[3]};
                        const f32x4 hg = o * gn;
                        ss = fmaf(o[0], o[0], fmaf(o[1], o[1], fmaf(o[2], o[2], fmaf(o[3], o[3], ss))));
                        v2u w; w.x = pk2(hg[0], hg[1]); w.y = pk2(hg[2], hg[3]); *(v2u*)(HBo + ro + bj * 128 + n * 16) = w; }
                ss += __shfl_xor(ss, 16); ss += __shfl_xor(ss, 32);
                if (fq == 0) SSQ[(size_t)row * 32 + u.pn * 4 + wc] = ss;
                if (m & 1) asm volatile("" ::: "memory"); }
    }
};
struct EpiWin {
    static constexpr bool PERM = false, AFTER_DRAIN = false;
    bf16* B1; bf16* V1; float* out;
    __device__ __forceinline__ void operator()(const f32x4 (&acc)[2][2][4][2], const Unit& u, int wr, int wc, int fr, int fq) const {
        fr = (int)pg8::pg8_vo((unsigned)fr); fq = (int)pg8::pg8_vo((unsigned)fq);
        const int row0 = u.pm * 256 + wr * 64 + fr;
        if (u.pn < 8) {
#pragma unroll
            for (int ai = 0; ai < 2; ++ai)
#pragma unroll
                for (int m = 0; m < 4; ++m) { const int row = row0 + ai * 128 + m * 16; const int col0 = u.pn * 128 + wc * 32 + 4 * fq;
                    float* cs = nullptr;
                    { const int s = row & (SEQ - 1); if (s >= SEQ - 2) cs = out + O_CP + ((size_t)(row >> 11) * 2 + (s - (SEQ - 2))) * D; }
#pragma unroll
                    for (int n = 0; n < 2; ++n) { const f32x4 v = acc[ai][0][m][n] * acc[ai][1][m][n];
                        v2u w; w.x = pk2(v[0], v[1]); w.y = pk2(v[2], v[3]); *(v2u*)(V1 + (size_t)row * D + col0 + n * 16) = w;
                        if (cs) *(f32x4*)(cs + col0 + n * 16) = v; } }
        } else {
#pragma unroll
            for (int ai = 0; ai < 2; ++ai)
#pragma unroll
                for (int m = 0; m < 4; ++m) { bf16* rowp = B1 + (size_t)(row0 + ai * 128 + m * 16) * D + (u.pn - 8) * 256 + wc * 32 + 4 * fq;
#pragma unroll
                    for (int bj = 0; bj < 2; ++bj)
#pragma unroll
                        for (int n = 0; n < 2; ++n) { const f32x4 v = acc[ai][bj][m][n]; v2u w; w.x = pk2(v[0], v[1]); w.y = pk2(v[2], v[3]); *(v2u*)(rowp + bj * 128 + n * 16) = w; } }
        }
    }
};
__device__ __forceinline__ bf16x8 mk8(v4u w) { return __builtin_bit_cast(bf16x8, w); }
__device__ __forceinline__ f32x4 mfma16(bf16x8 a, bf16x8 b, f32x4 c) { return __builtin_amdgcn_mfma_f32_16x16x32_bf16(a, b, c, 0, 0, 0); }

__device__ __forceinline__ void p0_transpose_item(const float* W, int N, int src_n0, bf16* WTrows, int k0, LAS float* scr, int lane) {
#pragma unroll
    for (int i = 0; i < 8; ++i) { const int kk = 8 * i + (lane >> 3), n4 = (lane & 7) * 4; const f32x4 v = *(const f32x4*)(W + (size_t)(k0 + kk) * N + src_n0 + n4);
        scr[kk * 33 + n4] = v[0]; scr[kk * 33 + n4 + 1] = v[1]; scr[kk * 33 + n4 + 2] = v[2]; scr[kk * 33 + n4 + 3] = v[3]; }
    LDS_WAIT();
    const int c = lane & 7;
#pragma unroll
    for (int j = 0; j < 4; ++j) { const int n = (lane >> 3) + 8 * j; const LAS float* s = scr + (8 * c) * 33 + n;
        v4u o; o.x = pk2(s[0 * 33], s[1 * 33]); o.y = pk2(s[2 * 33], s[3 * 33]); o.z = pk2(s[4 * 33], s[5 * 33]); o.w = pk2(s[6 * 33], s[7 * 33]);
        *(v4u*)(WTrows + (size_t)n * D + k0 + 8 * c) = o; }
    LDS_WAIT();
}
__device__ __forceinline__ void p0_transpose_item2(const float* W0, int N0, int sn0, bf16* WT0, int k0, bool two, const float* W1, int N1, int sn1, bf16* WT1, int k1, LAS float* scr, int lane) {
    f32x4 v0[8], v1[8];
#pragma unroll
    for (int i = 0; i < 8; ++i) { const int kk = 8 * i + (lane >> 3), n4 = (lane & 7) * 4; v0[i] = *(const f32x4*)(W0 + (size_t)(k0 + kk) * N0 + sn0 + n4); v1[i] = two ? *(const f32x4*)(W1 + (size_t)(k1 + kk) * N1 + sn1 + n4) : v0[i]; }
#pragma unroll
    for (int i = 0; i < 8; ++i) { const int kk = 8 * i + (lane >> 3), n4 = (lane & 7) * 4;
#pragma unroll
        for (int j = 0; j < 4; ++j) { scr[kk * 33 + n4 + j] = v0[i][j]; scr[2112 + kk * 33 + n4 + j] = v1[i][j]; } }
    LDS_WAIT();
    const int c = lane & 7;
#pragma unroll
    for (int j = 0; j < 4; ++j) { const int n = (lane >> 3) + 8 * j; const LAS float* s = scr + (8 * c) * 33 + n;
        v4u o; o.x = pk2(s[0 * 33], s[1 * 33]); o.y = pk2(s[2 * 33], s[3 * 33]); o.z = pk2(s[4 * 33], s[5 * 33]); o.w = pk2(s[6 * 33], s[7 * 33]);
        *(v4u*)(WT0 + (size_t)n * D + k0 + 8 * c) = o;
        if (two) { const LAS float* s2 = s + 2112; v4u o2; o2.x = pk2(s2[0 * 33], s2[1 * 33]); o2.y = pk2(s2[2 * 33], s2[3 * 33]); o2.z = pk2(s2[4 * 33], s2[5 * 33]); o2.w = pk2(s2[6 * 33], s2[7 * 33]);
            *(v4u*)(WT1 + (size_t)n * D + k1 + 8 * c) = o2; } }
    LDS_WAIT();
}
__device__ __forceinline__ void rms_row_bf16(const float* xrow, const float* g, bf16* orow, int lane) {
    const f32x4* xr = (const f32x4*)xrow + lane; f32x4 v[4]; float s = 0.f;
#pragma unroll
    for (int j = 0; j < 4; ++j) { v[j] = xr[64 * j]; s += (v[j].x * v[j].x + v[j].y * v[j].y) + (v[j].z * v[j].z + v[j].w * v[j].w); }
    const float r = 1.0f / sqrtf(wave_sum(s) * (1.0f / D) + RMS_EPS);
#pragma unroll
    for (int j = 0; j < 4; ++j) { const f32x4 gv = ((const f32x4*)g)[lane + 64 * j]; v2u w; w.x = pk2(v[j].x * r * gv.x, v[j].y * r * gv.y); w.y = pk2(v[j].z * r * gv.z, v[j].w * r * gv.w);
        *(v2u*)(orow + 4 * lane + 256 * j) = w; }
}

__device__ __forceinline__ void rms_row2_bf16(const float* x0, const float* x1, const float* g, bf16* o0, bf16* o1, int lane) {
    f32x4 v[2][4]; float s[2] = {0.f, 0.f}; const bool two = x1 != nullptr;
#pragma unroll
    for (int j = 0; j < 4; ++j) { v[0][j] = ((const f32x4*)x0)[lane + 64 * j]; if (two) v[1][j] = ((const f32x4*)x1)[lane + 64 * j]; else v[1][j] = (f32x4){0.f, 0.f, 0.f, 0.f}; }
#pragma unroll
    for (int h = 0; h < 2; ++h)
#pragma unroll
        for (int j = 0; j < 4; ++j) s[h] += (v[h][j].x * v[h][j].x + v[h][j].y * v[h][j].y) + (v[h][j].z * v[h][j].z + v[h][j].w * v[h][j].w);
    const float r0 = 1.0f / sqrtf(wave_sum(s[0]) * (1.0f / D) + RMS_EPS), r1 = 1.0f / sqrtf(wave_sum(s[1]) * (1.0f / D) + RMS_EPS);
#pragma unroll
    for (int j = 0; j < 4; ++j) { const f32x4 gv = ((const f32x4*)g)[lane + 64 * j];
        v2u w; w.x = pk2(v[0][j].x * r0 * gv.x, v[0][j].y * r0 * gv.y); w.y = pk2(v[0][j].z * r0 * gv.z, v[0][j].w * r0 * gv.w); *(v2u*)(o0 + 4 * lane + 256 * j) = w;
        if (two) { v2u w2; w2.x = pk2(v[1][j].x * r1 * gv.x, v[1][j].y * r1 * gv.y); w2.y = pk2(v[1][j].z * r1 * gv.z, v[1][j].w * r1 * gv.w); *(v2u*)(o1 + 4 * lane + 256 * j) = w2; } }
}
template <bool SAMPLE, bool WITH_Y>
__device__ __forceinline__ void s5_run(const bf16* HB, bf16* ZB, const bf16* BBW, const bf16* CCW, const float* dsk, LAS float* ST, int lane,
                                       int g, int row0, int nchunks, int b0, const float* s0re, const float* s0im, float* ore, float* oim, float lbr, float lbi, float& sr, float& si) {
    const int tl = lane & 15, q4 = lane >> 4;
    const bf16x8 zero8 = {0, 0, 0, 0, 0, 0, 0, 0};
    bf16x8 Abb[8], Acc[4];
#pragma unroll
    for (int tt = 0; tt < 8; ++tt) Abb[tt] = (q4 < 2) ? *(const bf16x8*)(BBW + ((size_t)(g * 128 + 16 * tt + tl)) * 16 + 8 * q4) : zero8;
    if (WITH_Y) {
#pragma unroll
        for (int s = 0; s < 4; ++s) Acc[s] = *(const bf16x8*)(CCW + ((size_t)(g * 16 + tl)) * 128 + 32 * s + 8 * q4); }
    const f32x4 dv = WITH_Y ? *(const f32x4*)(dsk + 16 * g + 4 * q4) : (f32x4){0.f, 0.f, 0.f, 0.f};
    const bf16* hp = HB + (size_t)(row0 + tl) * D + 16 * g;
    bf16x8 Bn = (q4 < 2) ? *(const bf16x8*)(hp + 8 * q4) : zero8; v2u hn = WITH_Y ? *(const v2u*)(hp + 4 * q4) : (v2u){0u, 0u};
    for (int ch = 0; ch < nchunks; ++ch) {
        const int rowc = row0 + 16 * ch;
        const bf16x8 Bu = Bn; const v2u hw = hn;
        if (ch + 1 < nchunks) { const bf16* hq = hp + (size_t)(16 * (ch + 1)) * D; Bn = (q4 < 2) ? *(const bf16x8*)(hq + 8 * q4) : zero8; if (WITH_Y) hn = *(const v2u*)(hq + 4 * q4); }
#pragma unroll
        for (int tt = 0; tt < 8; ++tt) { const f32x4 a = mfma16(Abb[tt], Bu, (f32x4){0.f, 0.f, 0.f, 0.f}); *(LAS f32x4*)(ST + tl * 132 + 16 * tt + 4 * q4) = a; }
        LDS_WAIT();
        float br[16], bi[16];
#pragma unroll
        for (int t = 0; t < 16; ++t) { br[t] = ST[t * 132 + lane]; bi[t] = ST[t * 132 + 64 + lane]; }
#pragma unroll
        for (int t = 0; t < 16; ++t) {
            if (SAMPLE && (t & 3) == 0) { const size_t si0 = ((size_t)(b0 + (t >> 2)) * 64 + g) * 64 + lane; sr = s0re[si0]; si = s0im[si0]; }
            const float nr = fmaf(-lbi, si, fmaf(lbr, sr, br[t])), ni = fmaf(lbi, sr, fmaf(lbr, si, bi[t]));
            sr = nr; si = ni;
            if (WITH_Y) { ST[t * 132 + lane] = sr; ST[t * 132 + 64 + lane] = si; }
            if (SAMPLE && (t & 3) == 3) { const size_t so = ((size_t)(b0 + (t >> 2)) * 64 + g) * 64 + lane; ore[so] = sr; oim[so] = si; }
        }
        LDS_WAIT();
        if (WITH_Y) {
            f32x4 y = {0.f, 0.f, 0.f, 0.f};
#pragma unroll
            for (int s = 0; s < 4; ++s) { const f32x4 lo = *(const LAS f32x4*)(ST + tl * 132 + 32 * s + 8 * q4), hi = *(const LAS f32x4*)(ST + tl * 132 + 32 * s + 8 * q4 + 4);
                v4u w; w.x = pk2(lo[0], lo[1]); w.y = pk2(lo[2], lo[3]); w.z = pk2(hi[0], hi[1]); w.w = pk2(hi[2], hi[3]);
                y = mfma16(Acc[s], mk8(w), y); }
            LDS_WAIT();
            y[0] = fmaf(dv[0], bflo(hw.x), y[0]); y[1] = fmaf(dv[1], bfhi(hw.x), y[1]); y[2] = fmaf(dv[2], bflo(hw.y), y[2]); y[3] = fmaf(dv[3], bfhi(hw.y), y[3]);
            const f32x2 g0 = pg8::gelu_pk((f32x2){y[0], y[1]}), g1 = pg8::gelu_pk((f32x2){y[2], y[3]});
            v2u zo; zo.x = pk2(g0.x, g0.y); zo.y = pk2(g1.x, g1.y);
            *(v2u*)(ZB + (size_t)(rowc + tl) * D + 16 * g + 4 * q4) = zo;
        }
    }
}
constexpr int S5_ST_BYTES = 8448, S5_XE_OFF = 8 * S5_ST_BYTES;
__device__ __forceinline__ void s5_prompt_seq(const bf16* HB, bf16* ZB, const bf16* BBW, const bf16* CCW, const float* LB, const float* dsk, LAS unsigned char* lds, int tid, int b, int g, float* ore, float* oim) {
    const int lane = tid & 63, seg = tid >> 6;
    LAS float* ST = (LAS float*)(lds + seg * S5_ST_BYTES); LAS float* XE = (LAS float*)(lds + S5_XE_OFF);
    const float lbr = LB[(g * 64 + lane) * 2], lbi = LB[(g * 64 + lane) * 2 + 1];
    const int row0 = b * SEQ + seg * 256;
    float sr = 0.f, si = 0.f;
    s5_run<false, false>(HB, ZB, BBW, CCW, dsk, ST, lane, g, row0, 16, b, nullptr, nullptr, nullptr, nullptr, lbr, lbi, sr, si);
    XE[(seg * 64 + lane) * 2] = sr; XE[(seg * 64 + lane) * 2 + 1] = si;
    float pr = lbr, pi = lbi;
#pragma unroll
    for (int k = 0; k < 8; ++k) { const float nr = pr * pr - pi * pi, ni = 2.f * pr * pi; pr = nr; pi = ni; }
    __syncthreads();
    float cr = 0.f, ci = 0.f;
    for (int sp = 0; sp < seg; ++sp) { const float er = XE[(sp * 64 + lane) * 2], ei = XE[(sp * 64 + lane) * 2 + 1]; const float nr = pr * cr - pi * ci + er, ni = pr * ci + pi * cr + ei; cr = nr; ci = ni; }
    __syncthreads();
    sr = cr; si = ci;
    s5_run<false, true>(HB, ZB, BBW, CCW, dsk, ST, lane, g, row0, 16, b, nullptr, nullptr, nullptr, nullptr, lbr, lbi, sr, si);
    if (seg == 7) { const size_t so = ((size_t)b * 64 + g) * 64 + lane; ore[so] = sr; oim[so] = si; }
}

__device__ __forceinline__ float xreduce16(const float (&p)[16], int lane) {
    float q[8], r[4], s[2];
    const bool b5 = (lane & 32) != 0, b4 = (lane & 16) != 0, b3 = (lane & 8) != 0, b2 = (lane & 4) != 0;
#pragma unroll
    for (int k = 0; k < 8; ++k) { const float send = b5 ? p[k] : p[k + 8], keep = b5 ? p[k + 8] : p[k]; q[k] = keep + __shfl_xor(send, 32); }
#pragma unroll
    for (int k = 0; k < 4; ++k) { const float send = b4 ? q[k] : q[k + 4], keep = b4 ? q[k + 4] : q[k]; r[k] = keep + __shfl_xor(send, 16); }
#pragma unroll
    for (int k = 0; k < 2; ++k) { const float send = b3 ? r[k] : r[k + 2], keep = b3 ? r[k + 2] : r[k]; s[k] = keep + __shfl_xor(send, 8); }
    const float send = b2 ? s[0] : s[1], keep = b2 ? s[1] : s[0]; float t = keep + __shfl_xor(send, 4);
    t += __shfl_xor(t, 2); t += __shfl_xor(t, 1);
    return t;
}

__host__ __device__ __forceinline__ int vt_pos(int m) { return (m & ~31) | (((m >> 2) & 3) << 3) | (((m >> 4) & 1) << 2) | (m & 3); }
__device__ __forceinline__ void stage_tile256(const bf16* src, int ldsrc, LAS unsigned char* tb, int tid) {
#pragma unroll 1
    for (int hp = 0; hp < 2; ++hp) { v4u r[8];
#pragma unroll
        for (int i = 0; i < 8; ++i) { const int c = tid + 512 * (8 * hp + i), row = c >> 5, ch = c & 31; r[i] = *(const v4u*)(src + (size_t)row * ldsrc + ch * 8); }
#pragma unroll
        for (int i = 0; i < 8; ++i) { const int c = tid + 512 * (8 * hp + i), row = c >> 5, ch = c & 31; *(LAS v4u*)(tb + row * 512 + ((ch ^ (row & 15)) << 4)) = r[i]; } }
}
__device__ __forceinline__ float attn_softmax(f32x4 (&S)[16], bf16x8 (&Pf)[8]) {
    float mx = -3.0e38f;
#pragma unroll
    for (int mt = 0; mt < 16; ++mt) mx = fmaxf(fmaxf(mx, fmaxf(S[mt][0], S[mt][1])), fmaxf(S[mt][2], S[mt][3]));
    mx = fmaxf(mx, __shfl_xor(mx, 16)); mx = fmaxf(mx, __shfl_xor(mx, 32));
    const float sc2 = 0.0625f * 1.4426950408889634f; float sum = 0.f;
#pragma unroll
    for (int mt = 0; mt < 16; ++mt)
#pragma unroll
        for (int i = 0; i < 4; ++i) { const float p = __builtin_amdgcn_exp2f((S[mt][i] - mx) * sc2); S[mt][i] = p; sum += p; }
    sum += __shfl_xor(sum, 16); sum += __shfl_xor(sum, 32);
#pragma unroll
    for (int ks = 0; ks < 8; ++ks) { v4u w; w.x = pk2(S[2 * ks][0], S[2 * ks][1]); w.y = pk2(S[2 * ks][2], S[2 * ks][3]); w.z = pk2(S[2 * ks + 1][0], S[2 * ks + 1][1]); w.w = pk2(S[2 * ks + 1][2], S[2 * ks + 1][3]); Pf[ks] = mk8(w); }
    return 1.0f / sum;
}
__device__ __forceinline__ void attn_prompt_wg(const bf16* QB, const bf16* KBl, const bf16* VTl, bf16* OB, int b, int h, int r0, LAS unsigned char* tb, int tid) {
    const int lane = tid & 63, w = tid >> 6, tl = lane & 15, q4 = lane >> 4;
    const size_t rowA = (size_t)b * SEQ + r0 + 16 * w + tl, rowB = rowA + 128;
    stage_tile256(KBl + (size_t)b * MEMT * D + h * HD, D, tb, tid);
    __syncthreads();
    f32x4 SA[16], SB[16];
#pragma unroll
    for (int mt = 0; mt < 16; ++mt) { SA[mt] = (f32x4){0.f, 0.f, 0.f, 0.f}; SB[mt] = (f32x4){0.f, 0.f, 0.f, 0.f}; }
    const bf16* qa = QB + rowA * D + h * HD + 8 * q4; const bf16* qb = QB + rowB * D + h * HD + 8 * q4;
    const LAS unsigned char* fb = tb + tl * 512;
#pragma unroll 2
    for (int ks = 0; ks < 8; ++ks) { const bf16x8 fa = *(const bf16x8*)(qa + 32 * ks), fbq = *(const bf16x8*)(qb + 32 * ks); const int co = ((4 * ks + q4) ^ tl) << 4;
#pragma unroll
        for (int mt = 0; mt < 16; ++mt) { const bf16x8 kf = *(const LAS bf16x8*)(fb + mt * 8192 + co); SA[mt] = mfma16(kf, fa, SA[mt]); SB[mt] = mfma16(kf, fbq, SB[mt]); } }
    bf16x8 PA[8], PB[8];
    const float invA = attn_softmax(SA, PA), invB = attn_softmax(SB, PB);
    __syncthreads();
    stage_tile256(VTl + ((size_t)b * NH + h) * HD * MEMT, MEMT, tb, tid);
    __syncthreads();
#pragma unroll 2
    for (int dt = 0; dt < 16; ++dt) { f32x4 oa = {0.f, 0.f, 0.f, 0.f}, ob = {0.f, 0.f, 0.f, 0.f};
#pragma unroll
        for (int ks = 0; ks < 8; ++ks) { const bf16x8 vf = *(const LAS bf16x8*)(fb + dt * 8192 + (((4 * ks + q4) ^ tl) << 4)); oa = mfma16(vf, PA[ks], oa); ob = mfma16(vf, PB[ks], ob); }
        v2u wa, wb; wa.x = pk2(oa[0] * invA, oa[1] * invA); wa.y = pk2(oa[2] * invA, oa[3] * invA); wb.x = pk2(ob[0] * invB, ob[1] * invB); wb.y = pk2(ob[2] * invB, ob[3] * invB);
        *(v2u*)(OB + rowA * D + h * HD + 16 * dt + 4 * q4) = wa; *(v2u*)(OB + rowB * D + h * HD + 16 * dt + 4 * q4) = wb; }
    __syncthreads();
}
__device__ __forceinline__ void attn_sample_task(const bf16* QB, const float* ck, const float* cv, bf16* OB, int l, int b, int h, LAS float* lds, int tid) {
    const int lane = tid & 63, w = tid >> 6;
    LAS float* sc = lds; LAS float* red = lds + 1024;
    const size_t cbase = ((((size_t)l * DB + b) * MEMT) * NH + h) * HD;
    const float* kp = ck + cbase + (size_t)(32 * w) * (NH * HD) + 4 * lane; const float* vp = cv + cbase + (size_t)(32 * w) * (NH * HD) + 4 * lane;
    f32x4 kr[32];
#pragma unroll
    for (int mi = 0; mi < 32; ++mi) kr[mi] = __builtin_nontemporal_load((const f32x4*)(kp + (size_t)mi * (NH * HD)));
    float qf[4][4];
#pragma unroll
    for (int s = 0; s < 4; ++s) { const v2u qw = *(const v2u*)(QB + (size_t)(TP + 4 * b + s) * D + h * HD + 4 * lane); qf[s][0] = bflo(qw.x); qf[s][1] = bfhi(qw.x); qf[s][2] = bflo(qw.y); qf[s][3] = bfhi(qw.y); }
#pragma unroll
    for (int gi = 0; gi < 8; ++gi) { float pd[16];
#pragma unroll
        for (int ri = 0; ri < 4; ++ri) { const f32x4 kv = kr[4 * gi + ri];
#pragma unroll
            for (int s = 0; s < 4; ++s) pd[4 * ri + s] = kv[0] * qf[s][0] + kv[1] * qf[s][1] + kv[2] * qf[s][2] + kv[3] * qf[s][3]; }
        const float tot = xreduce16(pd, lane); const int k = lane >> 2;
        if ((lane & 3) == 0) sc[(k & 3) * 256 + 32 * w + 4 * gi + (k >> 2)] = tot * 0.0625f; }
    f32x4 vr[32];
#pragma unroll
    for (int mi = 0; mi < 32; ++mi) vr[mi] = __builtin_nontemporal_load((const f32x4*)(vp + (size_t)mi * (NH * HD)));
    __syncthreads();
    if (w < 4) { float v[4]; float mx = -3.0e38f;
#pragma unroll
        for (int j = 0; j < 4; ++j) { v[j] = sc[w * 256 + lane + 64 * j]; mx = fmaxf(mx, v[j]); }
        mx = wave_max(mx); float sum = 0.f;
#pragma unroll
        for (int j = 0; j < 4; ++j) { v[j] = __expf(v[j] - mx); sum += v[j]; }
        sum = wave_sum(sum); const float inv = 1.0f / sum;
#pragma unroll
        for (int j = 0; j < 4; ++j) sc[w * 256 + lane + 64 * j] = v[j] * inv; }
    __syncthreads();
    f32x4 o[4];
#pragma unroll
    for (int s = 0; s < 4; ++s) o[s] = (f32x4){0.f, 0.f, 0.f, 0.f};
#pragma unroll
    for (int mi = 0; mi < 32; ++mi) {
#pragma unroll
        for (int s = 0; s < 4; ++s) { const float p = sc[s * 256 + 32 * w + mi]; o[s] += vr[mi] * p; } }
#pragma unroll
    for (int s = 0; s < 4; ++s) *(LAS f32x4*)(red + (w * 4 + s) * 256 + 4 * lane) = o[s];
    __syncthreads();
    { const int idx = tid * 2, s = idx >> 8, d = idx & 255; float a0 = 0.f, a1 = 0.f;
#pragma unroll
        for (int ww = 0; ww < 8; ++ww) { a0 += red[(ww * 4 + s) * 256 + d]; a1 += red[(ww * 4 + s) * 256 + d + 1]; }
        *(unsigned*)(OB + (size_t)(TP + 4 * b + s) * D + h * HD + d) = pk2(a0, a1); }
    __syncthreads();
}

__device__ __forceinline__ unsigned ord_of(float x) { const unsigned u = __builtin_bit_cast(unsigned, x); return u ^ ((u >> 31) ? 0xFFFFFFFFu : 0x80000000u); }
__device__ __forceinline__ float ord_inv(unsigned k) { const unsigned u = (k & 0x80000000u) ? (k ^ 0x80000000u) : ~k; return __builtin_bit_cast(float, u); }
__device__ __forceinline__ unsigned umax2(unsigned a, unsigned b) { return a > b ? a : b; }
__device__ __forceinline__ unsigned umax_x4(unsigned v) { v = umax2(v, (unsigned)__shfl_xor((int)v, 16)); return umax2(v, (unsigned)__shfl_xor((int)v, 32)); }
constexpr int PSEL_KEYS = 65536, PSEL_TI = 2048;
__device__ __forceinline__ void peer_stage_keys(const bf16* KEYl, LAS unsigned char* kl, int tid) {
#pragma unroll
    for (int i = 0; i < 8; ++i) { const int c = tid + 512 * i, hr = c >> 4, ch = c & 15; *(LAS v4u*)(kl + hr * 256 + ((ch ^ (hr & 15)) << 4)) = *(const v4u*)(KEYl + (size_t)hr * 128 + ch * 8); }
}
__device__ __forceinline__ unsigned umin2(unsigned a, unsigned b) { return a < b ? a : b; }
__device__ __forceinline__ void ce_desc(unsigned& a, unsigned& b) { const unsigned hi = umax2(a, b), lo = umin2(a, b); a = hi; b = lo; }
template <int N> __device__ __forceinline__ void bitonic_sort_desc(unsigned (&a)[N]) {
#pragma unroll
    for (int k = 2; k <= N; k <<= 1)
#pragma unroll
        for (int j = k >> 1; j > 0; j >>= 1)
#pragma unroll
            for (int i = 0; i < N; ++i) { const int l = i ^ j; if (l > i) { if ((i & k) == 0) ce_desc(a[i], a[l]); else ce_desc(a[l], a[i]); } }
}
__device__ __forceinline__ void merge_top16(unsigned (&a)[16], int mask, int l4_) {
    unsigned c[16];
#pragma unroll
    for (int i = 0; i < 16; ++i) c[i] = umax2(a[i], mk_shx(a[15 - i], mask, l4_));
#pragma unroll
    for (int j = 8; j > 0; j >>= 1)
#pragma unroll
        for (int i = 0; i < 16; ++i) { const int l = i ^ j; if (l > i) ce_desc(c[i], c[l]); }
#pragma unroll
    for (int i = 0; i < 16; ++i) a[i] = c[i];
}
__device__ __forceinline__ void peer_select_task(const bf16* QP, const LAS unsigned char* kl, int* EID, float* EG, int row0, int hh, LAS int* TI, int lane) {
    const int tl = lane & 15, q4 = lane >> 4;
    unsigned bk[2][16];
#pragma unroll
    for (int half = 0; half < 2; ++half) {
        f32x4 acc[8];
#pragma unroll
        for (int nt = 0; nt < 8; ++nt) acc[nt] = (f32x4){0.f, 0.f, 0.f, 0.f};
        const bf16* qb = QP + (size_t)(row0 + tl) * 2048 + hh * 256 + half * 128 + 8 * q4;
        const LAS unsigned char* kb = kl + (half * 128 + tl) * 256;
#pragma unroll
        for (int ks = 0; ks < 4; ++ks) { const bf16x8 qf = *(const bf16x8*)(qb + 32 * ks); const int co = ((4 * ks + q4) ^ tl) << 4;
#pragma unroll
            for (int nt = 0; nt < 8; ++nt) { const bf16x8 kf = *(const LAS bf16x8*)(kb + nt * 4096 + co); acc[nt] = mfma16(kf, qf, acc[nt]); } }
        unsigned kx[32];
#pragma unroll
        for (int nt = 0; nt < 8; ++nt)
#pragma unroll
            for (int i = 0; i < 4; ++i) kx[4 * nt + i] = (ord_of(acc[nt][i]) & 0xFFFFFF80u) | (unsigned)(16 * nt + 4 * q4 + i);
        bitonic_sort_desc<32>(kx);
        unsigned top[16];
#pragma unroll
        for (int r = 0; r < 16; ++r) top[r] = kx[r];
        merge_top16(top, 16, lane << 2); merge_top16(top, 32, lane << 2);
#pragma unroll
        for (int r = 0; r < 16; ++r) bk[half][r] = top[r];
    }
    if (q4 == 0) {
#pragma unroll
        for (int r = 0; r < 16; r += 4) { *(LAS v4i*)(TI + tl * 32 + r) = (v4i){(int)(bk[0][r] & 127u), (int)(bk[0][r + 1] & 127u), (int)(bk[0][r + 2] & 127u), (int)(bk[0][r + 3] & 127u)};
            *(LAS v4i*)(TI + tl * 32 + 16 + r) = (v4i){(int)(bk[1][r] & 127u), (int)(bk[1][r + 1] & 127u), (int)(bk[1][r + 2] & 127u), (int)(bk[1][r + 3] & 127u)}; } }
    float v2[16];
#pragma unroll
    for (int j = 0; j < 16; ++j) v2[j] = ord_inv(bk[1][j] & 0xFFFFFF80u);
    unsigned cx[32];
    { int sl = 0;
#pragma unroll
      for (int a = 0; a < 4; ++a) { const unsigned b0 = bk[0][4 * a], b1 = bk[0][4 * a + 1], b2 = bk[0][4 * a + 2], b3 = bk[0][4 * a + 3];
          const float v1s = ord_inv((q4 == 0 ? b0 : q4 == 1 ? b1 : q4 == 2 ? b2 : b3) & 0xFFFFFF80u); const int i = 4 * a + q4;
#pragma unroll
          for (int j = 0; j < 16 / (4 * a + 1); ++j) { const bool ok = (i + 1) * (j + 1) <= 16; cx[sl] = ok ? ((ord_of(v1s + v2[j]) & 0xFFFFFF00u) | (unsigned)(i * 16 + j)) : 0u; ++sl; } }
#pragma unroll
      for (int c = 21; c < 32; ++c) cx[c] = 0u; }
    bitonic_sort_desc<32>(cx);
    unsigned ct[16];
#pragma unroll
    for (int r = 0; r < 16; ++r) ct[r] = cx[r];
    merge_top16(ct, 16, lane << 2); merge_top16(ct, 32, lane << 2);
    LDS_WAIT();
    float sv[16]; float sum = 0.f; const float smax = ord_inv(ct[0] & 0xFFFFFF00u);
#pragma unroll
    for (int r = 0; r < 16; ++r) { sv[r] = __expf(ord_inv(ct[r] & 0xFFFFFF00u) - smax); sum += sv[r]; }
    const float inv = 1.0f / sum;
    unsigned c0, c1, c2, c3; f32x4 go;
    if (q4 == 0) { c0 = ct[0]; c1 = ct[1]; c2 = ct[2]; c3 = ct[3]; go = (f32x4){sv[0], sv[1], sv[2], sv[3]}; }
    else if (q4 == 1) { c0 = ct[4]; c1 = ct[5]; c2 = ct[6]; c3 = ct[7]; go = (f32x4){sv[4], sv[5], sv[6], sv[7]}; }
    else if (q4 == 2) { c0 = ct[8]; c1 = ct[9]; c2 = ct[10]; c3 = ct[11]; go = (f32x4){sv[8], sv[9], sv[10], sv[11]}; }
    else { c0 = ct[12]; c1 = ct[13]; c2 = ct[14]; c3 = ct[15]; go = (f32x4){sv[12], sv[13], sv[14], sv[15]}; }
    const LAS int* ti = TI + tl * 32;
    v4i eo;
    eo[0] = ti[(c0 >> 4) & 15] * 128 + ti[16 + (c0 & 15)]; eo[1] = ti[(c1 >> 4) & 15] * 128 + ti[16 + (c1 & 15)];
    eo[2] = ti[(c2 >> 4) & 15] * 128 + ti[16 + (c2 & 15)]; eo[3] = ti[(c3 >> 4) & 15] * 128 + ti[16 + (c3 & 15)];
    *(v4i*)(EID + (size_t)(row0 + tl) * 128 + hh * 16 + 4 * q4) = eo; *(f32x4*)(EG + (size_t)(row0 + tl) * 128 + hh * 16 + 4 * q4) = go * inv;
    LDS_WAIT();
}

constexpr float U_SCALE = 32.f, V_SCALE = 8.f;
__device__ __forceinline__ void cvt16(const v4u w, float (&f)[16]) {
#pragma unroll
    for (int q = 0; q < 4; ++q) { const f32x2 a = __builtin_amdgcn_cvt_pk_f32_fp8((int)w[q], false), b = __builtin_amdgcn_cvt_pk_f32_fp8((int)w[q], true); f[4 * q] = a.x; f[4 * q + 1] = a.y; f[4 * q + 2] = b.x; f[4 * q + 3] = b.y; }
}
__device__ __forceinline__ float xreduce8(const float (&p)[8], int lane) {
    float q[4], r[2];
    const bool b5 = (lane & 32) != 0, b4 = (lane & 16) != 0, b3 = (lane & 8) != 0;
#pragma unroll
    for (int k = 0; k < 4; ++k) { const float send = b5 ? p[k] : p[k + 4], keep = b5 ? p[k + 4] : p[k]; q[k] = keep + __shfl_xor(send, 32); }
#pragma unroll
    for (int k = 0; k < 2; ++k) { const float send = b4 ? q[k] : q[k + 2], keep = b4 ? q[k + 2] : q[k]; r[k] = keep + __shfl_xor(send, 16); }
    const float send = b3 ? r[0] : r[1], keep = b3 ? r[1] : r[0]; float t = keep + __shfl_xor(send, 8);
    t += __shfl_xor(t, 4); t += __shfl_xor(t, 2); t += __shfl_xor(t, 1);
    return t;
}
constexpr float U6_SCALE = 64.f, V6_SCALE = 16.f;
typedef float v32f __attribute__((ext_vector_type(32)));
typedef float v16f __attribute__((ext_vector_type(16)));
typedef unsigned v6u __attribute__((ext_vector_type(6)));
typedef unsigned v3u __attribute__((ext_vector_type(3)));
__device__ __forceinline__ v6u load6(const unsigned char* p) { const v3u a = *(const v3u*)p, b = *(const v3u*)(p + 12); v6u r; r[0] = a[0]; r[1] = a[1]; r[2] = a[2]; r[3] = b[0]; r[4] = b[1]; r[5] = b[2]; return r; }
__device__ __forceinline__ int mbcnt64(unsigned long long m) { return (int)__builtin_amdgcn_mbcnt_hi((unsigned)(m >> 32), __builtin_amdgcn_mbcnt_lo((unsigned)m, 0u)); }
template <bool FINAL>
__device__ __forceinline__ void peer_gather_wave6(int m0, int step, int tlim, int lane, unsigned char* wsb, int layer, float* YOUT, const float* gprev, const float* gnext, LAS unsigned char* lw) {
#define HB ((bf16*)(wsb + WS_HB))
#define EID ((const int*)(wsb + WS_EID))
#define EG ((const float*)(wsb + WS_EG))
#define SSQ ((const float*)(wsb + WS_SSQ))
#define RROW ((float*)(wsb + WS_RROW))
    const unsigned char* UV = wsb + WS_UV + (size_t)layer * NEXP * 1536;
    int t = m0; if (t >= tlim) return;
    int buf = 0;
#define PG6_SORT(TOK, BUF, FLIP) do { const size_t tb_ = (size_t)(TOK) * 128; const int e0_ = EID[tb_ + lane], e1_ = EID[tb_ + 64 + lane]; const float g0_ = EG[tb_ + lane], g1_ = EG[tb_ + 64 + lane]; \
        const int b0_ = (e0_ >> 10) ^ (FLIP), b1_ = (e1_ >> 10) ^ (FLIP); int off_ = 0, p0_ = 0, p1_ = 0; \
        _Pragma("unroll") for (int k_ = 0; k_ < 16; ++k_) { const unsigned long long m0_ = __ballot(b0_ == k_), m1_ = __ballot(b1_ == k_); const int c0_ = __popcll(m0_), c1_ = __popcll(m1_); \
            p0_ = (b0_ == k_) ? off_ + mbcnt64(m0_) : p0_; p1_ = (b1_ == k_) ? off_ + c0_ + mbcnt64(m1_) : p1_; off_ += c0_ + c1_; } \
        LAS int* se_ = (LAS int*)(lw + (BUF) * 1024); LAS float* sg_ = (LAS float*)(lw + (BUF) * 1024 + 512); se_[p0_] = e0_; sg_[p0_] = g0_; se_[p1_] = e1_; sg_[p1_] = g1_; } while (0)
#define PG6_IDS(BUF, ST, E_, G_) do { E_ = ((const LAS int*)(lw + (BUF) * 1024))[(ST) * 8 + xl]; G_ = ((const LAS float*)(lw + (BUF) * 1024 + 512))[(ST) * 8 + xl]; } while (0)
    const int hw = lane >> 5, li = lane & 31; const bool b4 = (lane & 16) != 0, b3 = (lane & 8) != 0;
#define l4_ (lane << 2)
    const int xl = 4 * ((lane >> 4) & 1) + 2 * ((lane >> 3) & 1) + hw;
    const unsigned char* uvl = UV + 24 * li;
    int flip = 0;
#pragma unroll
    for (int k = 0; k < 8; ++k) { if (t + k * step < tlim) PG6_SORT(t + k * step, k, (k & 1) ? 15 : 0); }
    LDS_WAIT();
    int eid; float gt; PG6_IDS(0, 0, eid, gt);
    v6u ub[4];
#pragma unroll
    for (int k = 0; k < 4; ++k) { const int ea = __builtin_amdgcn_readlane(eid, 8 * k), eb = __builtin_amdgcn_readlane(eid, 32 + 8 * k); ub[k] = load6(uvl + (size_t)(hw ? eb : ea) * 1536); }
    for (;;) {
        const int tn = t + step; const bool more = (tn < tlim) && (buf < 7); const int bufn = buf + 1;
        const float rin = row_rinv(SSQ, (size_t)t, 16) * (1.0f / U6_SCALE);
        float hf[32], acc[32];
        { const char* hp = (const char*)(HB + (size_t)t * D); const unsigned lo64 = pg8::pg8_vo((unsigned)(64 * li));
#pragma unroll
          for (int q = 0; q < 4; ++q) { const v4u h = *(const v4u*)(hp + lo64 + 16 * q); hf[8 * q] = bflo(h.x); hf[8 * q + 1] = bfhi(h.x); hf[8 * q + 2] = bflo(h.y); hf[8 * q + 3] = bfhi(h.y); hf[8 * q + 4] = bflo(h.z); hf[8 * q + 5] = bfhi(h.z); hf[8 * q + 6] = bflo(h.w); hf[8 * q + 7] = bfhi(h.w); } }
#pragma unroll
        for (int i = 0; i < 32; ++i) acc[i] = 0.f;
#pragma unroll 1
        for (int st = 0; st < 16; ++st) {
            v6u vb[4];
#pragma unroll
            for (int k = 0; k < 4; ++k) { const int ea = __builtin_amdgcn_readlane(eid, 8 * k), eb = __builtin_amdgcn_readlane(eid, 32 + 8 * k); vb[k] = load6(uvl + (size_t)(hw ? eb : ea) * 1536 + 768); }
            const bool nx = (st < 15) || more;
            int eid_n = 0; float gt_n = 0.f;
            if (st < 15) PG6_IDS(buf, st + 1, eid_n, gt_n); else if (more) PG6_IDS(bufn, 0, eid_n, gt_n);
            float pd[4];
#pragma unroll
            for (int k = 0; k < 4; ++k) { const v32f f = __builtin_amdgcn_cvt_scalef32_pk32_f32_fp6(ub[k], 1.0f); float d = f[0] * hf[0];
#pragma unroll
                for (int i = 1; i < 32; ++i) d = fmaf(f[i], hf[i], d);
                pd[k] = d; }
            float q0, q1;
            { const float s0 = b4 ? pd[0] : pd[2], k0 = b4 ? pd[2] : pd[0]; q0 = k0 + mk_shx(s0, 16, l4_); const float s1 = b4 ? pd[1] : pd[3], k1 = b4 ? pd[3] : pd[1]; q1 = k1 + mk_shx(s1, 16, l4_); }
            float tot; { const float sd = b3 ? q0 : q1, kp = b3 ? q1 : q0; tot = kp + mk_shx(sd, 8, l4_); }
            tot += mk_shx(tot, 4, l4_); tot += mk_shx(tot, 2, l4_); tot += mk_shx(tot, 1, l4_);
            const float wv = gt * gelu1(tot * rin) * (1.0f / V6_SCALE);
            if (nx) {
#pragma unroll
                for (int k = 0; k < 4; ++k) { const int ea = __builtin_amdgcn_readlane(eid_n, 8 * k), eb = __builtin_amdgcn_readlane(eid_n, 32 + 8 * k); ub[k] = load6(uvl + (size_t)(hw ? eb : ea) * 1536); } }
#pragma unroll
            for (int k = 0; k < 4; ++k) { const float wa = __builtin_bit_cast(float, __builtin_amdgcn_readlane(__builtin_bit_cast(int, wv), 8 * k)), wb = __builtin_bit_cast(float, __builtin_amdgcn_readlane(__builtin_bit_cast(int, wv), 32 + 8 * k));
                const float wk = hw ? wb : wa; const v32f f = __builtin_amdgcn_cvt_scalef32_pk32_f32_fp6(vb[k], 1.0f);
#pragma unroll
                for (int i = 0; i < 32; ++i) acc[i] = fmaf(wk, f[i], acc[i]); }
            eid = eid_n; gt = gt_n;
        }
        const unsigned cb4 = pg8::pg8_vo((unsigned)((32 * li + 16 * hw) * 4));
        f32x4 x[4]; float ss = 0.f;
#pragma unroll
        for (int j = 0; j < 4; ++j) { const f32x4 gp = *(const f32x4*)((const char*)gprev + cb4 + 16 * j);
#pragma unroll
            for (int i = 0; i < 4; ++i) { const int c = 4 * j + i; const float lo = acc[c] + mk_shx(acc[c], 32, l4_), hi = acc[16 + c] + mk_shx(acc[16 + c], 32, l4_);
                const float xv = (hw ? hf[16 + c] : hf[c]) / gp[i] + (hw ? hi : lo); x[j][i] = xv; ss = fmaf(xv, xv, ss); } }
        const float r = 1.0f / sqrtf(wave_sum(ss) * (1.0f / D) + RMS_EPS);
        f32x4 gv[4];
#pragma unroll
        for (int j = 0; j < 4; ++j) gv[j] = *(const f32x4*)((const char*)gnext + cb4 + 16 * j);
        if (FINAL) { char* yo = (char*)(YOUT + (size_t)t * D);
#pragma unroll
            for (int j = 0; j < 4; ++j) *(f32x4*)(yo + cb4 + 16 * j) = x[j] * r * gv[j];
        } else {
            const f32x4 a = x[0] * r * gv[0], bq = x[1] * r * gv[1], c = x[2] * r * gv[2], dq = x[3] * r * gv[3];
            v4u w0, w1;
            w0.x = pk2(a[0], a[1]); w0.y = pk2(a[2], a[3]); w0.z = pk2(bq[0], bq[1]); w0.w = pk2(bq[2], bq[3]);
            w1.x = pk2(c[0], c[1]); w1.y = pk2(c[2], c[3]); w1.z = pk2(dq[0], dq[1]); w1.w = pk2(dq[2], dq[3]);
            char* ho = (char*)(HB + (size_t)t * D); const unsigned cb2 = cb4 >> 1; *(v4u*)(ho + cb2) = w0; *(v4u*)(ho + cb2 + 16) = w1;
            if (lane == 0) RROW[t] = r;
        }
        if (!more) break;
        t = tn; buf = bufn;
    }
#undef PG6_SORT
#undef PG6_IDS
#undef l4_
#undef HB
#undef EID
#undef EG
#undef SSQ
#undef RROW
}

template <bool FINAL>
__device__ __forceinline__ void peer_gather_wg2(int t0, int tid, unsigned char* wsb, int layer, float* YOUT, const float* gprev, const float* gnext, LAS float* PL) {
#define HB ((bf16*)(wsb + WS_HB))
#define EID ((const int*)(wsb + WS_EID))
#define EG ((const float*)(wsb + WS_EG))
#define SSQ ((const float*)(wsb + WS_SSQ))
#define RROW ((float*)(wsb + WS_RROW))
    const unsigned char* UV = wsb + WS_UV + (size_t)layer * NEXP * 1536;
    const int lane = tid & 63, w = tid >> 6;
    const int hw = lane >> 5, li = lane & 31; const bool b4 = (lane & 16) != 0, b3 = (lane & 8) != 0;
    const int xl = 4 * ((lane >> 4) & 1) + 2 * ((lane >> 3) & 1) + hw;
    const unsigned char* uvl = UV + 24 * li;
#pragma unroll 1
    for (int k = 0; k < 2; ++k) { const int t = t0 + k;
        const float rin = row_rinv(SSQ, (size_t)t, 16) * (1.0f / U6_SCALE);
        float hf[32], acc[32];
        { const v4u* hp = (const v4u*)(HB + (size_t)t * D + 32 * li);
#pragma unroll
          for (int q = 0; q < 4; ++q) { const v4u h = hp[q]; hf[8 * q] = bflo(h.x); hf[8 * q + 1] = bfhi(h.x); hf[8 * q + 2] = bflo(h.y); hf[8 * q + 3] = bfhi(h.y); hf[8 * q + 4] = bflo(h.z); hf[8 * q + 5] = bfhi(h.z); hf[8 * q + 6] = bflo(h.w); hf[8 * q + 7] = bfhi(h.w); } }
#pragma unroll
        for (int i = 0; i < 32; ++i) acc[i] = 0.f;
#pragma unroll 1
        for (int st = 0; st < 2; ++st) {
            const size_t ib = (size_t)t * 128 + w * 16 + st * 8;
            const int eid = EID[ib + xl]; const float gt = EG[ib + xl];
            v6u ub[4], vb[4];
#pragma unroll
            for (int kk = 0; kk < 4; ++kk) { const int ea = __builtin_amdgcn_readlane(eid, 8 * kk), eb = __builtin_amdgcn_readlane(eid, 32 + 8 * kk); const unsigned char* p = uvl + (size_t)(hw ? eb : ea) * 1536; ub[kk] = load6(p); vb[kk] = load6(p + 768); }
            float pd[4];
#pragma unroll
            for (int kk = 0; kk < 4; ++kk) { const v32f f = __builtin_amdgcn_cvt_scalef32_pk32_f32_fp6(ub[kk], 1.0f); float d = f[0] * hf[0];
#pragma unroll
                for (int i = 1; i < 32; ++i) d = fmaf(f[i], hf[i], d);
                pd[kk] = d; }
            float q0, q1;
            { const float s0 = b4 ? pd[0] : pd[2], k0 = b4 ? pd[2] : pd[0]; q0 = k0 + __shfl_xor(s0, 16); const float s1 = b4 ? pd[1] : pd[3], k1 = b4 ? pd[3] : pd[1]; q1 = k1 + __shfl_xor(s1, 16); }
            float tot; { const float sd = b3 ? q0 : q1, kp = b3 ? q1 : q0; tot = kp + __shfl_xor(sd, 8); }
            tot += __shfl_xor(tot, 4); tot += __shfl_xor(tot, 2); tot += __shfl_xor(tot, 1);
            const float wv = gt * gelu1(tot * rin) * (1.0f / V6_SCALE);
#pragma unroll
            for (int kk = 0; kk < 4; ++kk) { const float wa = __builtin_bit_cast(float, __builtin_amdgcn_readlane(__builtin_bit_cast(int, wv), 8 * kk)), wb = __builtin_bit_cast(float, __builtin_amdgcn_readlane(__builtin_bit_cast(int, wv), 32 + 8 * kk));
                const float wk = hw ? wb : wa; const v32f f = __builtin_amdgcn_cvt_scalef32_pk32_f32_fp6(vb[kk], 1.0f);
#pragma unroll
                for (int i = 0; i < 32; ++i) acc[i] = fmaf(wk, f[i], acc[i]); }
        }
        LAS float* pl = PL + ((k * 8 + w) * D + 32 * li + 16 * hw);
#pragma unroll
        for (int j = 0; j < 4; ++j) { f32x4 o;
#pragma unroll
            for (int i = 0; i < 4; ++i) { const int c = 4 * j + i; const float lo = acc[c] + __shfl_xor(acc[c], 32), hi = acc[16 + c] + __shfl_xor(acc[16 + c], 32); o[i] = hw ? hi : lo; }
            *(LAS f32x4*)(pl + 4 * j) = o; }
    }
    __syncthreads();
    LAS float* ssw = PL + 2 * 8 * D;
    float xs[2][2];
#pragma unroll
    for (int k = 0; k < 2; ++k) { const int c0 = 128 * w + 2 * lane; const unsigned hw2 = *(const unsigned*)(HB + (size_t)(t0 + k) * D + c0); const f32x2 gp = *(const f32x2*)(gprev + c0); float a0 = bflo(hw2) / gp.x, a1 = bfhi(hw2) / gp.y;
#pragma unroll
        for (int ww = 0; ww < 8; ++ww) { const f32x2 pv = *(const LAS f32x2*)(PL + (k * 8 + ww) * D + c0); a0 += pv.x; a1 += pv.y; }
        xs[k][0] = a0; xs[k][1] = a1; const float ss = wave_sum(a0 * a0 + a1 * a1); if (lane == 0) ssw[k * 8 + w] = ss; }
    __syncthreads();
#pragma unroll
    for (int k = 0; k < 2; ++k) { const int c0 = 128 * w + 2 * lane; float tot = 0.f;
#pragma unroll
        for (int ww = 0; ww < 8; ++ww) tot += ssw[k * 8 + ww];
        const float r = 1.0f / sqrtf(tot * (1.0f / D) + RMS_EPS); const f32x2 gv = *(const f32x2*)(gnext + c0);
        if (FINAL) { *(f32x2*)(YOUT + (size_t)(t0 + k) * D + c0) = (f32x2){xs[k][0] * r * gv.x, xs[k][1] * r * gv.y}; }
        else { *(unsigned*)(HB + (size_t)(t0 + k) * D + c0) = pk2(xs[k][0] * r * gv.x, xs[k][1] * r * gv.y); if (tid == 0) RROW[t0 + k] = r; } }
    __syncthreads();
}
#undef HB
#undef EID
#undef EG
#undef SSQ
#undef RROW

enum { SK_GLU = 0, SK_RES = 1, SK_B16 = 2, SK_WINV = 3, SK_WINB = 4 };
struct SkArgs { const bf16* A; const bf16* W; bf16* hbo; float* ssq; const float* gnext; const float* gprev; const float* rprev; const float* xs; bf16* O; int ldc; int nslots; bf16* v1; bf16* b1; float* out; };
constexpr int SK_LDS_FLOATS = 8 * 32 * 68;
template <int MODE>
__device__ __forceinline__ void skinny_tile(const SkArgs& a, int rb, int cb, LAS float* P, int tid) {
    constexpr bool PAIRED = (MODE == SK_GLU || MODE == SK_WINV);
    const int lane = tid & 63, w = tid >> 6, tl = lane & 15, q4 = lane >> 4;
    const int g0 = PAIRED ? ((cb >> 2) * 256 + (cb & 3) * 32) : 64 * cb;
    f32x4 acc[2][4];
#pragma unroll
    for (int mt = 0; mt < 2; ++mt)
#pragma unroll
        for (int nt = 0; nt < 4; ++nt) acc[mt][nt] = (f32x4){0.f, 0.f, 0.f, 0.f};
    const bf16* ap = a.A + (size_t)(TP + 32 * rb + tl) * D + 128 * w + 8 * q4;
    const bf16* wp = a.W + (size_t)(g0 + tl) * D + 128 * w + 8 * q4;
    bf16x8 af[4][2], bfr[4][4];
#pragma unroll
    for (int ks = 0; ks < 4; ++ks) {
#pragma unroll
        for (int mt = 0; mt < 2; ++mt) af[ks][mt] = *(const bf16x8*)(ap + (size_t)(16 * mt) * D + 32 * ks);
#pragma unroll
        for (int nt = 0; nt < 4; ++nt) { const int wro = PAIRED ? ((nt >> 1) * 128 + (nt & 1) * 16) : 16 * nt; bfr[ks][nt] = *(const bf16x8*)(wp + (size_t)wro * D + 32 * ks); } }
    const int row = tid >> 4, c4 = (tid & 15) * 4; const size_t grow = (size_t)TP + 32 * rb + row;
    const int pcol = (cb >> 2) * 128 + (cb & 3) * 32 + (c4 & 31), col = 64 * cb + c4;
    f32x4 e0 = {0.f, 0.f, 0.f, 0.f}, e1 = {0.f, 0.f, 0.f, 0.f}; float ri = 0.f;
    if (MODE == SK_GLU) { e0 = *(const f32x4*)(a.xs + (size_t)(32 * rb + row) * D + pcol); e1 = *(const f32x4*)(a.gnext + pcol); }
    if (MODE == SK_RES) { const v2u h = *(const v2u*)(a.hbo + grow * D + col); const f32x4 gp = *(const f32x4*)(a.gprev + col); const float rr = a.rprev ? 1.0f / a.rprev[grow] : 1.0f;
        e0 = (f32x4){bflo(h.x) / gp[0], bfhi(h.x) / gp[1], bflo(h.y) / gp[2], bfhi(h.y) / gp[3]} * rr; e1 = *(const f32x4*)(a.gnext + col); }
    if (MODE == SK_B16) ri = row_rinv(a.ssq, grow, a.nslots);
#pragma unroll
    for (int ks = 0; ks < 4; ++ks)
#pragma unroll
        for (int nt = 0; nt < 4; ++nt)
#pragma unroll
            for (int mt = 0; mt < 2; ++mt) acc[mt][nt] = mfma16(bfr[ks][nt], af[ks][mt], acc[mt][nt]);
#pragma unroll
    for (int mt = 0; mt < 2; ++mt)
#pragma unroll
        for (int nt = 0; nt < 4; ++nt) *(LAS f32x4*)(P + (w * 32 + 16 * mt + tl) * 68 + 16 * nt + 4 * q4) = acc[mt][nt];
    __syncthreads();
    f32x4 v = {0.f, 0.f, 0.f, 0.f}, vb = {0.f, 0.f, 0.f, 0.f};
#pragma unroll
    for (int ww = 0; ww < 8; ++ww) v += *(const LAS f32x4*)(P + (ww * 32 + row) * 68 + c4);
    if (PAIRED && c4 < 32) {
#pragma unroll
        for (int ww = 0; ww < 8; ++ww) vb += *(const LAS f32x4*)(P + (ww * 32 + row) * 68 + c4 + 32); }
    if (MODE == SK_GLU) {
        float ss = 0.f;
        if (c4 < 32) { f32x4 o;
#pragma unroll
            for (int j = 0; j < 4; ++j) { o[j] = e0[j] + v[j] / (1.0f + __expf(-vb[j])); ss = fmaf(o[j], o[j], ss); }
            const f32x4 hg = o * e1; v2u wv; wv.x = pk2(hg[0], hg[1]); wv.y = pk2(hg[2], hg[3]); *(v2u*)(a.hbo + grow * D + pcol) = wv; }
        ss += __shfl_xor(ss, 1); ss += __shfl_xor(ss, 2); ss += __shfl_xor(ss, 4);
        if ((tid & 15) == 0) a.ssq[grow * 32 + cb] = ss;
    } else if (MODE == SK_RES) {
        const f32x4 o = e0 + v;
        float ss = o[0] * o[0] + o[1] * o[1] + o[2] * o[2] + o[3] * o[3];
        const f32x4 hg = o * e1; v2u wv; wv.x = pk2(hg[0], hg[1]); wv.y = pk2(hg[2], hg[3]); *(v2u*)(a.hbo + grow * D + col) = wv;
        ss += __shfl_xor(ss, 1); ss += __shfl_xor(ss, 2); ss += __shfl_xor(ss, 4); ss += __shfl_xor(ss, 8);
        if ((tid & 15) == 0) a.ssq[grow * 32 + cb] = ss;
    } else if (MODE == SK_B16) {
        const f32x4 o = v * ri; v2u wv; wv.x = pk2(o[0], o[1]); wv.y = pk2(o[2], o[3]);
        *(v2u*)(a.O + grow * a.ldc + col) = wv;
    } else if (MODE == SK_WINV) {
        if (c4 < 32) { const f32x4 vv = v * vb; v2u wv; wv.x = pk2(vv[0], vv[1]); wv.y = pk2(vv[2], vv[3]); *(v2u*)(a.v1 + grow * D + pcol) = wv;
            const int rs = 32 * rb + row, s = rs & 3; if (s >= 2) *(f32x4*)(a.out + O_CS + ((size_t)(rs >> 2) * 2 + (s - 2)) * D + pcol) = vv; }
    } else {
        v2u wv; wv.x = pk2(v[0], v[1]); wv.y = pk2(v[2], v[3]); *(v2u*)(a.b1 + grow * D + col) = wv;
    }
    __syncthreads();
}
#ifndef REP_P0
#define REP_P0 1
#endif
#ifndef REP_P1
#define REP_P1 1
#endif
#ifndef REP_GEMM
#define REP_GEMM 1
#endif
#ifndef REP_ATTN
#define REP_ATTN 1
#endif
#ifndef REP_PSEL
#define REP_PSEL 1
#endif
#ifndef REP_THIN
#define REP_THIN 1
#endif
#ifndef REP_SK
#define REP_SK 1
#endif
#ifndef REP_KV
#define REP_KV 1
#endif
#ifndef REP_S5P
#define REP_S5P 1
#endif
#ifndef REP_S5S
#define REP_S5S 1
#endif
struct Args { const float* in[N_IN]; float* out; unsigned char* ws; int ph_lo, ph_hi; };
__device__ __forceinline__ int opaque_idx(int k) { int r; asm volatile("s_mov_b32 %0, %1" : "=s"(r) : "s"(k)); return r; }
#define INP(k) ((const float*)(const GAS float*)(args.in[opaque_idx(k)]))
__device__ __forceinline__ unsigned char* opq_p(unsigned char* p) { GAS unsigned char* g = (GAS unsigned char*)p; asm volatile("" : "+s"(g)); return (unsigned char*)g; }
__device__ __forceinline__ float* opq_f(float* p) { GAS float* g = (GAS float*)p; asm volatile("" : "+s"(g)); return (float*)g; }
__device__ __forceinline__ int opq_i(int v) { asm volatile("" : "+s"(v)); return v; }
__device__ __forceinline__ int opq_v(int v) { asm volatile("" : "+v"(v)); return v; }
#define PH_LOCALS unsigned char* ws = opq_p(args.ws); float* out = opq_f(args.out); (void)ws; (void)out; \
    const int wave = opq_i(wave0), lane = opq_v(LANE_ID()), tid = wave * 64 + lane, G = opq_i((int)gridDim.x), bx = opq_i((int)blockIdx.x), gw = bx * NWAVES + wave, NGW = G * NWAVES; (void)lane; (void)gw; (void)NGW;
#define WALL ((bf16*)(ws + WS_WALL))
#define KEYS ((bf16*)(ws + WS_KEYS))
#define BBW ((bf16*)(ws + WS_BBW))
#define CCW ((bf16*)(ws + WS_CCW))
#define LBc ((float*)(ws + WS_LB))
#define MEMB ((bf16*)(ws + WS_MEMB))
#define KB ((bf16*)(ws + WS_KB))
#define VT ((bf16*)(ws + WS_VT))
#define EID ((int*)(ws + WS_EID))
#define EG ((float*)(ws + WS_EG))
#define HB ((bf16*)(ws + WS_HB))
#define ZB ((bf16*)(ws + WS_ZB))
#define QB ((bf16*)(ws + WS_QB))
#define QP ((bf16*)(ws + WS_QP))
#define B1 ((bf16*)(ws + WS_B1))
#define V1 ((bf16*)(ws + WS_V1))
#define UVT ((unsigned char*)(ws + WS_UV))
#define YOUT (out + O_Y)
#define RROWB ((float*)(ws + WS_RROW))
#define SSQB ((float*)(ws + WS_SSQ))

constexpr int N_PHASES = 18;

#define TABLE_CONVERT(LAYER, W0, NW) do { const float* sU = INP(I_PU) + (size_t)(LAYER) * NEXP * D; const float* sV = INP(I_PV) + (size_t)(LAYER) * NEXP * D; unsigned char* dst = UVT + (size_t)(LAYER) * NEXP * 1536; \
            const size_t ng = (size_t)NEXP * 32, st_ = (size_t)(NW) * 64; \
            for (size_t i0 = (size_t)(W0) * 64 + lane; i0 < 2 * ng; i0 += 4 * st_) { f32x4 xa[4][8]; bool ok[4]; \
                _Pragma("unroll") for (int h = 0; h < 4; ++h) { const size_t i = i0 + h * st_; ok[h] = i < 2 * ng; if (ok[h]) { const bool isv = i >= ng; const size_t j = isv ? i - ng : i; const f32x4* s = (const f32x4*)((isv ? sV : sU) + (j >> 5) * D + 32 * (int)(j & 31)); \
                    _Pragma("unroll") for (int q = 0; q < 8; ++q) xa[h][q] = s[q]; } } \
                _Pragma("unroll") for (int h = 0; h < 4; ++h) if (ok[h]) { const size_t i = i0 + h * st_; const bool isv = i >= ng; const size_t j = isv ? i - ng : i; const size_t row = j >> 5; const int c = (int)(j & 31); const float sc = isv ? V6_SCALE : U6_SCALE; v16f a, b; \
                    _Pragma("unroll") for (int q = 0; q < 8; ++q) { const f32x4 x0 = xa[h][q] * sc; a[2 * q] = x0[0]; b[2 * q] = x0[1]; a[2 * q + 1] = x0[2]; b[2 * q + 1] = x0[3]; } \
                    const v6u w = __builtin_amdgcn_cvt_scalef32_2xpk16_fp6_f32(a, b, 1.0f); \
                    unsigned char* dp = dst + (row * 2 + (isv ? 1 : 0)) * 768 + 24 * c; \
                    *(v2u*)dp = (v2u){w[0], w[1]}; *(v2u*)(dp + 8) = (v2u){w[2], w[3]}; *(v2u*)(dp + 16) = (v2u){w[4], w[5]}; } } } while (0)
__global__ void __launch_bounds__(NWAVES * 64, 2) mk_fwd(Args args) {
    extern __shared__ __attribute__((aligned(16))) unsigned char lds[];
    LAS unsigned char* L = (LAS unsigned char*)lds;
    volatile LAS unsigned* MISC = (volatile LAS unsigned*)(L + MISC_OFF);
    const int wave0 = __builtin_amdgcn_readfirstlane((int)threadIdx.x >> 6);
#define LANE_ID() mk_lane_id()
    const int tid0 = wave0 * 64 + LANE_ID();
    gu32* ctl = (gu32*)(args.ws + WS_CTL);

    for (int u = tid0; u < (LDS_BYTES - LDSCTL_OFF) / 4; u += NWAVES * 64) ((LAS unsigned*)(L + LDSCTL_OFF))[u] = 0u;
    __syncthreads();
    XcdBarrier bar = xcd_barrier_post((unsigned*)(ctl + CW_BAR), MISC + 8);
    const int lo = args.ph_lo, hi = args.ph_hi;
#define IN(k) (opq_i(lo) <= (k) && (k) < opq_i(hi))
#ifdef PROBE_SUB
    unsigned long long ps_prev = 0ull, ps_dt = 0ull;
#define PS_STAMP(k) do { const unsigned long long now_ = __builtin_amdgcn_s_memrealtime(); if ((k) == (PROBE_SUB)) ps_dt = now_ - ps_prev; ps_prev = now_; } while (0)
#else
#define PS_STAMP(k) do { } while (0)
#endif
#ifdef PROBE_PHASE
    unsigned long long pp_prev = __builtin_amdgcn_s_memrealtime(), pp_dt = 0ull;
#define PP_STAMP(k) do { const unsigned long long now_ = __builtin_amdgcn_s_memrealtime(); if ((k) == (PROBE_PHASE)) pp_dt = now_ - pp_prev; pp_prev = now_; } while (0)
#else
#define PP_STAMP(k) do { } while (0)
#endif
#define SEAM(k) do { if (IN(k) && IN((k) + 1)) xcd_barrier(bar); PP_STAMP(k); } while (0)
#define GEMM_PHASE(EpiT, Aptr, Brow, Mrows, Ncols, Eobj) do { pg8::Gemm g_{(const pg8::bf16_t*)(Aptr), (const pg8::bf16_t*)(WALL + (size_t)(Brow) * D), (Mrows), (Ncols), D}; \
        pg8::StaticOrder S_; S_.init((Mrows), (Ncols), G, bx); pg8::gemm_phase<EpiT, pg8::StaticOrder, true, true>(L + RING_OFF, g_, S_, Eobj); } while (0)

    if (IN(0)) { PH_LOCALS
      for (int rep_ = 0; rep_ < REP_P0; ++rep_) {
        PS_STAMP(-1);
        LAS float* scr = (LAS float*)(L + RING_OFF + wave * 16896);
#define TR_DECODE(IT, SRC, NN, SN0) do { int r = ((IT) >> 4) * 32; \
            if (r < R_GLU) { const int mat = r >> 10, l = mat >> 1; SRC = ((mat & 1) ? INP(I_WV) : INP(I_WK)) + (size_t)l * D * D; NN = D; SN0 = r & 1023; } \
            else if (r < R_Q) { r -= R_GLU; SRC = INP(I_WGLU); NN = 2 * D; SN0 = ((r >> 7) & 1) * 1024 + (r >> 8) * 128 + (r & 127); } \
            else if (r < R_O) { r -= R_Q; SRC = INP(I_WQ) + (size_t)(r >> 10) * D * D; NN = D; SN0 = r & 1023; } \
            else if (r < R_PQ) { r -= R_O; SRC = INP(I_WO) + (size_t)(r >> 10) * D * D; NN = D; SN0 = r & 1023; } \
            else if (r < R_WIN) { r -= R_PQ; SRC = INP(I_PWQ) + (size_t)(r >> 11) * D * 2048; NN = 2048; SN0 = r & 2047; } \
            else if (r < R_WOUT) { r -= R_WIN; SRC = INP(I_WIN); NN = 3 * D; SN0 = (r < 2048) ? (1024 + ((r >> 7) & 1) * 1024 + (r >> 8) * 128 + (r & 127)) : (r - 2048); } \
            else { r -= R_WOUT; SRC = INP(I_WOUT); NN = D; SN0 = r; } } while (0)
        for (int it = gw; it < (R_END / 32) * 16; it += 2 * NGW) { const int it2 = it + NGW; const bool two = it2 < (R_END / 32) * 16;
            const float* s0; int n0, c0; TR_DECODE(it, s0, n0, c0); const float* s1 = s0; int n1 = n0, c1 = c0; if (two) TR_DECODE(it2, s1, n1, c1);
            p0_transpose_item2(s0, n0, c0, WALL + (size_t)((it >> 4) * 32) * D, (it & 15) * 64, two, s1, n1, c1, WALL + (size_t)((it2 >> 4) * 32) * D, (it2 & 15) * 64, scr, lane);
        }
#undef TR_DECODE
        PS_STAMP(0);
        TABLE_CONVERT(0, gw, NGW);
        PS_STAMP(1);
        {
            const int gt = bx * 512 + tid, NT = G * 512;
            for (int i = gt; i < 2 * 2 * 128 * 128; i += NT) { const int l = i >> 15, hf = (i >> 14) & 1, r = i & 16383; const float* k1 = INP(I_K1); const float* k2 = INP(I_K2); KEYS[i] = (bf16)f2bf((hf ? k2 : k1)[(size_t)l * 16384 + r]); }
            { const f32x4* mp = (const f32x4*)INP(I_MEM); for (int i = gt; i < MROWS * D / 4; i += 2 * NT) { const int i2 = i + NT; const f32x4 a = mp[i], b = (i2 < MROWS * D / 4) ? mp[i2] : a; v2u w; w.x = pk2(a[0], a[1]); w.y = pk2(a[2], a[3]); ((v2u*)MEMB)[i] = w;
                if (i2 < MROWS * D / 4) { v2u w2; w2.x = pk2(b[0], b[1]); w2.y = pk2(b[2], b[3]); ((v2u*)MEMB)[i2] = w2; } } }
            { const float* pare = INP(I_ARE); const float* paim = INP(I_AIM); const float* pldt = INP(I_LDT); const float* pbre = INP(I_BRE); const float* pbim = INP(I_BIM); const float* pcre = INP(I_CRE); const float* pcim = INP(I_CIM);
              for (int j = gt; j < 64 * 64 * 16; j += NT) { const int c = j >> 12, i = j & 4095, g = i >> 6, p = i & 63;
                const double are = pare[i], aim = paim[i], dt = exp((double)pldt[g]);
                const double mag = exp(are * dt), ang = aim * dt, lbr = mag * cos(ang), lbi = mag * sin(ang), den = are * are + aim * aim;
                const double fr = ((lbr - 1.0) * are + lbi * aim) / den, fi = (lbi * are - (lbr - 1.0) * aim) / den;
                if (c == 0) { LBc[2 * i] = (float)lbr; LBc[2 * i + 1] = (float)lbi; }
                const double br = pbre[(size_t)i * 16 + c], bi = pbim[(size_t)i * 16 + c];
                BBW[((size_t)g * 128 + p) * 16 + c] = (bf16)f2bf((float)(fr * br - fi * bi)); BBW[((size_t)g * 128 + 64 + p) * 16 + c] = (bf16)f2bf((float)(fr * bi + fi * br));
                CCW[((size_t)g * 16 + c) * 128 + p] = (bf16)f2bf(pcre[((size_t)g * 16 + c) * 64 + p]); CCW[((size_t)g * 16 + c) * 128 + 64 + p] = (bf16)f2bf(-pcim[((size_t)g * 16 + c) * 64 + p]); } }
        }
        PS_STAMP(2);
        { const float* xp_ = INP(I_XP); const float* xs_ = INP(I_XS); const float* gm_ = INP(I_NMIX);
          for (int m = gw; m < T; m += 2 * NGW) { const int m2 = m + NGW; const bool two = m2 < T;
              rms_row2_bf16(m < TP ? xp_ + (size_t)m * D : xs_ + (size_t)(m - TP) * D, two ? (m2 < TP ? xp_ + (size_t)m2 * D : xs_ + (size_t)(m2 - TP) * D) : nullptr, gm_, HB + (size_t)m * D, HB + (size_t)m2 * D, lane); } }
        PS_STAMP(3);
      }
    }
    SEAM(0);
    if (IN(1)) { PH_LOCALS
      for (int rep_ = 0; rep_ < REP_P1; ++rep_) {
        { EpiKV E{out, KB, VT}; for (int r2_ = 0; r2_ < REP_KV; ++r2_) GEMM_PHASE(EpiKV, MEMB, R_KV, MROWS, 4096, E); }
        {
            const int half = G / 2, per = (NB * 64 - half + (G - half) - 1) / (G - half);
            const int s_lo = (bx < half) ? bx : half + (bx - half) * per, s_hi = (bx < half) ? bx + 1 : min(NB * 64, s_lo + per);
            for (int r2_ = 0; r2_ < REP_S5P; ++r2_)
#pragma unroll 1
            for (int sq = s_lo; sq < s_hi; ++sq) s5_prompt_seq(HB, ZB, BBW, CCW, LBc, INP(I_SD), L + RING_OFF, tid, sq >> 6, sq & 63, out + O_SRP, out + O_SIP);
            if (bx < half) TABLE_CONVERT(1, bx * NWAVES + wave, half * NWAVES);
            LAS float* ST = (LAS float*)(L + RING_OFF + wave * S5_ST_BYTES);
            for (int r2_ = 0; r2_ < REP_S5S; ++r2_)
#pragma unroll 1
            for (int tk = gw; tk < (DB / 4) * 64; tk += NGW) { const int b0 = (tk >> 6) * 4, g = tk & 63; float sr = 0.f, si = 0.f;
                const float lbr = LBc[(g * 64 + lane) * 2], lbi = LBc[(g * 64 + lane) * 2 + 1];
                s5_run<true, true>(HB, ZB, BBW, CCW, INP(I_SD), ST, lane, g, TP + 4 * b0, 1, b0, INP(I_SRE), INP(I_SIM), out + O_SRS, out + O_SIS, lbr, lbi, sr, si); }
        }
        if (REP_P1 > 1) __syncthreads();
      }
    }
    SEAM(1);
    if (IN(2)) { PH_LOCALS
        { EpiGLU E{INP(I_XP), HB, SSQB, INP(I_NMEM)}; for (int rep_ = 0; rep_ < REP_GEMM; ++rep_) GEMM_PHASE(EpiGLU, ZB, R_GLU, TP, 2048, E); }
        { SkArgs sa{}; sa.A = ZB; sa.W = WALL + (size_t)R_GLU * D; sa.hbo = HB; sa.ssq = SSQB; sa.gnext = INP(I_NMEM); sa.xs = INP(I_XS);
for (int rep_ = 0; rep_ < REP_SK; ++rep_)
#pragma unroll 1
          for (int tk = bx; tk < 16 * 32; tk += G) skinny_tile<SK_GLU>(sa, tk & 15, tk >> 4, (LAS float*)(L + RING_OFF), tid); }
    }
    SEAM(2);
#pragma unroll 1
    for (int layer = 0; layer < 2; ++layer) {
        const int pb = layer == 0 ? 3 : 12;
        if (layer == 1) {
            if (IN(9)) { PH_LOCALS
                { EpiWin E{B1, V1, out}; for (int rep_ = 0; rep_ < REP_GEMM; ++rep_) GEMM_PHASE(EpiWin, HB, R_WIN, TP, 3072, E); }
                { SkArgs sa{}; sa.A = HB; sa.W = WALL + (size_t)R_WIN * D; sa.v1 = V1; sa.out = out;
for (int rep_ = 0; rep_ < REP_SK; ++rep_)
#pragma unroll 1
                  for (int tk = bx; tk < 16 * 32; tk += G) skinny_tile<SK_WINV>(sa, tk & 15, tk >> 4, (LAS float*)(L + RING_OFF), tid);
                  sa.W = WALL + (size_t)(R_WIN + 2048) * D; sa.b1 = B1;
for (int rep_ = 0; rep_ < REP_SK; ++rep_)
#pragma unroll 1
                  for (int tk = bx; tk < 16 * 16; tk += G) skinny_tile<SK_WINB>(sa, tk & 15, tk >> 4, (LAS float*)(L + RING_OFF), tid); }
            }
            SEAM(9);
            if (IN(10)) { PH_LOCALS
                const float* cw = INP(I_CW);
                for (int m = gw; m < T; m += NGW) {
                    const bool smp = m >= TP; const int s = smp ? ((m - TP) & 3) : (m & (SEQ - 1));
#pragma unroll
                    for (int hh = 0; hh < 2; ++hh) { const int c0 = hh * 512 + 8 * lane;
                        const v4u bw = *(const v4u*)(B1 + (size_t)m * D + c0), v0 = *(const v4u*)(V1 + (size_t)m * D + c0);
                        float vm1[8], vm2[8];
                        if (s >= 1) { const v4u t1 = *(const v4u*)(V1 + (size_t)(m - 1) * D + c0); vm1[0] = bflo(t1.x); vm1[1] = bfhi(t1.x); vm1[2] = bflo(t1.y); vm1[3] = bfhi(t1.y); vm1[4] = bflo(t1.z); vm1[5] = bfhi(t1.z); vm1[6] = bflo(t1.w); vm1[7] = bfhi(t1.w); }
                        else if (smp) { const float* sp = INP(I_SCONV) + ((size_t)((m - TP) >> 2) * 2 + 1) * D + c0; const f32x4 a = *(const f32x4*)sp, b = *(const f32x4*)(sp + 4); vm1[0] = a[0]; vm1[1] = a[1]; vm1[2] = a[2]; vm1[3] = a[3]; vm1[4] = b[0]; vm1[5] = b[1]; vm1[6] = b[2]; vm1[7] = b[3]; }
                        else {
#pragma unroll
                            for (int i = 0; i < 8; ++i) vm1[i] = 0.f; }
                        if (s >= 2) { const v4u t2 = *(const v4u*)(V1 + (size_t)(m - 2) * D + c0); vm2[0] = bflo(t2.x); vm2[1] = bfhi(t2.x); vm2[2] = bflo(t2.y); vm2[3] = bfhi(t2.y); vm2[4] = bflo(t2.z); vm2[5] = bfhi(t2.z); vm2[6] = bflo(t2.w); vm2[7] = bfhi(t2.w); }
                        else if (smp) { const float* sp = INP(I_SCONV) + ((size_t)((m - TP) >> 2) * 2 + s) * D + c0; const f32x4 a = *(const f32x4*)sp, b = *(const f32x4*)(sp + 4); vm2[0] = a[0]; vm2[1] = a[1]; vm2[2] = a[2]; vm2[3] = a[3]; vm2[4] = b[0]; vm2[5] = b[1]; vm2[6] = b[2]; vm2[7] = b[3]; }
                        else {
#pragma unroll
                            for (int i = 0; i < 8; ++i) vm2[i] = 0.f; }
                        float vc[8], bg[8], w0[8], w1[8], w2[8];
                        vc[0] = bflo(v0.x); vc[1] = bfhi(v0.x); vc[2] = bflo(v0.y); vc[3] = bfhi(v0.y); vc[4] = bflo(v0.z); vc[5] = bfhi(v0.z); vc[6] = bflo(v0.w); vc[7] = bfhi(v0.w);
                        bg[0] = bflo(bw.x); bg[1] = bfhi(bw.x); bg[2] = bflo(bw.y); bg[3] = bfhi(bw.y); bg[4] = bflo(bw.z); bg[5] = bfhi(bw.z); bg[6] = bflo(bw.w); bg[7] = bfhi(bw.w);
                        { const f32x4 a = *(const f32x4*)(cw + c0), b = *(const f32x4*)(cw + c0 + 4); w0[0] = a[0]; w0[1] = a[1]; w0[2] = a[2]; w0[3] = a[3]; w0[4] = b[0]; w0[5] = b[1]; w0[6] = b[2]; w0[7] = b[3]; }
                        { const f32x4 a = *(const f32x4*)(cw + D + c0), b = *(const f32x4*)(cw + D + c0 + 4); w1[0] = a[0]; w1[1] = a[1]; w1[2] = a[2]; w1[3] = a[3]; w1[4] = b[0]; w1[5] = b[1]; w1[6] = b[2]; w1[7] = b[3]; }
                        { const f32x4 a = *(const f32x4*)(cw + 2 * D + c0), b = *(const f32x4*)(cw + 2 * D + c0 + 4); w2[0] = a[0]; w2[1] = a[1]; w2[2] = a[2]; w2[3] = a[3]; w2[4] = b[0]; w2[5] = b[1]; w2[6] = b[2]; w2[7] = b[3]; }
                        float r[8];
#pragma unroll
                        for (int i = 0; i < 8; ++i) r[i] = bg[i] * (w0[i] * vm2[i] + w1[i] * vm1[i] + w2[i] * vc[i]);
                        v4u ow; ow.x = pk2(r[0], r[1]); ow.y = pk2(r[2], r[3]); ow.z = pk2(r[4], r[5]); ow.w = pk2(r[6], r[7]);
                        *(v4u*)(ZB + (size_t)m * D + c0) = ow; }
                }
            }
            SEAM(10);
            if (IN(11)) { PH_LOCALS
                { EpiRes E{HB, SSQB, INP(I_NMEM) + D, INP(I_NMIX) + D, RROWB}; GEMM_PHASE(EpiRes, ZB, R_WOUT, TP, 1024, E); }
                { SkArgs sa{}; sa.A = ZB; sa.W = WALL + (size_t)R_WOUT * D; sa.hbo = HB; sa.ssq = SSQB; sa.gnext = INP(I_NMEM) + D; sa.gprev = INP(I_NMIX) + D; sa.rprev = RROWB;
#pragma unroll 1
                  for (int tk = bx; tk < 16 * 16; tk += G) skinny_tile<SK_RES>(sa, tk & 15, tk >> 4, (LAS float*)(L + RING_OFF), tid); }
            }
            SEAM(11);
        }
        const int ns_q = layer == 0 ? 32 : 16;
        if (IN(pb + 0)) { PH_LOCALS
            { EpiB16 E{QB, D, SSQB, ns_q}; for (int rep_ = 0; rep_ < REP_GEMM; ++rep_) GEMM_PHASE(EpiB16, HB, R_Q + layer * 1024, TP, 1024, E); }
            { SkArgs sa{}; sa.A = HB; sa.W = WALL + (size_t)(R_Q + layer * 1024) * D; sa.ssq = SSQB; sa.nslots = ns_q; sa.O = QB; sa.ldc = D;
for (int rep_ = 0; rep_ < REP_SK; ++rep_)
#pragma unroll 1
              for (int tk = bx; tk < 16 * 16; tk += G) skinny_tile<SK_B16>(sa, tk & 15, tk >> 4, (LAS float*)(L + RING_OFF), tid); }
        }
        SEAM(pb + 0);
        if (IN(pb + 1)) { PH_LOCALS
          for (int rep_ = 0; rep_ < REP_ATTN; ++rep_) {
            const bf16* KBl = KB + (size_t)layer * MROWS * D; const bf16* VTl = VT + (size_t)layer * NB * NH * HD * MEMT;
#pragma unroll 1
            for (int pass = 0; pass < 2; ++pass) {
              if ((pass ^ (bx & 1)) == 0) {
#pragma unroll 1
                for (int tk = bx; tk < NB * NH * (SEQ / 256); tk += G) { const int rb = tk & 7, bh = tk >> 3; attn_prompt_wg(QB, KBl, VTl, ZB, bh >> 2, bh & 3, rb * 256, L + RING_OFF, tid); }
              } else {
#pragma unroll 1
                for (int tk = bx; tk < DB * NH; tk += G) attn_sample_task(QB, INP(I_CK), INP(I_CV), ZB, layer, tk >> 2, tk & 3, (LAS float*)(L + RING_OFF), tid);
              }
            }
          }
        }
        SEAM(pb + 1);
        if (IN(pb + 2)) { PH_LOCALS
            { EpiRes E{HB, SSQB, INP(I_NFFN) + layer * D, INP(I_NMEM) + layer * D, nullptr}; GEMM_PHASE(EpiRes, ZB, R_O + layer * 1024, TP, 1024, E); }
            { SkArgs sa{}; sa.A = ZB; sa.W = WALL + (size_t)(R_O + layer * 1024) * D; sa.hbo = HB; sa.ssq = SSQB; sa.gnext = INP(I_NFFN) + layer * D; sa.gprev = INP(I_NMEM) + layer * D;
#pragma unroll 1
              for (int tk = bx; tk < 16 * 16; tk += G) skinny_tile<SK_RES>(sa, tk & 15, tk >> 4, (LAS float*)(L + RING_OFF), tid); }
        }
        SEAM(pb + 2);
        if (IN(pb + 3)) { PH_LOCALS
            { EpiB16 E{QP, 2048, SSQB, 16}; for (int rep_ = 0; rep_ < REP_GEMM; ++rep_) GEMM_PHASE(EpiB16, HB, R_PQ + layer * 2048, TP, 2048, E); }
            { SkArgs sa{}; sa.A = HB; sa.W = WALL + (size_t)(R_PQ + layer * 2048) * D; sa.ssq = SSQB; sa.nslots = 16; sa.O = QP; sa.ldc = 2048;
for (int rep_ = 0; rep_ < REP_SK; ++rep_)
#pragma unroll 1
              for (int tk = bx; tk < 16 * 32; tk += G) skinny_tile<SK_B16>(sa, tk & 15, tk >> 4, (LAS float*)(L + RING_OFF), tid); }
        }
        SEAM(pb + 3);
        if (IN(pb + 4)) { PH_LOCALS
          peer_stage_keys(KEYS + (size_t)layer * 2 * 128 * 128, L + RING_OFF, tid);
          __syncthreads();
          LAS int* ti = (LAS int*)(L + RING_OFF + PSEL_KEYS + wave * PSEL_TI);
          for (int rep_ = 0; rep_ < REP_PSEL; ++rep_)
#pragma unroll 1
            for (int tk = gw; tk < (T / 16) * 8; tk += NGW) peer_select_task(QP, L + RING_OFF, EID, EG, (tk >> 3) * 16, tk & 7, ti, lane);
        }
        SEAM(pb + 4);
        if (IN(pb + 5)) { PH_LOCALS
            if (layer == 0) { for (int m0 = gw; m0 < TP; m0 += 8 * NGW) peer_gather_wave6<false>(m0, NGW, TP, lane, ws, 0, YOUT, INP(I_NFFN), INP(I_NMIX) + D, L + RING_OFF + wave * 8192);
                __syncthreads(); const int tidb = opq_i(wave0) * 64 + opq_v(LANE_ID());
#pragma unroll 1
                for (int tp = opq_i((int)blockIdx.x); tp < TS / 2; tp += G) peer_gather_wg2<false>(TP + 2 * tp, tidb, ws, 0, YOUT, INP(I_NFFN), INP(I_NMIX) + D, (LAS float*)(L + RING_OFF)); }
            else { for (int m0 = gw; m0 < TP; m0 += 8 * NGW) peer_gather_wave6<true>(m0, NGW, TP, lane, ws, 1, YOUT, INP(I_NFFN) + D, INP(I_NFIN), L + RING_OFF + wave * 8192);
                __syncthreads(); const int tidb = opq_i(wave0) * 64 + opq_v(LANE_ID());
#pragma unroll 1
                for (int tp = opq_i((int)blockIdx.x); tp < TS / 2; tp += G) peer_gather_wg2<true>(TP + 2 * tp, tidb, ws, 1, YOUT, INP(I_NFFN) + D, INP(I_NFIN), (LAS float*)(L + RING_OFF)); }
        }
        if (layer == 0) SEAM(pb + 5);
    }
#ifdef PROBE_SUB
    if (blockIdx.x == 0 && wave0 == 0 && mk_lane_id() == 0) { const unsigned long long t0_ = __builtin_amdgcn_s_memrealtime(); while (__builtin_amdgcn_s_memrealtime() - t0_ < 4ull * ps_dt) __builtin_amdgcn_s_sleep(8); }
#endif
#ifdef PROBE_PHASE
    PP_STAMP(17);
    if (blockIdx.x == 0 && wave0 == 0 && mk_lane_id() == 0) { const unsigned long long t0_ = __builtin_amdgcn_s_memrealtime(); while (__builtin_amdgcn_s_memrealtime() - t0_ < 4ull * pp_dt) __builtin_amdgcn_s_sleep(8); }
#endif
#undef IN
#undef SEAM
#undef GEMM_PHASE
}

#ifndef MK_PER_PHASE
#define MK_PER_PHASE 0
#endif
extern "C" void kernel_launch(void* const* d_in, const int* in_sizes, int n_in, void* d_out, int out_size, void* d_ws, size_t ws_size, hipStream_t stream) {
    static int grid = 0;
    if (grid == 0) {
        if (n_in != N_IN || out_size != (int)O_END || ws_size < WS_END) { fprintf(stderr, "kernel_launch: unexpected shapes: n_in %d out %d ws %zu; nothing launched\n", n_in, out_size, ws_size); grid = -1; return; }
        int dev = 0, cus = 0, per_cu = 0;
        if (hipGetDevice(&dev) != hipSuccess || hipDeviceGetAttribute(&cus, hipDeviceAttributeMultiprocessorCount, dev) != hipSuccess) { fprintf(stderr, "kernel_launch: device query failed\n"); grid = -1; return; }
        if (hipFuncSetAttribute((const void*)mk_fwd, hipFuncAttributeMaxDynamicSharedMemorySize, LDS_BYTES) != hipSuccess) { fprintf(stderr, "kernel_launch: hipFuncSetAttribute failed\n"); grid = -1; return; }
        if (hipOccupancyMaxActiveBlocksPerMultiprocessor(&per_cu, (const void*)mk_fwd, NWAVES * 64, LDS_BYTES) != hipSuccess || per_cu < 1) { fprintf(stderr, "kernel_launch: occupancy query says %d blocks per CU\n", per_cu); per_cu = 1; }
        (void)hipGetLastError();
        grid = cus;
        if (grid > 256) grid = 256;
    }
    if (grid < 0) return;
    if (hipMemsetAsync((char*)d_ws + WS_CTL, 0, CTL_ZERO_BYTES, stream) != hipSuccess) { fprintf(stderr, "kernel_launch: memset failed\n"); return; }
    Args a{};
    for (int i = 0; i < N_IN; ++i) a.in[i] = (const float*)d_in[i];
    a.out = (float*)d_out; a.ws = (unsigned char*)d_ws;
#if MK_PER_PHASE
    for (int p = 0; p < N_PHASES; ++p) { a.ph_lo = p; a.ph_hi = p + 1; hipLaunchKernelGGL(mk_fwd, dim3(grid), dim3(NWAVES * 64), LDS_BYTES, stream, a); }
#else
    a.ph_lo = 0; a.ph_hi = N_PHASES;
    hipLaunchKernelGGL(mk_fwd, dim3(grid), dim3(NWAVES * 64), LDS_BYTES, stream, a);
#endif
    const hipError_t le = hipPeekAtLastError();
    if (le != hipSuccess) fprintf(stderr, "kernel_launch: launch failed: %s\n", hipGetErrorName(le));
}
```

```cpp
#include <hip/hip_runtime.h>
#include <cstdio>
#include <cstdint>
namespace pg8 {
#define PG8_LAS __attribute__((address_space(3)))
typedef unsigned short bf16_t;
typedef short bf16x8 __attribute__((ext_vector_type(8)));
typedef float f32x4 __attribute__((ext_vector_type(4)));
typedef unsigned u32x4 __attribute__((ext_vector_type(4)));
constexpr int BM = 256, BK = 64, HALF = 128, HTB = HALF * BK * 2  , STAGE_BYTES = 8 * HTB, NXCD = 8, WGM = 8;

__host__ __device__ __forceinline__ int lds_byte(int r, int c) { const int st = (r >> 4) * 2 + (c >> 5), rr = r & 15, cc = c & 31, ob = rr * 64 + cc * 2; return st * 1024 + (ob ^ (((ob >> 9) & 1) << 5)); }
__host__ __device__ __forceinline__ void stage_rc(int b, int& R, int& C) { const int st = b / 1024, sb = b % 1024, swz = sb ^ (((sb >> 9) & 1) << 5); R = (st >> 1) * 16 + swz / 64; C = (st & 1) * 32 + (swz % 64) / 2; }
__host__ __device__ __forceinline__ int perm32(int rho) { const int n = rho >> 4, i = rho & 15; return 8 * (i >> 2) + 4 * n + (i & 3); }

__device__ __forceinline__ const char* pg8_uni(const char* p) { asm volatile("" : "+s"(p)); return p; }
__device__ __forceinline__ unsigned pg8_vo(unsigned v) { asm volatile("" : "+v"(v)); return v; }
struct Unit { int pm, pn; };
struct Gemm { const bf16_t* A; const bf16_t* Bt; int M, N, K; };

struct StaticOrder {
    int nM, nN, nwg, G, c, w0;
    __host__ __device__ void init(int M, int N, int G_, int c_, int w0_ = 0) { nM = M / BM; nN = N / BM; nwg = nM * nN; G = G_; c = c_; w0 = w0_; }
    __host__ __device__ bool next(int i, Unit& u) const {
        const long L = (long)i * G + c; if (L >= nwg) return false;
        int wgid = (int)L; { const int q = nwg / NXCD, r = nwg % NXCD, xcd = wgid % NXCD, off = wgid / NXCD; wgid = (xcd < r ? xcd * (q + 1) : r * (q + 1) + (xcd - r) * q) + off; }
        const int nig = WGM * nN, gid = wgid / nig, fm = gid * WGM, gsz = (nM - fm) < WGM ? (nM - fm) : WGM;
        u.pm = fm + ((wgid % nig) % gsz); u.pn = (wgid % nig) / gsz; return true;
    }
    __device__ __forceinline__ void a_ready(const Unit&) const {}
    __device__ __forceinline__ void done(const Unit&) const {}
};

__device__ __forceinline__ unsigned cvt_pk_bf16(float lo, float hi) { unsigned r; asm volatile("v_cvt_pk_bf16_f32 %0, %1, %2" : "=v"(r) : "v"(lo), "v"(hi)); return r; }
typedef float f32x2 __attribute__((ext_vector_type(2)));
__device__ __forceinline__ f32x2 gelu_pk(f32x2 v) {
    const f32x2 av = __builtin_elementwise_abs(v), d = av * 0.2316418882f + 1.0f;
    f32x2 t; t.x = __builtin_amdgcn_rcpf(d.x); t.y = __builtin_amdgcn_rcpf(d.y);
    f32x2 q = t * 0.5307027145f + (-0.7265760135f); q = q * t + 0.7107068705f; q = q * t + (-0.142248368f); q = q * t + 0.127414796f; q = q * t;
    const f32x2 s = (v * v) * (-0.72134752044f);
    f32x2 e; e.x = __builtin_amdgcn_exp2f(s.x); e.y = __builtin_amdgcn_exp2f(s.y);
    const f32x2 m = v * (q * e), r = v - m;
    f32x2 o; o.x = v.x < 0.f ? m.x : r.x; o.y = v.y < 0.f ? m.y : r.y; return o;
}
template <class Epi, class Sched, bool ALIGN_EPI = false, bool SP2 = false>
__device__ __forceinline__ void gemm_phase(PG8_LAS unsigned char* lds, const Gemm g, const Sched& S, const Epi& E) {
    int lane_; asm volatile("v_mbcnt_lo_u32_b32 %0, -1, 0\n\tv_mbcnt_hi_u32_b32 %0, -1, %0" : "=v"(lane_));
    const int wid = __builtin_amdgcn_readfirstlane(S.w0), lane = lane_, tid = wid * 64 + lane; (void)tid;
    const int wr = wid >> 2, wc = wid & 3, fr = lane & 15, fq = lane >> 4;
    const int K = g.K, nt = K / BK;
    unsigned voffA[2], voffB[2];
#pragma unroll
    for (int i = 0; i < 2; ++i) { int R, C; stage_rc(tid * 16 + i * 8192, R, C); const int Rb = Epi::PERM ? ((R & ~31) + perm32(R & 31)) : R;
        voffA[i] = (unsigned)(R * K + C) * 2u; voffB[i] = (unsigned)(Rb * K + C) * 2u; }
    const size_t kstep = (size_t)(BK * 2);
    const size_t hstep = (size_t)HALF * K * 2;
    const size_t tstep = 2 * hstep;
    const unsigned ldsw = (unsigned)wid * 1024u;
    const int aoff = lds_byte(wr * 64 + fr, fq * 8), boff = lds_byte(wc * 32 + fr, fq * 8);
#define PG8_SA(b, h) (((b) * 2 + (h)) * HTB)
#define PG8_SB(b, h) ((4 + (b) * 2 + (h)) * HTB)
#define PG8_STAGE(bufoff, gbase, voff) do { _Pragma("unroll") for (int _i = 0; _i < 2; ++_i) \
        __builtin_amdgcn_global_load_lds((const unsigned*)(pg8_uni((const char*)(gbase)) + pg8_vo((voff)[_i])), (PG8_LAS unsigned*)(lds + (bufoff) + ldsw + _i * 8192), 16, 0, 0); } while (0)
#define PG8_LDA(dst, b, h) do { _Pragma("unroll") for (int m = 0; m < 4; ++m) _Pragma("unroll") for (int k = 0; k < 2; ++k) dst[m][k] = *(const PG8_LAS bf16x8*)(lds + PG8_SA(b, h) + aoff + m * 2048 + k * 1024); } while (0)
#define PG8_LDB(dst, b, h) do { _Pragma("unroll") for (int n = 0; n < 2; ++n) _Pragma("unroll") for (int k = 0; k < 2; ++k) dst[n][k] = *(const PG8_LAS bf16x8*)(lds + PG8_SB(b, h) + boff + n * 2048 + k * 1024); } while (0)
#define PG8_MMA(ai, bj, At, Bt) do { __builtin_amdgcn_s_setprio(1); _Pragma("unroll") for (int m = 0; m < 4; ++m) _Pragma("unroll") for (int n = 0; n < 2; ++n) _Pragma("unroll") for (int k = 0; k < 2; ++k) \
        acc[ai][bj][m][n] = __builtin_amdgcn_mfma_f32_16x16x32_bf16(Bt[n][k], At[m][k], acc[ai][bj][m][n], 0, 0, 0); __builtin_amdgcn_s_setprio(0); } while (0)
#define PG8_WAIT_V(n) asm volatile("s_waitcnt vmcnt(" #n ")" ::: "memory")
#define PG8_WAIT_L(n) asm volatile("s_waitcnt lgkmcnt(" #n ")" ::: "memory")
#define PG8_BAR __builtin_amdgcn_s_barrier()
#define PG8_SCHED __builtin_amdgcn_sched_barrier(0)
    Unit cur, nxt; int ui = 0;
    if (!S.next(0, cur)) return;
    f32x4 acc[2][2][4][2];
#pragma unroll
    for (int a = 0; a < 2; ++a)
#pragma unroll
        for (int b = 0; b < 2; ++b)
#pragma unroll
            for (int m = 0; m < 4; ++m)
#pragma unroll
                for (int n = 0; n < 2; ++n) acc[a][b][m][n] = (f32x4){0.f, 0.f, 0.f, 0.f};
    bf16x8 At[4][2], B0[2][2], B1[2][2];
    const char* cA = (const char*)g.A + (size_t)cur.pm * tstep; const char* cB = (const char*)g.Bt + (size_t)cur.pn * tstep;
    S.a_ready(cur);
    if constexpr (SP2) {
        PG8_STAGE(PG8_SB(0, 0), cB, voffB); PG8_STAGE(PG8_SB(0, 1), cB + hstep, voffB); PG8_STAGE(PG8_SA(0, 0), cA, voffA); PG8_STAGE(PG8_SA(0, 1), cA + hstep, voffA);
        if (wr == 1) PG8_BAR;
        PG8_WAIT_V(2); PG8_BAR;
        PG8_STAGE(PG8_SB(1, 0), cB + kstep, voffB); PG8_STAGE(PG8_SA(1, 0), cA + kstep, voffA); PG8_STAGE(PG8_SB(1, 1), cB + hstep + kstep, voffB);
        PG8_WAIT_V(6); PG8_BAR;
    } else {
        PG8_STAGE(PG8_SB(0, 0), cB, voffB); PG8_STAGE(PG8_SA(0, 0), cA, voffA); PG8_STAGE(PG8_SB(0, 1), cB + hstep, voffB); PG8_STAGE(PG8_SA(0, 1), cA + hstep, voffA);
        if (wr == 1) PG8_BAR;
        PG8_WAIT_V(4); PG8_BAR;
        PG8_STAGE(PG8_SB(1, 0), cB + kstep, voffB); PG8_STAGE(PG8_SA(1, 0), cA + kstep, voffA); PG8_STAGE(PG8_SB(1, 1), cB + hstep + kstep, voffB);
        PG8_WAIT_V(6); PG8_BAR;
    }
    for (;;) {
        const bool has_next = S.next(ui + 1, nxt);
        const char* nA = has_next ? (const char*)g.A + (size_t)nxt.pm * tstep : cA; const char* nB = has_next ? (const char*)g.Bt + (size_t)nxt.pn * tstep : cB;
        for (int t = 0; t < nt; t += 2) {
            const bool last = (t == nt - 2);
            const char* a1 = cA + (size_t)(t + 1) * kstep;
            const char* a2 = last ? nA : cA + (size_t)(t + 2) * kstep; const char* b2 = last ? nB : cB + (size_t)(t + 2) * kstep;
            const char* a3 = a2 + kstep; const char* b3 = b2 + kstep;
            if (last && has_next) S.a_ready(nxt);
            if constexpr (SP2) {
            PG8_LDB(B0, 0, 0); PG8_LDB(B1, 0, 1); PG8_SCHED; PG8_LDA(At, 0, 0); PG8_STAGE(PG8_SA(1, 1), a1 + hstep, voffA);
            PG8_WAIT_V(8); PG8_WAIT_L(0); PG8_BAR; PG8_MMA(0, 0, At, B0); PG8_MMA(0, 1, At, B1); PG8_BAR; PG8_SCHED;
            PG8_LDA(At, 0, 1); PG8_STAGE(PG8_SB(0, 0), b2, voffB); PG8_STAGE(PG8_SB(0, 1), b2 + hstep, voffB); PG8_STAGE(PG8_SA(0, 0), a2, voffA);
            PG8_WAIT_V(8); PG8_WAIT_L(0); PG8_BAR; PG8_MMA(1, 0, At, B0); PG8_MMA(1, 1, At, B1); PG8_BAR; PG8_SCHED;
            PG8_LDB(B0, 1, 0); PG8_LDB(B1, 1, 1); PG8_SCHED; PG8_LDA(At, 1, 0); PG8_STAGE(PG8_SA(0, 1), a2 + hstep, voffA);
            PG8_WAIT_V(8); PG8_WAIT_L(0); PG8_BAR; PG8_MMA(0, 0, At, B0); PG8_MMA(0, 1, At, B1); PG8_BAR; PG8_SCHED;
            PG8_LDA(At, 1, 1); PG8_STAGE(PG8_SB(1, 0), b3, voffB); PG8_STAGE(PG8_SB(1, 1), b3 + hstep, voffB); PG8_STAGE(PG8_SA(1, 0), a3, voffA);
            PG8_WAIT_V(8); PG8_WAIT_L(0); PG8_BAR; PG8_MMA(1, 0, At, B0); PG8_MMA(1, 1, At, B1); PG8_BAR; PG8_SCHED;
            } else {
            PG8_LDB(B0, 0, 0); PG8_SCHED; PG8_LDA(At, 0, 0); PG8_STAGE(PG8_SA(1, 1), a1 + hstep, voffA);
            PG8_WAIT_L(8); PG8_BAR; PG8_WAIT_L(0); PG8_MMA(0, 0, At, B0); PG8_BAR; PG8_SCHED;
            PG8_LDB(B1, 0, 1); PG8_STAGE(PG8_SB(0, 0), b2, voffB);
            PG8_BAR; PG8_WAIT_L(0); PG8_MMA(0, 1, At, B1); PG8_BAR;
            PG8_LDA(At, 0, 1); PG8_STAGE(PG8_SA(0, 0), a2, voffA);
            PG8_BAR; PG8_WAIT_L(0); PG8_MMA(1, 0, At, B0); PG8_BAR; PG8_SCHED;
            PG8_STAGE(PG8_SB(0, 1), b2 + hstep, voffB);
            PG8_WAIT_V(6); PG8_BAR; PG8_MMA(1, 1, At, B1); PG8_BAR;
            PG8_LDB(B0, 1, 0); PG8_SCHED; PG8_LDA(At, 1, 0); PG8_STAGE(PG8_SA(0, 1), a2 + hstep, voffA);
            PG8_WAIT_L(8); PG8_BAR; PG8_WAIT_L(0); PG8_MMA(0, 0, At, B0); PG8_BAR; PG8_SCHED;
            PG8_LDB(B1, 1, 1); PG8_STAGE(PG8_SB(1, 0), b3, voffB);
            PG8_BAR; PG8_WAIT_L(0); PG8_MMA(0, 1, At, B1); PG8_BAR;
            PG8_LDA(At, 1, 1); PG8_STAGE(PG8_SA(1, 0), a3, voffA);
            PG8_BAR; PG8_WAIT_L(0); PG8_MMA(1, 0, At, B0); PG8_BAR; PG8_SCHED;
            PG8_STAGE(PG8_SB(1, 1), b3 + hstep, voffB);
            PG8_WAIT_V(6); PG8_BAR; PG8_MMA(1, 1, At, B1); PG8_BAR;
            }
        }
        if constexpr (ALIGN_EPI) { if (wr == 0) PG8_BAR; }
        if constexpr (!Epi::AFTER_DRAIN) { E(acc, cur, wr, wc, fr, fq); S.done(cur); }
        if (!has_next) break;
#pragma unroll
        for (int a = 0; a < 2; ++a)
#pragma unroll
            for (int b = 0; b < 2; ++b)
#pragma unroll
                for (int m = 0; m < 4; ++m)
#pragma unroll
                    for (int n = 0; n < 2; ++n) acc[a][b][m][n] = (f32x4){0.f, 0.f, 0.f, 0.f};
        cur = nxt; cA = nA; cB = nB; ++ui;
        if constexpr (ALIGN_EPI) { if (wr == 1) PG8_BAR; }
    }
    PG8_WAIT_V(0);
    if constexpr (!ALIGN_EPI) { if (wr == 0) PG8_BAR; }
    PG8_BAR;
    if constexpr (Epi::AFTER_DRAIN) { E.fused(acc, cur, wr, wc, fr, fq, lds, wid, lane); S.done(cur); }
#undef PG8_SA
#undef PG8_SB
#undef PG8_STAGE
#undef PG8_LDA
#undef PG8_LDB
#undef PG8_MMA
#undef PG8_WAIT_V
#undef PG8_WAIT_L
#undef PG8_BAR
#undef PG8_SCHED
}
}
#define GAS __attribute__((address_space(1)))
#define LAS __attribute__((address_space(3)))
typedef unsigned short bf16;
typedef unsigned v4u __attribute__((ext_vector_type(4)));
typedef unsigned v2u __attribute__((ext_vector_type(2)));
typedef int v4i __attribute__((ext_vector_type(4)));
typedef float f32x4 __attribute__((ext_vector_type(4)));
typedef float f32x2 __attribute__((ext_vector_type(2)));
typedef short bf16x8 __attribute__((ext_vector_type(8)));
typedef __bf16 bf16x2_t __attribute__((ext_vector_type(2)));
typedef __bf16 v2bf __attribute__((ext_vector_type(2)));
typedef __bf16 v32bf __attribute__((ext_vector_type(32)));
typedef GAS unsigned gu32;
#define RLX_AGENT __ATOMIC_RELAXED, __HIP_MEMORY_SCOPE_AGENT
#define LDS_WAIT() asm volatile("s_waitcnt lgkmcnt(0)" ::: "memory")
#define VM_WAIT() asm volatile("s_waitcnt vmcnt(0)" ::: "memory")
__device__ __forceinline__ unsigned f2bf(float f) { unsigned u = __builtin_bit_cast(unsigned, f); return (u + 0x7fffu + ((u >> 16) & 1u)) >> 16; }
__device__ __forceinline__ unsigned pk2(float lo, float hi) { return pg8::cvt_pk_bf16(lo, hi); }
__device__ __forceinline__ float bflo(unsigned w) { return __builtin_bit_cast(float, w << 16); }
__device__ __forceinline__ float bfhi(unsigned w) { return __builtin_bit_cast(float, w & 0xffff0000u); }

__device__ __forceinline__ int mk_lane_id() { int r; asm volatile("v_mbcnt_lo_u32_b32 %0, -1, 0\n\tv_mbcnt_hi_u32_b32 %0, -1, %0" : "=v"(r)); return r; }
__device__ __forceinline__ int mk_bperm(int idx4, int v) { return __builtin_amdgcn_ds_bpermute(idx4, v); }
__device__ __forceinline__ float mk_shfl_xor(float v, int m) { return __builtin_bit_cast(float, mk_bperm((mk_lane_id() ^ m) << 2, __builtin_bit_cast(int, v))); }
__device__ __forceinline__ int mk_shfl_xor(int v, int m) { return mk_bperm((mk_lane_id() ^ m) << 2, v); }
__device__ __forceinline__ unsigned mk_shfl_xor(unsigned v, int m) { return (unsigned)mk_bperm((mk_lane_id() ^ m) << 2, (int)v); }
__device__ __forceinline__ float mk_shfl(float v, int src) { return __builtin_bit_cast(float, mk_bperm(src << 2, __builtin_bit_cast(int, v))); }
__device__ __forceinline__ float mk_shx(float v, int m, int l4) { return __builtin_bit_cast(float, mk_bperm(l4 ^ (m << 2), __builtin_bit_cast(int, v))); }
__device__ __forceinline__ unsigned mk_shx(unsigned v, int m, int l4) { return (unsigned)mk_bperm(l4 ^ (m << 2), (int)v); }
#define __shfl_xor(v, m) mk_shfl_xor((v), (m))
#define __shfl(v, s) mk_shfl((v), (s))
__device__ __forceinline__ float wave_sum(float v) {
#pragma unroll
    for (int o = 1; o < 64; o <<= 1) v += __shfl_xor(v, o);
    return v;
}
__device__ __forceinline__ float wave_max(float v) {
#pragma unroll
    for (int o = 1; o < 64; o <<= 1) v = fmaxf(v, __shfl_xor(v, o));
    return v;
}
__device__ __forceinline__ float gelu1(float v) { const f32x2 r = pg8::gelu_pk((f32x2){v, 0.f}); return r.x; }
#define XB_TMO      128
#define XB_XCNT(j)  (256  + 64 * (j))
#define XB_XSUB(j)  (1280 + 64 * (j))
#define XB_XGEN(j)  (2304 + 64 * (j))
#define XB_TOP      3328
#define XB_TOPGEN   3392
#define XCD_BAR_WORDS 3456
#define XB_SPIN_CAP (1u << 21)

__device__ __forceinline__ unsigned xb_ld(unsigned* p)              { return __hip_atomic_load(p, __ATOMIC_RELAXED, __HIP_MEMORY_SCOPE_AGENT); }
__device__ __forceinline__ unsigned xb_add(unsigned* p, unsigned v) { return __hip_atomic_fetch_add(p, v, __ATOMIC_RELAXED, __HIP_MEMORY_SCOPE_AGENT); }
__device__ __forceinline__ unsigned xb_xcc_id() { return (unsigned)__builtin_amdgcn_s_getreg((3 << 11) | 20) & 0xFu; }
#define XB_SPIN(cond, bar) do { unsigned _sp = 0; while (cond) { __builtin_amdgcn_s_sleep(1); \
    if ((++_sp & 255u) == 0u) { if (xb_ld(&(bar)[XB_TMO])) break; if (_sp > XB_SPIN_CAP) { atomicAdd(&(bar)[XB_TMO], 1u); break; } } } } while (0)

struct XcdBarrier {
    unsigned* bar; unsigned x;
    bool lead;
    volatile LAS unsigned* st;
};

__device__ __forceinline__ XcdBarrier xcd_barrier_post(unsigned* bar, volatile LAS unsigned* st) {
    XcdBarrier b; b.bar = bar; b.x = xb_xcc_id(); b.st = st; b.lead = (threadIdx.x >> 6) == 0;
    if (threadIdx.x == 0) (void)xb_add(&bar[XB_XCNT(b.x)], 1u);
    return b;
}
__device__ __forceinline__ void xcd_barrier_complete(unsigned* bar, unsigned x, unsigned& nloc, unsigned& nx) {
    const unsigned G = gridDim.x * gridDim.y * gridDim.z;
    unsigned sum, cnt, mine, sp = 0u;
    for (;;) {
        sum = 0u; cnt = 0u; mine = 0u;
#pragma unroll
        for (unsigned j = 0; j < 16; ++j) { const unsigned c = xb_ld(&bar[XB_XCNT(j)]); sum += c; cnt += (c > 0u) ? 1u : 0u; mine = (j == x) ? c : mine; }
        if (sum == G) break;
        __builtin_amdgcn_s_sleep(1);
        if ((++sp & 255u) == 0u) { if (xb_ld(&bar[XB_TMO])) break; if (sp > XB_SPIN_CAP) { atomicAdd(&bar[XB_TMO], 1u); break; } }
    }
    nloc = mine > 0u ? mine : 1u; nx = cnt > 0u ? cnt : 1u;
}

__device__ __forceinline__ void xcd_barrier(const XcdBarrier& b) {
    asm volatile("s_waitcnt vmcnt(0)" ::: "memory");
    __syncthreads();
    int xl_; asm volatile("v_mbcnt_lo_u32_b32 %0, -1, 0\n\tv_mbcnt_hi_u32_b32 %0, -1, %0" : "=v"(xl_));
    if (b.lead && xl_ == 0) {
        unsigned* bar = b.bar;
        __builtin_amdgcn_s_waitcnt(0);
        unsigned nloc = b.st[0], nx = b.st[1];
        if (nloc == 0u) { xcd_barrier_complete(bar, b.x, nloc, nx); b.st[0] = nloc; b.st[1] = nx; }
        const unsigned old = xb_add(&bar[XB_XSUB(b.x)], 1u);
        const unsigned gen = old / nloc;
        if (old + 1u == (gen + 1u) * nloc) {
            __builtin_amdgcn_fence(__ATOMIC_RELEASE, "agent");
            asm volatile("s_waitcnt vmcnt(0)" ::: "memory");
            const unsigned og = xb_add(&bar[XB_TOP], 1u);
            const unsigned tg = og / nx;
            if (og + 1u == (tg + 1u) * nx) xb_add(&bar[XB_TOPGEN], 1u);
            else XB_SPIN(xb_ld(&bar[XB_TOPGEN]) == tg, bar);
            __builtin_amdgcn_fence(__ATOMIC_ACQUIRE, "agent");
            xb_add(&bar[XB_XGEN(b.x)], 1u);
            asm volatile("s_waitcnt vmcnt(0)" ::: "memory");
        } else {
            XB_SPIN(xb_ld(&bar[XB_XGEN(b.x)]) == gen, bar);
            __builtin_amdgcn_fence(__ATOMIC_ACQUIRE, "agent");
            asm volatile("s_waitcnt vmcnt(0)" ::: "memory");
        }
    }
    __syncthreads();
}
constexpr int NWAVES = 8;
constexpr int D = 1024, NB = 8, SEQ = 2048, TP = NB * SEQ, DB = 128, DSQ = 4, TS = DB * DSQ, T = TP + TS;
constexpr int MEMT = 256, NH = 4, HD = 256, MROWS = NB * MEMT;
constexpr int NEXP = 16384;
constexpr float RMS_EPS = 1e-6f;
constexpr size_t O_Y = 0, O_SRP = 17301504, O_SIP = 17334272, O_CP = 17367040, O_MK = 17383424, O_MV = 21577728, O_SRS = 25772032, O_SIS = 26296320, O_CS = 26820608, O_END = 27082752;
enum { I_XP = 0, I_XS, I_MEM, I_SRE, I_SIM, I_SCONV, I_CK, I_CV, I_NMIX, I_NMEM, I_NFFN, I_NFIN, I_ARE, I_AIM, I_LDT, I_BRE, I_BIM, I_CRE, I_CIM, I_SD, I_WGLU, I_WIN, I_CW, I_WOUT,
       I_WQ, I_WK, I_WV, I_WO, I_PWQ, I_K1, I_K2, I_PU, I_PV, N_IN };
constexpr int R_KV = 0, R_GLU = 4096, R_Q = 6144, R_O = 8192, R_PQ = 10240, R_WIN = 14336, R_WOUT = 17408, R_END = 18432;
constexpr size_t MiB = 1u << 20;
constexpr size_t WS_CTL = 0, CTL_ZERO_BYTES = 1 * MiB;
constexpr size_t WS_WALL = 2 * MiB;
constexpr size_t WS_KEYS = 38 * MiB;
constexpr size_t WS_BBW = 39 * MiB;
constexpr size_t WS_CCW = 39 * MiB + 512 * 1024;
constexpr size_t WS_LB = 40 * MiB;
constexpr size_t WS_MEMB = 41 * MiB;
constexpr size_t WS_KB = 45 * MiB;
constexpr size_t WS_VT = 53 * MiB;
constexpr size_t WS_EID = 61 * MiB;
constexpr size_t WS_EG = 70 * MiB;
constexpr size_t WS_HB = 80 * MiB;
constexpr size_t WS_ZB = 114 * MiB;
constexpr size_t WS_QB = 148 * MiB;
constexpr size_t WS_QP = 182 * MiB;
constexpr size_t WS_B1 = 249 * MiB;
constexpr size_t WS_V1 = 283 * MiB;
constexpr size_t WS_UV = 320 * MiB;
constexpr size_t WS_SSQ = 384 * MiB;
constexpr size_t WS_RROW = 388 * MiB;
constexpr size_t WS_LBP = 389 * MiB;
constexpr size_t WS_BBT = 390 * MiB;
constexpr size_t WS_BBF = 390 * MiB + 512 * 1024;
constexpr size_t WS_END = 392 * MiB;
constexpr int CW_BAR = 4096;
constexpr int RING_OFF = 0, RING_BYTES = 131072;
constexpr int LDSCTL_OFF = 146432, MISC_OFF = LDSCTL_OFF + 320;
constexpr int LDS_BYTES = 147456;
using pg8::Unit;
struct EpiKV {
    static constexpr bool PERM = false, AFTER_DRAIN = true;
    float* out; bf16* KB; bf16* VT;
    __device__ __forceinline__ void fused(const f32x4 (&acc)[2][2][4][2], const Unit& u, int wr, int wc, int fr, int fq, PG8_LAS unsigned char* lds, int wid, int lane) const {
        fr = (int)pg8::pg8_vo((unsigned)fr); fq = (int)pg8::pg8_vo((unsigned)fq);
        const int b = u.pm, mat = u.pn >> 2, l = mat >> 1, isv = mat & 1, h = u.pn & 3;
        float* ob = out + (isv ? O_MV : O_MK) + (size_t)(l * NB + b) * MEMT * D + h * HD;
        PG8_LAS bf16* vt = (PG8_LAS bf16*)lds;
#pragma unroll
        for (int ai = 0; ai < 2; ++ai)
#pragma unroll
            for (int m = 0; m < 4; ++m) { const int mm = ai * 128 + wr * 64 + m * 16 + fr; const int pm_ = (mm & ~31) | (((mm >> 2) & 3) << 3) | (((mm >> 4) & 1) << 2) | (mm & 3);
#pragma unroll
                for (int bj = 0; bj < 2; ++bj)
#pragma unroll
                    for (int n = 0; n < 2; ++n) { const int dl = bj * 128 + wc * 32 + n * 16 + 4 * fq; const f32x4 v = acc[ai][bj][m][n];
                        *(f32x4*)(ob + (size_t)mm * D + dl) = v;
                        if (!isv) { v2u w; w.x = pk2(v[0], v[1]); w.y = pk2(v[2], v[3]); *(v2u*)(KB + ((size_t)l * MROWS + b * MEMT + mm) * D + h * HD + dl) = w; }
                        else {
#pragma unroll
                            for (int j = 0; j < 4; ++j) vt[(dl + j) * 256 + pm_] = (bf16)f2bf(v[j]); } } }
        if (isv) {
            __syncthreads();
            bf16* vg = VT + (((size_t)l * NB + b) * NH + h) * HD * MEMT; const int tid = wid * 64 + lane;
#pragma unroll
            for (int i = 0; i < 16; ++i) { const int c = tid + 512 * i; *(v4u*)(vg + (size_t)c * 8) = *(const PG8_LAS v4u*)(vt + c * 8); }
            __syncthreads();
        }
    }
};
struct EpiGLU {
    static constexpr bool PERM = false, AFTER_DRAIN = false;
    const float* xp; bf16* HBo; float* SSQ; const float* gnext;
    __device__ __forceinline__ void operator()(const f32x4 (&acc)[2][2][4][2], const Unit& u, int wr, int wc, int fr, int fq) const {
        fr = (int)pg8::pg8_vo((unsigned)fr); fq = (int)pg8::pg8_vo((unsigned)fq);
        const int row0 = u.pm * 256 + wr * 64 + fr, col0 = u.pn * 128 + wc * 32 + 4 * fq;
        const f32x4 g0 = *(const f32x4*)(gnext + col0), g1 = *(const f32x4*)(gnext + col0 + 16);
        f32x4 xv[2][2], xn[2][2];
#define GLU_LOADX(G, XV) do { _Pragma("unroll") for (int mm = 0; mm < 2; ++mm) _Pragma("unroll") for (int n = 0; n < 2; ++n) XV[mm][n] = *(const f32x4*)(xp + (size_t)(row0 + ((G) >> 1) * 128 + (2 * ((G) & 1) + mm) * 16) * D + col0 + n * 16); } while (0)
        GLU_LOADX(0, xv);
#pragma unroll
        for (int g = 0; g < 4; ++g) { const int ai = g >> 1, mp = g & 1;
                if (g < 3) GLU_LOADX(g + 1, xn);
#pragma unroll
                for (int mm = 0; mm < 2; ++mm) { const int m = 2 * mp + mm, row = row0 + ai * 128 + m * 16; const size_t ro = (size_t)row * D + col0; float ss = 0.f;
#pragma unroll
                    for (int n = 0; n < 2; ++n) { const f32x4 a = acc[ai][0][m][n], b = acc[ai][1][m][n]; f32x4 o;
#pragma unroll
                        for (int j = 0; j < 4; ++j) { o[j] = xv[mm][n][j] + a[j] / (1.0f + __expf(-b[j])); ss = fmaf(o[j], o[j], ss); }
                        const f32x4 hg = o * (n ? g1 : g0); v2u w; w.x = pk2(hg[0], hg[1]); w.y = pk2(hg[2], hg[3]); *(v2u*)(HBo + ro + n * 16) = w; }
                    ss += __shfl_xor(ss, 16); ss += __shfl_xor(ss, 32);
                    if (fq == 0) SSQ[(size_t)row * 32 + u.pn * 4 + wc] = ss; }
                asm volatile("" ::: "memory");
#pragma unroll
                for (int mm = 0; mm < 2; ++mm)
#pragma unroll
                    for (int n = 0; n < 2; ++n) xv[mm][n] = xn[mm][n]; }
#undef GLU_LOADX
    }
};
__device__ __forceinline__ float row_rinv(const float* SSQ, size_t row, int nslots) {
    const f32x4* p = (const f32x4*)(SSQ + row * 32); f32x4 s = p[0] + p[1] + p[2] + p[3];
    if (nslots > 16) s += p[4] + p[5] + p[6] + p[7];
    return 1.0f / sqrtf(((s[0] + s[1]) + (s[2] + s[3])) * (1.0f / D) + RMS_EPS);
}
struct EpiB16 {
    static constexpr bool PERM = true, AFTER_DRAIN = false;
    bf16* O; int ldc; const float* SSQ; int nslots;
    __device__ __forceinline__ void operator()(const f32x4 (&acc)[2][2][4][2], const Unit& u, int wr, int wc, int fr, int fq) const {
        fr = (int)pg8::pg8_vo((unsigned)fr); fq = (int)pg8::pg8_vo((unsigned)fq);
        const int rb = u.pm * 256 + wr * 64, row0 = rb + fr, col0 = u.pn * 256 + wc * 32 + 8 * fq, ln = fq * 16 + fr;
        const float r0 = row_rinv(SSQ, (size_t)(rb + ln), nslots), r1 = row_rinv(SSQ, (size_t)(rb + 128 + ln), nslots);
#pragma unroll
        for (int ai = 0; ai < 2; ++ai)
#pragma unroll
            for (int m = 0; m < 4; ++m) { const size_t row = (size_t)(row0 + ai * 128 + m * 16); bf16* rowp = O + row * ldc + col0; const float ri = __shfl(ai ? r1 : r0, m * 16 + fr);
#pragma unroll
                for (int bj = 0; bj < 2; ++bj) { const f32x4 v0 = acc[ai][bj][m][0] * ri, v1 = acc[ai][bj][m][1] * ri;
                    v4u w; w.x = pk2(v0[0], v0[1]); w.y = pk2(v0[2], v0[3]); w.z = pk2(v1[0], v1[1]); w.w = pk2(v1[2], v1[3]);
                    *(v4u*)(rowp + bj * 128) = w; } }
    }
};
struct EpiRes {
    static constexpr bool PERM = false, AFTER_DRAIN = false;
    bf16* HBo; float* SSQ; const float* gnext; const float* gprev; const float* rprev;
    __device__ __forceinline__ void operator()(const f32x4 (&acc)[2][2][4][2], const Unit& u, int wr, int wc, int fr, int fq) const {
        fr = (int)pg8::pg8_vo((unsigned)fr); fq = (int)pg8::pg8_vo((unsigned)fq);
        const int row0 = u.pm * 256 + wr * 64 + fr, col0 = u.pn * 256 + wc * 32 + 4 * fq;
        v2u hv[2][2], hn[2][2]; float rq = 1.0f, rqn = 1.0f;
#define RES_LOADH(I, HV, RQ) do { const int row_ = row0 + ((I) >> 2) * 128 + ((I) & 3) * 16; const size_t ro_ = (size_t)row_ * D + col0; { const float* rp_ = rprev ? rprev + row_ : gnext; const float rl_ = *rp_; RQ = rprev ? rl_ : 1.0f; }        \
            _Pragma("unroll") for (int bj = 0; bj < 2; ++bj) _Pragma("unroll") for (int n = 0; n < 2; ++n) HV[bj][n] = *(const v2u*)(HBo + ro_ + bj * 128 + n * 16); } while (0)
        RES_LOADH(0, hv, rq);
#pragma unroll
        for (int i = 0; i < 8; ++i) { const int ai = i >> 2, m = i & 3; const int row = row0 + ai * 128 + m * 16; const size_t ro = (size_t)row * D + col0; float ss = 0.f;
                if (i < 7) RES_LOADH(i + 1, hn, rqn);
                const float rr = 1.0f / rq;
#pragma unroll
                for (int bj = 0; bj < 2; ++bj)
#pragma unroll
                    for (int n = 0; n < 2; ++n) { const v2u h = hv[bj][n]; const f32x4 gp = *(const f32x4*)(gprev + col0 + bj * 128 + n * 16), gn = *(const f32x4*)(gnext + col0 + bj * 128 + n * 16);
                        const f32x4 t = (f32x4){bflo(h.x), bfhi(h.x), bflo(h.y), bfhi(h.y)} * rr + acc[ai][bj][m][n] * gp;
                        const f32x4 o = (f32x4){t[0] / gp[0], t[1] / gp[1], t[2] / gp[2], t[3] / gp[3]};
                        const f32x4 hg = o * gn;
                        ss = fmaf(o[0], o[0], fmaf(o[1], o[1], fmaf(o[2], o[2], fmaf(o[3], o[3], ss))));
                        v2u w; w.x = pk2(hg[0], hg[1]); w.y = pk2(hg[2], hg[3]); *(v2u*)(HBo + ro + bj * 128 + n * 16) = w; }
                ss += __shfl_xor(ss, 16); ss += __shfl_xor(ss, 32);
                if (fq == 0) SSQ[(size_t)row * 32 + u.pn * 4 + wc] = ss;
                asm volatile("" ::: "memory");
                rq = rqn;
#pragma unroll
                for (int bj = 0; bj < 2; ++bj)
#pragma unroll
                    for (int n = 0; n < 2; ++n) hv[bj][n] = hn[bj][n]; }
#undef RES_LOADH
    }
};
struct EpiWin {
    static constexpr bool PERM = false, AFTER_DRAIN = false;
    bf16* B1; bf16* V1; float* out;
    __device__ __forceinline__ void operator()(const f32x4 (&acc)[2][2][4][2], const Unit& u, int wr, int wc, int fr, int fq) const {
        fr = (int)pg8::pg8_vo((unsigned)fr); fq = (int)pg8::pg8_vo((unsigned)fq);
        const int row0 = u.pm * 256 + wr * 64 + fr;
        if (u.pn < 8) {
#pragma unroll
            for (int ai = 0; ai < 2; ++ai)
#pragma unroll
                for (int m = 0; m < 4; ++m) { const int row = row0 + ai * 128 + m * 16; const int col0 = u.pn * 128 + wc * 32 + 4 * fq;
                    float* cs = nullptr;
                    { const int s = row & (SEQ - 1); if (s >= SEQ - 2) cs = out + O_CP + ((size_t)(row >> 11) * 2 + (s - (SEQ - 2))) * D; }
#pragma unroll
                    for (int n = 0; n < 2; ++n) { const f32x4 v = acc[ai][0][m][n] * acc[ai][1][m][n];
                        v2u w; w.x = pk2(v[0], v[1]); w.y = pk2(v[2], v[3]); *(v2u*)(V1 + (size_t)row * D + col0 + n * 16) = w;
                        if (cs) *(f32x4*)(cs + col0 + n * 16) = v; } }
        } else {
#pragma unroll
            for (int ai = 0; ai < 2; ++ai)
#pragma unroll
                for (int m = 0; m < 4; ++m) { bf16* rowp = B1 + (size_t)(row0 + ai * 128 + m * 16) * D + (u.pn - 8) * 256 + wc * 32 + 4 * fq;
#pragma unroll
                    for (int bj = 0; bj < 2; ++bj)
#pragma unroll
                        for (int n = 0; n < 2; ++n) { const f32x4 v = acc[ai][bj][m][n]; v2u w; w.x = pk2(v[0], v[1]); w.y = pk2(v[2], v[3]); *(v2u*)(rowp + bj * 128 + n * 16) = w; } }
        }
    }
};
__device__ __forceinline__ bf16x8 mk8(v4u w) { return __builtin_bit_cast(bf16x8, w); }
__device__ __forceinline__ f32x4 mfma16(bf16x8 a, bf16x8 b, f32x4 c) { return __builtin_amdgcn_mfma_f32_16x16x32_bf16(a, b, c, 0, 0, 0); }

__device__ __forceinline__ void p0_transpose_item(const float* W, int N, int src_n0, bf16* WTrows, int k0, LAS float* scr, int lane) {
#pragma unroll
    for (int i = 0; i < 8; ++i) { const int kk = 8 * i + (lane >> 3), n4 = (lane & 7) * 4; const f32x4 v = *(const f32x4*)(W + (size_t)(k0 + kk) * N + src_n0 + n4);
        scr[kk * 33 + n4] = v[0]; scr[kk * 33 + n4 + 1] = v[1]; scr[kk * 33 + n4 + 2] = v[2]; scr[kk * 33 + n4 + 3] = v[3]; }
    LDS_WAIT();
    const int c = lane & 7;
#pragma unroll
    for (int j = 0; j < 4; ++j) { const int n = (lane >> 3) + 8 * j; const LAS float* s = scr + (8 * c) * 33 + n;
        v4u o; o.x = pk2(s[0 * 33], s[1 * 33]); o.y = pk2(s[2 * 33], s[3 * 33]); o.z = pk2(s[4 * 33], s[5 * 33]); o.w = pk2(s[6 * 33], s[7 * 33]);
        *(v4u*)(WTrows + (size_t)n * D + k0 + 8 * c) = o; }
    LDS_WAIT();
}
__device__ __forceinline__ void p0_tr_load(const float* W, int N, int sn, int k0, f32x4 (&v)[8], int lane) {
#pragma unroll
    for (int i = 0; i < 8; ++i) { const int kk = 8 * i + (lane >> 3), n4 = (lane & 7) * 4; v[i] = *(const f32x4*)(W + (size_t)(k0 + kk) * N + sn + n4); }
}
__device__ __forceinline__ void p0_tr_store2(const f32x4 (&v0)[8], const f32x4 (&v1)[8], bf16* WT0, int k0, bool two, bf16* WT1, int k1, LAS float* scr, int lane) {
#pragma unroll
    for (int i = 0; i < 8; ++i) { const int kk = 8 * i + (lane >> 3), n4 = (lane & 7) * 4;
#pragma unroll
        for (int j = 0; j < 4; ++j) { scr[kk * 33 + n4 + j] = v0[i][j]; scr[2112 + kk * 33 + n4 + j] = v1[i][j]; } }
    LDS_WAIT();
    const int c = lane & 7;
#pragma unroll
    for (int j = 0; j < 4; ++j) { const int n = (lane >> 3) + 8 * j; const LAS float* s = scr + (8 * c) * 33 + n;
        v4u o; o.x = pk2(s[0 * 33], s[1 * 33]); o.y = pk2(s[2 * 33], s[3 * 33]); o.z = pk2(s[4 * 33], s[5 * 33]); o.w = pk2(s[6 * 33], s[7 * 33]);
        *(v4u*)(WT0 + (size_t)n * D + k0 + 8 * c) = o;
        if (two) { const LAS float* s2 = s + 2112; v4u o2; o2.x = pk2(s2[0 * 33], s2[1 * 33]); o2.y = pk2(s2[2 * 33], s2[3 * 33]); o2.z = pk2(s2[4 * 33], s2[5 * 33]); o2.w = pk2(s2[6 * 33], s2[7 * 33]);
            *(v4u*)(WT1 + (size_t)n * D + k1 + 8 * c) = o2; } }
    LDS_WAIT();
}
__device__ __forceinline__ void rms_row_bf16(const float* xrow, const float* g, bf16* orow, int lane) {
    const f32x4* xr = (const f32x4*)xrow + lane; f32x4 v[4]; float s = 0.f;
#pragma unroll
    for (int j = 0; j < 4; ++j) { v[j] = xr[64 * j]; s += (v[j].x * v[j].x + v[j].y * v[j].y) + (v[j].z * v[j].z + v[j].w * v[j].w); }
    const float r = 1.0f / sqrtf(wave_sum(s) * (1.0f / D) + RMS_EPS);
#pragma unroll
    for (int j = 0; j < 4; ++j) { const f32x4 gv = ((const f32x4*)g)[lane + 64 * j]; v2u w; w.x = pk2(v[j].x * r * gv.x, v[j].y * r * gv.y); w.y = pk2(v[j].z * r * gv.z, v[j].w * r * gv.w);
        *(v2u*)(orow + 4 * lane + 256 * j) = w; }
}

__device__ __forceinline__ void rms_row2_bf16(const float* x0, const float* x1, const float* g, bf16* o0, bf16* o1, int lane) {
    f32x4 v[2][4]; float s[2] = {0.f, 0.f}; const bool two = x1 != nullptr;
#pragma unroll
    for (int j = 0; j < 4; ++j) { v[0][j] = ((const f32x4*)x0)[lane + 64 * j]; if (two) v[1][j] = ((const f32x4*)x1)[lane + 64 * j]; else v[1][j] = (f32x4){0.f, 0.f, 0.f, 0.f}; }
#pragma unroll
    for (int h = 0; h < 2; ++h)
#pragma unroll
        for (int j = 0; j < 4; ++j) s[h] += (v[h][j].x * v[h][j].x + v[h][j].y * v[h][j].y) + (v[h][j].z * v[h][j].z + v[h][j].w * v[h][j].w);
    const float r0 = 1.0f / sqrtf(wave_sum(s[0]) * (1.0f / D) + RMS_EPS), r1 = 1.0f / sqrtf(wave_sum(s[1]) * (1.0f / D) + RMS_EPS);
#pragma unroll
    for (int j = 0; j < 4; ++j) { const f32x4 gv = ((const f32x4*)g)[lane + 64 * j];
        v2u w; w.x = pk2(v[0][j].x * r0 * gv.x, v[0][j].y * r0 * gv.y); w.y = pk2(v[0][j].z * r0 * gv.z, v[0][j].w * r0 * gv.w); *(v2u*)(o0 + 4 * lane + 256 * j) = w;
        if (two) { v2u w2; w2.x = pk2(v[1][j].x * r1 * gv.x, v[1][j].y * r1 * gv.y); w2.y = pk2(v[1][j].z * r1 * gv.z, v[1][j].w * r1 * gv.w); *(v2u*)(o1 + 4 * lane + 256 * j) = w2; } }
}
template <bool SAMPLE, bool WITH_Y>
__device__ __forceinline__ void s5_run(const bf16* HB, bf16* ZB, const bf16* BBW, const bf16* CCW, const float* dsk, LAS float* ST, int lane,
                                       int g, int row0, int nchunks, int b0, const float* s0re, const float* s0im, float* ore, float* oim, float lbr, float lbi, float& sr, float& si) {
    const int tl = lane & 15, q4 = lane >> 4;
    const bf16x8 zero8 = {0, 0, 0, 0, 0, 0, 0, 0};
    bf16x8 Abb[8], Acc[4];
#pragma unroll
    for (int tt = 0; tt < 8; ++tt) Abb[tt] = (q4 < 2) ? *(const bf16x8*)(BBW + ((size_t)(g * 128 + 16 * tt + tl)) * 16 + 8 * q4) : zero8;
    if (WITH_Y) {
#pragma unroll
        for (int s = 0; s < 4; ++s) Acc[s] = *(const bf16x8*)(CCW + ((size_t)(g * 16 + tl)) * 128 + 32 * s + 8 * q4); }
    const f32x4 dv = WITH_Y ? *(const f32x4*)(dsk + 16 * g + 4 * q4) : (f32x4){0.f, 0.f, 0.f, 0.f};
    const bf16* hp = HB + (size_t)(row0 + tl) * D + 16 * g;
    bf16x8 Bn = (q4 < 2) ? *(const bf16x8*)(hp + 8 * q4) : zero8; v2u hn = WITH_Y ? *(const v2u*)(hp + 4 * q4) : (v2u){0u, 0u};
    float s0r_[4] = {0.f, 0.f, 0.f, 0.f}, s0i_[4] = {0.f, 0.f, 0.f, 0.f};
    if (SAMPLE) {
#pragma unroll
        for (int bq = 0; bq < 4; ++bq) { const size_t si0 = ((size_t)(b0 + bq) * 64 + g) * 64 + lane; s0r_[bq] = s0re[si0]; s0i_[bq] = s0im[si0]; } }
    for (int ch = 0; ch < nchunks; ++ch) {
        const int rowc = row0 + 16 * ch;
        const bf16x8 Bu = Bn; const v2u hw = hn;
        if (ch + 1 < nchunks) { const bf16* hq = hp + (size_t)(16 * (ch + 1)) * D; Bn = (q4 < 2) ? *(const bf16x8*)(hq + 8 * q4) : zero8; if (WITH_Y) hn = *(const v2u*)(hq + 4 * q4); }
#pragma unroll
        for (int tt = 0; tt < 8; ++tt) { const f32x4 a = mfma16(Abb[tt], Bu, (f32x4){0.f, 0.f, 0.f, 0.f}); *(LAS f32x4*)(ST + tl * 132 + 16 * tt + 4 * q4) = a; }
        LDS_WAIT();
        float br[16], bi[16];
#pragma unroll
        for (int t = 0; t < 16; ++t) { br[t] = ST[t * 132 + lane]; bi[t] = ST[t * 132 + 64 + lane]; }
#pragma unroll
        for (int t = 0; t < 16; ++t) {
            if (SAMPLE && (t & 3) == 0) { sr = s0r_[t >> 2]; si = s0i_[t >> 2]; }
            const float nr = fmaf(-lbi, si, fmaf(lbr, sr, br[t])), ni = fmaf(lbi, sr, fmaf(lbr, si, bi[t]));
            sr = nr; si = ni;
            if (WITH_Y) { ST[t * 132 + lane] = sr; ST[t * 132 + 64 + lane] = si; }
            if (SAMPLE && (t & 3) == 3) { const size_t so = ((size_t)(b0 + (t >> 2)) * 64 + g) * 64 + lane; ore[so] = sr; oim[so] = si; }
        }
        LDS_WAIT();
        if (WITH_Y) {
            f32x4 y = {0.f, 0.f, 0.f, 0.f};
#pragma unroll
            for (int s = 0; s < 4; ++s) { const f32x4 lo = *(const LAS f32x4*)(ST + tl * 132 + 32 * s + 8 * q4), hi = *(const LAS f32x4*)(ST + tl * 132 + 32 * s + 8 * q4 + 4);
                v4u w; w.x = pk2(lo[0], lo[1]); w.y = pk2(lo[2], lo[3]); w.z = pk2(hi[0], hi[1]); w.w = pk2(hi[2], hi[3]);
                y = mfma16(Acc[s], mk8(w), y); }
            LDS_WAIT();
            y[0] = fmaf(dv[0], bflo(hw.x), y[0]); y[1] = fmaf(dv[1], bfhi(hw.x), y[1]); y[2] = fmaf(dv[2], bflo(hw.y), y[2]); y[3] = fmaf(dv[3], bfhi(hw.y), y[3]);
            const f32x2 g0 = pg8::gelu_pk((f32x2){y[0], y[1]}), g1 = pg8::gelu_pk((f32x2){y[2], y[3]});
            v2u zo; zo.x = pk2(g0.x, g0.y); zo.y = pk2(g1.x, g1.y);
            *(v2u*)(ZB + (size_t)(rowc + tl) * D + 16 * g + 4 * q4) = zo;
        }
    }
}
#define LDS_ORDER() asm volatile("" ::: "memory")
constexpr int S5_ST_BYTES = 8448, S5_XE_OFF = 8 * S5_ST_BYTES;
constexpr int S5_MAT_OFF = S5_XE_OFF + 4096, S5_KT_OFF = S5_MAT_OFF + 65536, S5_LDS_END = S5_KT_OFF + 8704;
static_assert(S5_LDS_END <= LDSCTL_OFF, "S5 LDS image overlaps the control words");
__device__ __forceinline__ void s5_prompt_seq(const bf16* HB, bf16* ZB, const float* LBP, const float* BBF, const bf16* BBT, const bf16* CCW, const float* cre, const float* cim, const float* dsk,
                                              LAS unsigned char* lds, int tid, int b, int g, float* ore, float* oim) {
    const int lane = tid & 63, seg = tid >> 6, tl = lane & 15, q4 = lane >> 4;
    LAS float* ST = (LAS float*)(lds + seg * S5_ST_BYTES); LAS float* XE = (LAS float*)(lds + S5_XE_OFF);
    LAS unsigned char* MAT = lds + S5_MAT_OFF; LAS unsigned char* KTL = lds + S5_KT_OFF;
    const float l16r = LBP[((size_t)(g * 17 + 16) * 64 + lane) * 2], l16i = LBP[((size_t)(g * 17 + 16) * 64 + lane) * 2 + 1];
    const int row0 = b * SEQ + seg * 256;
    bf16x8 Uf[8]; v2u hw[16]; bf16x8 Bf[4];
    const bf16* hp = HB + (size_t)(row0 + 16 * tl) * D + 16 * g + 4 * q4; bf16* zp = ZB + (size_t)(row0 + 16 * tl) * D + 16 * g + 4 * q4;
    { const bf16* up = HB + (size_t)(row0 + 16 * tl + (q4 >> 1)) * D + 16 * g + 8 * (q4 & 1);
#pragma unroll
      for (int ks = 0; ks < 8; ++ks) Uf[ks] = *(const bf16x8*)(up + (size_t)(2 * ks) * D); }
    {
        const f32x4* bb = (const f32x4*)(BBF + (size_t)(g * 64 + lane) * 32); f32x4 bv[8];
#pragma unroll
        for (int k = 0; k < 8; ++k) bv[k] = bb[k];
#pragma unroll
        for (int i = 0; i < 2; ++i) { const int n = seg + 8 * i, sidx = 15 - n; const f32x2 pw = *(const f32x2*)(LBP + ((size_t)(g * 17 + n) * 64 + lane) * 2);
            v4u re0, re1, im0, im1;
#define S5_WE2(K, RE, IM) { const float ar = pw.x * bv[K][0] - pw.y * bv[K][1], ai = pw.x * bv[K][1] + pw.y * bv[K][0], br_ = pw.x * bv[K][2] - pw.y * bv[K][3], bi_ = pw.x * bv[K][3] + pw.y * bv[K][2]; RE = pk2(ar, br_); IM = pk2(ai, bi_); }
            S5_WE2(0, re0.x, im0.x) S5_WE2(1, re0.y, im0.y) S5_WE2(2, re0.z, im0.z) S5_WE2(3, re0.w, im0.w) S5_WE2(4, re1.x, im1.x) S5_WE2(5, re1.y, im1.y) S5_WE2(6, re1.z, im1.z) S5_WE2(7, re1.w, im1.w)
#undef S5_WE2
            *(LAS v4u*)(MAT + lane * 512 + (((2 * sidx) ^ tl) << 4)) = re0; *(LAS v4u*)(MAT + lane * 512 + (((2 * sidx + 1) ^ tl) << 4)) = re1;
            *(LAS v4u*)(MAT + (64 + lane) * 512 + (((2 * sidx) ^ tl) << 4)) = im0; *(LAS v4u*)(MAT + (64 + lane) * 512 + (((2 * sidx + 1) ^ tl) << 4)) = im1; } }
    __syncthreads();
    const int cp8 = tid & 7, cc_ = (tid >> 3) & 15;
    const f32x4* crp = (const f32x4*)(cre + (size_t)(g * 16 + cc_) * 64 + 8 * cp8); const f32x4* cip = (const f32x4*)(cim + (size_t)(g * 16 + cc_) * 64 + 8 * cp8);
    const f32x4 cr0 = crp[0], cr1 = crp[1], ci0 = cip[0], ci1 = cip[1];
#pragma unroll 2
    for (int mt = 0; mt < 8; ++mt) { f32x4 a = {0.f, 0.f, 0.f, 0.f};
#pragma unroll
        for (int ks = 0; ks < 8; ++ks) a = mfma16(*(const LAS bf16x8*)(MAT + (16 * mt + tl) * 512 + (((4 * ks + q4) ^ tl) << 4)), Uf[ks], a);
        *(LAS f32x4*)(ST + tl * 132 + 16 * mt + 4 * q4) = a; }
    LDS_ORDER();
    float er[16], ei[16];
#pragma unroll
    for (int j = 0; j < 16; ++j) { er[j] = ST[j * 132 + lane]; ei[j] = ST[j * 132 + 64 + lane]; }
    float sr = 0.f, si = 0.f;
#pragma unroll
    for (int j = 0; j < 16; ++j) { const float nr = fmaf(-l16i, si, fmaf(l16r, sr, er[j])), ni = fmaf(l16i, sr, fmaf(l16r, si, ei[j])); sr = nr; si = ni; }
    XE[(seg * 64 + lane) * 2] = sr; XE[(seg * 64 + lane) * 2 + 1] = si;
    float pr = l16r, pi = l16i;
#pragma unroll
    for (int k = 0; k < 4; ++k) { const float nr = pr * pr - pi * pi, ni = 2.f * pr * pi; pr = nr; pi = ni; }
    __syncthreads();
    {
        const int p8 = cp8, c = cc_;
#pragma unroll
        for (int i = 0; i < 4; ++i) { const int t = (tid >> 7) + 4 * i; const f32x4* lp = (const f32x4*)(LBP + ((size_t)(g * 17 + t + 1) * 64 + 8 * p8) * 2);
            const f32x4 l0 = lp[0], l1 = lp[1], l2 = lp[2], l3 = lp[3]; v4u re, im;
            re.x = pk2(cr0[0] * l0[0] - ci0[0] * l0[1], cr0[1] * l0[2] - ci0[1] * l0[3]); im.x = pk2(-(cr0[0] * l0[1] + ci0[0] * l0[0]), -(cr0[1] * l0[3] + ci0[1] * l0[2]));
            re.y = pk2(cr0[2] * l1[0] - ci0[2] * l1[1], cr0[3] * l1[2] - ci0[3] * l1[3]); im.y = pk2(-(cr0[2] * l1[1] + ci0[2] * l1[0]), -(cr0[3] * l1[3] + ci0[3] * l1[2]));
            re.z = pk2(cr1[0] * l2[0] - ci1[0] * l2[1], cr1[1] * l2[2] - ci1[1] * l2[3]); im.z = pk2(-(cr1[0] * l2[1] + ci1[0] * l2[0]), -(cr1[1] * l2[3] + ci1[1] * l2[2]));
            re.w = pk2(cr1[2] * l3[0] - ci1[2] * l3[1], cr1[3] * l3[2] - ci1[3] * l3[3]); im.w = pk2(-(cr1[2] * l3[1] + ci1[2] * l3[0]), -(cr1[3] * l3[3] + ci1[3] * l3[2]));
            const int row = 16 * t + c;
            *(LAS v4u*)(MAT + row * 256 + ((p8 ^ c) << 4)) = re; *(LAS v4u*)(MAT + row * 256 + (((8 + p8) ^ c) << 4)) = im; } }
#pragma unroll
    for (int k4 = 0; k4 < 4; ++k4) Bf[k4] = *(const bf16x8*)(BBT + (size_t)(g * 16 + tl) * 128 + 32 * k4 + 8 * q4);
    float cr = 0.f, ci = 0.f;
    for (int sp = 0; sp < seg; ++sp) { const float xr_ = XE[(sp * 64 + lane) * 2], xi_ = XE[(sp * 64 + lane) * 2 + 1]; const float nr = pr * cr - pi * ci + xr_, ni = pr * ci + pi * cr + xi_; cr = nr; ci = ni; }
    sr = cr; si = ci;
#pragma unroll
    for (int j = 0; j < 16; ++j) { ST[j * 132 + lane] = sr; ST[j * 132 + 64 + lane] = si;
        const float nr = fmaf(-l16i, si, fmaf(l16r, sr, er[j])), ni = fmaf(l16i, sr, fmaf(l16r, si, ei[j])); sr = nr; si = ni; }
    if (seg == 7) { const size_t so = ((size_t)b * 64 + g) * 64 + lane; ore[so] = sr; oim[so] = si; }
    __syncthreads();
    const f32x4 dv = *(const f32x4*)(dsk + 16 * g + 4 * q4);
#pragma unroll
    for (int t = 0; t < 16; ++t) hw[t] = *(const v2u*)(hp + (size_t)t * D);
    {
#pragma unroll
        for (int i = 0; i < 2; ++i) { const int tau = 2 * seg + i; f32x4 ka = {0.f, 0.f, 0.f, 0.f};
#pragma unroll
            for (int k4 = 0; k4 < 4; ++k4) { const bf16x8 a = (tau == 0) ? *(const bf16x8*)(CCW + (size_t)(g * 16 + tl) * 128 + 32 * k4 + 8 * q4) : *(const LAS bf16x8*)(MAT + (16 * (tau - 1) + tl) * 256 + (((4 * k4 + q4) ^ tl) << 4));
                ka = mfma16(a, Bf[k4], ka); }
#pragma unroll
            for (int r = 0; r < 4; ++r) *(LAS bf16*)(KTL + (1 + tau) * 512 + (4 * q4 + r) * 32 + tl * 2) = (bf16)f2bf(ka[r]); }
        if (tid < 32) *(LAS v4u*)(KTL + tid * 16) = (v4u){0u, 0u, 0u, 0u};
    }
    bf16x8 Cf[4];
#pragma unroll
    for (int k4 = 0; k4 < 4; ++k4) { const f32x4 lo = *(const LAS f32x4*)(ST + tl * 132 + 32 * k4 + 8 * q4), hi = *(const LAS f32x4*)(ST + tl * 132 + 32 * k4 + 8 * q4 + 4);
        v4u w; w.x = pk2(lo[0], lo[1]); w.y = pk2(lo[2], lo[3]); w.z = pk2(hi[0], hi[1]); w.w = pk2(hi[2], hi[3]); Cf[k4] = mk8(w); }
    const LAS unsigned char* kp = KTL + tl * 32 + 16 * (q4 & 1);
    __syncthreads();
#pragma unroll
    for (int t = 0; t < 16; ++t) { f32x4 y = {0.f, 0.f, 0.f, 0.f};
#pragma unroll
        for (int ks = 0; ks <= (t >> 1); ++ks) { const int tau = t - 2 * ks - (q4 >> 1); const int blk = tau >= 0 ? tau + 1 : 0; y = mfma16(*(const LAS bf16x8*)(kp + blk * 512), Uf[ks], y); }
#pragma unroll
        for (int k4 = 0; k4 < 4; ++k4) y = mfma16(*(const LAS bf16x8*)(MAT + (16 * t + tl) * 256 + (((4 * k4 + q4) ^ tl) << 4)), Cf[k4], y);
        y[0] = fmaf(dv[0], bflo(hw[t].x), y[0]); y[1] = fmaf(dv[1], bfhi(hw[t].x), y[1]); y[2] = fmaf(dv[2], bflo(hw[t].y), y[2]); y[3] = fmaf(dv[3], bfhi(hw[t].y), y[3]);
        const f32x2 g0 = pg8::gelu_pk((f32x2){y[0], y[1]}), g1 = pg8::gelu_pk((f32x2){y[2], y[3]});
        v2u zo; zo.x = pk2(g0.x, g0.y); zo.y = pk2(g1.x, g1.y);
        *(v2u*)(zp + (size_t)t * D) = zo; }
    __syncthreads();
}

__device__ __forceinline__ float xreduce16(const float (&p)[16], int lane) {
    float q[8], r[4], s[2];
    const bool b5 = (lane & 32) != 0, b4 = (lane & 16) != 0, b3 = (lane & 8) != 0, b2 = (lane & 4) != 0;
#pragma unroll
    for (int k = 0; k < 8; ++k) { const float send = b5 ? p[k] : p[k + 8], keep = b5 ? p[k + 8] : p[k]; q[k] = keep + __shfl_xor(send, 32); }
#pragma unroll
    for (int k = 0; k < 4; ++k) { const float send = b4 ? q[k] : q[k + 4], keep = b4 ? q[k + 4] : q[k]; r[k] = keep + __shfl_xor(send, 16); }
#pragma unroll
    for (int k = 0; k < 2; ++k) { const float send = b3 ? r[k] : r[k + 2], keep = b3 ? r[k + 2] : r[k]; s[k] = keep + __shfl_xor(send, 8); }
    const float send = b2 ? s[0] : s[1], keep = b2 ? s[1] : s[0]; float t = keep + __shfl_xor(send, 4);
    t += __shfl_xor(t, 2); t += __shfl_xor(t, 1);
    return t;
}

__host__ __device__ __forceinline__ int vt_pos(int m) { return (m & ~31) | (((m >> 2) & 3) << 3) | (((m >> 4) & 1) << 2) | (m & 3); }
template <int NB_>
__device__ __forceinline__ void stage_tile256(const bf16* src, int ldsrc, LAS unsigned char* tb, int tid) {
#pragma unroll 1
    for (int hp = 0; hp < 16 / NB_; ++hp) { v4u r[NB_];
#pragma unroll
        for (int i = 0; i < NB_; ++i) { const int c = tid + 512 * (NB_ * hp + i), row = c >> 5, ch = c & 31; r[i] = *(const v4u*)(src + (size_t)row * ldsrc + ch * 8); }
#pragma unroll
        for (int i = 0; i < NB_; ++i) { const int c = tid + 512 * (NB_ * hp + i), row = c >> 5, ch = c & 31; *(LAS v4u*)(tb + row * 512 + ((ch ^ (row & 15)) << 4)) = r[i]; } }
}
__device__ __forceinline__ float attn_softmax(f32x4 (&S)[16], bf16x8 (&Pf)[8]) {
    float mx = -3.0e38f;
#pragma unroll
    for (int mt = 0; mt < 16; ++mt) mx = fmaxf(fmaxf(mx, fmaxf(S[mt][0], S[mt][1])), fmaxf(S[mt][2], S[mt][3]));
    mx = fmaxf(mx, __shfl_xor(mx, 16)); mx = fmaxf(mx, __shfl_xor(mx, 32));
    const float sc2 = 0.0625f * 1.4426950408889634f; float sum = 0.f;
#pragma unroll
    for (int mt = 0; mt < 16; ++mt)
#pragma unroll
        for (int i = 0; i < 4; ++i) { const float p = __builtin_amdgcn_exp2f((S[mt][i] - mx) * sc2); S[mt][i] = p; sum += p; }
    sum += __shfl_xor(sum, 16); sum += __shfl_xor(sum, 32);
#pragma unroll
    for (int ks = 0; ks < 8; ++ks) { v4u w; w.x = pk2(S[2 * ks][0], S[2 * ks][1]); w.y = pk2(S[2 * ks][2], S[2 * ks][3]); w.z = pk2(S[2 * ks + 1][0], S[2 * ks + 1][1]); w.w = pk2(S[2 * ks + 1][2], S[2 * ks + 1][3]); Pf[ks] = mk8(w); }
    return 1.0f / sum;
}
__device__ __forceinline__ void attn_prompt_wg(const bf16* QB, const bf16* KBl, const bf16* VTl, bf16* OB, int b, int h, int r0, LAS unsigned char* tb, int tid) {
    const int lane = tid & 63, w = tid >> 6, tl = lane & 15, q4 = lane >> 4;
    const size_t rowA = (size_t)b * SEQ + r0 + 16 * w + tl, rowB = rowA + 128;
    stage_tile256<16>(KBl + (size_t)b * MEMT * D + h * HD, D, tb, tid);
    __syncthreads();
    f32x4 SA[16], SB[16];
#pragma unroll
    for (int mt = 0; mt < 16; ++mt) { SA[mt] = (f32x4){0.f, 0.f, 0.f, 0.f}; SB[mt] = (f32x4){0.f, 0.f, 0.f, 0.f}; }
    const bf16* qa = QB + rowA * D + h * HD + 8 * q4; const bf16* qb = QB + rowB * D + h * HD + 8 * q4;
    const LAS unsigned char* fb = tb + tl * 512;
#pragma unroll 2
    for (int ks = 0; ks < 8; ++ks) { const bf16x8 fa = *(const bf16x8*)(qa + 32 * ks), fbq = *(const bf16x8*)(qb + 32 * ks); const int co = ((4 * ks + q4) ^ tl) << 4;
#pragma unroll
        for (int mt = 0; mt < 16; ++mt) { const bf16x8 kf = *(const LAS bf16x8*)(fb + mt * 8192 + co); SA[mt] = mfma16(kf, fa, SA[mt]); SB[mt] = mfma16(kf, fbq, SB[mt]); } }
    bf16x8 PA[8], PB[8];
    const float invA = attn_softmax(SA, PA), invB = attn_softmax(SB, PB);
    __syncthreads();
    stage_tile256<16>(VTl + ((size_t)b * NH + h) * HD * MEMT, MEMT, tb, tid);
    __syncthreads();
#pragma unroll 2
    for (int dt = 0; dt < 16; ++dt) { f32x4 oa = {0.f, 0.f, 0.f, 0.f}, ob = {0.f, 0.f, 0.f, 0.f};
#pragma unroll
        for (int ks = 0; ks < 8; ++ks) { const bf16x8 vf = *(const LAS bf16x8*)(fb + dt * 8192 + (((4 * ks + q4) ^ tl) << 4)); oa = mfma16(vf, PA[ks], oa); ob = mfma16(vf, PB[ks], ob); }
        v2u wa, wb; wa.x = pk2(oa[0] * invA, oa[1] * invA); wa.y = pk2(oa[2] * invA, oa[3] * invA); wb.x = pk2(ob[0] * invB, ob[1] * invB); wb.y = pk2(ob[2] * invB, ob[3] * invB);
        *(v2u*)(OB + rowA * D + h * HD + 16 * dt + 4 * q4) = wa; *(v2u*)(OB + rowB * D + h * HD + 16 * dt + 4 * q4) = wb; }
    __syncthreads();
}
__device__ __forceinline__ void attn_sample_task(const bf16* QB, const float* ck, const float* cv, bf16* OB, int l, int b, int h, LAS float* lds, int tid) {
    const int lane = tid & 63, w = tid >> 6;
    LAS float* sc = lds; LAS float* red = lds + 1024;
    const size_t cbase = ((((size_t)l * DB + b) * MEMT) * NH + h) * HD;
    const float* kp = ck + cbase + (size_t)(32 * w) * (NH * HD) + 4 * lane; const float* vp = cv + cbase + (size_t)(32 * w) * (NH * HD) + 4 * lane;
    f32x4 kr[32];
#pragma unroll
    for (int mi = 0; mi < 32; ++mi) kr[mi] = __builtin_nontemporal_load((const f32x4*)(kp + (size_t)mi * (NH * HD)));
    float qf[4][4];
#pragma unroll
    for (int s = 0; s < 4; ++s) { const v2u qw = *(const v2u*)(QB + (size_t)(TP + 4 * b + s) * D + h * HD + 4 * lane); qf[s][0] = bflo(qw.x); qf[s][1] = bfhi(qw.x); qf[s][2] = bflo(qw.y); qf[s][3] = bfhi(qw.y); }
#pragma unroll
    for (int gi = 0; gi < 8; ++gi) { float pd[16];
#pragma unroll
        for (int ri = 0; ri < 4; ++ri) { const f32x4 kv = kr[4 * gi + ri];
#pragma unroll
            for (int s = 0; s < 4; ++s) pd[4 * ri + s] = kv[0] * qf[s][0] + kv[1] * qf[s][1] + kv[2] * qf[s][2] + kv[3] * qf[s][3]; }
        const float tot = xreduce16(pd, lane); const int k = lane >> 2;
        if ((lane & 3) == 0) sc[(k & 3) * 256 + 32 * w + 4 * gi + (k >> 2)] = tot * 0.0625f; }
    f32x4 vr[32];
#pragma unroll
    for (int mi = 0; mi < 32; ++mi) vr[mi] = __builtin_nontemporal_load((const f32x4*)(vp + (size_t)mi * (NH * HD)));
    __syncthreads();
    if (w < 4) { float v[4]; float mx = -3.0e38f;
#pragma unroll
        for (int j = 0; j < 4; ++j) { v[j] = sc[w * 256 + lane + 64 * j]; mx = fmaxf(mx, v[j]); }
        mx = wave_max(mx); float sum = 0.f;
#pragma unroll
        for (int j = 0; j < 4; ++j) { v[j] = __expf(v[j] - mx); sum += v[j]; }
        sum = wave_sum(sum); const float inv = 1.0f / sum;
#pragma unroll
        for (int j = 0; j < 4; ++j) sc[w * 256 + lane + 64 * j] = v[j] * inv; }
    __syncthreads();
    f32x4 o[4];
#pragma unroll
    for (int s = 0; s < 4; ++s) o[s] = (f32x4){0.f, 0.f, 0.f, 0.f};
#pragma unroll
    for (int mi = 0; mi < 32; ++mi) {
#pragma unroll
        for (int s = 0; s < 4; ++s) { const float p = sc[s * 256 + 32 * w + mi]; o[s] += vr[mi] * p; } }
#pragma unroll
    for (int s = 0; s < 4; ++s) *(LAS f32x4*)(red + (w * 4 + s) * 256 + 4 * lane) = o[s];
    __syncthreads();
    { const int idx = tid * 2, s = idx >> 8, d = idx & 255; float a0 = 0.f, a1 = 0.f;
#pragma unroll
        for (int ww = 0; ww < 8; ++ww) { a0 += red[(ww * 4 + s) * 256 + d]; a1 += red[(ww * 4 + s) * 256 + d + 1]; }
        *(unsigned*)(OB + (size_t)(TP + 4 * b + s) * D + h * HD + d) = pk2(a0, a1); }
    __syncthreads();
}

__device__ __forceinline__ unsigned ord_of(float x) { const unsigned u = __builtin_bit_cast(unsigned, x); return u ^ ((u >> 31) ? 0xFFFFFFFFu : 0x80000000u); }
__device__ __forceinline__ float ord_inv(unsigned k) { const unsigned u = (k & 0x80000000u) ? (k ^ 0x80000000u) : ~k; return __builtin_bit_cast(float, u); }
__device__ __forceinline__ unsigned umax2(unsigned a, unsigned b) { return a > b ? a : b; }
__device__ __forceinline__ unsigned umax_x4(unsigned v) { v = umax2(v, (unsigned)__shfl_xor((int)v, 16)); return umax2(v, (unsigned)__shfl_xor((int)v, 32)); }
constexpr int PSEL_KEYS = 65536, PSEL_TI = 2048;
__device__ __forceinline__ void peer_stage_keys(const bf16* KEYl, LAS unsigned char* kl, int tid) {
#pragma unroll
    for (int i = 0; i < 8; ++i) { const int c = tid + 512 * i, hr = c >> 4, ch = c & 15; *(LAS v4u*)(kl + hr * 256 + ((ch ^ (hr & 15)) << 4)) = *(const v4u*)(KEYl + (size_t)hr * 128 + ch * 8); }
}
__device__ __forceinline__ unsigned umin2(unsigned a, unsigned b) { return a < b ? a : b; }
__device__ __forceinline__ void ce_desc(unsigned& a, unsigned& b) { const unsigned hi = umax2(a, b), lo = umin2(a, b); a = hi; b = lo; }
template <int N> __device__ __forceinline__ void bitonic_sort_desc(unsigned (&a)[N]) {
#pragma unroll
    for (int k = 2; k <= N; k <<= 1)
#pragma unroll
        for (int j = k >> 1; j > 0; j >>= 1)
#pragma unroll
            for (int i = 0; i < N; ++i) { const int l = i ^ j; if (l > i) { if ((i & k) == 0) ce_desc(a[i], a[l]); else ce_desc(a[l], a[i]); } }
}
template <int N> __device__ __forceinline__ void oem_sort_desc(unsigned (&a)[N]) {
#pragma unroll
    for (int p = 1; p < N; p <<= 1)
#pragma unroll
        for (int k = p; k >= 1; k >>= 1)
#pragma unroll
            for (int j = k % p; j + k < N; j += 2 * k)
#pragma unroll
                for (int i = 0; i < k; ++i) if (i + j + k < N && (i + j) / (2 * p) == (i + j + k) / (2 * p)) ce_desc(a[i + j], a[i + j + k]);
}
__device__ __forceinline__ void bitonic_merge16_desc(unsigned (&c)[16]) {
#pragma unroll
    for (int j = 8; j > 0; j >>= 1)
#pragma unroll
        for (int i = 0; i < 16; ++i) { const int l = i ^ j; if (l > i) ce_desc(c[i], c[l]); }
}
__device__ __forceinline__ void merge_top16(unsigned (&a)[16], int mask, int l4_) {
    unsigned c[16];
#pragma unroll
    for (int i = 0; i < 16; ++i) c[i] = umax2(a[i], mk_shx(a[15 - i], mask, l4_));
    bitonic_merge16_desc(c);
#pragma unroll
    for (int i = 0; i < 16; ++i) a[i] = c[i];
}
__device__ __forceinline__ void peer_select_loadq(const bf16* QP, int row0, int hh, int lane, bf16x8 (&q)[8]) {
    const int r_ = lane & 15, tok_ = hh < 0 ? row0 + (r_ >> 3) : row0 + r_, hd_ = hh < 0 ? (r_ & 7) : hh;
    const bf16* qb = QP + (size_t)tok_ * 2048 + hd_ * 256 + 8 * (lane >> 4);
#pragma unroll
    for (int i = 0; i < 8; ++i) q[i] = *(const bf16x8*)(qb + (i >> 2) * 128 + 32 * (i & 3));
}
__device__ __forceinline__ void peer_select_task(const bf16x8 (&qin)[8], const LAS unsigned char* kl, int* EID, float* EG, int row0, int hh, LAS int* TI, int lane) {
    const int tl = lane & 15, q4 = lane >> 4;
    unsigned bk[2][16];
#pragma unroll
    for (int half = 0; half < 2; ++half) {
        f32x4 acc[8];
#pragma unroll
        for (int nt = 0; nt < 8; ++nt) acc[nt] = (f32x4){0.f, 0.f, 0.f, 0.f};
        const LAS unsigned char* kb = kl + (half * 128 + tl) * 256;
#pragma unroll
        for (int ks = 0; ks < 4; ++ks) { const bf16x8 qf = qin[half * 4 + ks]; const int co = ((4 * ks + q4) ^ tl) << 4;
#pragma unroll
            for (int nt = 0; nt < 8; ++nt) { const bf16x8 kf = *(const LAS bf16x8*)(kb + nt * 4096 + co); acc[nt] = mfma16(kf, qf, acc[nt]); } }
        unsigned ka[16], kc[16];
#pragma unroll
        for (int nt = 0; nt < 4; ++nt)
#pragma unroll
            for (int i = 0; i < 4; ++i) { ka[4 * nt + i] = (ord_of(acc[nt][i]) & 0xFFFFFF80u) | (unsigned)(16 * nt + 4 * q4 + i); kc[4 * nt + i] = (ord_of(acc[nt + 4][i]) & 0xFFFFFF80u) | (unsigned)(16 * (nt + 4) + 4 * q4 + i); }
        oem_sort_desc<16>(ka); oem_sort_desc<16>(kc);
        unsigned top[16];
#pragma unroll
        for (int r = 0; r < 16; ++r) top[r] = umax2(ka[r], kc[15 - r]);
        bitonic_merge16_desc(top);
        merge_top16(top, 16, lane << 2); merge_top16(top, 32, lane << 2);
#pragma unroll
        for (int r = 0; r < 16; ++r) bk[half][r] = top[r];
    }
    if (q4 == 0) {
#pragma unroll
        for (int r = 0; r < 16; r += 4) { *(LAS v4i*)(TI + tl * 32 + r) = (v4i){(int)(bk[0][r] & 127u), (int)(bk[0][r + 1] & 127u), (int)(bk[0][r + 2] & 127u), (int)(bk[0][r + 3] & 127u)};
            *(LAS v4i*)(TI + tl * 32 + 16 + r) = (v4i){(int)(bk[1][r] & 127u), (int)(bk[1][r + 1] & 127u), (int)(bk[1][r + 2] & 127u), (int)(bk[1][r + 3] & 127u)}; } }
    float v2[16];
#pragma unroll
    for (int j = 0; j < 16; ++j) v2[j] = ord_inv(bk[1][j] & 0xFFFFFF80u);
    unsigned ct[16], cb[5];
    { const float v1a = ord_inv((q4 == 0 ? bk[0][0] : q4 == 1 ? bk[0][1] : q4 == 2 ? bk[0][2] : bk[0][3]) & 0xFFFFFF80u), v1b = ord_inv((q4 == 0 ? bk[0][4] : q4 == 1 ? bk[0][5] : q4 == 2 ? bk[0][6] : bk[0][7]) & 0xFFFFFF80u);
      const float v1c = ord_inv((q4 == 0 ? bk[0][8] : q4 == 1 ? bk[0][9] : q4 == 2 ? bk[0][10] : bk[0][11]) & 0xFFFFFF80u), v1d = ord_inv((q4 == 0 ? bk[0][12] : q4 == 1 ? bk[0][13] : q4 == 2 ? bk[0][14] : bk[0][15]) & 0xFFFFFF80u);
#pragma unroll
      for (int j = 0; j < 16; ++j) { const bool ok = (q4 + 1) * (j + 1) <= 16; ct[j] = ok ? ((ord_of(v1a + v2[j]) & 0xFFFFFF00u) | (unsigned)(255 - (q4 * 16 + j))) : 0u; }
#pragma unroll
      for (int j = 0; j < 3; ++j) { const bool ok = (q4 + 5) * (j + 1) <= 16; cb[j] = ok ? ((ord_of(v1b + v2[j]) & 0xFFFFFF00u) | (unsigned)(255 - ((4 + q4) * 16 + j))) : 0u; }
      cb[3] = (ord_of(v1c + v2[0]) & 0xFFFFFF00u) | (unsigned)(255 - (8 + q4) * 16); cb[4] = (ord_of(v1d + v2[0]) & 0xFFFFFF00u) | (unsigned)(255 - (12 + q4) * 16); }
    ce_desc(cb[0], cb[1]); ce_desc(cb[3], cb[4]); ce_desc(cb[2], cb[4]); ce_desc(cb[2], cb[3]); ce_desc(cb[0], cb[3]); ce_desc(cb[0], cb[2]); ce_desc(cb[1], cb[4]); ce_desc(cb[1], cb[3]); ce_desc(cb[1], cb[2]);
#pragma unroll
    for (int k = 0; k < 5; ++k) ct[15 - k] = umax2(ct[15 - k], cb[k]);
    bitonic_merge16_desc(ct);
    merge_top16(ct, 16, lane << 2); merge_top16(ct, 32, lane << 2);
    LDS_WAIT();
    float sv[16]; float sum = 0.f; const float smax = ord_inv(ct[0] & 0xFFFFFF00u);
#pragma unroll
    for (int r = 0; r < 16; ++r) { sv[r] = __expf(ord_inv(ct[r] & 0xFFFFFF00u) - smax); sum += sv[r]; }
    const float inv = 1.0f / sum;
    unsigned c0, c1, c2, c3; f32x4 go;
    if (q4 == 0) { c0 = ct[0]; c1 = ct[1]; c2 = ct[2]; c3 = ct[3]; go = (f32x4){sv[0], sv[1], sv[2], sv[3]}; }
    else if (q4 == 1) { c0 = ct[4]; c1 = ct[5]; c2 = ct[6]; c3 = ct[7]; go = (f32x4){sv[4], sv[5], sv[6], sv[7]}; }
    else if (q4 == 2) { c0 = ct[8]; c1 = ct[9]; c2 = ct[10]; c3 = ct[11]; go = (f32x4){sv[8], sv[9], sv[10], sv[11]}; }
    else { c0 = ct[12]; c1 = ct[13]; c2 = ct[14]; c3 = ct[15]; go = (f32x4){sv[12], sv[13], sv[14], sv[15]}; }
    const LAS int* ti = TI + tl * 32;
    v4i eo;
    c0 = ~c0; c1 = ~c1; c2 = ~c2; c3 = ~c3;
    eo[0] = ti[(c0 >> 4) & 15] * 128 + ti[16 + (c0 & 15)]; eo[1] = ti[(c1 >> 4) & 15] * 128 + ti[16 + (c1 & 15)];
    eo[2] = ti[(c2 >> 4) & 15] * 128 + ti[16 + (c2 & 15)]; eo[3] = ti[(c3 >> 4) & 15] * 128 + ti[16 + (c3 & 15)];
    { const int tok_ = hh < 0 ? row0 + (tl >> 3) : row0 + tl, hd_ = hh < 0 ? (tl & 7) : hh;
      *(v4i*)(EID + (size_t)tok_ * 128 + hd_ * 16 + 4 * q4) = eo; *(f32x4*)(EG + (size_t)tok_ * 128 + hd_ * 16 + 4 * q4) = go * inv; }
    LDS_WAIT();
}

constexpr float U_SCALE = 32.f, V_SCALE = 8.f;
__device__ __forceinline__ void cvt16(const v4u w, float (&f)[16]) {
#pragma unroll
    for (int q = 0; q < 4; ++q) { const f32x2 a = __builtin_amdgcn_cvt_pk_f32_fp8((int)w[q], false), b = __builtin_amdgcn_cvt_pk_f32_fp8((int)w[q], true); f[4 * q] = a.x; f[4 * q + 1] = a.y; f[4 * q + 2] = b.x; f[4 * q + 3] = b.y; }
}
__device__ __forceinline__ float xreduce8(const float (&p)[8], int lane) {
    float q[4], r[2];
    const bool b5 = (lane & 32) != 0, b4 = (lane & 16) != 0, b3 = (lane & 8) != 0;
#pragma unroll
    for (int k = 0; k < 4; ++k) { const float send = b5 ? p[k] : p[k + 4], keep = b5 ? p[k + 4] : p[k]; q[k] = keep + __shfl_xor(send, 32); }
#pragma unroll
    for (int k = 0; k < 2; ++k) { const float send = b4 ? q[k] : q[k + 2], keep = b4 ? q[k + 2] : q[k]; r[k] = keep + __shfl_xor(send, 16); }
    const float send = b3 ? r[0] : r[1], keep = b3 ? r[1] : r[0]; float t = keep + __shfl_xor(send, 8);
    t += __shfl_xor(t, 4); t += __shfl_xor(t, 2); t += __shfl_xor(t, 1);
    return t;
}
constexpr float U6_SCALE = 64.f, V6_SCALE = 16.f;
typedef float v32f __attribute__((ext_vector_type(32)));
typedef float v16f __attribute__((ext_vector_type(16)));
typedef unsigned v6u __attribute__((ext_vector_type(6)));
typedef unsigned v3u __attribute__((ext_vector_type(3)));
__device__ __forceinline__ v6u load6(const unsigned char* p) { const v3u a = *(const v3u*)p, b = *(const v3u*)(p + 12); v6u r; r[0] = a[0]; r[1] = a[1]; r[2] = a[2]; r[3] = b[0]; r[4] = b[1]; r[5] = b[2]; return r; }
__device__ __forceinline__ int mbcnt64(unsigned long long m) { return (int)__builtin_amdgcn_mbcnt_hi((unsigned)(m >> 32), __builtin_amdgcn_mbcnt_lo((unsigned)m, 0u)); }
template <bool FINAL>
__device__ __forceinline__ void peer_gather_wave6(int m0, int step, int tlim, int lane, unsigned char* wsb, int layer, float* YOUT, const float* gprev, const float* gnext, LAS unsigned char* lw) {
#define HB ((bf16*)(wsb + WS_HB))
#define EID ((const int*)(wsb + WS_EID))
#define EG ((const float*)(wsb + WS_EG))
#define SSQ ((const float*)(wsb + WS_SSQ))
#define RROW ((float*)(wsb + WS_RROW))
    const unsigned char* UV = wsb + WS_UV + (size_t)layer * NEXP * 1536;
    int t = m0; if (t >= tlim) return;
    int buf = 0;
#define PG6_SORT(E0, E1, G0, G1, BUF, FLIP) do { const int e0_ = (E0), e1_ = (E1); const float g0_ = (G0), g1_ = (G1); \
        const int b0_ = (e0_ >> 10) ^ (FLIP), b1_ = (e1_ >> 10) ^ (FLIP); int off_ = 0, p0_ = 0, p1_ = 0; \
        _Pragma("unroll") for (int k_ = 0; k_ < 16; ++k_) { const unsigned long long m0_ = __ballot(b0_ == k_), m1_ = __ballot(b1_ == k_); const int c0_ = __popcll(m0_), c1_ = __popcll(m1_); \
            p0_ = (b0_ == k_) ? off_ + mbcnt64(m0_) : p0_; p1_ = (b1_ == k_) ? off_ + c0_ + mbcnt64(m1_) : p1_; off_ += c0_ + c1_; } \
        LAS int* se_ = (LAS int*)(lw + (BUF) * 1024); LAS float* sg_ = (LAS float*)(lw + (BUF) * 1024 + 512); se_[p0_] = e0_; sg_[p0_] = g0_; se_[p1_] = e1_; sg_[p1_] = g1_; } while (0)
#define PG6_IDS(BUF, ST, E_, G_) do { E_ = ((const LAS int*)(lw + (BUF) * 1024))[(ST) * 8 + xl]; G_ = ((const LAS float*)(lw + (BUF) * 1024 + 512))[(ST) * 8 + xl]; } while (0)
#define l4_ (lane << 2)
    int flip = 0;
    int pe0[8], pe1[8]; float pg0[8], pg1[8];
#pragma unroll
    for (int k = 0; k < 8; ++k) { const int tk_ = (t + k * step < tlim) ? t + k * step : t;
        const size_t tb_ = (size_t)tk_ * 128; const char* eb_ = (const char*)(EID + tb_); const char* gb_ = (const char*)(EG + tb_); const unsigned lo_ = pg8::pg8_vo((unsigned)(4 * lane));
        pe0[k] = *(const int*)(eb_ + lo_); pe1[k] = *(const int*)(eb_ + lo_ + 256); pg0[k] = *(const float*)(gb_ + lo_); pg1[k] = *(const float*)(gb_ + lo_ + 256); }
#pragma unroll
    for (int k = 0; k < 8; ++k) { if (t + k * step < tlim) PG6_SORT(pe0[k], pe1[k], pg0[k], pg1[k], k, (k & 1) ? 15 : 0); }
    LDS_WAIT();
    int eid; float gt; { const int xl = 4 * ((mk_lane_id() >> 4) & 1) + 2 * ((mk_lane_id() >> 3) & 1) + (mk_lane_id() >> 5); PG6_IDS(0, 0, eid, gt); }
    v6u ub[4], vbA[4], vbB[4];
#define PG6_LOADU(E_, UB) do { _Pragma("unroll") for (int k = 0; k < 4; ++k) { const int ea = __builtin_amdgcn_readlane(E_, 8 * k), eb = __builtin_amdgcn_readlane(E_, 32 + 8 * k); UB[k] = load6(UV + pg8::pg8_vo((unsigned)(hw ? eb : ea) * 1536u + 24u * (unsigned)li)); } } while (0)
#define PG6_LOADV(E_, VB) do { _Pragma("unroll") for (int k = 0; k < 4; ++k) { const int ea = __builtin_amdgcn_readlane(E_, 8 * k), eb = __builtin_amdgcn_readlane(E_, 32 + 8 * k); VB[k] = load6(UV + pg8::pg8_vo((unsigned)(hw ? eb : ea) * 1536u + 24u * (unsigned)li + 768u)); } } while (0)
#define PG6_DOTS(UB, GT, WV) do { float pd[4]; \
        _Pragma("unroll") for (int k = 0; k < 4; ++k) { const v32bf f = __builtin_amdgcn_cvt_scalef32_pk32_bf16_fp6(UB[k], 1.0f); float d = 0.f; \
            _Pragma("unroll") for (int i = 0; i < 16; ++i) d = __builtin_amdgcn_fdot2_f32_bf16((v2bf){f[2 * i], f[2 * i + 1]}, __builtin_bit_cast(v2bf, hfp[i]), d, false); \
            pd[k] = d; } \
        float q0, q1; const int l4s_ = mk_lane_id() << 2;            \
        { const float s0 = b4 ? pd[0] : pd[2], k0 = b4 ? pd[2] : pd[0]; q0 = k0 + mk_shx(s0, 16, l4s_); const float s1 = b4 ? pd[1] : pd[3], k1 = b4 ? pd[3] : pd[1]; q1 = k1 + mk_shx(s1, 16, l4s_); } \
        float tot; { const float sd = b3 ? q0 : q1, kp = b3 ? q1 : q0; tot = kp + mk_shx(sd, 8, l4s_); } \
        tot += mk_shx(tot, 4, l4s_); tot += mk_shx(tot, 2, l4s_); tot += mk_shx(tot, 1, l4s_); \
        WV = (GT) * gelu1(tot * rin) * (1.0f / V6_SCALE); } while (0)
#define PG6_ACC(VB, WV) do { _Pragma("unroll") for (int k = 0; k < 4; ++k) { const float wa = __builtin_bit_cast(float, __builtin_amdgcn_readlane(__builtin_bit_cast(int, WV), 8 * k)), wb = __builtin_bit_cast(float, __builtin_amdgcn_readlane(__builtin_bit_cast(int, WV), 32 + 8 * k)); \
            const float wk = hw ? wb : wa; const v32f f = __builtin_amdgcn_cvt_scalef32_pk32_f32_fp6(VB[k], 1.0f); \
            _Pragma("unroll") for (int i = 0; i < 32; ++i) acc[i] = fmaf(wk, f[i], acc[i]); __builtin_amdgcn_sched_barrier(0); } } while (0)
    { const int ln_ = mk_lane_id(); const int hw = ln_ >> 5, li = ln_ & 31; const bool b4 = (ln_ & 16) != 0, b3 = (ln_ & 8) != 0; const int xl = 4 * ((ln_ >> 4) & 1) + 2 * ((ln_ >> 3) & 1) + hw; const unsigned char* uvl = UV + 24 * li; (void)b4; (void)b3; (void)xl; (void)uvl; PG6_LOADU(eid, ub); PG6_LOADV(eid, vbA); }
    for (;;) {
        const int tn = t + step; const bool more = (tn < tlim) && (buf < 7); const int bufn = buf + 1;
        const float rin = row_rinv(SSQ, (size_t)t, 16) * (1.0f / U6_SCALE);
        unsigned hfp[16]; float acc[32];
        { const int li = mk_lane_id() & 31; const char* hp = (const char*)(HB + (size_t)t * D); const unsigned lo64 = pg8::pg8_vo((unsigned)(64 * li));
#pragma unroll
          for (int q = 0; q < 4; ++q) { const v4u h = *(const v4u*)(hp + lo64 + 16 * q); hfp[4 * q] = h.x; hfp[4 * q + 1] = h.y; hfp[4 * q + 2] = h.z; hfp[4 * q + 3] = h.w; } }
#pragma unroll
        for (int i = 0; i < 32; ++i) acc[i] = 0.f;
#pragma unroll 1
        for (int st = 0; st < 16; st += 2) {
            const int ln_ = mk_lane_id(); const int hw = ln_ >> 5, li = ln_ & 31; const bool b4 = (ln_ & 16) != 0, b3 = (ln_ & 8) != 0; const int xl = 4 * ((ln_ >> 4) & 1) + 2 * ((ln_ >> 3) & 1) + hw; const unsigned char* uvl = UV + 24 * li; (void)b4; (void)b3; (void)xl; (void)uvl;
            int eid_b; float gt_b; PG6_IDS(buf, st + 1, eid_b, gt_b);
            PG6_LOADV(eid_b, vbB);
            float gt_a; { int e_; PG6_IDS(buf, st, e_, gt_a); (void)e_; }
            float wva; PG6_DOTS(ub, gt_a, wva);
            PG6_LOADU(eid_b, ub);
            PG6_ACC(vbA, wva);
            int eid_n = eid_b; float gt_n = 0.f;
            if (st < 14) PG6_IDS(buf, st + 2, eid_n, gt_n); else if (more) PG6_IDS(bufn, 0, eid_n, gt_n);
            PG6_LOADV(eid_n, vbA);
            float wvb; PG6_DOTS(ub, gt_b, wvb);
            PG6_LOADU(eid_n, ub);
            PG6_ACC(vbB, wvb);
        }
        { const int ln_ = mk_lane_id(); const int hw = ln_ >> 5, li = ln_ & 31; const bool b4 = (ln_ & 16) != 0, b3 = (ln_ & 8) != 0; const int xl = 4 * ((ln_ >> 4) & 1) + 2 * ((ln_ >> 3) & 1) + hw; const unsigned char* uvl = UV + 24 * li; (void)b4; (void)b3; (void)xl; (void)uvl;
        const unsigned cb4 = pg8::pg8_vo((unsigned)((32 * li + 16 * hw) * 4));
        f32x4 x[4]; float ss = 0.f;
#pragma unroll
        for (int j = 0; j < 4; ++j) { const f32x4 gp = *(const f32x4*)((const char*)gprev + cb4 + 16 * j);
#pragma unroll
            for (int i = 0; i < 4; ++i) { const int c = 4 * j + i; const float lo = acc[c] + mk_shx(acc[c], 32, ln_ << 2), hi = acc[16 + c] + mk_shx(acc[16 + c], 32, ln_ << 2);
                const unsigned hq = hw ? hfp[8 + (c >> 1)] : hfp[c >> 1]; const float xv = ((c & 1) ? bfhi(hq) : bflo(hq)) / gp[i] + (hw ? hi : lo); x[j][i] = xv; ss = fmaf(xv, xv, ss); } }
        const float r = 1.0f / sqrtf(wave_sum(ss) * (1.0f / D) + RMS_EPS);
        f32x4 gv[4];
#pragma unroll
        for (int j = 0; j < 4; ++j) gv[j] = *(const f32x4*)((const char*)gnext + cb4 + 16 * j);
        if (FINAL) { char* yo = (char*)(YOUT + (size_t)t * D);
#pragma unroll
            for (int j = 0; j < 4; ++j) *(f32x4*)(yo + cb4 + 16 * j) = x[j] * r * gv[j];
        } else {
            const f32x4 a = x[0] * r * gv[0], bq = x[1] * r * gv[1], c = x[2] * r * gv[2], dq = x[3] * r * gv[3];
            v4u w0, w1;
            w0.x = pk2(a[0], a[1]); w0.y = pk2(a[2], a[3]); w0.z = pk2(bq[0], bq[1]); w0.w = pk2(bq[2], bq[3]);
            w1.x = pk2(c[0], c[1]); w1.y = pk2(c[2], c[3]); w1.z = pk2(dq[0], dq[1]); w1.w = pk2(dq[2], dq[3]);
            char* ho = (char*)(HB + (size_t)t * D); const unsigned cb2 = cb4 >> 1; *(v4u*)(ho + cb2) = w0; *(v4u*)(ho + cb2 + 16) = w1;
            if (ln_ == 0) RROW[t] = r;
        }
        }
        if (!more) break;
        t = tn; buf = bufn;
    }
#undef PG6_SORT
#undef PG6_IDS
#undef PG6_LOADU
#undef PG6_LOADV
#undef PG6_DOTS
#undef PG6_ACC
#undef l4_
#undef HB
#undef EID
#undef EG
#undef SSQ
#undef RROW
}

template <bool FINAL>
__device__ __forceinline__ void peer_gather_wg2(int t0, int tid, unsigned char* wsb, int layer, float* YOUT, const float* gprev, const float* gnext, LAS float* PL, bool split) {
#define HB ((bf16*)(wsb + WS_HB))
#define EID ((const int*)(wsb + WS_EID))
#define EG ((const float*)(wsb + WS_EG))
#define SSQ ((const float*)(wsb + WS_SSQ))
#define RROW ((float*)(wsb + WS_RROW))
    const unsigned char* UV = wsb + WS_UV + (size_t)layer * NEXP * 1536;
    const int lane = tid & 63, w = tid >> 6;
    const int hw = lane >> 5, li = lane & 31; const bool b4 = (lane & 16) != 0, b3 = (lane & 8) != 0;
    const int xl = 4 * ((lane >> 4) & 1) + 2 * ((lane >> 3) & 1) + hw;
    const unsigned char* uvl = UV + 24 * li;
    const int hd0 = split ? (w < 4 ? w : 16) : w, hdst = split ? 4 : 8;
#pragma unroll 1
    for (int task = hd0; task < 16; task += hdst) { const int k = task >> 3, hd = task & 7; const int t = t0 + k;
        const float rin = row_rinv(SSQ, (size_t)t, 16) * (1.0f / U6_SCALE);
        float hf[32], acc[32];
        { const v4u* hp = (const v4u*)(HB + (size_t)t * D + 32 * li);
#pragma unroll
          for (int q = 0; q < 4; ++q) { const v4u h = hp[q]; hf[8 * q] = bflo(h.x); hf[8 * q + 1] = bfhi(h.x); hf[8 * q + 2] = bflo(h.y); hf[8 * q + 3] = bfhi(h.y); hf[8 * q + 4] = bflo(h.z); hf[8 * q + 5] = bfhi(h.z); hf[8 * q + 6] = bflo(h.w); hf[8 * q + 7] = bfhi(h.w); } }
#pragma unroll
        for (int i = 0; i < 32; ++i) acc[i] = 0.f;
        const size_t ib = (size_t)t * 128 + hd * 16;
        const int eid0 = EID[ib + xl], eid1 = EID[ib + 8 + xl]; const float gt0 = EG[ib + xl], gt1 = EG[ib + 8 + xl];
#pragma unroll 1
        for (int st = 0; st < 2; ++st) {
            const int eid = st ? eid1 : eid0; const float gt = st ? gt1 : gt0;
            v6u ub[4], vb[4];
#pragma unroll
            for (int kk = 0; kk < 4; ++kk) { const int ea = __builtin_amdgcn_readlane(eid, 8 * kk), eb = __builtin_amdgcn_readlane(eid, 32 + 8 * kk); const unsigned char* p = uvl + (size_t)(hw ? eb : ea) * 1536; ub[kk] = load6(p); vb[kk] = load6(p + 768); }
            float pd[4];
#pragma unroll
            for (int kk = 0; kk < 4; ++kk) { const v32f f = __builtin_amdgcn_cvt_scalef32_pk32_f32_fp6(ub[kk], 1.0f); f32x2 d2 = (f32x2){f[0], f[1]} * (f32x2){hf[0], hf[1]};
#pragma unroll
                for (int i = 1; i < 16; ++i) d2 = __builtin_elementwise_fma((f32x2){f[2 * i], f[2 * i + 1]}, (f32x2){hf[2 * i], hf[2 * i + 1]}, d2);
                pd[kk] = d2.x + d2.y; }
            float q0, q1;
            { const float s0 = b4 ? pd[0] : pd[2], k0 = b4 ? pd[2] : pd[0]; q0 = k0 + __shfl_xor(s0, 16); const float s1 = b4 ? pd[1] : pd[3], k1 = b4 ? pd[3] : pd[1]; q1 = k1 + __shfl_xor(s1, 16); }
            float tot; { const float sd = b3 ? q0 : q1, kp = b3 ? q1 : q0; tot = kp + __shfl_xor(sd, 8); }
            tot += __shfl_xor(tot, 4); tot += __shfl_xor(tot, 2); tot += __shfl_xor(tot, 1);
            const float wv = gt * gelu1(tot * rin) * (1.0f / V6_SCALE);
#pragma unroll
            for (int kk = 0; kk < 4; ++kk) { const float wa = __builtin_bit_cast(float, __builtin_amdgcn_readlane(__builtin_bit_cast(int, wv), 8 * kk)), wb = __builtin_bit_cast(float, __builtin_amdgcn_readlane(__builtin_bit_cast(int, wv), 32 + 8 * kk));
                const float wk = hw ? wb : wa; const v32f f = __builtin_amdgcn_cvt_scalef32_pk32_f32_fp6(vb[kk], 1.0f);
#pragma unroll
                for (int i = 0; i < 32; ++i) acc[i] = fmaf(wk, f[i], acc[i]); }
        }
        LAS float* pl = PL + ((k * 8 + hd) * D + 32 * li + 16 * hw);
#pragma unroll
        for (int j = 0; j < 4; ++j) { f32x4 o;
#pragma unroll
            for (int i = 0; i < 4; ++i) { const int c = 4 * j + i; const float lo = acc[c] + __shfl_xor(acc[c], 32), hi = acc[16 + c] + __shfl_xor(acc[16 + c], 32); o[i] = hw ? hi : lo; }
            *(LAS f32x4*)(pl + 4 * j) = o; }
    }
    __syncthreads();
    LAS float* ssw = PL + 2 * 8 * D;
    float xs[2][2];
#pragma unroll
    for (int k = 0; k < 2; ++k) { const int c0 = 128 * w + 2 * lane; const unsigned hw2 = *(const unsigned*)(HB + (size_t)(t0 + k) * D + c0); const f32x2 gp = *(const f32x2*)(gprev + c0); float a0 = bflo(hw2) / gp.x, a1 = bfhi(hw2) / gp.y;
#pragma unroll
        for (int ww = 0; ww < 8; ++ww) { const f32x2 pv = *(const LAS f32x2*)(PL + (k * 8 + ww) * D + c0); a0 += pv.x; a1 += pv.y; }
        xs[k][0] = a0; xs[k][1] = a1; const float ss = wave_sum(a0 * a0 + a1 * a1); if (lane == 0) ssw[k * 8 + w] = ss; }
    __syncthreads();
#pragma unroll
    for (int k = 0; k < 2; ++k) { const int c0 = 128 * w + 2 * lane; float tot = 0.f;
#pragma unroll
        for (int ww = 0; ww < 8; ++ww) tot += ssw[k * 8 + ww];
        const float r = 1.0f / sqrtf(tot * (1.0f / D) + RMS_EPS); const f32x2 gv = *(const f32x2*)(gnext + c0);
        if (FINAL) { *(f32x2*)(YOUT + (size_t)(t0 + k) * D + c0) = (f32x2){xs[k][0] * r * gv.x, xs[k][1] * r * gv.y}; }
        else { *(unsigned*)(HB + (size_t)(t0 + k) * D + c0) = pk2(xs[k][0] * r * gv.x, xs[k][1] * r * gv.y); if (tid == 0) RROW[t0 + k] = r; } }
    __syncthreads();
}
#undef HB
#undef EID
#undef EG
#undef SSQ
#undef RROW

enum { SK_GLU = 0, SK_RES = 1, SK_B16 = 2, SK_WINV = 3, SK_WINB = 4 };
struct SkArgs { const bf16* A; const bf16* W; bf16* hbo; float* ssq; const float* gnext; const float* gprev; const float* rprev; const float* xs; bf16* O; int ldc; int nslots; bf16* v1; bf16* b1; float* out; };
constexpr int SK_LDS_FLOATS = 8 * 32 * 68;
template <int MODE>
__device__ __forceinline__ void skinny_tile(const SkArgs& a, int rb, int cb, LAS float* P, int tid) {
    constexpr bool PAIRED = (MODE == SK_GLU || MODE == SK_WINV);
    const int lane = tid & 63, w = tid >> 6, tl = lane & 15, q4 = lane >> 4;
    const int g0 = PAIRED ? ((cb >> 2) * 256 + (cb & 3) * 32) : 64 * cb;
    f32x4 acc[2][4];
#pragma unroll
    for (int mt = 0; mt < 2; ++mt)
#pragma unroll
        for (int nt = 0; nt < 4; ++nt) acc[mt][nt] = (f32x4){0.f, 0.f, 0.f, 0.f};
    const bf16* ap = a.A + (size_t)(TP + 32 * rb + tl) * D + 128 * w + 8 * q4;
    const bf16* wp = a.W + (size_t)(g0 + tl) * D + 128 * w + 8 * q4;
    bf16x8 af[4][2], bfr[4][4];
#pragma unroll
    for (int ks = 0; ks < 4; ++ks) {
#pragma unroll
        for (int mt = 0; mt < 2; ++mt) af[ks][mt] = *(const bf16x8*)(ap + (size_t)(16 * mt) * D + 32 * ks);
#pragma unroll
        for (int nt = 0; nt < 4; ++nt) { const int wro = PAIRED ? ((nt >> 1) * 128 + (nt & 1) * 16) : 16 * nt; bfr[ks][nt] = *(const bf16x8*)(wp + (size_t)wro * D + 32 * ks); } }
    const int row = tid >> 4, c4 = (tid & 15) * 4; const size_t grow = (size_t)TP + 32 * rb + row;
    const int pcol = (cb >> 2) * 128 + (cb & 3) * 32 + (c4 & 31), col = 64 * cb + c4;
    f32x4 e0 = {0.f, 0.f, 0.f, 0.f}, e1 = {0.f, 0.f, 0.f, 0.f}; float ri = 0.f;
    if (MODE == SK_GLU) { e0 = *(const f32x4*)(a.xs + (size_t)(32 * rb + row) * D + pcol); e1 = *(const f32x4*)(a.gnext + pcol); }
    if (MODE == SK_RES) { const v2u h = *(const v2u*)(a.hbo + grow * D + col); const f32x4 gp = *(const f32x4*)(a.gprev + col); const float rr = a.rprev ? 1.0f / a.rprev[grow] : 1.0f;
        e0 = (f32x4){bflo(h.x) / gp[0], bfhi(h.x) / gp[1], bflo(h.y) / gp[2], bfhi(h.y) / gp[3]} * rr; e1 = *(const f32x4*)(a.gnext + col); }
    if (MODE == SK_B16) ri = row_rinv(a.ssq, grow, a.nslots);
#pragma unroll
    for (int ks = 0; ks < 4; ++ks)
#pragma unroll
        for (int nt = 0; nt < 4; ++nt)
#pragma unroll
            for (int mt = 0; mt < 2; ++mt) acc[mt][nt] = mfma16(bfr[ks][nt], af[ks][mt], acc[mt][nt]);
#pragma unroll
    for (int mt = 0; mt < 2; ++mt)
#pragma unroll
        for (int nt = 0; nt < 4; ++nt) *(LAS f32x4*)(P + (w * 32 + 16 * mt + tl) * 68 + 16 * nt + 4 * q4) = acc[mt][nt];
    __syncthreads();
    f32x4 v = {0.f, 0.f, 0.f, 0.f}, vb = {0.f, 0.f, 0.f, 0.f};
#pragma unroll
    for (int ww = 0; ww < 8; ++ww) v += *(const LAS f32x4*)(P + (ww * 32 + row) * 68 + c4);
    if (PAIRED && c4 < 32) {
#pragma unroll
        for (int ww = 0; ww < 8; ++ww) vb += *(const LAS f32x4*)(P + (ww * 32 + row) * 68 + c4 + 32); }
    if (MODE == SK_GLU) {
        float ss = 0.f;
        if (c4 < 32) { f32x4 o;
#pragma unroll
            for (int j = 0; j < 4; ++j) { o[j] = e0[j] + v[j] / (1.0f + __expf(-vb[j])); ss = fmaf(o[j], o[j], ss); }
            const f32x4 hg = o * e1; v2u wv; wv.x = pk2(hg[0], hg[1]); wv.y = pk2(hg[2], hg[3]); *(v2u*)(a.hbo + grow * D + pcol) = wv; }
        ss += __shfl_xor(ss, 1); ss += __shfl_xor(ss, 2); ss += __shfl_xor(ss, 4);
        if ((tid & 15) == 0) a.ssq[grow * 32 + cb] = ss;
    } else if (MODE == SK_RES) {
        const f32x4 o = e0 + v;
        float ss = o[0] * o[0] + o[1] * o[1] + o[2] * o[2] + o[3] * o[3];
        const f32x4 hg = o * e1; v2u wv; wv.x = pk2(hg[0], hg[1]); wv.y = pk2(hg[2], hg[3]); *(v2u*)(a.hbo + grow * D + col) = wv;
        ss += __shfl_xor(ss, 1); ss += __shfl_xor(ss, 2); ss += __shfl_xor(ss, 4); ss += __shfl_xor(ss, 8);
        if ((tid & 15) == 0) a.ssq[grow * 32 + cb] = ss;
    } else if (MODE == SK_B16) {
        const f32x4 o = v * ri; v2u wv; wv.x = pk2(o[0], o[1]); wv.y = pk2(o[2], o[3]);
        *(v2u*)(a.O + grow * a.ldc + col) = wv;
    } else if (MODE == SK_WINV) {
        if (c4 < 32) { const f32x4 vv = v * vb; v2u wv; wv.x = pk2(vv[0], vv[1]); wv.y = pk2(vv[2], vv[3]); *(v2u*)(a.v1 + grow * D + pcol) = wv;
            const int rs = 32 * rb + row, s = rs & 3; if (s >= 2) *(f32x4*)(a.out + O_CS + ((size_t)(rs >> 2) * 2 + (s - 2)) * D + pcol) = vv; }
    } else {
        v2u wv; wv.x = pk2(v[0], v[1]); wv.y = pk2(v[2], v[3]); *(v2u*)(a.b1 + grow * D + col) = wv;
    }
    __syncthreads();
}
#ifndef REP_P0
#define REP_P0 1
#endif
#ifndef REP_P1
#define REP_P1 1
#endif
#ifndef REP_GEMM
#define REP_GEMM 1
#endif
#ifndef REP_ATTN
#define REP_ATTN 1
#endif
#ifndef REP_PSEL
#define REP_PSEL 1
#endif
#ifndef REP_THIN
#define REP_THIN 1
#endif
#ifndef REP_SK
#define REP_SK 1
#endif
#ifndef REP_KV
#define REP_KV 1
#endif
#ifndef REP_S5P
#define REP_S5P 1
#endif
#ifndef REP_S5S
#define REP_S5S 1
#endif
struct Args { const float* in[N_IN]; float* out; unsigned char* ws; int ph_lo, ph_hi; };
__device__ __forceinline__ int opaque_idx(int k) { int r; asm volatile("s_mov_b32 %0, %1" : "=s"(r) : "s"(k)); return r; }
#define INP(k) ((const float*)(const GAS float*)(args.in[opaque_idx(k)]))
__device__ __forceinline__ unsigned char* opq_p(unsigned char* p) { GAS unsigned char* g = (GAS unsigned char*)p; asm volatile("" : "+s"(g)); return (unsigned char*)g; }
__device__ __forceinline__ float* opq_f(float* p) { GAS float* g = (GAS float*)p; asm volatile("" : "+s"(g)); return (float*)g; }
__device__ __forceinline__ int opq_i(int v) { asm volatile("" : "+s"(v)); return v; }
__device__ __forceinline__ int opq_v(int v) { asm volatile("" : "+v"(v)); return v; }
#define PH_LOCALS unsigned char* ws = opq_p(args.ws); float* out = opq_f(args.out); (void)ws; (void)out; \
    const int wave = opq_i(wave0), lane = opq_v(LANE_ID()), tid = wave * 64 + lane, G = opq_i((int)gridDim.x), bx = opq_i((int)blockIdx.x), gw = bx * NWAVES + wave, NGW = G * NWAVES; (void)lane; (void)gw; (void)NGW;
#define WALL ((bf16*)(ws + WS_WALL))
#define KEYS ((bf16*)(ws + WS_KEYS))
#define BBW ((bf16*)(ws + WS_BBW))
#define CCW ((bf16*)(ws + WS_CCW))
#define LBc ((float*)(ws + WS_LB))
#define LBPB ((float*)(ws + WS_LBP))
#define BBTB ((bf16*)(ws + WS_BBT))
#define BBFB ((float*)(ws + WS_BBF))
#define MEMB ((bf16*)(ws + WS_MEMB))
#define KB ((bf16*)(ws + WS_KB))
#define VT ((bf16*)(ws + WS_VT))
#define EID ((int*)(ws + WS_EID))
#define EG ((float*)(ws + WS_EG))
#define HB ((bf16*)(ws + WS_HB))
#define ZB ((bf16*)(ws + WS_ZB))
#define QB ((bf16*)(ws + WS_QB))
#define QP ((bf16*)(ws + WS_QP))
#define B1 ((bf16*)(ws + WS_B1))
#define V1 ((bf16*)(ws + WS_V1))
#define UVT ((unsigned char*)(ws + WS_UV))
#define YOUT (out + O_Y)
#define RROWB ((float*)(ws + WS_RROW))
#define SSQB ((float*)(ws + WS_SSQ))

constexpr int N_PHASES = 18;

#define SK_RB(TK) ((((TK) & 255) >> 3) & 15)
#define SK_CB(TK) ((((TK) >> 8) << 4) + 2 * ((TK) & 7) + ((((TK) & 255) >> 3) >> 4))
#define TABLE_CONVERT(LAYER, W0, NW, I_LO, I_HI, ALLOK) do { const float* sU = INP(I_PU) + (size_t)(LAYER) * NEXP * D; const float* sV = INP(I_PV) + (size_t)(LAYER) * NEXP * D; unsigned char* dst = UVT + (size_t)(LAYER) * NEXP * 1536; \
            const size_t ng = (size_t)NEXP * 32, st_ = (size_t)(NW) * 64; \
            for (size_t i0 = (size_t)(I_LO) + (size_t)(W0) * 64 + lane; i0 < (size_t)(I_HI); i0 += 4 * st_) { f32x4 xa[4][8]; bool ok[4]; \
                _Pragma("unroll") for (int h = 0; h < 4; ++h) { const size_t i = i0 + h * st_; ok[h] = (ALLOK) || i < (size_t)(I_HI); if (ok[h]) { const bool isv = i >= ng; const size_t j = isv ? i - ng : i; const f32x4* s = (const f32x4*)((isv ? sV : sU) + (j >> 5) * D + 32 * (int)(j & 31)); \
                    _Pragma("unroll") for (int q = 0; q < 8; ++q) xa[h][q] = s[q]; } } \
                _Pragma("unroll") for (int h = 0; h < 4; ++h) if (ok[h]) { const size_t i = i0 + h * st_; const bool isv = i >= ng; const size_t j = isv ? i - ng : i; const size_t row = j >> 5; const int c = (int)(j & 31); const float sc = isv ? V6_SCALE : U6_SCALE; v16f a, b; \
                    _Pragma("unroll") for (int q = 0; q < 8; ++q) { const f32x4 x0 = xa[h][q] * sc; a[2 * q] = x0[0]; b[2 * q] = x0[1]; a[2 * q + 1] = x0[2]; b[2 * q + 1] = x0[3]; } \
                    const v6u w = __builtin_amdgcn_cvt_scalef32_2xpk16_fp6_f32(a, b, 1.0f); \
                    unsigned char* dp = dst + (row * 2 + (isv ? 1 : 0)) * 768 + 24 * c; \
                    *(v2u*)dp = (v2u){w[0], w[1]}; *(v2u*)(dp + 8) = (v2u){w[2], w[3]}; *(v2u*)(dp + 16) = (v2u){w[4], w[5]}; } } } while (0)
__global__ void __launch_bounds__(NWAVES * 64, 2) mk_fwd(Args args) {
    extern __shared__ __attribute__((aligned(16))) unsigned char lds[];
    LAS unsigned char* L = (LAS unsigned char*)lds;
    volatile LAS unsigned* MISC = (volatile LAS unsigned*)(L + MISC_OFF);
    const int wave0 = __builtin_amdgcn_readfirstlane((int)threadIdx.x >> 6);
#define LANE_ID() mk_lane_id()
    const int tid0 = wave0 * 64 + LANE_ID();
    gu32* ctl = (gu32*)(args.ws + WS_CTL);

    for (int u = tid0; u < (LDS_BYTES - LDSCTL_OFF) / 4; u += NWAVES * 64) ((LAS unsigned*)(L + LDSCTL_OFF))[u] = 0u;
    __syncthreads();
    XcdBarrier bar = xcd_barrier_post((unsigned*)(ctl + CW_BAR), MISC + 8);
    bar.lead = (wave0 == 0);
    const int lo = args.ph_lo, hi = args.ph_hi;
#define IN(k) (opq_i(lo) <= (k) && (k) < opq_i(hi))
#ifdef PROBE_SUB
    unsigned long long ps_prev = 0ull, ps_dt = 0ull;
#define PS_STAMP(k) do { const unsigned long long now_ = __builtin_amdgcn_s_memrealtime(); if ((k) == (PROBE_SUB)) ps_dt = now_ - ps_prev; ps_prev = now_; } while (0)
    unsigned long long ps_mark = 0ull;
#define PS_MARK() do { ps_mark = __builtin_amdgcn_s_memrealtime(); } while (0)
#define PS_CUM(k) do { if ((k) == (PROBE_SUB)) ps_dt = __builtin_amdgcn_s_memrealtime() - ps_mark; } while (0)
#else
#define PS_STAMP(k) do { } while (0)
#define PS_MARK() do { } while (0)
#define PS_CUM(k) do { } while (0)
#endif
#ifdef PROBE_PHASE
    unsigned long long pp_prev = __builtin_amdgcn_s_memrealtime(), pp_dt = 0ull;
#define PP_STAMP(k) do { const unsigned long long now_ = __builtin_amdgcn_s_memrealtime(); if ((k) == (PROBE_PHASE)) pp_dt = now_ - pp_prev; pp_prev = now_; } while (0)
#else
#define PP_STAMP(k) do { } while (0)
#endif
#define SEAM(k) do { if (IN(k) && IN((k) + 1)) xcd_barrier(bar); PP_STAMP(k); } while (0)
#define GEMM_PHASE(EpiT, Aptr, Brow, Mrows, Ncols, Eobj) do { pg8::Gemm g_{(const pg8::bf16_t*)(Aptr), (const pg8::bf16_t*)(WALL + (size_t)(Brow) * D), (Mrows), (Ncols), D}; \
        pg8::StaticOrder S_; S_.init((Mrows), (Ncols), G, bx, wave); pg8::gemm_phase<EpiT, pg8::StaticOrder, true, true>(L + RING_OFF, g_, S_, Eobj); } while (0)

    if (IN(0)) { PH_LOCALS
      for (int rep_ = 0; rep_ < REP_P0; ++rep_) {
        PS_STAMP(-1); PS_MARK();
        if (wave & 1) {
        { const int lane = opq_v(LANE_ID()), tid = wave * 64 + lane; (void)tid;
        { const float* xp_ = INP(I_XP); const float* xs_ = INP(I_XS); const float* gm_ = INP(I_NMIX);
          for (int m = wave * G + bx; m < T; m += 2 * NGW) { const int m2 = m + NGW; const bool two = m2 < T;
              rms_row2_bf16(m < TP ? xp_ + (size_t)m * D : xs_ + (size_t)(m - TP) * D, two ? (m2 < TP ? xp_ + (size_t)m2 * D : xs_ + (size_t)(m2 - TP) * D) : nullptr, gm_, HB + (size_t)m * D, HB + (size_t)m2 * D, lane); } }
        PS_STAMP(3);
        }
        { const int lane = opq_v(LANE_ID()), tid = wave * 64 + lane; (void)tid;
        {
            const int gt = bx * 512 + tid, NT = G * 512;
            for (int i = gt; i < 2 * 2 * 128 * 128; i += NT) { const int l = i >> 15, hf = (i >> 14) & 1, r = i & 16383; const float* k1 = INP(I_K1); const float* k2 = INP(I_K2); KEYS[i] = (bf16)f2bf((hf ? k2 : k1)[(size_t)l * 16384 + r]); }
            PS_STAMP(20);
            { const f32x4* mp = (const f32x4*)INP(I_MEM);
              for (int i = gt; i < MROWS * D / 4; i += 8 * NT) { f32x4 a[8];
#pragma unroll
                for (int q = 0; q < 8; ++q) { const int iq = i + q * NT; a[q] = mp[iq < MROWS * D / 4 ? iq : i]; }
#pragma unroll
                for (int q = 0; q < 8; ++q) { const int iq = i + q * NT; if (iq < MROWS * D / 4) { v2u w; w.x = pk2(a[q][0], a[q][1]); w.y = pk2(a[q][2], a[q][3]); ((v2u*)MEMB)[iq] = w; } } } }
            PS_STAMP(21);
            { const float* pare = INP(I_ARE); const float* paim = INP(I_AIM); const float* pldt = INP(I_LDT); const float* pbre = INP(I_BRE); const float* pbim = INP(I_BIM); const float* pcre = INP(I_CRE); const float* pcim = INP(I_CIM);
              for (int j = (wave * G + bx) * 64 + lane; j < 64 * 64 * 16; j += NT) { const int c = j >> 12, i = j & 4095, g = i >> 6, p = i & 63;
                const float are = pare[i], aim = paim[i], dt = expf(pldt[g]);
                const float mag = expf(are * dt), ang = aim * dt, lbr = mag * cosf(ang), lbi = mag * sinf(ang), den = are * are + aim * aim;
                const float fr = ((lbr - 1.0f) * are + lbi * aim) / den, fi = (lbi * are - (lbr - 1.0f) * aim) / den;
                if (c == 0) { LBc[2 * i] = lbr; LBc[2 * i + 1] = lbi; }
                {
                    float qr = 1.0f, qi = 0.0f, sr_ = lbr, si_ = lbi;
#pragma unroll
                    for (int e = 0; e < 4; ++e) { if ((c >> e) & 1) { const float t_ = qr * sr_ - qi * si_; qi = qr * si_ + qi * sr_; qr = t_; } const float t2_ = sr_ * sr_ - si_ * si_; si_ = 2.0f * sr_ * si_; sr_ = t2_; }
                    LBPB[((size_t)(g * 17 + c) * 64 + p) * 2] = qr; LBPB[((size_t)(g * 17 + c) * 64 + p) * 2 + 1] = qi;
                    if (c == 15) { LBPB[((size_t)(g * 17 + 16) * 64 + p) * 2] = sr_; LBPB[((size_t)(g * 17 + 16) * 64 + p) * 2 + 1] = si_; } }
                const float br = pbre[(size_t)i * 16 + c], bi = pbim[(size_t)i * 16 + c];
                const float bbr_ = fr * br - fi * bi, bbi_ = fr * bi + fi * br;
                BBW[((size_t)g * 128 + p) * 16 + c] = (bf16)f2bf(bbr_); BBW[((size_t)g * 128 + 64 + p) * 16 + c] = (bf16)f2bf(bbi_);
                BBTB[((size_t)g * 16 + c) * 128 + p] = (bf16)f2bf(bbr_); BBTB[((size_t)g * 16 + c) * 128 + 64 + p] = (bf16)f2bf(bbi_);
                BBFB[((size_t)i * 16 + c) * 2] = bbr_; BBFB[((size_t)i * 16 + c) * 2 + 1] = bbi_;
                CCW[((size_t)g * 16 + c) * 128 + p] = (bf16)f2bf(pcre[((size_t)g * 16 + c) * 64 + p]); CCW[((size_t)g * 16 + c) * 128 + 64 + p] = (bf16)f2bf(-pcim[((size_t)g * 16 + c) * 64 + p]); } }
        }
        PS_STAMP(2);
        }
        { const int lane = opq_v(LANE_ID()), tid = wave * 64 + lane; (void)tid;
        if (G == 256) TABLE_CONVERT(0, gw, NGW, 0, 2 * (size_t)NEXP * 32, true); else TABLE_CONVERT(0, gw, NGW, 0, 2 * (size_t)NEXP * 32, false);
        PS_STAMP(1);
        }
        { const int lane = opq_v(LANE_ID()), tid = wave * 64 + lane; (void)tid;
        LAS float* scr = (LAS float*)(L + RING_OFF + wave * 16896);
#define TR_DECODE(IT, SRC, NN, SN0) do { int r = ((IT) >> 4) * 32; \
            if (r < R_GLU) { const int mat = r >> 10, l = mat >> 1; SRC = ((mat & 1) ? INP(I_WV) : INP(I_WK)) + (size_t)l * D * D; NN = D; SN0 = r & 1023; } \
            else if (r < R_Q) { r -= R_GLU; SRC = INP(I_WGLU); NN = 2 * D; SN0 = ((r >> 7) & 1) * 1024 + (r >> 8) * 128 + (r & 127); } \
            else if (r < R_O) { r -= R_Q; SRC = INP(I_WQ) + (size_t)(r >> 10) * D * D; NN = D; SN0 = r & 1023; } \
            else if (r < R_PQ) { r -= R_O; SRC = INP(I_WO) + (size_t)(r >> 10) * D * D; NN = D; SN0 = r & 1023; } \
            else if (r < R_WIN) { r -= R_PQ; SRC = INP(I_PWQ) + (size_t)(r >> 11) * D * 2048; NN = 2048; SN0 = r & 2047; } \
            else if (r < R_WOUT) { r -= R_WIN; SRC = INP(I_WIN); NN = 3 * D; SN0 = (r < 2048) ? (1024 + ((r >> 7) & 1) * 1024 + (r >> 8) * 128 + (r & 127)) : (r - 2048); } \
            else { r -= R_WOUT; SRC = INP(I_WOUT); NN = D; SN0 = r; } } while (0)
        {
            constexpr int NIT = (R_END / 32) * 16; const int vw = wave * G + bx;
#pragma unroll 1
            for (int it = vw; it < NIT; it += 2 * NGW) { const int it2 = it + NGW; f32x4 va[8], vb[8];
                { const float* s0; int n0, c0; TR_DECODE(it, s0, n0, c0); p0_tr_load(s0, n0, c0, (it & 15) * 64, va, lane); }
                if (it2 < NIT) { const float* s0; int n0, c0; TR_DECODE(it2, s0, n0, c0); p0_tr_load(s0, n0, c0, (it2 & 15) * 64, vb, lane); } else {
#pragma unroll
                    for (int q = 0; q < 8; ++q) vb[q] = va[q]; }
                p0_tr_store2(va, vb, WALL + (size_t)((it >> 4) * 32) * D, (it & 15) * 64, it2 < NIT, WALL + (size_t)((it2 >> 4) * 32) * D, (it2 & 15) * 64, scr, lane); }
        }
#undef TR_DECODE
        PS_STAMP(0);
        }
        } else {
        { const int lane = opq_v(LANE_ID()), tid = wave * 64 + lane; (void)tid;
        LAS float* scr = (LAS float*)(L + RING_OFF + wave * 16896);
#define TR_DECODE(IT, SRC, NN, SN0) do { int r = ((IT) >> 4) * 32; \
            if (r < R_GLU) { const int mat = r >> 10, l = mat >> 1; SRC = ((mat & 1) ? INP(I_WV) : INP(I_WK)) + (size_t)l * D * D; NN = D; SN0 = r & 1023; } \
            else if (r < R_Q) { r -= R_GLU; SRC = INP(I_WGLU); NN = 2 * D; SN0 = ((r >> 7) & 1) * 1024 + (r >> 8) * 128 + (r & 127); } \
            else if (r < R_O) { r -= R_Q; SRC = INP(I_WQ) + (size_t)(r >> 10) * D * D; NN = D; SN0 = r & 1023; } \
            else if (r < R_PQ) { r -= R_O; SRC = INP(I_WO) + (size_t)(r >> 10) * D * D; NN = D; SN0 = r & 1023; } \
            else if (r < R_WIN) { r -= R_PQ; SRC = INP(I_PWQ) + (size_t)(r >> 11) * D * 2048; NN = 2048; SN0 = r & 2047; } \
            else if (r < R_WOUT) { r -= R_WIN; SRC = INP(I_WIN); NN = 3 * D; SN0 = (r < 2048) ? (1024 + ((r >> 7) & 1) * 1024 + (r >> 8) * 128 + (r & 127)) : (r - 2048); } \
            else { r -= R_WOUT; SRC = INP(I_WOUT); NN = D; SN0 = r; } } while (0)
        {
            constexpr int NIT = (R_END / 32) * 16; const int vw = wave * G + bx;
#pragma unroll 1
            for (int it = vw; it < NIT; it += 2 * NGW) { const int it2 = it + NGW; f32x4 va[8], vb[8];
                { const float* s0; int n0, c0; TR_DECODE(it, s0, n0, c0); p0_tr_load(s0, n0, c0, (it & 15) * 64, va, lane); }
                if (it2 < NIT) { const float* s0; int n0, c0; TR_DECODE(it2, s0, n0, c0); p0_tr_load(s0, n0, c0, (it2 & 15) * 64, vb, lane); } else {
#pragma unroll
                    for (int q = 0; q < 8; ++q) vb[q] = va[q]; }
                p0_tr_store2(va, vb, WALL + (size_t)((it >> 4) * 32) * D, (it & 15) * 64, it2 < NIT, WALL + (size_t)((it2 >> 4) * 32) * D, (it2 & 15) * 64, scr, lane); }
        }
#undef TR_DECODE
        PS_STAMP(0);
        }
        { const int lane = opq_v(LANE_ID()), tid = wave * 64 + lane; (void)tid;
        if (G == 256) TABLE_CONVERT(0, gw, NGW, 0, 2 * (size_t)NEXP * 32, true); else TABLE_CONVERT(0, gw, NGW, 0, 2 * (size_t)NEXP * 32, false);
        PS_STAMP(1);
        }
        { const int lane = opq_v(LANE_ID()), tid = wave * 64 + lane; (void)tid;
        {
            const int gt = bx * 512 + tid, NT = G * 512;
            for (int i = gt; i < 2 * 2 * 128 * 128; i += NT) { const int l = i >> 15, hf = (i >> 14) & 1, r = i & 16383; const float* k1 = INP(I_K1); const float* k2 = INP(I_K2); KEYS[i] = (bf16)f2bf((hf ? k2 : k1)[(size_t)l * 16384 + r]); }
            PS_STAMP(20);
            { const f32x4* mp = (const f32x4*)INP(I_MEM);
              for (int i = gt; i < MROWS * D / 4; i += 8 * NT) { f32x4 a[8];
#pragma unroll
                for (int q = 0; q < 8; ++q) { const int iq = i + q * NT; a[q] = mp[iq < MROWS * D / 4 ? iq : i]; }
#pragma unroll
                for (int q = 0; q < 8; ++q) { const int iq = i + q * NT; if (iq < MROWS * D / 4) { v2u w; w.x = pk2(a[q][0], a[q][1]); w.y = pk2(a[q][2], a[q][3]); ((v2u*)MEMB)[iq] = w; } } } }
            PS_STAMP(21);
            { const float* pare = INP(I_ARE); const float* paim = INP(I_AIM); const float* pldt = INP(I_LDT); const float* pbre = INP(I_BRE); const float* pbim = INP(I_BIM); const float* pcre = INP(I_CRE); const float* pcim = INP(I_CIM);
              for (int j = (wave * G + bx) * 64 + lane; j < 64 * 64 * 16; j += NT) { const int c = j >> 12, i = j & 4095, g = i >> 6, p = i & 63;
                const float are = pare[i], aim = paim[i], dt = expf(pldt[g]);
                const float mag = expf(are * dt), ang = aim * dt, lbr = mag * cosf(ang), lbi = mag * sinf(ang), den = are * are + aim * aim;
                const float fr = ((lbr - 1.0f) * are + lbi * aim) / den, fi = (lbi * are - (lbr - 1.0f) * aim) / den;
                if (c == 0) { LBc[2 * i] = lbr; LBc[2 * i + 1] = lbi; }
                {
                    float qr = 1.0f, qi = 0.0f, sr_ = lbr, si_ = lbi;
#pragma unroll
                    for (int e = 0; e < 4; ++e) { if ((c >> e) & 1) { const float t_ = qr * sr_ - qi * si_; qi = qr * si_ + qi * sr_; qr = t_; } const float t2_ = sr_ * sr_ - si_ * si_; si_ = 2.0f * sr_ * si_; sr_ = t2_; }
                    LBPB[((size_t)(g * 17 + c) * 64 + p) * 2] = qr; LBPB[((size_t)(g * 17 + c) * 64 + p) * 2 + 1] = qi;
                    if (c == 15) { LBPB[((size_t)(g * 17 + 16) * 64 + p) * 2] = sr_; LBPB[((size_t)(g * 17 + 16) * 64 + p) * 2 + 1] = si_; } }
                const float br = pbre[(size_t)i * 16 + c], bi = pbim[(size_t)i * 16 + c];
                const float bbr_ = fr * br - fi * bi, bbi_ = fr * bi + fi * br;
                BBW[((size_t)g * 128 + p) * 16 + c] = (bf16)f2bf(bbr_); BBW[((size_t)g * 128 + 64 + p) * 16 + c] = (bf16)f2bf(bbi_);
                BBTB[((size_t)g * 16 + c) * 128 + p] = (bf16)f2bf(bbr_); BBTB[((size_t)g * 16 + c) * 128 + 64 + p] = (bf16)f2bf(bbi_);
                BBFB[((size_t)i * 16 + c) * 2] = bbr_; BBFB[((size_t)i * 16 + c) * 2 + 1] = bbi_;
                CCW[((size_t)g * 16 + c) * 128 + p] = (bf16)f2bf(pcre[((size_t)g * 16 + c) * 64 + p]); CCW[((size_t)g * 16 + c) * 128 + 64 + p] = (bf16)f2bf(-pcim[((size_t)g * 16 + c) * 64 + p]); } }
        }
        PS_STAMP(2);
        }
        { const int lane = opq_v(LANE_ID()), tid = wave * 64 + lane; (void)tid;
        { const float* xp_ = INP(I_XP); const float* xs_ = INP(I_XS); const float* gm_ = INP(I_NMIX);
          for (int m = wave * G + bx; m < T; m += 2 * NGW) { const int m2 = m + NGW; const bool two = m2 < T;
              rms_row2_bf16(m < TP ? xp_ + (size_t)m * D : xs_ + (size_t)(m - TP) * D, two ? (m2 < TP ? xp_ + (size_t)m2 * D : xs_ + (size_t)(m2 - TP) * D) : nullptr, gm_, HB + (size_t)m * D, HB + (size_t)m2 * D, lane); } }
        PS_STAMP(3);
        }
        }
        PS_CUM(40);
      }
    }
    SEAM(0);
    if (IN(1)) { PH_LOCALS
      for (int rep_ = 0; rep_ < REP_P1; ++rep_) {
        PS_STAMP(9); PS_MARK();
        { EpiKV E{out, KB, VT}; pg8::Gemm g_{(const pg8::bf16_t*)(MEMB), (const pg8::bf16_t*)(WALL + (size_t)(R_KV) * D), MROWS, 4096, D}; pg8::StaticOrder S_; S_.init(MROWS, 4096, G, bx, wave);
          if ((MROWS / 256) * (4096 / 256) <= G) pg8::gemm_phase<EpiKV, pg8::StaticOrder, false, true>(L + RING_OFF, g_, S_, E); }
        PS_STAMP(10);
        {
            const int half = G / 2, per = (NB * 64 - half + (G - half) - 1) / (G - half), xw = ((bx < half) ? bx : bx - half), xx = xw & 7, xj = xw >> 3, nj = half / 8;
            const bool xa = (G == 256);
            const int s_lo = xa ? ((bx < half) ? xx * nj + xj : half + xx * nj * per + xj) : ((bx < half) ? bx : half + (bx - half) * per);
            const int s_hi = xa ? ((bx < half) ? s_lo + 1 : min(NB * 64, half + (xx + 1) * nj * per)) : ((bx < half) ? bx + 1 : min(NB * 64, s_lo + per)), s_st = xa ? nj : 1;
            for (int r2_ = 0; r2_ < REP_S5P; ++r2_)
#pragma unroll 1
            for (int sq = s_lo; sq < s_hi; sq += s_st) s5_prompt_seq(HB, ZB, LBPB, BBFB, BBTB, CCW, INP(I_CRE), INP(I_CIM), INP(I_SD), L + RING_OFF, opq_v(tid), sq >> 6, sq & 63, out + O_SRP, out + O_SIP);
            PS_STAMP(11);
            {
                constexpr size_t TC_ALL = 2 * (size_t)NEXP * 32, TC_SPLIT = (TC_ALL * 66 / 100) & ~(size_t)63;
                if (bx < half) TABLE_CONVERT(1, bx * NWAVES + wave, half * NWAVES, 0, TC_SPLIT, false); else TABLE_CONVERT(1, (bx - half) * NWAVES + wave, (G - half) * NWAVES, TC_SPLIT, TC_ALL, false); }
            PS_STAMP(12);
            LAS float* ST = (LAS float*)(L + RING_OFF + wave * S5_ST_BYTES); const int lane2 = opq_v(LANE_ID());
            for (int r2_ = 0; r2_ < REP_S5S; ++r2_)
#pragma unroll 1
            for (int tk = gw; tk < (DB / 4) * 64; tk += NGW) { const int b0 = (tk >> 6) * 4, g = tk & 63; float sr = 0.f, si = 0.f;
                const float lbr = LBc[(g * 64 + lane2) * 2], lbi = LBc[(g * 64 + lane2) * 2 + 1];
                s5_run<true, true>(HB, ZB, BBW, CCW, INP(I_SD), ST, lane2, g, TP + 4 * b0, 1, b0, INP(I_SRE), INP(I_SIM), out + O_SRS, out + O_SIS, lbr, lbi, sr, si); }
            PS_STAMP(13); PS_CUM(14);
        }
        if (REP_P1 > 1) __syncthreads();
      }
    }
    SEAM(1);
    if (IN(2)) { PH_LOCALS
        { EpiGLU E{INP(I_XP), HB, SSQB, INP(I_NMEM)}; for (int rep_ = 0; rep_ < REP_GEMM; ++rep_) GEMM_PHASE(EpiGLU, ZB, R_GLU, TP, 2048, E); }
        { SkArgs sa{}; sa.A = ZB; sa.W = WALL + (size_t)R_GLU * D; sa.hbo = HB; sa.ssq = SSQB; sa.gnext = INP(I_NMEM); sa.xs = INP(I_XS);
for (int rep_ = 0; rep_ < REP_SK; ++rep_)
#pragma unroll 1
          for (int tk = bx; tk < 16 * 32; tk += G) skinny_tile<SK_GLU>(sa, SK_RB(tk), SK_CB(tk), (LAS float*)(L + RING_OFF), tid); }
    }
    SEAM(2);
#pragma unroll 1
    for (int layer = 0; layer < 2; ++layer) {
        const int pb = layer == 0 ? 3 : 12;
        if (layer == 1) {
            if (IN(9)) { PH_LOCALS
                { EpiWin E{B1, V1, out}; for (int rep_ = 0; rep_ < REP_GEMM; ++rep_) GEMM_PHASE(EpiWin, HB, R_WIN, TP, 3072, E); }
                { SkArgs sa{}; sa.A = HB; sa.W = WALL + (size_t)R_WIN * D; sa.v1 = V1; sa.out = out;
for (int rep_ = 0; rep_ < REP_SK; ++rep_)
#pragma unroll 1
                  for (int tk = bx; tk < 16 * 32; tk += G) skinny_tile<SK_WINV>(sa, SK_RB(tk), SK_CB(tk), (LAS float*)(L + RING_OFF), tid);
                  sa.W = WALL + (size_t)(R_WIN + 2048) * D; sa.b1 = B1;
for (int rep_ = 0; rep_ < REP_SK; ++rep_)
#pragma unroll 1
                  for (int tk = bx; tk < 16 * 16; tk += G) skinny_tile<SK_WINB>(sa, SK_RB(tk), SK_CB(tk), (LAS float*)(L + RING_OFF), tid); }
            }
            SEAM(9);
            if (IN(10)) { PH_LOCALS
                const float* cw = INP(I_CW);
                if (G == 256) {
#define CV_UNPK(W, F) do { F[0] = bflo(W.x); F[1] = bfhi(W.x); F[2] = bflo(W.y); F[3] = bfhi(W.y); F[4] = bflo(W.z); F[5] = bfhi(W.z); F[6] = bflo(W.w); F[7] = bfhi(W.w); } while (0)
                    float w0[2][8], w1[2][8], w2[2][8];
#pragma unroll
                    for (int hh = 0; hh < 2; ++hh) { const int c0 = hh * 512 + 8 * lane;
                        { const f32x4 a = *(const f32x4*)(cw + c0), b = *(const f32x4*)(cw + c0 + 4); w0[hh][0] = a[0]; w0[hh][1] = a[1]; w0[hh][2] = a[2]; w0[hh][3] = a[3]; w0[hh][4] = b[0]; w0[hh][5] = b[1]; w0[hh][6] = b[2]; w0[hh][7] = b[3]; }
                        { const f32x4 a = *(const f32x4*)(cw + D + c0), b = *(const f32x4*)(cw + D + c0 + 4); w1[hh][0] = a[0]; w1[hh][1] = a[1]; w1[hh][2] = a[2]; w1[hh][3] = a[3]; w1[hh][4] = b[0]; w1[hh][5] = b[1]; w1[hh][6] = b[2]; w1[hh][7] = b[3]; }
                        { const f32x4 a = *(const f32x4*)(cw + 2 * D + c0), b = *(const f32x4*)(cw + 2 * D + c0 + 4); w2[hh][0] = a[0]; w2[hh][1] = a[1]; w2[hh][2] = a[2]; w2[hh][3] = a[3]; w2[hh][4] = b[0]; w2[hh][5] = b[1]; w2[hh][6] = b[2]; w2[hh][7] = b[3]; } }
#pragma unroll 1
                    for (int hb = 0; hb < 2; ++hb) { const int m0 = 8 * gw + 4 * hb; const bool head = (m0 & (SEQ - 1)) == 0;
                        v4u vv[6][2], bb[4][2];
#pragma unroll
                        for (int r = 0; r < 6; ++r) { const int row = (head && r < 2) ? m0 : m0 - 2 + r;
#pragma unroll
                            for (int hh = 0; hh < 2; ++hh) vv[r][hh] = *(const v4u*)(V1 + (size_t)row * D + hh * 512 + 8 * lane); }
#pragma unroll
                        for (int j = 0; j < 4; ++j)
#pragma unroll
                            for (int hh = 0; hh < 2; ++hh) bb[j][hh] = *(const v4u*)(B1 + (size_t)(m0 + j) * D + hh * 512 + 8 * lane);
#pragma unroll
                        for (int j = 0; j < 4; ++j)
#pragma unroll
                            for (int hh = 0; hh < 2; ++hh) { float vm2[8], vm1[8], vc[8], bg[8], r[8];
                                CV_UNPK(vv[j][hh], vm2); CV_UNPK(vv[j + 1][hh], vm1); CV_UNPK(vv[j + 2][hh], vc); CV_UNPK(bb[j][hh], bg);
                                const float k2 = (head && j < 2) ? 0.f : 1.f, k1 = (head && j < 1) ? 0.f : 1.f;
#pragma unroll
                                for (int i = 0; i < 8; ++i) r[i] = bg[i] * (w0[hh][i] * (k2 * vm2[i]) + w1[hh][i] * (k1 * vm1[i]) + w2[hh][i] * vc[i]);
                                v4u ow; ow.x = pk2(r[0], r[1]); ow.y = pk2(r[2], r[3]); ow.z = pk2(r[4], r[5]); ow.w = pk2(r[6], r[7]);
                                *(v4u*)(ZB + (size_t)(m0 + j) * D + hh * 512 + 8 * lane) = ow; } }
#undef CV_UNPK
                }
                for (int m = (G == 256 ? TP + gw : gw); m < T; m += NGW) {
                    const bool smp = m >= TP; const int s = smp ? ((m - TP) & 3) : (m & (SEQ - 1));
#pragma unroll
                    for (int hh = 0; hh < 2; ++hh) { const int c0 = hh * 512 + 8 * lane;
                        const v4u bw = *(const v4u*)(B1 + (size_t)m * D + c0), v0 = *(const v4u*)(V1 + (size_t)m * D + c0);
                        float vm1[8], vm2[8];
                        if (s >= 1) { const v4u t1 = *(const v4u*)(V1 + (size_t)(m - 1) * D + c0); vm1[0] = bflo(t1.x); vm1[1] = bfhi(t1.x); vm1[2] = bflo(t1.y); vm1[3] = bfhi(t1.y); vm1[4] = bflo(t1.z); vm1[5] = bfhi(t1.z); vm1[6] = bflo(t1.w); vm1[7] = bfhi(t1.w); }
                        else if (smp) { const float* sp = INP(I_SCONV) + ((size_t)((m - TP) >> 2) * 2 + 1) * D + c0; const f32x4 a = *(const f32x4*)sp, b = *(const f32x4*)(sp + 4); vm1[0] = a[0]; vm1[1] = a[1]; vm1[2] = a[2]; vm1[3] = a[3]; vm1[4] = b[0]; vm1[5] = b[1]; vm1[6] = b[2]; vm1[7] = b[3]; }
                        else {
#pragma unroll
                            for (int i = 0; i < 8; ++i) vm1[i] = 0.f; }
                        if (s >= 2) { const v4u t2 = *(const v4u*)(V1 + (size_t)(m - 2) * D + c0); vm2[0] = bflo(t2.x); vm2[1] = bfhi(t2.x); vm2[2] = bflo(t2.y); vm2[3] = bfhi(t2.y); vm2[4] = bflo(t2.z); vm2[5] = bfhi(t2.z); vm2[6] = bflo(t2.w); vm2[7] = bfhi(t2.w); }
                        else if (smp) { const float* sp = INP(I_SCONV) + ((size_t)((m - TP) >> 2) * 2 + s) * D + c0; const f32x4 a = *(const f32x4*)sp, b = *(const f32x4*)(sp + 4); vm2[0] = a[0]; vm2[1] = a[1]; vm2[2] = a[2]; vm2[3] = a[3]; vm2[4] = b[0]; vm2[5] = b[1]; vm2[6] = b[2]; vm2[7] = b[3]; }
                        else {
#pragma unroll
                            for (int i = 0; i < 8; ++i) vm2[i] = 0.f; }
                        float vc[8], bg[8], w0[8], w1[8], w2[8];
                        vc[0] = bflo(v0.x); vc[1] = bfhi(v0.x); vc[2] = bflo(v0.y); vc[3] = bfhi(v0.y); vc[4] = bflo(v0.z); vc[5] = bfhi(v0.z); vc[6] = bflo(v0.w); vc[7] = bfhi(v0.w);
                        bg[0] = bflo(bw.x); bg[1] = bfhi(bw.x); bg[2] = bflo(bw.y); bg[3] = bfhi(bw.y); bg[4] = bflo(bw.z); bg[5] = bfhi(bw.z); bg[6] = bflo(bw.w); bg[7] = bfhi(bw.w);
                        { const f32x4 a = *(const f32x4*)(cw + c0), b = *(const f32x4*)(cw + c0 + 4); w0[0] = a[0]; w0[1] = a[1]; w0[2] = a[2]; w0[3] = a[3]; w0[4] = b[0]; w0[5] = b[1]; w0[6] = b[2]; w0[7] = b[3]; }
                        { const f32x4 a = *(const f32x4*)(cw + D + c0), b = *(const f32x4*)(cw + D + c0 + 4); w1[0] = a[0]; w1[1] = a[1]; w1[2] = a[2]; w1[3] = a[3]; w1[4] = b[0]; w1[5] = b[1]; w1[6] = b[2]; w1[7] = b[3]; }
                        { const f32x4 a = *(const f32x4*)(cw + 2 * D + c0), b = *(const f32x4*)(cw + 2 * D + c0 + 4); w2[0] = a[0]; w2[1] = a[1]; w2[2] = a[2]; w2[3] = a[3]; w2[4] = b[0]; w2[5] = b[1]; w2[6] = b[2]; w2[7] = b[3]; }
                        float r[8];
#pragma unroll
                        for (int i = 0; i < 8; ++i) r[i] = bg[i] * (w0[i] * vm2[i] + w1[i] * vm1[i] + w2[i] * vc[i]);
                        v4u ow; ow.x = pk2(r[0], r[1]); ow.y = pk2(r[2], r[3]); ow.z = pk2(r[4], r[5]); ow.w = pk2(r[6], r[7]);
                        *(v4u*)(ZB + (size_t)m * D + c0) = ow; }
                }
            }
            SEAM(10);
            if (IN(11)) { PH_LOCALS
                { EpiRes E{HB, SSQB, INP(I_NMEM) + D, INP(I_NMIX) + D, RROWB}; GEMM_PHASE(EpiRes, ZB, R_WOUT, TP, 1024, E); }
                { SkArgs sa{}; sa.A = ZB; sa.W = WALL + (size_t)R_WOUT * D; sa.hbo = HB; sa.ssq = SSQB; sa.gnext = INP(I_NMEM) + D; sa.gprev = INP(I_NMIX) + D; sa.rprev = RROWB;
#pragma unroll 1
                  for (int tk = bx; tk < 16 * 16; tk += G) skinny_tile<SK_RES>(sa, SK_RB(tk), SK_CB(tk), (LAS float*)(L + RING_OFF), tid); }
            }
            SEAM(11);
        }
        const int ns_q = layer == 0 ? 32 : 16;
        if (IN(pb + 0)) { PH_LOCALS
            { EpiB16 E{QB, D, SSQB, ns_q}; for (int rep_ = 0; rep_ < REP_GEMM; ++rep_) GEMM_PHASE(EpiB16, HB, R_Q + layer * 1024, TP, 1024, E); }
            { SkArgs sa{}; sa.A = HB; sa.W = WALL + (size_t)(R_Q + layer * 1024) * D; sa.ssq = SSQB; sa.nslots = ns_q; sa.O = QB; sa.ldc = D;
for (int rep_ = 0; rep_ < REP_SK; ++rep_)
#pragma unroll 1
              for (int tk = bx; tk < 16 * 16; tk += G) skinny_tile<SK_B16>(sa, SK_RB(tk), SK_CB(tk), (LAS float*)(L + RING_OFF), tid); }
        }
        SEAM(pb + 0);
        if (IN(pb + 1)) { PH_LOCALS
          for (int rep_ = 0; rep_ < REP_ATTN; ++rep_) {
            const bf16* KBl = KB + (size_t)layer * MROWS * D; const bf16* VTl = VT + (size_t)layer * NB * NH * HD * MEMT;
#pragma unroll 1
            for (int pass = 0; pass < 2; ++pass) {
              if ((pass ^ (bx & 1)) == 0) {
#pragma unroll 1
                for (int tk = bx; tk < NB * NH * (SEQ / 256); tk += G) { const int rb = (tk >> 3) & 7, bh = 4 * (tk & 7) + (tk >> 6);        attn_prompt_wg(QB, KBl, VTl, ZB, bh >> 2, bh & 3, rb * 256, L + RING_OFF, opq_i(wave0) * 64 + opq_v(LANE_ID())); }
              } else {
#pragma unroll 1
                for (int tk = bx; tk < DB * NH; tk += G) attn_sample_task(QB, INP(I_CK), INP(I_CV), ZB, layer, tk >> 2, tk & 3, (LAS float*)(L + RING_OFF), opq_i(wave0) * 64 + opq_v(LANE_ID()));
              }
            }
          }
        }
        SEAM(pb + 1);
        if (IN(pb + 2)) { PH_LOCALS
            { EpiRes E{HB, SSQB, INP(I_NFFN) + layer * D, INP(I_NMEM) + layer * D, nullptr}; GEMM_PHASE(EpiRes, ZB, R_O + layer * 1024, TP, 1024, E); }
            { SkArgs sa{}; sa.A = ZB; sa.W = WALL + (size_t)(R_O + layer * 1024) * D; sa.hbo = HB; sa.ssq = SSQB; sa.gnext = INP(I_NFFN) + layer * D; sa.gprev = INP(I_NMEM) + layer * D;
#pragma unroll 1
              for (int tk = bx; tk < 16 * 16; tk += G) skinny_tile<SK_RES>(sa, SK_RB(tk), SK_CB(tk), (LAS float*)(L + RING_OFF), tid); }
        }
        SEAM(pb + 2);
        if (IN(pb + 3)) { PH_LOCALS
            { EpiB16 E{QP, 2048, SSQB, 16}; for (int rep_ = 0; rep_ < REP_GEMM; ++rep_) GEMM_PHASE(EpiB16, HB, R_PQ + layer * 2048, TP, 2048, E); }
            { SkArgs sa{}; sa.A = HB; sa.W = WALL + (size_t)(R_PQ + layer * 2048) * D; sa.ssq = SSQB; sa.nslots = 16; sa.O = QP; sa.ldc = 2048;
for (int rep_ = 0; rep_ < REP_SK; ++rep_)
#pragma unroll 1
              for (int tk = bx; tk < 16 * 32; tk += G) skinny_tile<SK_B16>(sa, SK_RB(tk), SK_CB(tk), (LAS float*)(L + RING_OFF), tid); }
        }
        SEAM(pb + 3);
        if (IN(pb + 4)) { PH_LOCALS
          peer_stage_keys(KEYS + (size_t)layer * 2 * 128 * 128, L + RING_OFF, tid);
          __syncthreads();
          LAS int* ti = (LAS int*)(L + RING_OFF + PSEL_KEYS + wave * PSEL_TI);
          for (int rep_ = 0; rep_ < REP_PSEL; ++rep_)
            if (G == 256) {
              bf16x8 qc[8]; const int nt_ = (wave == 0) ? 5 : 4;
#define SEL_ROW0(J) ((J) < 4 ? 64 * bx + 16 * (J) : TP + 2 * bx)
#define SEL_HEAD(J) ((J) < 4 ? wave : -1)
              peer_select_loadq(QP, SEL_ROW0(0), SEL_HEAD(0), lane, qc);
#pragma unroll 1
              for (int j = 0; j < nt_; ++j) { bf16x8 qn[8]; const int jn = j + 1 < nt_ ? j + 1 : j;
                  peer_select_loadq(QP, SEL_ROW0(jn), SEL_HEAD(jn), lane, qn);
                  peer_select_task(qc, L + RING_OFF, EID, EG, SEL_ROW0(j), SEL_HEAD(j), ti, lane);
#pragma unroll
                  for (int i = 0; i < 8; ++i) qc[i] = qn[i]; }
#undef SEL_ROW0
#undef SEL_HEAD
            } else
            { bf16x8 qc[8]; int tk = wave * G + bx;
              peer_select_loadq(QP, (tk >> 3) * 16, tk & 7, lane, qc);
#pragma unroll 1
              for (; tk < (T / 16) * 8; tk += NGW) { bf16x8 qn[8]; const int tn = tk + NGW < (T / 16) * 8 ? tk + NGW : tk;
                  peer_select_loadq(QP, (tn >> 3) * 16, tn & 7, lane, qn);
                  peer_select_task(qc, L + RING_OFF, EID, EG, (tk >> 3) * 16, tk & 7, ti, lane);
#pragma unroll
                  for (int i = 0; i < 8; ++i) qc[i] = qn[i]; } }
        }
        if (opq_i((int)gridDim.x) == 256) { if (IN(pb + 4) && IN(pb + 5)) { __builtin_amdgcn_fence(__ATOMIC_RELEASE, "workgroup"); asm volatile("s_waitcnt vmcnt(0)" ::: "memory"); __syncthreads(); __builtin_amdgcn_fence(__ATOMIC_ACQUIRE, "workgroup"); } PP_STAMP(pb + 4); }
        else SEAM(pb + 4);
        if (IN(pb + 5)) { PH_LOCALS
            if (layer == 0) { PS_STAMP(30); if (G == 256) {
                    const int tm0 = 64 * bx + (wave >= 4 ? 7 * (wave - 4) : 28 + 9 * wave);
                    peer_gather_wave6<false>(tm0, 1, tm0 + 7, opq_v(LANE_ID()), ws, 0, YOUT, INP(I_NFFN), INP(I_NMIX) + D, L + RING_OFF + wave * 8192);
                    if (wave < 4) peer_gather_wave6<false>(tm0 + 7, 1, tm0 + 9, opq_v(LANE_ID()), ws, 0, YOUT, INP(I_NFFN), INP(I_NMIX) + D, L + RING_OFF + wave * 8192); }
                else for (int m0 = gw; m0 < TP; m0 += 8 * NGW) peer_gather_wave6<false>(m0, NGW, TP, opq_v(LANE_ID()), ws, 0, YOUT, INP(I_NFFN), INP(I_NMIX) + D, L + RING_OFF + wave * 8192);
                PS_STAMP(31);
                const int tidb = opq_i(wave0) * 64 + opq_v(LANE_ID());
#pragma unroll 1
                for (int tp = opq_i((int)blockIdx.x); tp < TS / 2; tp += G) peer_gather_wg2<false>(TP + 2 * tp, tidb, ws, 0, YOUT, INP(I_NFFN), INP(I_NMIX) + D, (LAS float*)(L + RING_OFF + 65536), opq_i((int)gridDim.x) == 256); PS_STAMP(32); }
            else { if (G == 256) { const int tm0 = 64 * bx + (wave >= 4 ? 7 * (wave - 4) : 28 + 9 * wave);
                    peer_gather_wave6<true>(tm0, 1, tm0 + 7, opq_v(LANE_ID()), ws, 1, YOUT, INP(I_NFFN) + D, INP(I_NFIN), L + RING_OFF + wave * 8192);
                    if (wave < 4) peer_gather_wave6<true>(tm0 + 7, 1, tm0 + 9, opq_v(LANE_ID()), ws, 1, YOUT, INP(I_NFFN) + D, INP(I_NFIN), L + RING_OFF + wave * 8192); }
                else for (int m0 = gw; m0 < TP; m0 += 8 * NGW) peer_gather_wave6<true>(m0, NGW, TP, opq_v(LANE_ID()), ws, 1, YOUT, INP(I_NFFN) + D, INP(I_NFIN), L + RING_OFF + wave * 8192);
                const int tidb = opq_i(wave0) * 64 + opq_v(LANE_ID());
#pragma unroll 1
                for (int tp = opq_i((int)blockIdx.x); tp < TS / 2; tp += G) peer_gather_wg2<true>(TP + 2 * tp, tidb, ws, 1, YOUT, INP(I_NFFN) + D, INP(I_NFIN), (LAS float*)(L + RING_OFF + 65536), opq_i((int)gridDim.x) == 256); }
        }
        if (layer == 0) SEAM(pb + 5);
    }
#ifdef PROBE_SUB
#ifndef PROBE_BLK
#define PROBE_BLK 0
#endif
#ifndef PROBE_WAVE
#define PROBE_WAVE 0
#endif
    if (blockIdx.x == PROBE_BLK && wave0 == PROBE_WAVE && mk_lane_id() == 0) { const unsigned long long t0_ = __builtin_amdgcn_s_memrealtime(); while (__builtin_amdgcn_s_memrealtime() - t0_ < 4ull * ps_dt) __builtin_amdgcn_s_sleep(8); }
#endif
#ifdef PROBE_PHASE
    PP_STAMP(17);
    if (blockIdx.x == 0 && wave0 == 0 && mk_lane_id() == 0) { const unsigned long long t0_ = __builtin_amdgcn_s_memrealtime(); while (__builtin_amdgcn_s_memrealtime() - t0_ < 4ull * pp_dt) __builtin_amdgcn_s_sleep(8); }
#endif
#undef IN
#undef SEAM
#undef GEMM_PHASE
}

#ifndef MK_PER_PHASE
#define MK_PER_PHASE 0
#endif
extern "C" void kernel_launch(void* const* d_in, const int* in_sizes, int n_in, void* d_out, int out_size, void* d_ws, size_t ws_size, hipStream_t stream) {
    static int grid = 0;
    if (grid == 0) {
        if (n_in != N_IN || out_size != (int)O_END || ws_size < WS_END) { fprintf(stderr, "kernel_launch: unexpected shapes: n_in %d out %d ws %zu; nothing launched\n", n_in, out_size, ws_size); grid = -1; return; }
        int dev = 0, cus = 0, per_cu = 0;
        if (hipGetDevice(&dev) != hipSuccess || hipDeviceGetAttribute(&cus, hipDeviceAttributeMultiprocessorCount, dev) != hipSuccess) { fprintf(stderr, "kernel_launch: device query failed\n"); grid = -1; return; }
        if (hipFuncSetAttribute((const void*)mk_fwd, hipFuncAttributeMaxDynamicSharedMemorySize, LDS_BYTES) != hipSuccess) { fprintf(stderr, "kernel_launch: hipFuncSetAttribute failed\n"); grid = -1; return; }
        if (hipOccupancyMaxActiveBlocksPerMultiprocessor(&per_cu, (const void*)mk_fwd, NWAVES * 64, LDS_BYTES) != hipSuccess || per_cu < 1) { fprintf(stderr, "kernel_launch: occupancy query says %d blocks per CU\n", per_cu); per_cu = 1; }
        (void)hipGetLastError();
        grid = cus;
        if (grid > 256) grid = 256;
    }
    if (grid < 0) return;
    if (hipMemsetAsync((char*)d_ws + WS_CTL, 0, CTL_ZERO_BYTES, stream) != hipSuccess) { fprintf(stderr, "kernel_launch: memset failed\n"); return; }
    Args a{};
    for (int i = 0; i < N_IN; ++i) a.in[i] = (const float*)d_in[i];
    a.out = (float*)d_out; a.ws = (unsigned char*)d_ws;
#if MK_PER_PHASE
    for (int p = 0; p < N_PHASES; ++p) { a.ph_lo = p; a.ph_hi = p + 1; hipLaunchKernelGGL(mk_fwd, dim3(grid), dim3(NWAVES * 64), LDS_BYTES, stream, a); }
#else
    a.ph_lo = 0; a.ph_hi = N_PHASES;
    hipLaunchKernelGGL(mk_fwd, dim3(grid), dim3(NWAVES * 64), LDS_BYTES, stream, a);
#endif
    const hipError_t le = hipPeekAtLastError();
    if (le != hipSuccess) fprintf(stderr, "kernel_launch: launch failed: %s\n", hipGetErrorName(le));
}
```
